# Optimizing an MI355X kernel written in HIP

```python
import math
import jax
import jax.numpy as jnp
from jax import lax
import numpy as np

D_MODEL = 2048
BATCH = 1
SEQ = 16384
DEPTH = 4
DEC_BATCH = 4
DEC_SEQ = 2048
PAST_LEN = 128

N_BRANCH = 4
W_BR = D_MODEL // 2
LRU_BLOCKS = 8
LRU_BS = W_BR // LRU_BLOCKS
CONV_W = 4
CONV_PAD = (2, 1)
LRU_C = 8.0
RWKV_HEAD = 64
RWKV_H = W_BR // RWKV_HEAD
RWKV_LORA_W = 64
RWKV_LORA_A = 64
RWKV_LN_EPS = RWKV_HEAD * 1e-5
RET_H = 4
RET_DK = W_BR // 2 // RET_H
RET_DV = W_BR // RET_H
RET_CHUNK = 128
RET_GN_EPS = 1e-5
ROPE_BASE = 10000.0
S5_P = 16
S5_G = W_BR // S5_P
S5_N = 64
LAM_RE_MAX = -1e-4
NORM_EPS = 1e-6

SPLITS = (
    W_BR, W_BR,
    W_BR, W_BR, W_BR, RWKV_LORA_W, RWKV_LORA_W, RWKV_LORA_A, W_BR,
    RET_H * RET_DK, RET_H * RET_DK, W_BR, W_BR,
    W_BR, W_BR,
    N_BRANCH * D_MODEL,
)
N_IN = sum(SPLITS)

kernel_name = 'hybrid_bidir_lru_rwkv7_retnet_s5_encoder'


def _rmsnorm(x, g):
    xf = x.astype(jnp.float32)
    y = xf * lax.rsqrt(jnp.mean(xf * xf, axis=-1, keepdims=True) + NORM_EPS)
    return (y * g.astype(jnp.float32)).astype(x.dtype)


def _head_norm(y, eps):
    mean = jnp.mean(y, axis=-1, keepdims=True)
    yc = y - mean
    var = jnp.mean(yc * yc, axis=-1, keepdims=True)
    return yc * lax.rsqrt(var + eps)


def _split_cols(p):
    outs = []
    start = 0
    for n in SPLITS:
        outs.append(p[..., start:start + n])
        start += n
    return outs


def _linear_scan_combine(e1, e2):
    a1, b1 = e1
    a2, b2 = e2
    return a1 * a2, a2 * b1 + b2


def _centred_shift(x):
    prev = jnp.pad(x[:, :-1], ((0, 0), (1, 0), (0, 0)))
    nxt = jnp.pad(x[:, 1:], ((0, 0), (0, 1), (0, 0)))
    return 0.5 * (prev + nxt)


def _rotary(x, pos):
    half = x.shape[-1] // 2
    inv = ROPE_BASE ** (-jnp.arange(half, dtype=jnp.float32) / half)
    ang = pos[:, None] * inv[None, :]
    cos = jnp.cos(ang)[None, :, None, :]
    sin = jnp.sin(ang)[None, :, None, :]
    x1, x2 = x[..., :half], x[..., half:]
    return jnp.concatenate([x1 * cos - x2 * sin, x1 * sin + x2 * cos], axis=-1)


def _rglru_branch(xa, conv_w, conv_b, w_r, b_r, w_i, b_i, lam):
    f32 = jnp.float32
    bsz, seqlen, _ = xa.shape
    xc = lax.conv_general_dilated(
        xa.astype(f32), conv_w.astype(f32)[:, None, :], window_strides=(1,),
        padding=[CONV_PAD], dimension_numbers=('NWC', 'WIO', 'NWC'),
        feature_group_count=W_BR) + conv_b.astype(f32)
    xblk = xc.reshape(bsz, seqlen, LRU_BLOCKS, LRU_BS)
    t = jnp.arange(seqlen)
    h_sum = jnp.zeros_like(xc)
    for d in range(2):
        r = jax.nn.sigmoid(jnp.einsum('blhi,hij->blhj', xblk, w_r[d].astype(f32)).reshape(bsz, seqlen, W_BR) + b_r[d].astype(f32))
        i = jax.nn.sigmoid(jnp.einsum('blhi,hij->blhj', xblk, w_i[d].astype(f32)).reshape(bsz, seqlen, W_BR) + b_i[d].astype(f32))
        log_a = -LRU_C * r * jax.nn.softplus(-lam[d].astype(f32))
        a = jnp.exp(log_a)
        mult = jnp.sqrt(-jnp.expm1(2.0 * log_a))
        first = 0 if d == 0 else seqlen - 1
        mult = jnp.where((t == first)[None, :, None], 1.0, mult)
        _, h = lax.associative_scan(_linear_scan_combine, (a, mult * i * xc), reverse=(d == 1), axis=1)
        h_sum = h_sum + h
    return h_sum


def _rwkv7_scan(r, w, k, v, a_vec, b_vec, reverse):
    bsz = r.shape[0]

    def step(state, inp):
        r_t, w_t, k_t, v_t, a_t, b_t = inp
        sa = jnp.einsum('bhvk,bhk->bhv', state, a_t)
        state = state * w_t[:, :, None, :] + sa[..., None] * b_t[:, :, None, :] + v_t[..., None] * k_t[:, :, None, :]
        return state, jnp.einsum('bhvk,bhk->bhv', state, r_t)

    xs = tuple(jnp.moveaxis(t, 1, 0) for t in (r, w, k, v, a_vec, b_vec))
    s0 = jnp.zeros((bsz, RWKV_H, RWKV_HEAD, RWKV_HEAD), jnp.float32)
    _, y = lax.scan(step, s0, xs, reverse=reverse)
    return jnp.moveaxis(y, 0, 1)


def _rwkv7_branch(r, k, v, wd_f, wd_b, ad, mu, w0, w2, a0, a2, k_k, k_a, r_k, lnx_g, lnx_b):
    f32 = jnp.float32
    bsz, seqlen, _ = r.shape
    mu = mu.astype(f32)
    r, k, v = [t + mu[j] * (_centred_shift(t) - t) for j, t in enumerate((r.astype(f32), k.astype(f32), v.astype(f32)))]
    a = jax.nn.sigmoid(a0.astype(f32) + ad.astype(f32) @ a2.astype(f32))
    heads = lambda t: t.reshape(bsz, seqlen, RWKV_H, RWKV_HEAD)
    kk = heads(k * k_k.astype(f32))
    kk = kk / jnp.maximum(jnp.sqrt(jnp.sum(kk * kk, axis=-1, keepdims=True)), 1e-12)
    k = k * (1.0 + (a - 1.0) * k_a.astype(f32))
    rh, kh, vh, ah = heads(r), heads(k), heads(v), heads(a)
    a_vec = -kk
    b_vec = kk * ah
    y = jnp.zeros_like(vh)
    for d, wd in enumerate((wd_f, wd_b)):
        w_log = -jax.nn.softplus(-(w0[d].astype(f32) + jnp.tanh(wd.astype(f32)) @ w2[d].astype(f32))) - 0.5
        decay = heads(jnp.exp(-jnp.exp(w_log)))
        y = y + _rwkv7_scan(rh, decay, kh, vh, a_vec, b_vec, reverse=(d == 1))
    y = _head_norm(y, RWKV_LN_EPS) * lnx_g.astype(f32).reshape(RWKV_H, RWKV_HEAD) + lnx_b.astype(f32).reshape(RWKV_H, RWKV_HEAD)
    bonus = jnp.sum(rh * kh * r_k.astype(f32), axis=-1, keepdims=True) * vh
    return (y + bonus).reshape(bsz, seqlen, W_BR)


def _retention_branch(q, k, v, gn_g):
    f32 = jnp.float32
    bsz, seqlen, _ = q.shape
    n_chunk = seqlen // RET_CHUNK
    pos_all = jnp.arange(seqlen, dtype=f32)
    q = _rotary(q.astype(f32).reshape(bsz, seqlen, RET_H, RET_DK), pos_all)
    k = _rotary(k.astype(f32).reshape(bsz, seqlen, RET_H, RET_DK), pos_all) * (RET_DK ** -0.5)
    v = v.astype(f32).reshape(bsz, seqlen, RET_H, RET_DV)
    log_g = jnp.log(1.0 - 2.0 ** (-5.0 - jnp.arange(RET_H, dtype=f32)))
    qc = q.reshape(bsz, n_chunk, RET_CHUNK, RET_H, RET_DK)
    kc = k.reshape(bsz, n_chunk, RET_CHUNK, RET_H, RET_DK)
    vc = v.reshape(bsz, n_chunk, RET_CHUNK, RET_H, RET_DV)
    pos = jnp.arange(RET_CHUNK, dtype=f32)
    intra = jnp.exp(log_g[:, None, None] * jnp.abs(pos[:, None] - pos[None, :]))
    s = jnp.einsum('bnihd,bnjhd->bnhij', qc, kc) * intra
    o = jnp.einsum('bnhij,bnjhe->bnihe', s, vc)
    dec_end = jnp.exp(log_g[:, None] * (RET_CHUNK - 1.0 - pos)[None, :])
    dec_start = jnp.exp(log_g[:, None] * pos[None, :])
    kv_f = jnp.einsum('bnjhd,bnjhe,hj->nbhde', kc, vc, dec_end)
    kv_b = jnp.einsum('bnjhd,bnjhe,hj->nbhde', kc, vc, dec_start)
    g_chunk = jnp.exp(log_g * RET_CHUNK)[None, :, None, None]

    def chunk_step(state, kv):
        return g_chunk * state + kv, state

    s0 = jnp.zeros((bsz, RET_H, RET_DK, RET_DV), f32)
    _, s_prev = lax.scan(chunk_step, s0, kv_f)
    _, s_next = lax.scan(chunk_step, s0, kv_b, reverse=True)
    dq_f = jnp.exp(log_g[None, :] * (pos[:, None] + 1.0))[:, :, None]
    dq_b = jnp.exp(log_g[None, :] * (RET_CHUNK - pos[:, None]))[:, :, None]
    o = o + jnp.einsum('bnihd,nbhde->bnihe', qc * dq_f, s_prev) + jnp.einsum('bnihd,nbhde->bnihe', qc * dq_b, s_next)
    o = o.reshape(bsz, seqlen, RET_H, RET_DV)
    o = _head_norm(o, RET_GN_EPS) * gn_g.astype(f32).reshape(RET_H, RET_DV)
    return o.reshape(bsz, seqlen, W_BR)


def _s5_branch(u, lam_re, lam_im, log_step, b_re, b_im, c_re, c_im, d_skip, glu_w, glu_b):
    f32 = jnp.float32
    bsz, seqlen, _ = u.shape
    uf = u.astype(f32)
    b_mat = lax.complex(b_re.astype(f32), b_im.astype(f32))
    c_mat = lax.complex(c_re.astype(f32), c_im.astype(f32))
    bu = jnp.einsum('blgp,gnp->blgn', uf.reshape(bsz, seqlen, S5_G, S5_P).astype(jnp.complex64), b_mat)
    state = jnp.zeros(bu.shape, jnp.complex64)
    for d in range(2):
        lam = lax.complex(jnp.minimum(lam_re[d].astype(f32), LAM_RE_MAX), lam_im[d].astype(f32))
        step = jnp.exp(log_step[d].astype(f32))[:, None]
        lam_bar = jnp.exp(lam * step)
        b_gain = (lam_bar - 1.0) / lam
        a = jnp.broadcast_to(lam_bar, bu.shape)
        _, xs = lax.associative_scan(_linear_scan_combine, (a, b_gain * bu), reverse=(d == 1), axis=1)
        state = state + xs
    y = jnp.einsum('blgn,gpn->blgp', state, c_mat).real.reshape(bsz, seqlen, W_BR) + d_skip.astype(f32) * uf
    y = jax.nn.gelu(y)
    return y * jax.nn.sigmoid(y @ glu_w.astype(f32) + glu_b.astype(f32))


def _layer(x, norm_g, w_in, lru_conv_w, lru_conv_b, lru_w_r, lru_b_r, lru_w_i, lru_b_i, lru_lambda,
           rwkv_mu, rwkv_w0, rwkv_w2, rwkv_a0, rwkv_a2, rwkv_k_k, rwkv_k_a, rwkv_r_k, rwkv_lnx_g, rwkv_lnx_b,
           ret_gn_g, s5_lam_re, s5_lam_im, s5_log_step, s5_b_re, s5_b_im, s5_c_re, s5_c_im, s5_d, s5_glu_w,
           s5_glu_b, w_branch, w_out):
    f32 = jnp.float32
    dt = x.dtype
    bsz, seqlen, _ = x.shape
    h = _rmsnorm(x, norm_g)
    proj = h @ w_in
    (p_lru_x, p_lru_z, p_rw_r, p_rw_k, p_rw_v, p_rw_wdf, p_rw_wdb, p_rw_ad, p_rw_z,
     p_ret_q, p_ret_k, p_ret_v, p_ret_z, p_s5_u, p_s5_z, p_gates) = _split_cols(proj)
    silu = lambda z: jax.nn.silu(z.astype(f32))
    y_a = _rglru_branch(p_lru_x, lru_conv_w, lru_conv_b, lru_w_r, lru_b_r, lru_w_i, lru_b_i, lru_lambda) * silu(p_lru_z)
    y_b = _rwkv7_branch(p_rw_r, p_rw_k, p_rw_v, p_rw_wdf, p_rw_wdb, p_rw_ad, rwkv_mu, rwkv_w0, rwkv_w2, rwkv_a0,
                        rwkv_a2, rwkv_k_k, rwkv_k_a, rwkv_r_k, rwkv_lnx_g, rwkv_lnx_b) * silu(p_rw_z)
    y_c = _retention_branch(p_ret_q, p_ret_k, p_ret_v, ret_gn_g) * silu(p_ret_z)
    y_d = _s5_branch(p_s5_u, s5_lam_re, s5_lam_im, s5_log_step, s5_b_re, s5_b_im, s5_c_re, s5_c_im, s5_d,
                     s5_glu_w, s5_glu_b) * silu(p_s5_z)
    gates = jax.nn.sigmoid(p_gates.astype(f32)).reshape(bsz, seqlen, N_BRANCH, D_MODEL)
    merged = jnp.zeros((bsz, seqlen, D_MODEL), f32)
    for i, yb in enumerate((y_a, y_b, y_c, y_d)):
        merged = merged + gates[:, :, i] * (yb.astype(dt) @ w_branch[i]).astype(f32)
    out = merged.astype(dt) @ w_out
    return x + out


def _trunk(x, norm_g, w_in, lru_conv_w, lru_conv_b, lru_w_r, lru_b_r, lru_w_i, lru_b_i, lru_lambda,
           rwkv_mu, rwkv_w0, rwkv_w2, rwkv_a0, rwkv_a2, rwkv_k_k, rwkv_k_a, rwkv_r_k, rwkv_lnx_g, rwkv_lnx_b,
           ret_gn_g, s5_lam_re, s5_lam_im, s5_log_step, s5_b_re, s5_b_im, s5_c_re, s5_c_im, s5_d, s5_glu_w,
           s5_glu_b, w_branch, w_out, final_g):
    for l in range(DEPTH):
        x = _layer(x, norm_g[l], w_in[l], lru_conv_w[l], lru_conv_b[l], lru_w_r[l], lru_b_r[l], lru_w_i[l],
                   lru_b_i[l], lru_lambda[l], rwkv_mu[l], rwkv_w0[l], rwkv_w2[l], rwkv_a0[l], rwkv_a2[l],
                   rwkv_k_k[l], rwkv_k_a[l], rwkv_r_k[l], rwkv_lnx_g[l], rwkv_lnx_b[l], ret_gn_g[l],
                   s5_lam_re[l], s5_lam_im[l], s5_log_step[l], s5_b_re[l], s5_b_im[l], s5_c_re[l], s5_c_im[l],
                   s5_d[l], s5_glu_w[l], s5_glu_b[l], w_branch[l], w_out[l])
    return _rmsnorm(x, final_g)


def setup_inputs(seed: int = 0) -> dict:
    key = jax.random.key(seed)
    ks = jax.random.split(key, 40)
    f32 = jnp.float32
    nrm = lambda k, shape, scale: jax.random.normal(k, shape, f32) * scale
    a0 = jax.random.uniform(ks[9], (DEPTH, 2, W_BR), f32, minval=0.9, maxval=0.999)
    base = a0 ** (1.0 / LRU_C)
    lru_lambda = jnp.log(base) - jnp.log1p(-base)
    ratio = jnp.arange(W_BR, dtype=f32) / (W_BR - 1)
    w0_base = -7.0 + 5.0 * ratio ** 0.85 + 0.5
    return {
        'x_prompt': nrm(ks[0], (BATCH, SEQ, D_MODEL), 1.0),
        'x_sample': nrm(ks[1], (DEC_BATCH, DEC_SEQ, D_MODEL), 1.0),
        'norm_g': 1.0 + nrm(ks[2], (DEPTH, D_MODEL), 0.01),
        'w_in': nrm(ks[3], (DEPTH, D_MODEL, N_IN), D_MODEL ** -0.5),
        'lru_conv_w': nrm(ks[4], (DEPTH, CONV_W, W_BR), CONV_W ** -0.5),
        'lru_conv_b': nrm(ks[5], (DEPTH, W_BR), 0.01),
        'lru_w_r': nrm(ks[6], (DEPTH, 2, LRU_BLOCKS, LRU_BS, LRU_BS), LRU_BS ** -0.5),
        'lru_b_r': nrm(ks[7], (DEPTH, 2, W_BR), 0.01),
        'lru_w_i': nrm(ks[8], (DEPTH, 2, LRU_BLOCKS, LRU_BS, LRU_BS), LRU_BS ** -0.5),
        'lru_b_i': nrm(ks[10], (DEPTH, 2, W_BR), 0.01),
        'lru_lambda': lru_lambda,
        'rwkv_mu': jax.random.uniform(ks[11], (DEPTH, 3, W_BR), f32, minval=0.2, maxval=0.8),
        'rwkv_w0': w0_base + nrm(ks[12], (DEPTH, 2, W_BR), 0.1),
        'rwkv_w2': nrm(ks[13], (DEPTH, 2, RWKV_LORA_W, W_BR), 0.1 * RWKV_LORA_W ** -0.5),
        'rwkv_a0': nrm(ks[14], (DEPTH, W_BR), 0.1),
        'rwkv_a2': nrm(ks[15], (DEPTH, RWKV_LORA_A, W_BR), 0.1 * RWKV_LORA_A ** -0.5),
        'rwkv_k_k': 0.85 + nrm(ks[16], (DEPTH, W_BR), 0.05),
        'rwkv_k_a': 1.0 + nrm(ks[17], (DEPTH, W_BR), 0.05),
        'rwkv_r_k': -0.04 + nrm(ks[18], (DEPTH, RWKV_H, RWKV_HEAD), 0.1),
        'rwkv_lnx_g': 1.0 + nrm(ks[19], (DEPTH, W_BR), 0.01),
        'rwkv_lnx_b': nrm(ks[20], (DEPTH, W_BR), 0.01),
        'ret_gn_g': 1.0 + nrm(ks[21], (DEPTH, W_BR), 0.01),
        's5_lam_re': -0.5 + nrm(ks[22], (DEPTH, 2, S5_G, S5_N), 0.01),
        's5_lam_im': math.pi * jnp.arange(S5_N, dtype=f32) + nrm(ks[23], (DEPTH, 2, S5_G, S5_N), 0.01),
        's5_log_step': jax.random.uniform(ks[24], (DEPTH, 2, S5_G), f32, minval=math.log(0.001), maxval=math.log(0.1)),
        's5_b_re': nrm(ks[25], (DEPTH, S5_G, S5_N, S5_P), (2.0 * S5_P) ** -0.5),
        's5_b_im': nrm(ks[26], (DEPTH, S5_G, S5_N, S5_P), (2.0 * S5_P) ** -0.5),
        's5_c_re': nrm(ks[27], (DEPTH, S5_G, S5_P, S5_N), (2.0 * S5_N) ** -0.5),
        's5_c_im': nrm(ks[28], (DEPTH, S5_G, S5_P, S5_N), (2.0 * S5_N) ** -0.5),
        's5_d': nrm(ks[29], (DEPTH, W_BR), 1.0),
        's5_glu_w': nrm(ks[30], (DEPTH, W_BR, W_BR), W_BR ** -0.5),
        's5_glu_b': nrm(ks[31], (DEPTH, W_BR), 0.01),
        'w_branch': nrm(ks[32], (DEPTH, N_BRANCH, W_BR, D_MODEL), W_BR ** -0.5),
        'w_out': nrm(ks[33], (DEPTH, D_MODEL, D_MODEL), D_MODEL ** -0.5),
        'final_g': 1.0 + nrm(ks[34], (D_MODEL,), 0.01),
    }


def reference(x_prompt, x_sample, norm_g, w_in, lru_conv_w, lru_conv_b, lru_w_r, lru_b_r, lru_w_i, lru_b_i,
              lru_lambda, rwkv_mu, rwkv_w0, rwkv_w2, rwkv_a0, rwkv_a2, rwkv_k_k, rwkv_k_a, rwkv_r_k, rwkv_lnx_g,
              rwkv_lnx_b, ret_gn_g, s5_lam_re, s5_lam_im, s5_log_step, s5_b_re, s5_b_im, s5_c_re, s5_c_im, s5_d,
              s5_glu_w, s5_glu_b, w_branch, w_out, final_g):
    weights = (norm_g, w_in, lru_conv_w, lru_conv_b, lru_w_r, lru_b_r, lru_w_i, lru_b_i, lru_lambda,
               rwkv_mu, rwkv_w0, rwkv_w2, rwkv_a0, rwkv_a2, rwkv_k_k, rwkv_k_a, rwkv_r_k, rwkv_lnx_g, rwkv_lnx_b,
               ret_gn_g, s5_lam_re, s5_lam_im, s5_log_step, s5_b_re, s5_b_im, s5_c_re, s5_c_im, s5_d, s5_glu_w,
               s5_glu_b, w_branch, w_out, final_g)
    y_prompt = _trunk(x_prompt, *weights)
    y_sample = _trunk(x_sample, *weights)
    return (y_prompt, y_sample)
```

```cpp
#include <hip/hip_runtime.h>
#include <cstdio>
#include <cstdint>

#ifndef MK_ONE_LAUNCH
#define MK_ONE_LAUNCH 1
#endif

#define LAS __attribute__((address_space(3)))
#define GAS __attribute__((address_space(1)))
typedef unsigned short bf16;
typedef short bf16x8 __attribute__((ext_vector_type(8)));
typedef float f32x4 __attribute__((ext_vector_type(4)));
typedef float f32x2 __attribute__((ext_vector_type(2)));
typedef unsigned u32x4 __attribute__((ext_vector_type(4)));
typedef unsigned u32x2 __attribute__((ext_vector_type(2)));

constexpr int T = 24576, TP = 16384, LS = 2048, D = 2048, WB = 1024, DEPTH = 4;
constexpr int NPJ = 11520, NIN = 19648, GOFF = 11456, NALL = 19712;
constexpr int C_LRUX = 0, C_LRUZ = 1024, C_RWR = 2048, C_RWK = 3072, C_RWV = 4096, C_WDF = 5120, C_WDB = 5184, C_AD = 5248, C_RWZ = 5312,
              C_RQ = 6336, C_RK = 6848, C_RV = 7360, C_RZ = 8384, C_SU = 9408, C_SZ = 10432;
constexpr int NCH_S5 = T / 16;
constexpr int NCH_RET = T / 128;
constexpr int NCH_LRU = T / 128;

constexpr size_t al(size_t x) { return (x + 0xFFFFFu) & ~(size_t)0xFFFFFu; }
constexpr size_t WS_CTL = 0, CTL_BYTES = 1u << 20;
constexpr size_t WS_WALLT = al(WS_CTL + CTL_BYTES);
constexpr size_t WS_LRUW  = al(WS_WALLT + (size_t)DEPTH * NALL * D * 2);
constexpr size_t WS_GLUT  = al(WS_LRUW + (size_t)DEPTH * 4096 * 256 * 2);
constexpr size_t WS_WBRT  = al(WS_GLUT + (size_t)DEPTH * 1024 * 1024 * 2);
constexpr size_t WS_WOUTT = al(WS_WBRT + (size_t)DEPTH * 2048 * 4096 * 2);
constexpr size_t WS_S5MAIN= al(WS_WOUTT + (size_t)DEPTH * 2048 * 2048 * 2);
constexpr size_t WS_S5INC = al(WS_S5MAIN + (size_t)DEPTH * 64 * 256 * 512 * 2);
constexpr size_t WS_S5TAB = al(WS_S5INC + (size_t)DEPTH * 64 * 256 * 256 * 2);
constexpr size_t WS_W2ALL = al(WS_S5TAB + (size_t)DEPTH * 2 * 64 * 64 * 33 * 8);
constexpr size_t WS_ROT   = al(WS_W2ALL + (size_t)DEPTH * 3072 * 256 * 2);
constexpr size_t WS_RSS   = al(WS_ROT + (size_t)16384 * 64 * 8);
constexpr size_t WS_RSP   = al(WS_RSS + (size_t)2 * T * 4);
constexpr size_t WS_H     = al(WS_RSP + (size_t)T * 32 * 4);
constexpr size_t WS_PROJ  = al(WS_H + (size_t)T * D * 2);
constexpr size_t WS_Y     = al(WS_PROJ + (size_t)T * NPJ * 2);
constexpr size_t WS_STP   = al(WS_Y + (size_t)T * 4096 * 2);
constexpr size_t WS_SCR   = al(WS_STP + (size_t)2 * 768 * 256 * 128 * 2);
constexpr size_t TW4 = (size_t)T * WB * 4, TW2 = (size_t)T * WB * 2;
constexpr int NCH_L32 = T / 32;
constexpr size_t SA_XC = 0, SA_LA = al(SA_XC + TW2), SA_BB = al(SA_LA + 2 * TW2), SA_PA = al(SA_BB + 2 * TW2),
                 SA_PB = al(SA_PA + (size_t)NCH_L32 * 2 * WB * 4), SA_CAR = al(SA_PB + (size_t)NCH_L32 * 2 * WB * 4), SA_END = al(SA_CAR + (size_t)NCH_L32 * 2 * WB * 4);
constexpr size_t SD_UC = 0, SD_INC = al(SD_UC + (size_t)64 * NCH_S5 * 512 * 2), SD_YG = al(SD_INC + (size_t)64 * NCH_S5 * 256 * 4), SD_END = al(SD_YG + TW2);
constexpr size_t SC_KVT = 0, SC_END = al(SC_KVT + (size_t)2 * 768 * 256 * 128 * 4);
constexpr size_t SB_R = 0, SB_KM = al(SB_R + TW2), SB_V = al(SB_KM + TW2), SB_KK = al(SB_V + TW2), SB_AG = al(SB_KK + TW2), SB_LWF = al(SB_AG + TW2), SB_LWB = al(SB_LWF + TW2),
                 SB_CH = al(SB_LWB + TW2), SB_SS = al(SB_CH + (size_t)(T / 64) * 16 * 2 * 4 * 4096 * 2), SB_END = al(SB_SS + (size_t)(T / 64) * 16 * 2 * 4096 * 2), SB_LO = SB_CH;
constexpr size_t SM_GS = 0, SM_MG = al(SM_GS + (size_t)T * 4 * D * 2), SM_END = al(SM_MG + (size_t)T * D * 2);
constexpr size_t cmax(size_t a, size_t b) { return a > b ? a : b; }
constexpr size_t SCR_BYTES = cmax(cmax(cmax(SA_END, SD_END), cmax(SC_END, SB_END)), SM_END);
constexpr size_t WS_END = WS_SCR + SCR_BYTES;
static_assert(WS_END < (size_t)2500 * 1000 * 1000, "workspace budget");

__device__ __forceinline__ float ld_agent(const float* p) { return __hip_atomic_load(p, __ATOMIC_RELAXED, __HIP_MEMORY_SCOPE_AGENT); }
__device__ __forceinline__ void st_agent(float* p, float v) { __hip_atomic_store(p, v, __ATOMIC_RELAXED, __HIP_MEMORY_SCOPE_AGENT); }
__device__ __forceinline__ int lane_id() { unsigned m = ~0u; asm volatile("" : "+s"(m)); return (int)__builtin_amdgcn_mbcnt_hi(m, __builtin_amdgcn_mbcnt_lo(m, 0u)); }
__device__ __forceinline__ float bf2f(bf16 b) { return __uint_as_float(((unsigned)b) << 16); }
typedef __bf16 hwbf16x2 __attribute__((ext_vector_type(2)));
__device__ __forceinline__ unsigned pk2(float lo, float hi) { const f32x2 v = {lo, hi}; return __builtin_bit_cast(unsigned, __builtin_convertvector(v, hwbf16x2)); }
__device__ __forceinline__ unsigned f2bf(float f) { return pk2(f, 0.f) & 0xffffu; }
__device__ __forceinline__ float sigmoidf_(float x) { return __builtin_amdgcn_rcpf(1.0f + __expf(-x)); }
__device__ __forceinline__ float siluf_(float x) { return x * __builtin_amdgcn_rcpf(1.0f + __expf(-x)); }
__device__ __forceinline__ float tanhf_(float x) { const float e = __expf(2.0f * fminf(fmaxf(x, -15.f), 15.f)); return 1.0f - 2.0f * __builtin_amdgcn_rcpf(e + 1.0f); }
__device__ __forceinline__ float softplusf_(float x) { return fmaxf(x, 0.f) + __logf(1.0f + __expf(-fabsf(x))); }
__device__ __forceinline__ float gelu_tanh(float x) { const float u = 0.7978845608028654f * (x + 0.044715f * x * x * x); const float e = __expf(2.f * u); const float th = 1.f - 2.f * __builtin_amdgcn_rcpf(e + 1.f); return 0.5f * x * (1.f + th); }
template <int O> __device__ __forceinline__ float shx(float v) {
    if constexpr (O < 32) return __int_as_float(__builtin_amdgcn_ds_swizzle(__float_as_int(v), (O << 10) | 0x1f));
    else { const int lane = lane_id(); return __int_as_float(__builtin_amdgcn_ds_bpermute((lane ^ O) << 2, __float_as_int(v))); }
}
__device__ __forceinline__ float wave_sum(float v) { v += shx<1>(v); v += shx<2>(v); v += shx<4>(v); v += shx<8>(v); v += shx<16>(v); v += shx<32>(v); return v; }
__device__ __forceinline__ void seq_of(int t, int& pos, int& L) { if (t < TP) { pos = t; L = TP; } else { pos = (t - TP) & (LS - 1); L = LS; } }
__device__ __forceinline__ void unpack8(const u32x4 w, float (&x)[8]) {
    x[0] = __uint_as_float(w.x << 16); x[1] = __uint_as_float(w.x & 0xffff0000u); x[2] = __uint_as_float(w.y << 16); x[3] = __uint_as_float(w.y & 0xffff0000u);
    x[4] = __uint_as_float(w.z << 16); x[5] = __uint_as_float(w.z & 0xffff0000u); x[6] = __uint_as_float(w.w << 16); x[7] = __uint_as_float(w.w & 0xffff0000u);
}
__device__ __forceinline__ u32x4 pack8(const float (&x)[8]) { u32x4 w; w.x = pk2(x[0], x[1]); w.y = pk2(x[2], x[3]); w.z = pk2(x[4], x[5]); w.w = pk2(x[6], x[7]); return w; }

namespace pg8 {
#define PG8_LAS __attribute__((address_space(3)))
typedef unsigned short bf16_t;
constexpr int BM = 256, BK = 64, HALF = 128, HTB = HALF * BK * 2, STAGE_BYTES = 8 * HTB, NXCD = 8, WGM = 8;
__host__ __device__ __forceinline__ int lds_byte(int r, int c) { const int st = (r >> 4) * 2 + (c >> 5), rr = r & 15, cc = c & 31, ob = rr * 64 + cc * 2; return st * 1024 + (ob ^ (((ob >> 9) & 1) << 5)); }
__host__ __device__ __forceinline__ void stage_rc(int b, int& R, int& C) { const int st = b / 1024, sb = b % 1024, swz = sb ^ (((sb >> 9) & 1) << 5); R = (st >> 1) * 16 + swz / 64; C = (st & 1) * 32 + (swz % 64) / 2; }
__host__ __device__ __forceinline__ int perm32(int rho) { const int n = rho >> 4, i = rho & 15; return 8 * (i >> 2) + 4 * n + (i & 3); }

struct Unit { int pm, pn, z; size_t aoff, boff; };
struct Gemm { const bf16_t* A; const bf16_t* Bt; int lda, ldb, K; };

struct Order {
    int nM, nN, nZ, G, c; size_t a_pm, a_z, b_pn, b_z; int kwin = 0; int zfast = 0;
    __device__ __forceinline__ void init(int nM_, int nN_, int nZ_, int G_, int c_, size_t a_pm_, size_t a_z_, size_t b_pn_, size_t b_z_) { nM = nM_; nN = nN_; nZ = nZ_; G = G_; c = c_; a_pm = a_pm_; a_z = a_z_; b_pn = b_pn_; b_z = b_z_; }
    __device__ __forceinline__ bool next(int i, Unit& u) const {
        const int nwg = nM * nN; int z, wgid;
        if (zfast) { const long L = (long)(i / nZ) * G + c; if (L >= (long)nwg) return false; z = i % nZ; wgid = (int)L; }
        else { const long L = (long)i * G + c; if (L >= (long)nwg * nZ) return false; z = (int)(L / nwg); wgid = (int)(L % nwg); }
        { const int q = nwg / NXCD, r = nwg % NXCD, xcd = wgid % NXCD, off = wgid / NXCD; wgid = (xcd < r ? xcd * (q + 1) : r * (q + 1) + (xcd - r) * q) + off; }
        const int nig = WGM * nN, gid = wgid / nig, fm = gid * WGM, gsz = (nM - fm) < WGM ? (nM - fm) : WGM;
        u.pm = fm + ((wgid % nig) % gsz); u.pn = (wgid % nig) / gsz; u.z = z;
        u.aoff = (size_t)u.pm * a_pm + (size_t)z * a_z + (size_t)(((u.pn & 7) >> 1) * kwin); u.boff = (size_t)u.pn * b_pn + (size_t)z * b_z; return true;
    }
};

template <class Epi>
__device__ __forceinline__ void gemm_phase(PG8_LAS unsigned char* lds, const Gemm g, const Order& S, const Epi& E, int tid_in) {
    int tid_ = tid_in; asm volatile("" : "+v"(tid_));
    const int tid = tid_, wid = __builtin_amdgcn_readfirstlane(tid >> 6), lane = tid & 63, wr = wid >> 2, wc = wid & 3, fr = lane & 15, fq = lane >> 4;
    const int K = g.K, nt = K / BK;
    unsigned voffA[2], voffB[2];
#pragma unroll
    for (int i = 0; i < 2; ++i) { int R, C; stage_rc(tid * 16 + i * 8192, R, C); const int Rb = Epi::PERM ? ((R & ~31) + perm32(R & 31)) : R;
        voffA[i] = (unsigned)(R * g.lda + C) * 2u; voffB[i] = (unsigned)(Rb * g.ldb + C) * 2u; }
    const size_t kstep = (size_t)(BK * 2);
    const size_t hstepA = (size_t)HALF * g.lda * 2, hstepB = (size_t)HALF * g.ldb * 2;
    const unsigned ldsw = (unsigned)wid * 1024u;
    const int aoff = lds_byte(wr * 64 + fr, fq * 8), boff = lds_byte(wc * 32 + fr, fq * 8);
#define PG8_SA(b, h) (((b) * 2 + (h)) * HTB)
#define PG8_SB(b, h) ((4 + (b) * 2 + (h)) * HTB)
#define PG8_STAGE(bufoff, gbase, voff) do { _Pragma("unroll") for (int _i = 0; _i < 2; ++_i) \
        __builtin_amdgcn_global_load_lds((const unsigned*)((const char*)(gbase) + (voff)[_i]), (PG8_LAS unsigned*)(lds + (bufoff) + ldsw + _i * 8192), 16, 0, 0); } while (0)
#define PG8_LDA(dst, b, h) do { _Pragma("unroll") for (int m = 0; m < 4; ++m) _Pragma("unroll") for (int k = 0; k < 2; ++k) dst[m][k] = *(const PG8_LAS bf16x8*)(lds + PG8_SA(b, h) + aoff + m * 2048 + k * 1024); } while (0)
#define PG8_LDB(dst, b, h) do { _Pragma("unroll") for (int n = 0; n < 2; ++n) _Pragma("unroll") for (int k = 0; k < 2; ++k) dst[n][k] = *(const PG8_LAS bf16x8*)(lds + PG8_SB(b, h) + boff + n * 2048 + k * 1024); } while (0)
#define PG8_MMA(ai, bj, At, Bt) do { __builtin_amdgcn_s_setprio(1); _Pragma("unroll") for (int m = 0; m < 4; ++m) _Pragma("unroll") for (int n = 0; n < 2; ++n) _Pragma("unroll") for (int k = 0; k < 2; ++k) \
        acc[ai][bj][m][n] = __builtin_amdgcn_mfma_f32_16x16x32_bf16(Bt[n][k], At[m][k], acc[ai][bj][m][n], 0, 0, 0); __builtin_amdgcn_s_setprio(0); } while (0)
#define PG8_WAIT_V(n) asm volatile("s_waitcnt vmcnt(" #n ")" ::: "memory")
#define PG8_WAIT_L(n) asm volatile("s_waitcnt lgkmcnt(" #n ")" ::: "memory")
#define PG8_BAR __builtin_amdgcn_s_barrier()
#define PG8_SCHED __builtin_amdgcn_sched_barrier(0)
    Unit cur, nxt; int ui = 0;
    if (!S.next(0, cur)) return;
    f32x4 acc[2][2][4][2];
#pragma unroll
    for (int a = 0; a < 2; ++a)
#pragma unroll
        for (int b = 0; b < 2; ++b)
#pragma unroll
            for (int m = 0; m < 4; ++m)
#pragma unroll
                for (int n = 0; n < 2; ++n) acc[a][b][m][n] = (f32x4){0.f, 0.f, 0.f, 0.f};
    const char* cA = (const char*)g.A + cur.aoff; const char* cB = (const char*)g.Bt + cur.boff;
    PG8_STAGE(PG8_SB(0, 0), cB, voffB); PG8_STAGE(PG8_SB(0, 1), cB + hstepB, voffB); PG8_STAGE(PG8_SA(0, 0), cA, voffA); PG8_STAGE(PG8_SA(0, 1), cA + hstepA, voffA);
    if (wr == 1) PG8_BAR;
    PG8_WAIT_V(2); PG8_BAR;
    PG8_STAGE(PG8_SB(1, 0), cB + kstep, voffB); PG8_STAGE(PG8_SA(1, 0), cA + kstep, voffA); PG8_STAGE(PG8_SB(1, 1), cB + hstepB + kstep, voffB);
    PG8_WAIT_V(6); PG8_BAR;
    for (;;) {
        const bool has_next = S.next(ui + 1, nxt);
        const char* nA = has_next ? (const char*)g.A + nxt.aoff : cA; const char* nB = has_next ? (const char*)g.Bt + nxt.boff : cB;
#pragma unroll 1
        for (int t = 0; t < nt; t += 2) {
            const bool last = (t == nt - 2);
            const char* a1 = cA + (size_t)(t + 1) * kstep;
            const char* a2 = last ? nA : cA + (size_t)(t + 2) * kstep; const char* b2 = last ? nB : cB + (size_t)(t + 2) * kstep;
            const char* a3 = a2 + kstep; const char* b3 = b2 + kstep;
            bf16x8 At[4][2], B0[2][2], B1[2][2];
            PG8_LDB(B0, 0, 0); PG8_LDB(B1, 0, 1); PG8_SCHED; PG8_LDA(At, 0, 0); PG8_STAGE(PG8_SA(1, 1), a1 + hstepA, voffA);
            PG8_WAIT_V(8); PG8_WAIT_L(0); PG8_BAR; PG8_MMA(0, 0, At, B0); PG8_MMA(0, 1, At, B1); PG8_BAR; PG8_SCHED;
            PG8_LDA(At, 0, 1); PG8_STAGE(PG8_SB(0, 0), b2, voffB); PG8_STAGE(PG8_SB(0, 1), b2 + hstepB, voffB); PG8_STAGE(PG8_SA(0, 0), a2, voffA);
            PG8_WAIT_V(8); PG8_WAIT_L(0); PG8_BAR; PG8_MMA(1, 0, At, B0); PG8_MMA(1, 1, At, B1); PG8_BAR; PG8_SCHED;
            PG8_LDB(B0, 1, 0); PG8_LDB(B1, 1, 1); PG8_SCHED; PG8_LDA(At, 1, 0); PG8_STAGE(PG8_SA(0, 1), a2 + hstepA, voffA);
            PG8_WAIT_V(8); PG8_WAIT_L(0); PG8_BAR; PG8_MMA(0, 0, At, B0); PG8_MMA(0, 1, At, B1); PG8_BAR; PG8_SCHED;
            PG8_LDA(At, 1, 1); PG8_STAGE(PG8_SB(1, 0), b3, voffB); PG8_STAGE(PG8_SB(1, 1), b3 + hstepB, voffB); PG8_STAGE(PG8_SA(1, 0), a3, voffA);
            PG8_WAIT_V(8); PG8_WAIT_L(0); PG8_BAR; PG8_MMA(1, 0, At, B0); PG8_MMA(1, 1, At, B1); PG8_BAR; PG8_SCHED;
        }
        if (wr == 0) PG8_BAR;
        asm volatile("" ::: "memory");
        { const int ln_ = lane_id(); E(acc, cur, wr, wc, ln_ & 15, ln_ >> 4); }
        asm volatile("" ::: "memory");
        if (!has_next) break;
        if (!(Epi::KEEP && cur.z + 1 < S.nZ)) {
#pragma unroll
        for (int a = 0; a < 2; ++a)
#pragma unroll
            for (int b = 0; b < 2; ++b)
#pragma unroll
                for (int m = 0; m < 4; ++m)
#pragma unroll
                    for (int n = 0; n < 2; ++n) acc[a][b][m][n] = (f32x4){0.f, 0.f, 0.f, 0.f}; }
        cur = nxt; cA = nA; cB = nB; ++ui;
        if (wr == 1) PG8_BAR;
    }
    PG8_WAIT_V(0);
    PG8_BAR;
#undef PG8_SA
#undef PG8_SB
#undef PG8_STAGE
#undef PG8_LDA
#undef PG8_LDB
#undef PG8_MMA
#undef PG8_WAIT_V
#undef PG8_WAIT_L
#undef PG8_BAR
#undef PG8_SCHED
}
}
using pg8::Unit; using pg8::HALF; using pg8::BM;
typedef f32x4 AccT[2][2][4][2];

struct EpiBf16 {
    static constexpr bool PERM = true, KEEP = false;
    bf16* O; int ldc; int tanh_pn;
    const float* rss;
    __device__ __forceinline__ void operator()(const AccT& acc, const Unit& u, int wr, int wc, int fr, int fq) const {
        const int row0 = u.pm * BM + wr * 64 + fr, col0 = u.pn * BM + wc * 32 + 8 * fq;
        float rsv[2][4];
#pragma unroll
        for (int ai = 0; ai < 2; ++ai)
#pragma unroll
            for (int m = 0; m < 4; ++m) rsv[ai][m] = rss ? rss[row0 + ai * HALF + m * 16] : 0.f;
#pragma unroll
        for (int ai = 0; ai < 2; ++ai)
#pragma unroll
            for (int m = 0; m < 4; ++m) { bf16* rowp = O + (size_t)(row0 + ai * HALF + m * 16) * ldc + col0; const float rs = rss ? __builtin_amdgcn_rsqf(rsv[ai][m] * (1.0f / D) + 1e-6f) : 1.0f;
#pragma unroll
                for (int bj = 0; bj < 2; ++bj) { f32x4 v0 = acc[ai][bj][m][0] * rs, v1 = acc[ai][bj][m][1] * rs;
                    if (bj == 0 && u.pn == tanh_pn) {
#pragma unroll
                        for (int j = 0; j < 4; ++j) { v0[j] = tanhf_(v0[j]); v1[j] = tanhf_(v1[j]); } }
                    u32x4 w; w.x = pk2(v0[0], v0[1]); w.y = pk2(v0[2], v0[3]); w.z = pk2(v1[0], v1[1]); w.w = pk2(v1[2], v1[3]);
                    __builtin_nontemporal_store(w, (u32x4*)(rowp + bj * HALF)); } }
    }
};
struct EpiF32 {
    static constexpr bool PERM = false, KEEP = false;
    float* C; int ldc; size_t zstride;
    __device__ __forceinline__ void operator()(const AccT& acc, const Unit& u, int wr, int wc, int fr, int fq) const {
        const int row0 = u.pm * BM + wr * 64 + fr, col0 = u.pn * BM + wc * 32 + 4 * fq; float* Cz = C + (size_t)u.z * zstride;
#pragma unroll
        for (int ai = 0; ai < 2; ++ai)
#pragma unroll
            for (int m = 0; m < 4; ++m) { float* rowp = Cz + (size_t)(row0 + ai * HALF + m * 16) * ldc + col0;
#pragma unroll
                for (int bj = 0; bj < 2; ++bj)
#pragma unroll
                    for (int n = 0; n < 2; ++n) *(f32x4*)(rowp + bj * HALF + n * 16) = acc[ai][bj][m][n]; }
    }
};
struct EpiLru {
    static constexpr bool PERM = false, KEEP = false;
    const float *b_r, *b_i, *lam;
    const bf16* XC; bf16* LA; bf16* BB;
    __device__ __forceinline__ void operator()(const AccT& acc, const Unit& u, int wr, int wc, int fr, int fq) const {
        const int d = u.pn >> 3, h = u.pn & 7; const int row0 = u.pm * BM + wr * 64 + fr;
#pragma unroll
        for (int n = 0; n < 2; ++n) { const int ch0 = h * 128 + wc * 32 + n * 16 + fq * 4; float br[4], bi[4], sp[4];
#pragma unroll
            for (int j = 0; j < 4; ++j) { br[j] = b_r[d * WB + ch0 + j]; bi[j] = b_i[d * WB + ch0 + j]; sp[j] = -8.0f * softplusf_(-lam[d * WB + ch0 + j]); }
            u32x2 xwv[2][4];
#pragma unroll
            for (int ai = 0; ai < 2; ++ai)
#pragma unroll
                for (int m = 0; m < 4; ++m) xwv[ai][m] = *(const u32x2*)(XC + (size_t)(row0 + ai * HALF + m * 16) * WB + ch0);
#pragma unroll
            for (int ai = 0; ai < 2; ++ai)
#pragma unroll
                for (int m = 0; m < 4; ++m) { const int t = row0 + ai * HALF + m * 16; int pos, L; seq_of(t, pos, L); const bool first = (d == 0) ? (pos == 0) : (pos == L - 1);
                    const f32x4 ar = acc[ai][0][m][n], aiq = acc[ai][1][m][n];
                    const u32x2 xw = xwv[ai][m];
                    const float xc[4] = {__uint_as_float(xw.x << 16), __uint_as_float(xw.x & 0xffff0000u), __uint_as_float(xw.y << 16), __uint_as_float(xw.y & 0xffff0000u)};
                    float oa[4], ob[4];
#pragma unroll
                    for (int j = 0; j < 4; ++j) { const float rg = sigmoidf_(ar[j] + br[j]), ig = sigmoidf_(aiq[j] + bi[j]); const float la = rg * sp[j];
                        float mult = __builtin_amdgcn_sqrtf(fmaxf(1.0f - __expf(2.0f * la), 0.f)); if (first) mult = 1.0f; oa[j] = la; ob[j] = mult * ig * xc[j]; }
                    u32x2 wa, wb; wa.x = pk2(oa[0], oa[1]); wa.y = pk2(oa[2], oa[3]); wb.x = pk2(ob[0], ob[1]); wb.y = pk2(ob[2], ob[3]);
                    *(u32x2*)(LA + ((size_t)d * T + t) * WB + ch0) = wa; *(u32x2*)(BB + ((size_t)d * T + t) * WB + ch0) = wb; } }
    }
};
struct EpiS5Main {
    static constexpr bool PERM = true, KEEP = false;
    bf16* YG;
    __device__ __forceinline__ void operator()(const AccT& acc, const Unit& u, int wr, int wc, int fr, int fq) const {
        const int row0 = u.pm * BM + wr * 64 + fr; const int g = u.z;
#pragma unroll
        for (int ai = 0; ai < 2; ++ai)
#pragma unroll
            for (int m = 0; m < 4; ++m) { const int c = row0 + ai * HALF + m * 16;
#pragma unroll
                for (int bj = 0; bj < 2; ++bj) { const int cc = bj * HALF + wc * 32 + 8 * fq; const int tau = cc >> 4, p0 = cc & 15; const f32x4 v0 = acc[ai][bj][m][0], v1 = acc[ai][bj][m][1];
                    u32x4 w; w.x = pk2(gelu_tanh(v0[0]), gelu_tanh(v0[1])); w.y = pk2(gelu_tanh(v0[2]), gelu_tanh(v0[3])); w.z = pk2(gelu_tanh(v1[0]), gelu_tanh(v1[1])); w.w = pk2(gelu_tanh(v1[2]), gelu_tanh(v1[3]));
                    *(u32x4*)(YG + (size_t)(c * 16 + tau) * WB + g * 16 + p0) = w; } }
    }
};
struct EpiGlu {
    static constexpr bool PERM = true, KEEP = false;
    const bf16* YG; const bf16* PROJ; const float* glu_b; bf16* Y;
    __device__ __forceinline__ void operator()(const AccT& acc, const Unit& u, int wr, int wc, int fr, int fq) const {
        const int row0 = u.pm * BM + wr * 64 + fr, col0 = u.pn * BM + wc * 32 + 8 * fq;
#pragma unroll
        for (int ai = 0; ai < 2; ++ai)
#pragma unroll
            for (int m = 0; m < 4; m += 2) { u32x4 ygw[2][2], zzw[2][2];
#pragma unroll
              for (int mm = 0; mm < 2; ++mm)
#pragma unroll
                for (int bj = 0; bj < 2; ++bj) { const int t = row0 + ai * HALF + (m + mm) * 16, col = col0 + bj * HALF; ygw[mm][bj] = *(const u32x4*)(YG + (size_t)t * WB + col); zzw[mm][bj] = *(const u32x4*)(PROJ + (size_t)t * NPJ + C_SZ + col); }
#pragma unroll
              for (int mm = 0; mm < 2; ++mm) { const int t = row0 + ai * HALF + (m + mm) * 16;
#pragma unroll
                for (int bj = 0; bj < 2; ++bj) { const int col = col0 + bj * HALF; const f32x4 v0 = acc[ai][bj][m + mm][0], v1 = acc[ai][bj][m + mm][1];
                    float yg[8], zz[8], o[8]; unpack8(ygw[mm][bj], yg); unpack8(zzw[mm][bj], zz);
                    const f32x4 b0 = *(const f32x4*)(glu_b + col), b1 = *(const f32x4*)(glu_b + col + 4);
#pragma unroll
                    for (int j = 0; j < 4; ++j) { o[j] = yg[j] * sigmoidf_(v0[j] + b0[j]) * siluf_(zz[j]); o[4 + j] = yg[4 + j] * sigmoidf_(v1[j] + b1[j]) * siluf_(zz[4 + j]); }
                    *(u32x4*)(Y + (size_t)t * 4096 + 3072 + col) = pack8(o); } } }
    }
};
struct EpiGate {
    static constexpr bool PERM = false, KEEP = false;
    bf16* GR; const float* rss;
    __device__ __forceinline__ void operator()(const AccT& acc, const Unit& u, int wr, int wc, int fr, int fq) const {
        const int row0 = u.pm * BM + wr * 64 + fr, ch0 = u.pn * 64 + wc * 16 + 4 * fq;
        float rsv[2][4];
#pragma unroll
        for (int ai = 0; ai < 2; ++ai)
#pragma unroll
            for (int m = 0; m < 4; ++m) rsv[ai][m] = rss[row0 + ai * HALF + m * 16];
#pragma unroll
        for (int ai = 0; ai < 2; ++ai)
#pragma unroll
            for (int m = 0; m < 4; ++m) { const size_t t = (size_t)(row0 + ai * HALF + m * 16); const float rs = __builtin_amdgcn_rsqf(rsv[ai][m] * (1.0f / D) + 1e-6f);
                float e1[4][4], g[4][4];
#pragma unroll
                for (int z = 0; z < 4; ++z) { const f32x4 v = acc[ai][z >> 1][m][z & 1] * rs;
#pragma unroll
                    for (int j = 0; j < 4; ++j) { e1[z][j] = 1.0f + __expf(-__builtin_amdgcn_fmed3f(v[j], -30.0f, 30.0f)); g[z][j] = __builtin_amdgcn_rcpf(e1[z][j]); } }
#pragma unroll
                for (int z = 0; z < 4; ++z) { float f[4];
#pragma unroll
                    for (int j = 0; j < 4; ++j) f[j] = z < 3 ? g[z][j] * e1[z + 1][j] : g[3][j];
                    u32x2 w; w.x = pk2(f[0], f[1]); w.y = pk2(f[2], f[3]); *(u32x2*)(GR + ((size_t)z * T + t) * D + ch0) = w; } }
    }
};
struct EpiBranchAll {
    static constexpr bool PERM = false, KEEP = true;
    const bf16* GR; bf16* MG;
    __device__ __forceinline__ void operator()(AccT& acc, const Unit& u, int wr, int wc, int fr, int fq) const {
        const int row0 = u.pm * BM + wr * 64 + fr, col0 = u.pn * BM + wc * 32 + 4 * fq; const int z = u.z;
#pragma unroll
        for (int ai = 0; ai < 2; ++ai)
          { u32x2 gv[4][2][2];
#pragma unroll
            for (int m = 0; m < 4; ++m)
#pragma unroll
                for (int bj = 0; bj < 2; ++bj)
#pragma unroll
                    for (int n = 0; n < 2; ++n) gv[m][bj][n] = *(const u32x2*)(GR + ((size_t)z * T + (size_t)(row0 + ai * HALF + m * 16)) * D + col0 + bj * HALF + n * 16);
#pragma unroll
            for (int m = 0; m < 4; ++m) { const size_t t = (size_t)(row0 + ai * HALF + m * 16);
#pragma unroll
                for (int bj = 0; bj < 2; ++bj)
#pragma unroll
                    for (int n = 0; n < 2; ++n) { const int o = bj * HALF + n * 16; const u32x2 g0 = gv[m][bj][n]; f32x4& a = acc[ai][bj][m][n];
                        a[0] *= __uint_as_float(g0.x << 16); a[1] *= __uint_as_float(g0.x & 0xffff0000u); a[2] *= __uint_as_float(g0.y << 16); a[3] *= __uint_as_float(g0.y & 0xffff0000u);
                        if (z == 3) { u32x2 w; w.x = pk2(a[0], a[1]); w.y = pk2(a[2], a[3]); *(u32x2*)(MG + t * D + col0 + o) = w; } } } }
    }
};
struct EpiOut {
    static constexpr bool PERM = false, KEEP = false;
    const float* xp; const float* xs; float* out; bf16* XB; float* rsp; int first;
    __device__ __forceinline__ void operator()(const AccT& acc, const Unit& u, int wr, int wc, int fr, int fq) const {
        const int row0 = u.pm * BM + wr * 64 + fr, col0 = u.pn * BM + wc * 32 + 4 * fq;
#pragma unroll
        for (int ai = 0; ai < 2; ++ai)
#pragma unroll
            for (int m2 = 0; m2 < 4; m2 += 2) { f32x4 sv[2][2][2];
#pragma unroll
              for (int mm = 0; mm < 2; ++mm) { const int t = row0 + ai * HALF + (m2 + mm) * 16; const size_t ro = (size_t)t * D + col0; const float* src = first ? (t < TP ? xp + ro : xs + (ro - (size_t)TP * D)) : out + ro;
#pragma unroll
                for (int bj = 0; bj < 2; ++bj)
#pragma unroll
                    for (int n = 0; n < 2; ++n) sv[mm][bj][n] = *(const f32x4*)(src + bj * HALF + n * 16); }
#pragma unroll
              for (int mm = 0; mm < 2; ++mm) { const int m = m2 + mm; const int t = row0 + ai * HALF + m * 16; const size_t ro = (size_t)t * D + col0; float ss = 0.f;
#pragma unroll
                for (int bj = 0; bj < 2; ++bj)
#pragma unroll
                    for (int n = 0; n < 2; ++n) { const int o = bj * HALF + n * 16; const f32x4 v = sv[mm][bj][n] + acc[ai][bj][m][n]; *(f32x4*)(out + ro + o) = v;
                        u32x2 w; w.x = pk2(v[0], v[1]); w.y = pk2(v[2], v[3]); *(u32x2*)(XB + ro + o) = w; ss += (v[0] * v[0] + v[1] * v[1]) + (v[2] * v[2] + v[3] * v[3]); }
                ss += shx<16>(ss); ss += shx<32>(ss);
                if (fq == 0) rsp[(size_t)t * 32 + u.pn * 4 + wc] = ss; } }
    }
};

struct EpiNull { static constexpr bool PERM = false, KEEP = false; __device__ __forceinline__ void operator()(const AccT&, const Unit&, int, int, int, int) const {} };
#define XB_TMO      128
#define XB_XCNT(j)  (256  + 64 * (j))
#define XB_XSUB(j)  (1280 + 64 * (j))
#define XB_XGEN(j)  (2304 + 64 * (j))
#define XB_TOP      3328
#define XB_TOPGEN   3392
#define XCD_BAR_WORDS 3456
#define XB_SPIN_CAP (1u << 24)
__device__ __forceinline__ unsigned xb_ld(unsigned* p)              { return __hip_atomic_load(p, __ATOMIC_RELAXED, __HIP_MEMORY_SCOPE_AGENT); }
__device__ __forceinline__ unsigned xb_add(unsigned* p, unsigned v) { return __hip_atomic_fetch_add(p, v, __ATOMIC_RELAXED, __HIP_MEMORY_SCOPE_AGENT); }
__device__ __forceinline__ unsigned xb_xcc_id() { return (unsigned)__builtin_amdgcn_s_getreg((3 << 11) | 20) & 0xFu; }
#define XB_SPIN(cond, bar) do { unsigned _sp = 0; while (cond) { __builtin_amdgcn_s_sleep(1); \
    if ((++_sp & 255u) == 0u) { if (xb_ld(&(bar)[XB_TMO])) break; if (_sp > XB_SPIN_CAP) { atomicAdd(&(bar)[XB_TMO], 1u); break; } } } } while (0)
struct XcdBarrier { unsigned* bar; unsigned x; volatile LAS unsigned* st; int wave; };
__device__ __forceinline__ XcdBarrier xcd_barrier_post(unsigned* bar, volatile LAS unsigned* st) {
    XcdBarrier b; b.bar = bar; b.x = xb_xcc_id(); b.st = st;
    if (threadIdx.x == 0) (void)xb_add(&bar[XB_XCNT(b.x)], 1u);
    return b;
}
__device__ __forceinline__ void xcd_barrier_complete(unsigned* bar, unsigned x, unsigned& nloc, unsigned& nx) {
    const unsigned G = gridDim.x * gridDim.y * gridDim.z;
    unsigned sum, cnt, mine, sp = 0u;
    for (;;) {
        sum = 0u; cnt = 0u; mine = 0u;
#pragma unroll 1
        for (unsigned j = 0; j < 16; ++j) { const unsigned c = xb_ld(&bar[XB_XCNT(j)]); sum += c; cnt += (c > 0u) ? 1u : 0u; mine = (j == x) ? c : mine; }
        if (sum == G) break;
        __builtin_amdgcn_s_sleep(1);
        if ((++sp & 255u) == 0u) { if (xb_ld(&bar[XB_TMO])) break; if (sp > XB_SPIN_CAP) { atomicAdd(&bar[XB_TMO], 1u); break; } }
    }
    nloc = mine > 0u ? mine : 1u; nx = cnt > 0u ? cnt : 1u;
}
__device__ __forceinline__ void xcd_barrier(const XcdBarrier& b) {
    asm volatile("s_waitcnt vmcnt(0)" ::: "memory");
    __syncthreads();
    if (b.wave == 0 && lane_id() == 0) {
        unsigned* bar = b.bar;
        __builtin_amdgcn_s_waitcnt(0);
        unsigned nloc = b.st[0], nx = b.st[1];
        if (nloc == 0u) { xcd_barrier_complete(bar, b.x, nloc, nx); b.st[0] = nloc; b.st[1] = nx; }
        const unsigned old = xb_add(&bar[XB_XSUB(b.x)], 1u);
        const unsigned gen = old / nloc;
        if (old + 1u == (gen + 1u) * nloc) {
            __builtin_amdgcn_fence(__ATOMIC_RELEASE, "agent");
            asm volatile("s_waitcnt vmcnt(0)" ::: "memory");
            const unsigned og = xb_add(&bar[XB_TOP], 1u);
            const unsigned tg = og / nx;
            if (og + 1u == (tg + 1u) * nx) xb_add(&bar[XB_TOPGEN], 1u);
            else XB_SPIN(xb_ld(&bar[XB_TOPGEN]) == tg, bar);
            __builtin_amdgcn_fence(__ATOMIC_ACQUIRE, "agent");
            xb_add(&bar[XB_XGEN(b.x)], 1u);
            asm volatile("s_waitcnt vmcnt(0)" ::: "memory");
        } else {
            XB_SPIN(xb_ld(&bar[XB_XGEN(b.x)]) == gen, bar);
            __builtin_amdgcn_fence(__ATOMIC_ACQUIRE, "agent");
            asm volatile("s_waitcnt vmcnt(0)" ::: "memory");
        }
    }
    __syncthreads();
}
constexpr int NWAVES = 8, NTHR = 512;
constexpr int LDS_BYTES = 147456;
constexpr int LDS_MISC = LDS_BYTES - 256;
struct Args { const float* in[35]; float* out; unsigned char* ws; int ph_lo, ph_hi; };
constexpr int LDS_ARGS = LDS_BYTES - 1024;
struct AP { const LAS unsigned long long* q; unsigned char* ws; float* out;
    __device__ __forceinline__ const float* in(int i) const { const unsigned long long v = q[i]; const unsigned lo = __builtin_amdgcn_readfirstlane((unsigned)v), hi = __builtin_amdgcn_readfirstlane((unsigned)(v >> 32)); return (const float*)(((unsigned long long)hi << 32) | lo); } };
struct Frame { LAS unsigned char* lds; int tid, lane, wave, gw, ngw, gt, ngt; };
enum { I_XP = 0, I_XS, I_NORMG, I_WIN, I_CONVW, I_CONVB, I_WR, I_BR, I_WI, I_BI, I_LAM, I_MU, I_W0, I_W2, I_A0, I_A2, I_KK, I_KA, I_RK, I_LNG, I_LNB, I_GNG,
       I_SLRE, I_SLIM, I_SLOG, I_SBRE, I_SBIM, I_SCRE, I_SCIM, I_SD, I_GLUW, I_GLUB, I_WBR, I_WOUT, I_FING };

__device__ __forceinline__ float sin_rev(float x) { return __builtin_amdgcn_sinf(x); }
__device__ __forceinline__ float cos_rev(float x) { return __builtin_amdgcn_cosf(x); }
__device__ __forceinline__ f32x2 cexp_pow(float lre, float lim, float st, int k) {
    const float mag = __expf((float)k * lre * st); double ph = (double)k * (double)lim * (double)st * 0.15915494309189535; ph -= rint(ph);
    const float f = (float)ph; return (f32x2){mag * cos_rev(f), mag * sin_rev(f)};
}

__device__ __forceinline__ void ph_tables(const AP& a, const Frame& F) {
    f32x2* TAB = (f32x2*)(a.ws + WS_S5TAB); f32x2* ROT = (f32x2*)(a.ws + WS_ROT);
    for (int i = F.gt; i < DEPTH * 2 * 64 * 64; i += F.ngt) {
        const float lre = fminf(a.in(I_SLRE)[i], -1e-4f), lim = a.in(I_SLIM)[i]; const float st = __expf(a.in(I_SLOG)[i >> 6]);
        const f32x2 p1 = cexp_pow(lre, lim, st, 1); const float nr = p1.x - 1.f, ni = p1.y, den = lre * lre + lim * lim;
        const float gr = (nr * lre + ni * lim) / den, gi = (ni * lre - nr * lim) / den;
        for (int k = 0; k <= 16; ++k) { const f32x2 p = cexp_pow(lre, lim, st, k); TAB[(size_t)i * 33 + 16 + k] = p; if (k < 16) TAB[(size_t)i * 33 + k] = (f32x2){p.x * gr - p.y * gi, p.x * gi + p.y * gr}; }
    }
    for (int i = F.gt; i < 16384 * 64; i += F.ngt) { const int pos = i >> 6, j = i & 63;
        const double inv = exp(-(double)j * (9.210340371976184 / 64.0)); double ph = (double)pos * inv * 0.15915494309189535; ph -= rint(ph); const float f = (float)ph;
        ROT[i] = (f32x2){cos_rev(f), sin_rev(f)}; }
}
struct TrItem { const float* W; int ldw; bf16* WT; int ldt, k0, n0, drow0, dcol0; const float* ksc; int gmap; };
__device__ __forceinline__ TrItem tr_decode(const AP& a, int it) {
    bf16* WALLT = (bf16*)(a.ws + WS_WALLT); bf16* GLUT = (bf16*)(a.ws + WS_GLUT); bf16* WBRT = (bf16*)(a.ws + WS_WBRT); bf16* WOUTT = (bf16*)(a.ws + WS_WOUTT);
    constexpr int I_IN = 32 * (NIN / 32), I_GL = 16 * 32, I_BRI = 16 * 64, I_OUT = 32 * 64, PER = I_IN + I_GL + 4 * I_BRI + I_OUT;
    const int l = it / PER; int r = it % PER; TrItem d;
    if (r < I_IN) { const int kb = r / (NIN / 32), nb = r % (NIN / 32), n0 = nb * 32; d = TrItem{a.in(I_WIN) + (size_t)l * D * NIN, NIN, WALLT + (size_t)l * NALL * D, D, kb * 64, n0, 0, 0, a.in(I_NORMG) + (size_t)l * D, n0 >= GOFF ? 1 : 0}; return d; } r -= I_IN;
    if (r < I_GL) { const int kb = r / 32, nb = r % 32; d = TrItem{a.in(I_GLUW) + (size_t)l * WB * WB, WB, GLUT + (size_t)l * WB * WB, WB, kb * 64, nb * 32, 0, 0, nullptr, 0}; return d; } r -= I_GL;
    if (r < 4 * I_BRI) { const int br = r / I_BRI, q = r % I_BRI, kb = q / 64, nb = q % 64; d = TrItem{a.in(I_WBR) + ((size_t)l * 4 + br) * WB * D, D, WBRT + (size_t)l * D * 4096, 4096, kb * 64, nb * 32, 0, br * WB, nullptr, 0}; return d; } r -= 4 * I_BRI;
    { const int kb = r / 64, nb = r % 64; d = TrItem{a.in(I_WOUT) + (size_t)l * D * D, D, WOUTT + (size_t)l * D * D, D, kb * 64, nb * 32, 0, 0, nullptr, 0}; return d; }
}
__device__ __forceinline__ void tr_load(const TrItem& d, float (&x)[32], int lane) {
#pragma unroll
    for (int i = 0; i < 32; ++i) { const int kk = 2 * i + (lane >> 5); x[i] = d.W[(size_t)(d.k0 + kk) * d.ldw + d.n0 + (lane & 31)] * (d.ksc ? d.ksc[d.k0 + kk] : 1.0f); }
}
__device__ __forceinline__ void tr_store(const TrItem& d, const float (&x)[32], LAS float* scr, int lane) {
#pragma unroll
    for (int i = 0; i < 32; ++i) { const int kk = 2 * i + (lane >> 5); scr[kk * 33 + (lane & 31)] = x[i]; }
    asm volatile("s_waitcnt lgkmcnt(0)" ::: "memory");
    const int c = lane & 7;
#pragma unroll
    for (int j = 0; j < 4; ++j) { const int n = (lane >> 3) + 8 * j; const LAS float* s = scr + (8 * c) * 33 + n;
        u32x4 o; o.x = pk2(s[0 * 33], s[1 * 33]); o.y = pk2(s[2 * 33], s[3 * 33]); o.z = pk2(s[4 * 33], s[5 * 33]); o.w = pk2(s[6 * 33], s[7 * 33]);
        int drow = d.drow0 + d.n0 + n;
        if (d.gmap) { const int g0 = d.n0 + n - GOFF, z = g0 >> 11, nn = g0 & 2047, gp = nn >> 6, nl = nn & 63;
            drow = NPJ + gp * 256 + 128 * (z >> 1) + 16 * (z & 1) + 32 * (nl >> 4) + (nl & 15); }
        *(u32x4*)(d.WT + (size_t)drow * d.ldt + d.dcol0 + d.k0 + 8 * c) = o; }
    asm volatile("s_waitcnt lgkmcnt(0)" ::: "memory");
}
__device__ __forceinline__ void ph_convert(const AP& a, const Frame& F) {
    LAS float* scr = (LAS float*)(F.lds + F.wave * 16384);
    bf16* WALLT = (bf16*)(a.ws + WS_WALLT);
    constexpr int PERI = 32 * (NIN / 32) + 16 * 32 + 4 * 16 * 64 + 32 * 64; const int NIT = DEPTH * PERI;
    { float xa[32], xb[32]; int it = F.gw;
      if (it < NIT) { TrItem da = tr_decode(a, it); tr_load(da, xa, F.lane);
          for (;;) { const int itb = it + F.ngw; TrItem db; const bool hb = itb < NIT; if (hb) { db = tr_decode(a, itb); tr_load(db, xb, F.lane); }
              tr_store(da, xa, scr, F.lane); if (!hb) break;
              const int ita = itb + F.ngw; const bool ha = ita < NIT; if (ha) { da = tr_decode(a, ita); tr_load(da, xa, F.lane); }
              tr_store(db, xb, scr, F.lane); if (!ha) break; it = ita; } } }
    for (int i = F.gt; i < DEPTH * 64 * (D / 8); i += F.ngt) { const int l = i / (64 * (D / 8)), r = (i / (D / 8)) % 64, c8 = i % (D / 8); *(u32x4*)(WALLT + ((size_t)l * NALL + GOFF + r) * D + c8 * 8) = (u32x4){0u, 0u, 0u, 0u}; }
    bf16* LRUW = (bf16*)(a.ws + WS_LRUW);
    for (int i = F.gt; i < DEPTH * 4096 * 32; i += F.ngt) { const int k8 = i & 31, n = (i >> 5) & 4095, l = i >> 17; const int pn = n >> 8, d = pn >> 3, h = pn & 7, gate = (n >> 7) & 1, j = n & 127;
        u32x4 o = (u32x4){0u, 0u, 0u, 0u};
        if ((k8 >> 4) == (h & 1)) { const float* w = (gate ? a.in(I_WI) : a.in(I_WR)) + ((((size_t)l * 2 + d) * 8 + h) * 128) * 128 + j; const int i0 = (k8 & 15) * 8; float x[8];
#pragma unroll
            for (int q = 0; q < 8; ++q) x[q] = w[(size_t)(i0 + q) * 128]; o = pack8(x); }
        *(u32x4*)(LRUW + ((size_t)l * 4096 + n) * 256 + k8 * 8) = o; }
    bf16* W2ALL = (bf16*)(a.ws + WS_W2ALL);
    for (int i = F.gt; i < DEPTH * 3072 * 32; i += F.ngt) { const int k8 = i & 31, n = (i >> 5) % 3072, l = (i >> 5) / 3072; const int blk = n >> 10, c = n & 1023; u32x4 o = (u32x4){0u, 0u, 0u, 0u};
        if ((k8 >> 3) == blk) { const int j0 = (k8 & 7) * 8; const float* w = blk < 2 ? a.in(I_W2) + (((size_t)l * 2 + blk) * 64 + j0) * WB + c : a.in(I_A2) + ((size_t)l * 64 + j0) * WB + c; float x[8];
#pragma unroll
            for (int q = 0; q < 8; ++q) x[q] = w[(size_t)q * WB]; o = pack8(x); }
        *(u32x4*)(W2ALL + ((size_t)l * 3072 + n) * 256 + k8 * 8) = o; }
    float* KTAB = (float*)(a.ws + WS_PROJ); const f32x2* TAB = (const f32x2*)(a.ws + WS_S5TAB);
    for (int i = F.gt; i < DEPTH * 64 * 2 * 16 * 16; i += F.ngt) { const int p = i & 15, dl = (i >> 4) & 15, dir = (i >> 8) & 1, g = (i >> 9) & 63, l = i >> 15;
        const float* cre = a.in(I_SCRE) + (((size_t)l * 64 + g) * 16 + p) * 64; const float* cim = a.in(I_SCIM) + (((size_t)l * 64 + g) * 16 + p) * 64;
        const float* bre = a.in(I_SBRE) + ((size_t)l * 64 + g) * 64 * 16; const float* bim = a.in(I_SBIM) + ((size_t)l * 64 + g) * 64 * 16;
        const f32x2* tb = TAB + ((((size_t)l * 2 + dir) * 64 + g) * 64) * 33 + dl; f32x4 s[4] = {(f32x4){0.f, 0.f, 0.f, 0.f}, (f32x4){0.f, 0.f, 0.f, 0.f}, (f32x4){0.f, 0.f, 0.f, 0.f}, (f32x4){0.f, 0.f, 0.f, 0.f}};
        for (int n = 0; n < 64; ++n) { const f32x2 gk = tb[(size_t)n * 33]; const float cr = cre[n], ci = cim[n]; const float zr = cr * gk.x - ci * gk.y, zi = cr * gk.y + ci * gk.x;
#pragma unroll
            for (int q4 = 0; q4 < 4; ++q4) { const f32x4 br = *(const f32x4*)(bre + n * 16 + q4 * 4), bi = *(const f32x4*)(bim + n * 16 + q4 * 4); s[q4] += br * zr - bi * zi; } }
        float* o = KTAB + ((((size_t)(l * 64 + g) * 2 + dir) * 16 + dl) * 16 + p) * 16;
#pragma unroll
        for (int q4 = 0; q4 < 4; ++q4) *(f32x4*)(o + q4 * 4) = s[q4]; }
}
__device__ __forceinline__ void ph_s5mats(const AP& a, const Frame& F) {
    const float* KTAB = (const float*)(a.ws + WS_PROJ); const f32x2* TAB = (const f32x2*)(a.ws + WS_S5TAB);
    bf16* MAIN = (bf16*)(a.ws + WS_S5MAIN); bf16* INCM = (bf16*)(a.ws + WS_S5INC);
    for (int i = F.gt; i < DEPTH * 64 * 256 * 64; i += F.ngt) { const int c8 = i & 63, row = (i >> 6) & 255, g = (i >> 14) & 63, l = i >> 20; const int tau = row >> 4, p = row & 15; float x[8];
        if (c8 < 32) { const int sg = c8 >> 1, q0 = (c8 & 1) * 8; const float* kb = KTAB + ((size_t)l * 64 + g) * 2 * 16 * 256;
            if (sg < tau) { const float* k = kb + ((0 * 16 + (tau - sg)) * 16 + p) * 16 + q0;
#pragma unroll
                for (int q = 0; q < 8; ++q) x[q] = k[q]; }
            else if (sg > tau) { const float* k = kb + ((1 * 16 + (sg - tau)) * 16 + p) * 16 + q0;
#pragma unroll
                for (int q = 0; q < 8; ++q) x[q] = k[q]; }
            else { const float* k0 = kb + ((0 * 16 + 0) * 16 + p) * 16 + q0; const float* k1 = kb + ((1 * 16 + 0) * 16 + p) * 16 + q0; const float dsk = a.in(I_SD)[(size_t)l * WB + g * 16 + p];
#pragma unroll
                for (int q = 0; q < 8; ++q) x[q] = k0[q] + k1[q] + ((q0 + q) == p ? dsk : 0.f); }
        } else { const int part = (c8 - 32) >> 3, n0 = ((c8 - 32) & 7) * 8, dir = part >> 1; const int k = dir == 0 ? (tau + 1) : (16 - tau);
            const float* cre = a.in(I_SCRE) + (((size_t)l * 64 + g) * 16 + p) * 64 + n0; const float* cim = a.in(I_SCIM) + (((size_t)l * 64 + g) * 16 + p) * 64 + n0;
            const f32x2* tb = TAB + ((((size_t)l * 2 + dir) * 64 + g) * 64 + n0) * 33 + 16 + k;
#pragma unroll
            for (int q = 0; q < 8; ++q) { const f32x2 pw = tb[(size_t)q * 33]; const float zr = cre[q] * pw.x - cim[q] * pw.y, zi = cre[q] * pw.y + cim[q] * pw.x; x[q] = (part & 1) ? -zi : zr; } }
        *(u32x4*)(MAIN + ((((size_t)l * 64 + g) * 256 + row) * 512) + c8 * 8) = pack8(x); }
    for (int i = F.gt; i < DEPTH * 64 * 256 * 32; i += F.ngt) { const int c8 = i & 31, row = (i >> 5) & 255, g = (i >> 13) & 63, l = i >> 19; const int part = row >> 6, n = row & 63, dir = part >> 1, sg = c8 >> 1, q0 = (c8 & 1) * 8;
        const int k = dir == 0 ? (15 - sg) : sg; const f32x2 gk = TAB[((((size_t)l * 2 + dir) * 64 + g) * 64 + n) * 33 + k];
        const float* bre = a.in(I_SBRE) + (((size_t)l * 64 + g) * 64 + n) * 16 + q0; const float* bim = a.in(I_SBIM) + (((size_t)l * 64 + g) * 64 + n) * 16 + q0; float x[8];
#pragma unroll
        for (int q = 0; q < 8; ++q) { const float zr = gk.x * bre[q] - gk.y * bim[q], zi = gk.x * bim[q] + gk.y * bre[q]; x[q] = (part & 1) ? zi : zr; }
        *(u32x4*)(INCM + ((((size_t)l * 64 + g) * 256 + row) * 256) + c8 * 8) = pack8(x); }
}

__device__ __forceinline__ void ph_x0(const AP& a, const Frame& F) {
    bf16* H = (bf16*)(a.ws + WS_H); float* RSS = (float*)(a.ws + WS_RSS);
    for (int t = F.gw; t < T; t += F.ngw) { const float* xr = t < TP ? a.in(I_XP) + (size_t)t * D : a.in(I_XS) + (size_t)(t - TP) * D; float s = 0.f;
#pragma unroll
        for (int j = 0; j < 8; ++j) { const f32x4 v = *(const f32x4*)(xr + (F.lane + 64 * j) * 4); s += (v[0] * v[0] + v[1] * v[1]) + (v[2] * v[2] + v[3] * v[3]); u32x2 w; w.x = pk2(v[0], v[1]); w.y = pk2(v[2], v[3]); *(u32x2*)(H + (size_t)t * D + (F.lane + 64 * j) * 4) = w; }
        s = wave_sum(s); if (F.lane == 0) RSS[t] = s; }
}
__device__ __forceinline__ void ph_rss(const AP& a, const Frame& F, int l) {
    const float* P = (const float*)(a.ws + WS_RSP); float* R = (float*)(a.ws + WS_RSS) + (size_t)((l + 1) & 1) * T;
    for (int t = F.gt; t < T; t += F.ngt) { float s = 0.f;
#pragma unroll
        for (int j = 0; j < 8; ++j) { const f32x4 v = *(const f32x4*)(P + (size_t)t * 32 + j * 4); s += (v[0] + v[1]) + (v[2] + v[3]); }
        R[t] = s; }
}
__device__ __forceinline__ void ph_final(const AP& a, const Frame& F) {
    const float* RSS = (const float*)(a.ws + WS_RSS) + (size_t)(DEPTH & 1) * T; const float* g = a.in(I_FING);
#pragma unroll 4
    for (int i = F.gt; i < T * (D / 4); i += F.ngt) { const int t = i / (D / 4), c4 = (i % (D / 4)) * 4; const float rs = __builtin_amdgcn_rsqf(RSS[t] * (1.0f / D) + 1e-6f);
        float* p = a.out + (size_t)t * D + c4; *(f32x4*)p = *(const f32x4*)p * rs * *(const f32x4*)(g + c4); }
}
__device__ __forceinline__ void ph_lru_conv(const AP& a, const Frame& F, int l) {
    const bf16* PROJ = (const bf16*)(a.ws + WS_PROJ); bf16* XC = (bf16*)(a.ws + WS_SCR + SA_XC);
    const float* cw = a.in(I_CONVW) + (size_t)l * 4 * WB; const float* cb = a.in(I_CONVB) + (size_t)l * WB;
    if ((F.ngt & 127) == 0) {
        const int c8 = (F.gt & 127) * 8; float wv[4][8], bv[8];
#pragma unroll
        for (int q = 0; q < 8; ++q) { bv[q] = cb[c8 + q];
#pragma unroll
            for (int j = 0; j < 4; ++j) wv[j][q] = cw[j * WB + c8 + q]; }
#pragma unroll 2
        for (int i = F.gt; i < T * 128; i += F.ngt) { const int t = i >> 7; int pos, L; seq_of(t, pos, L); u32x4 xr[4];
#pragma unroll
            for (int j = 0; j < 4; ++j) { const int pp = pos + j - 2; xr[j] = (pp >= 0 && pp < L) ? *(const u32x4*)(PROJ + (size_t)(t + j - 2) * NPJ + C_LRUX + c8) : (u32x4){0u, 0u, 0u, 0u}; }
            float acc[8];
#pragma unroll
            for (int q = 0; q < 8; ++q) acc[q] = bv[q];
#pragma unroll
            for (int j = 0; j < 4; ++j) { float x[8]; unpack8(xr[j], x);
#pragma unroll
                for (int q = 0; q < 8; ++q) acc[q] += wv[j][q] * x[q]; }
            *(u32x4*)(XC + (size_t)t * WB + c8) = pack8(acc); }
        return; }
    for (int i = F.gt; i < T * 128; i += F.ngt) { const int t = i >> 7, c8 = (i & 127) * 8; int pos, L; seq_of(t, pos, L); float acc[8];
#pragma unroll
        for (int q = 0; q < 8; ++q) acc[q] = cb[c8 + q];
#pragma unroll
        for (int j = 0; j < 4; ++j) { const int pp = pos + j - 2; if (pp >= 0 && pp < L) { float x[8]; unpack8(*(const u32x4*)(PROJ + (size_t)(t + j - 2) * NPJ + C_LRUX + c8), x);
#pragma unroll
                for (int q = 0; q < 8; ++q) acc[q] += cw[j * WB + c8 + q] * x[q]; } }
        *(u32x4*)(XC + (size_t)t * WB + c8) = pack8(acc); }
}
#define LOF(x) __uint_as_float((x) << 16)
#define HIF(x) __uint_as_float((x) & 0xffff0000u)
__device__ __forceinline__ void ph_lru_scan1(const AP& a, const Frame& F) {
    const bf16* LA = (const bf16*)(a.ws + WS_SCR + SA_LA); const bf16* BB = (const bf16*)(a.ws + WS_SCR + SA_BB); float* PA = (float*)(a.ws + WS_SCR + SA_PA); float* PB = (float*)(a.ws + WS_SCR + SA_PB);
    for (int i = F.gt; i < NCH_L32 * 2 * 512; i += F.ngt) { const int ch = (i & 511) * 2, d = (i >> 9) & 1, c = i >> 10; float s0 = 0.f, s1 = 0.f, h0 = 0.f, h1 = 0.f;
        unsigned la[32], bb[32];
#pragma unroll
        for (int s = 0; s < 32; ++s) { const int t = c * 32 + (d == 0 ? s : 31 - s); const size_t o = ((size_t)d * T + t) * WB + ch; la[s] = *(const unsigned*)(LA + o); bb[s] = *(const unsigned*)(BB + o); }
#pragma unroll
        for (int s = 0; s < 32; ++s) { const float l0 = LOF(la[s]), l1 = HIF(la[s]); h0 = __expf(l0) * h0 + LOF(bb[s]); h1 = __expf(l1) * h1 + HIF(bb[s]); s0 += l0; s1 += l1; }
        const size_t o = ((size_t)c * 2 + d) * WB + ch; *(f32x2*)(PA + o) = (f32x2){__expf(s0), __expf(s1)}; *(f32x2*)(PB + o) = (f32x2){h0, h1}; }
}
__device__ __forceinline__ void ph_lru_scan2(const AP& a, const Frame& F) {
    const float* PA = (const float*)(a.ws + WS_SCR + SA_PA); const float* PB = (const float*)(a.ws + WS_SCR + SA_PB); float* CAR = (float*)(a.ws + WS_SCR + SA_CAR);
    LAS float* ex = (LAS float*)F.lds;
    for (int it = blockIdx.x; it < 5 * 2 * 16; it += gridDim.x) { const int slab = it & 15, d = (it >> 4) & 1, sq = it >> 5; const int c0 = sq == 0 ? 0 : 512 + (sq - 1) * 64, nc = sq == 0 ? 512 : 64, ns = nc / 8;
        const int ch = slab * 64 + F.lane, seg = F.wave; float p = 1.f, h = 0.f;
        for (int s0 = 0; s0 < ns; s0 += 8) { float pa[8], pb[8];
#pragma unroll
            for (int u = 0; u < 8; ++u) { const int sp = seg * ns + s0 + u, c = c0 + (d == 0 ? sp : nc - 1 - sp); const size_t o = ((size_t)c * 2 + d) * WB + ch; pa[u] = PA[o]; pb[u] = PB[o]; }
#pragma unroll
            for (int u = 0; u < 8; ++u) { h = pa[u] * h + pb[u]; p *= pa[u]; } }
        __syncthreads(); ex[(seg * 64 + F.lane) * 2] = p; ex[(seg * 64 + F.lane) * 2 + 1] = h; __syncthreads();
        float x = 0.f;
        for (int s2 = 0; s2 < seg; ++s2) x = ex[(s2 * 64 + F.lane) * 2] * x + ex[(s2 * 64 + F.lane) * 2 + 1];
        for (int s0 = 0; s0 < ns; s0 += 8) { float pa[8], pb[8];
#pragma unroll
            for (int u = 0; u < 8; ++u) { const int sp = seg * ns + s0 + u, c = c0 + (d == 0 ? sp : nc - 1 - sp); const size_t o = ((size_t)c * 2 + d) * WB + ch; pa[u] = PA[o]; pb[u] = PB[o]; }
#pragma unroll
            for (int u = 0; u < 8; ++u) { const int sp = seg * ns + s0 + u, c = c0 + (d == 0 ? sp : nc - 1 - sp); CAR[((size_t)c * 2 + d) * WB + ch] = x; x = pa[u] * x + pb[u]; } }
    }
}
__device__ __forceinline__ void ph_lru_scan3(const AP& a, const Frame& F) {
    const bf16* LA = (const bf16*)(a.ws + WS_SCR + SA_LA); const bf16* BB = (const bf16*)(a.ws + WS_SCR + SA_BB); const float* CAR = (const float*)(a.ws + WS_SCR + SA_CAR);
    const bf16* PROJ = (const bf16*)(a.ws + WS_PROJ); bf16* Y = (bf16*)(a.ws + WS_Y);
    for (int i = F.gt; i < NCH_L32 * 512; i += F.ngt) { const int ch = (i & 511) * 2, c = i >> 9;
        unsigned la[32], bb[32], hf[32];
#pragma unroll
        for (int s = 0; s < 32; ++s) { const size_t o = (size_t)(c * 32 + s) * WB + ch; la[s] = *(const unsigned*)(LA + o); bb[s] = *(const unsigned*)(BB + o); }
        f32x2 h = *(const f32x2*)(CAR + ((size_t)c * 2 + 0) * WB + ch);
#pragma unroll
        for (int s = 0; s < 32; ++s) { h[0] = __expf(LOF(la[s])) * h[0] + LOF(bb[s]); h[1] = __expf(HIF(la[s])) * h[1] + HIF(bb[s]); hf[s] = pk2(h[0], h[1]); }
        asm volatile("" ::: "memory");
#pragma unroll
        for (int s = 0; s < 32; ++s) { const size_t o = ((size_t)T + c * 32 + s) * WB + ch; la[s] = *(const unsigned*)(LA + o); bb[s] = *(const unsigned*)(BB + o); }
        h = *(const f32x2*)(CAR + ((size_t)c * 2 + 1) * WB + ch);
#pragma unroll
        for (int s0 = 16; s0 >= 0; s0 -= 16) { unsigned zq[16];
#pragma unroll
            for (int u = 0; u < 16; ++u) zq[u] = *(const unsigned*)(PROJ + (size_t)(c * 32 + s0 + u) * NPJ + C_LRUZ + ch);
#pragma unroll
            for (int u = 15; u >= 0; --u) { const int s = s0 + u; h[0] = __expf(LOF(la[s])) * h[0] + LOF(bb[s]); h[1] = __expf(HIF(la[s])) * h[1] + HIF(bb[s]); const unsigned zz = zq[u];
                *(unsigned*)(Y + (size_t)(c * 32 + s) * 4096 + ch) = pk2((LOF(hf[s]) + h[0]) * siluf_(LOF(zz)), (HIF(hf[s]) + h[1]) * siluf_(HIF(zz))); } } }
}
#undef LOF
#undef HIF

__device__ __forceinline__ void ph_s5_rearr(const AP& a, const Frame& F) {
    const bf16* PROJ = (const bf16*)(a.ws + WS_PROJ); bf16* UC = (bf16*)(a.ws + WS_SCR + SD_UC);
#pragma unroll 4
    for (int i = F.gt; i < T * 64; i += F.ngt) { const int g = i & 63, t = i >> 6, c = t >> 4, tau = t & 15; const u32x4* s = (const u32x4*)(PROJ + (size_t)t * NPJ + C_SU + g * 16);
        u32x4* d = (u32x4*)(UC + ((size_t)g * NCH_S5 + c) * 512 + tau * 16); d[0] = s[0]; d[1] = s[1]; }
}
__device__ __forceinline__ void ph_s5_scan(const AP& a, const Frame& F, int l) {
    const float* INC = (const float*)(a.ws + WS_SCR + SD_INC); bf16* UC = (bf16*)(a.ws + WS_SCR + SD_UC); const f32x2* TAB = (const f32x2*)(a.ws + WS_S5TAB);
    LAS float* ex = (LAS float*)F.lds;
    for (int it = blockIdx.x; it < 5 * 64 * 2; it += gridDim.x) { const int d = it & 1, g = (it >> 1) & 63, sq = it >> 7; const int c0 = sq == 0 ? 0 : 1024 + (sq - 1) * 128, nc = sq == 0 ? 1024 : 128, ns = nc / 8;
        const int n = F.lane, seg = F.wave; const f32x2 lc = TAB[((((size_t)l * 2 + d) * 64 + g) * 64 + n) * 33 + 32];
        float xr = 0.f, xi = 0.f, pr = 1.f, pi = 0.f;
        for (int s0 = 0; s0 < ns; s0 += 8) { float ir[8], ii[8];
#pragma unroll
            for (int u = 0; u < 8; ++u) { const int sp = seg * ns + s0 + u, c = c0 + (d == 0 ? sp : nc - 1 - sp); const size_t ro = (size_t)g * NCH_S5 + c; ir[u] = INC[ro * 256 + d * 128 + n]; ii[u] = INC[ro * 256 + d * 128 + 64 + n]; }
#pragma unroll
            for (int u = 0; u < 8; ++u) { const float nr = lc.x * xr - lc.y * xi + ir[u], ni = lc.x * xi + lc.y * xr + ii[u]; xr = nr; xi = ni; const float qr = lc.x * pr - lc.y * pi, qi = lc.x * pi + lc.y * pr; pr = qr; pi = qi; } }
        __syncthreads(); ex[(seg * 64 + n) * 2] = xr; ex[(seg * 64 + n) * 2 + 1] = xi; __syncthreads();
        xr = 0.f; xi = 0.f;
        for (int s2 = 0; s2 < seg; ++s2) { const float er = ex[(s2 * 64 + n) * 2], ei = ex[(s2 * 64 + n) * 2 + 1]; const float nr = pr * xr - pi * xi + er, ni = pr * xi + pi * xr + ei; xr = nr; xi = ni; }
        for (int s0 = 0; s0 < ns; s0 += 8) { float ir[8], ii[8];
#pragma unroll
            for (int u = 0; u < 8; ++u) { const int sp = seg * ns + s0 + u, c = c0 + (d == 0 ? sp : nc - 1 - sp); const size_t ro = (size_t)g * NCH_S5 + c; ir[u] = INC[ro * 256 + d * 128 + n]; ii[u] = INC[ro * 256 + d * 128 + 64 + n]; }
#pragma unroll
            for (int u = 0; u < 8; ++u) { const int sp = seg * ns + s0 + u, c = c0 + (d == 0 ? sp : nc - 1 - sp); const size_t ro = (size_t)g * NCH_S5 + c;
                UC[ro * 512 + 256 + d * 128 + n] = (bf16)f2bf(xr); UC[ro * 512 + 256 + d * 128 + 64 + n] = (bf16)f2bf(xi);
                const float nr = lc.x * xr - lc.y * xi + ir[u], ni = lc.x * xi + lc.y * xr + ii[u]; xr = nr; xi = ni; } }
    }
}
template <int NT> __device__ __forceinline__ void mma_lds(f32x4 (&acc)[NT], const LAS bf16* As, int pa, const LAS bf16* Bs, int pb, int K, int lane) {
    const int r = lane & 15, q = lane >> 4;
    for (int kk = 0; kk < K; kk += 32) { const bf16x8 av = *(const LAS bf16x8*)(As + r * pa + kk + q * 8);
#pragma unroll
        for (int nt = 0; nt < NT; ++nt) { const bf16x8 bv = *(const LAS bf16x8*)(Bs + (nt * 16 + r) * pb + kk + q * 8); acc[nt] = __builtin_amdgcn_mfma_f32_16x16x32_bf16(av, bv, acc[nt], 0, 0, 0); } }
}
template <int NT> __device__ __forceinline__ void mma_glb(f32x4 (&acc)[NT], const LAS bf16* As, int pa, const bf16* Bg, int pb, int K, int lane) {
    const int r = lane & 15, q = lane >> 4;
    for (int kk = 0; kk < K; kk += 32) { const bf16x8 av = *(const LAS bf16x8*)(As + r * pa + kk + q * 8);
#pragma unroll
        for (int n0 = 0; n0 < NT; n0 += 8) { bf16x8 bv[8];
#pragma unroll
            for (int u = 0; u < 8; ++u) bv[u] = *(const bf16x8*)(Bg + (size_t)((n0 + u) * 16 + r) * pb + kk + q * 8);
#pragma unroll
            for (int u = 0; u < 8; ++u) acc[n0 + u] = __builtin_amdgcn_mfma_f32_16x16x32_bf16(av, bv[u], acc[n0 + u], 0, 0, 0); } }
}
#define LBAR() do { asm volatile("s_waitcnt lgkmcnt(0)" ::: "memory"); __builtin_amdgcn_s_barrier(); asm volatile("" ::: "memory"); } while (0)
constexpr int RP = 136;
__device__ __forceinline__ float ret_log2g(int h) { return log2f(1.0f - exp2f(-5.0f - (float)h)); }

__device__ __forceinline__ void ph_ret_kv(const AP& a, const Frame& F) {
    const bf16* PROJ = (const bf16*)(a.ws + WS_PROJ); const f32x2* ROT = (const f32x2*)(a.ws + WS_ROT); bf16* KVT = (bf16*)(a.ws + WS_SCR + SC_KVT);
    LAS bf16* VT = (LAS bf16*)F.lds; LAS bf16* KTf = VT + 128 * RP; LAS bf16* KTb = KTf + 128 * RP;
    for (int it = blockIdx.x; it < NCH_RET * 4 * 2; it += gridDim.x) { const int eh = it & 1, h = (it >> 1) & 3, cn = it >> 3; const float l2g = ret_log2g(h);
        LBAR();
        { const int pp = F.lane, ta = cn * 128 + 2 * pp;
#pragma unroll
          for (int oc = 0; oc < 2; ++oc) { const int e8 = (F.wave * 2 + oc) * 8;
              const u32x4 va = *(const u32x4*)(PROJ + (size_t)ta * NPJ + C_RV + h * 256 + eh * 128 + e8), vb = *(const u32x4*)(PROJ + (size_t)(ta + 1) * NPJ + C_RV + h * 256 + eh * 128 + e8);
              const unsigned wa[4] = {va.x, va.y, va.z, va.w}, wb[4] = {vb.x, vb.y, vb.z, vb.w};
#pragma unroll
              for (int i = 0; i < 4; ++i) { *(LAS unsigned*)(VT + (e8 + 2 * i) * RP + 2 * pp) = (wa[i] & 0xffffu) | (wb[i] << 16); *(LAS unsigned*)(VT + (e8 + 2 * i + 1) * RP + 2 * pp) = (wa[i] >> 16) | (wb[i] & 0xffff0000u); } }
          { const int i8 = F.wave * 8; int posa, L; seq_of(ta, posa, L);
            float x1a[8], x2a[8], x1b[8], x2b[8];
            unpack8(*(const u32x4*)(PROJ + (size_t)ta * NPJ + C_RK + h * 128 + i8), x1a); unpack8(*(const u32x4*)(PROJ + (size_t)ta * NPJ + C_RK + h * 128 + 64 + i8), x2a);
            unpack8(*(const u32x4*)(PROJ + (size_t)(ta + 1) * NPJ + C_RK + h * 128 + i8), x1b); unpack8(*(const u32x4*)(PROJ + (size_t)(ta + 1) * NPJ + C_RK + h * 128 + 64 + i8), x2b);
            const f32x4* ra = (const f32x4*)(ROT + (size_t)posa * 64 + i8); const f32x4* rb = (const f32x4*)(ROT + (size_t)(posa + 1) * 64 + i8);
            const float sc = 0.08838834764831845f; const float dfa = __builtin_amdgcn_exp2f(l2g * (float)(127 - 2 * pp)) * sc, dba = __builtin_amdgcn_exp2f(l2g * (float)(2 * pp)) * sc, dfb = __builtin_amdgcn_exp2f(l2g * (float)(126 - 2 * pp)) * sc, dbb = __builtin_amdgcn_exp2f(l2g * (float)(2 * pp + 1)) * sc;
#pragma unroll
            for (int i2 = 0; i2 < 4; ++i2) { const f32x4 ca = ra[i2], cb2 = rb[i2];
#pragma unroll
                for (int u = 0; u < 2; ++u) { const int i = 2 * i2 + u; const float c_a = ca[2 * u], s_a = ca[2 * u + 1], c_b = cb2[2 * u], s_b = cb2[2 * u + 1];
                    const float o1a = x1a[i] * c_a - x2a[i] * s_a, o2a = x1a[i] * s_a + x2a[i] * c_a, o1b = x1b[i] * c_b - x2b[i] * s_b, o2b = x1b[i] * s_b + x2b[i] * c_b;
                    *(LAS unsigned*)(KTf + (i8 + i) * RP + 2 * pp) = pk2(o1a * dfa, o1b * dfb); *(LAS unsigned*)(KTf + (64 + i8 + i) * RP + 2 * pp) = pk2(o2a * dfa, o2b * dfb);
                    *(LAS unsigned*)(KTb + (i8 + i) * RP + 2 * pp) = pk2(o1a * dba, o1b * dbb); *(LAS unsigned*)(KTb + (64 + i8 + i) * RP + 2 * pp) = pk2(o2a * dba, o2b * dbb); } } } }
        LBAR();
        f32x4 af[8], ab[8];
#pragma unroll
        for (int n = 0; n < 8; ++n) { af[n] = (f32x4){0.f, 0.f, 0.f, 0.f}; ab[n] = (f32x4){0.f, 0.f, 0.f, 0.f}; }
        mma_lds<8>(af, KTf + F.wave * 16 * RP, RP, VT, RP, 128, F.lane); mma_lds<8>(ab, KTb + F.wave * 16 * RP, RP, VT, RP, 128, F.lane);
        const int r = F.lane & 15, q4 = F.lane >> 4; const size_t item = (size_t)cn * 4 + h;
#pragma unroll
        for (int n = 0; n < 8; ++n) { const int e = eh * 128 + n * 16 + r, d0 = F.wave * 16 + q4 * 4; *(u32x2*)(KVT + ((0 * 768 + item) * 256 + e) * 128 + d0) = (u32x2){pk2(af[n][0], af[n][1]), pk2(af[n][2], af[n][3])}; *(u32x2*)(KVT + ((768 + item) * 256 + e) * 128 + d0) = (u32x2){pk2(ab[n][0], ab[n][1]), pk2(ab[n][2], ab[n][3])}; }
    }
}
__device__ __forceinline__ void ph_ret_scan(const AP& a, const Frame& F) {
    const unsigned* KVT = (const unsigned*)(a.ws + WS_SCR + SC_KVT); unsigned* STP = (unsigned*)(a.ws + WS_STP);
    for (int i = F.gt; i < 5 * 2 * 4 * 16384; i += F.ngt) { const int ed = i & 16383, h = (i >> 14) & 3, dir = (i >> 16) & 1, sq = i >> 17; const int c0 = sq == 0 ? 0 : 128 + (sq - 1) * 16, nc = sq == 0 ? 128 : 16;
        const float g128 = __builtin_amdgcn_exp2f(ret_log2g(h) * 128.0f); float s0_ = 0.f, s1_ = 0.f;
        for (int s0 = 0; s0 < nc; s0 += 16) { unsigned kv[16];
#pragma unroll
            for (int u = 0; u < 16; ++u) { const int cn = c0 + (dir == 0 ? s0 + u : nc - 1 - s0 - u); kv[u] = KVT[(((size_t)dir * 768 + cn * 4 + h) * 16384) + ed]; }
#pragma unroll
            for (int u = 0; u < 16; ++u) { const int cn = c0 + (dir == 0 ? s0 + u : nc - 1 - s0 - u); STP[(((size_t)dir * 768 + cn * 4 + h) * 16384) + ed] = pk2(s0_, s1_);
                s0_ = g128 * s0_ + __uint_as_float(kv[u] << 16); s1_ = g128 * s1_ + __uint_as_float(kv[u] & 0xffff0000u); } } }
}
__device__ __forceinline__ void ph_ret_out(const AP& a, const Frame& F, int l) {
    const bf16* PROJ = (const bf16*)(a.ws + WS_PROJ); const f32x2* ROT = (const f32x2*)(a.ws + WS_ROT); const bf16* STP = (const bf16*)(a.ws + WS_STP); bf16* Y = (bf16*)(a.ws + WS_Y);
    const float* gn = a.in(I_GNG) + (size_t)l * WB;
    LAS bf16* Qs = (LAS bf16*)F.lds; LAS bf16* Ks = Qs + 128 * RP; LAS bf16* VT = Ks + 128 * RP;
    unsigned* cnt = (unsigned*)(a.ws + WS_CTL) + 16384 + 64 * l; volatile LAS unsigned* tick = (volatile LAS unsigned*)(F.lds + LDS_MISC) + 16;
    for (;;) { LBAR(); if (F.tid == 0) tick[0] = __hip_atomic_fetch_add(cnt, 1u, __ATOMIC_RELAXED, __HIP_MEMORY_SCOPE_AGENT); LBAR();
        const int it = (int)tick[0]; if (it >= NCH_RET * 4) break; const int h = it & 3, cn = it >> 2; const float l2g = ret_log2g(h);
        LBAR();
        { const int pp = F.lane, ta = cn * 128 + 2 * pp;
#pragma unroll
          for (int oc = 0; oc < 4; ++oc) { const int e8 = (F.wave * 4 + oc) * 8;
              const u32x4 va = *(const u32x4*)(PROJ + (size_t)ta * NPJ + C_RV + h * 256 + e8), vb = *(const u32x4*)(PROJ + (size_t)(ta + 1) * NPJ + C_RV + h * 256 + e8);
              const unsigned wa[4] = {va.x, va.y, va.z, va.w}, wb[4] = {vb.x, vb.y, vb.z, vb.w};
#pragma unroll
              for (int i = 0; i < 4; ++i) { *(LAS unsigned*)(VT + (e8 + 2 * i) * RP + 2 * pp) = (wa[i] & 0xffffu) | (wb[i] << 16); *(LAS unsigned*)(VT + (e8 + 2 * i + 1) * RP + 2 * pp) = (wa[i] >> 16) | (wb[i] & 0xffff0000u); } } }
#pragma unroll
        for (int rep2 = 0; rep2 < 2; ++rep2) { const int qq = F.tid + rep2 * NTHR, j = qq >> 3, i8 = (qq & 7) * 8; const int t = cn * 128 + j; int pos, L; seq_of(t, pos, L);
            float k1[8], k2[8], q1[8], q2[8], ok1[8], ok2[8], oq1[8], oq2[8];
            unpack8(*(const u32x4*)(PROJ + (size_t)t * NPJ + C_RK + h * 128 + i8), k1); unpack8(*(const u32x4*)(PROJ + (size_t)t * NPJ + C_RK + h * 128 + 64 + i8), k2);
            unpack8(*(const u32x4*)(PROJ + (size_t)t * NPJ + C_RQ + h * 128 + i8), q1); unpack8(*(const u32x4*)(PROJ + (size_t)t * NPJ + C_RQ + h * 128 + 64 + i8), q2);
            const f32x4* rr = (const f32x4*)(ROT + (size_t)pos * 64 + i8); const float sc = 0.08838834764831845f;
#pragma unroll
            for (int i2 = 0; i2 < 4; ++i2) { const f32x4 cs4 = rr[i2];
#pragma unroll
                for (int u = 0; u < 2; ++u) { const int i = 2 * i2 + u; const float c = cs4[2 * u], s = cs4[2 * u + 1];
                    ok1[i] = (k1[i] * c - k2[i] * s) * sc; ok2[i] = (k1[i] * s + k2[i] * c) * sc; oq1[i] = q1[i] * c - q2[i] * s; oq2[i] = q1[i] * s + q2[i] * c; } }
            *(LAS u32x4*)(Ks + j * RP + i8) = pack8(ok1); *(LAS u32x4*)(Ks + j * RP + 64 + i8) = pack8(ok2); *(LAS u32x4*)(Qs + j * RP + i8) = pack8(oq1); *(LAS u32x4*)(Qs + j * RP + 64 + i8) = pack8(oq2); }
        LBAR();
        const int r = F.lane & 15, q4 = F.lane >> 4, i0 = F.wave * 16 + q4 * 4;
        f32x4 sa[8];
#pragma unroll
        for (int n = 0; n < 8; ++n) sa[n] = (f32x4){0.f, 0.f, 0.f, 0.f};
        mma_lds<8>(sa, Qs + F.wave * 16 * RP, RP, Ks, RP, 128, F.lane);
        LBAR();
#pragma unroll
        for (int n = 0; n < 8; ++n)
#pragma unroll
            for (int j = 0; j < 4; ++j) { const int i = i0 + j, jj = n * 16 + r; const int dd = i > jj ? i - jj : jj - i; Ks[i * RP + jj] = (bf16)f2bf(sa[n][j] * __builtin_amdgcn_exp2f(l2g * (float)dd)); }
        asm volatile("s_waitcnt lgkmcnt(0)" ::: "memory");
        f32x4 o[16];
#pragma unroll
        for (int n = 0; n < 16; ++n) o[n] = (f32x4){0.f, 0.f, 0.f, 0.f};
        const size_t item = (size_t)cn * 4 + h;
        float r1[4], f2[4];
#pragma unroll
        for (int j = 0; j < 4; ++j) { r1[j] = __builtin_amdgcn_exp2f(l2g * (float)(2 * (i0 + j) - 127)); f2[j] = __builtin_amdgcn_exp2f(l2g * (float)(128 - i0 - j)); }
        mma_glb<16>(o, Qs + F.wave * 16 * RP, RP, STP + (0 * 768 + item) * 32768, 128, 128, F.lane);
#pragma unroll
        for (int n = 0; n < 16; ++n)
#pragma unroll
            for (int j = 0; j < 4; ++j) o[n][j] *= r1[j];
        mma_glb<16>(o, Qs + F.wave * 16 * RP, RP, STP + (768 + item) * 32768, 128, 128, F.lane);
#pragma unroll
        for (int n = 0; n < 16; ++n)
#pragma unroll
            for (int j = 0; j < 4; ++j) o[n][j] *= f2[j];
        mma_lds<16>(o, Ks + F.wave * 16 * RP, RP, VT, RP, 128, F.lane);
        float gnv[16];
#pragma unroll
        for (int n = 0; n < 16; ++n) gnv[n] = gn[h * 256 + n * 16 + r];
#pragma unroll
        for (int j = 0; j < 4; ++j) { float s = 0.f; unsigned short zz[16];
#pragma unroll
            for (int n = 0; n < 16; ++n) zz[n] = PROJ[(size_t)(cn * 128 + i0 + j) * NPJ + C_RZ + h * 256 + n * 16 + r];
#pragma unroll
            for (int n = 0; n < 16; ++n) s += o[n][j];
            s += shx<1>(s); s += shx<2>(s); s += shx<4>(s); s += shx<8>(s); const float mean = s * (1.0f / 256.0f); float v = 0.f;
#pragma unroll
            for (int n = 0; n < 16; ++n) { const float dlt = o[n][j] - mean; v += dlt * dlt; }
            v += shx<1>(v); v += shx<2>(v); v += shx<4>(v); v += shx<8>(v); const float rstd = __builtin_amdgcn_rsqf(v * (1.0f / 256.0f) + 1e-5f);
            const int t = cn * 128 + i0 + j;
#pragma unroll
            for (int n = 0; n < 16; ++n) { const int e = n * 16 + r; Y[(size_t)t * 4096 + 2048 + h * 256 + e] = (bf16)f2bf((o[n][j] - mean) * rstd * gnv[n] * siluf_(bf2f(zz[n]))); } }
    }
}

__device__ __forceinline__ float rdl(float x, int j) { return __int_as_float(__builtin_amdgcn_readlane(__float_as_int(x), j)); }
__device__ __forceinline__ void ph_rwkv_prep(const AP& a, const Frame& F, int l) {
    const bf16* PROJ = (const bf16*)(a.ws + WS_PROJ); unsigned char* S = a.ws + WS_SCR;
    bf16* R = (bf16*)(S + SB_R); bf16* KM = (bf16*)(S + SB_KM); bf16* V = (bf16*)(S + SB_V); bf16* KK = (bf16*)(S + SB_KK); bf16* AG = (bf16*)(S + SB_AG); bf16* LWF = (bf16*)(S + SB_LWF); bf16* LWB = (bf16*)(S + SB_LWB); const bf16* LO = (const bf16*)(S + SB_LO);
    const float* mu = a.in(I_MU) + (size_t)l * 3 * WB; const float* w0 = a.in(I_W0) + (size_t)l * 2 * WB;
    const float* a0 = a.in(I_A0) + (size_t)l * WB; const float* kkp = a.in(I_KK) + (size_t)l * WB; const float* kap = a.in(I_KA) + (size_t)l * WB;
#define UP4(W_, O_) do { const u32x2 w_ = (W_); O_[0] = __uint_as_float(w_[0] << 16); O_[1] = __uint_as_float(w_[0] & 0xffff0000u); O_[2] = __uint_as_float(w_[1] << 16); O_[3] = __uint_as_float(w_[1] & 0xffff0000u); } while (0)
#define PK4(O_) ((u32x2){pk2(O_[0], O_[1]), pk2(O_[2], O_[3])})
    for (int it = F.gw; it < (T / 4) * 4; it += F.ngw) { const int hq = it & 3, t0 = (it >> 2) * 4, c = hq * 256 + F.lane * 4; int pos0, L; seq_of(t0, pos0, L);
        u32x2 xr[6], xk[6], xv[6];
#pragma unroll
        for (int i = 0; i < 6; ++i) { const int pp = pos0 + i - 1; const bool ok = pp >= 0 && pp < L; const bf16* pr = PROJ + (size_t)(t0 + i - 1) * NPJ + c; const u32x2 z2 = (u32x2){0u, 0u};
            xr[i] = ok ? *(const u32x2*)(pr + C_RWR) : z2; xk[i] = ok ? *(const u32x2*)(pr + C_RWK) : z2; xv[i] = ok ? *(const u32x2*)(pr + C_RWV) : z2; }
        u32x2 lo0[4], lo1[4], lo2[4];
#pragma unroll
        for (int i = 0; i < 4; ++i) { const bf16* lo = LO + (size_t)(t0 + i) * 3072 + c; lo0[i] = *(const u32x2*)lo; lo1[i] = *(const u32x2*)(lo + 1024); lo2[i] = *(const u32x2*)(lo + 2048); }
        const f32x4 mur = *(const f32x4*)(mu + c), muk = *(const f32x4*)(mu + WB + c), muv = *(const f32x4*)(mu + 2 * WB + c), w0f = *(const f32x4*)(w0 + c), w0b = *(const f32x4*)(w0 + WB + c),
                    a0v = *(const f32x4*)(a0 + c), kkw = *(const f32x4*)(kkp + c), kaw = *(const f32x4*)(kap + c);
#pragma unroll
        for (int i = 0; i < 4; ++i) { const int t = t0 + i; float rp[4], r0[4], rn[4], kp[4], k0[4], kn[4], vp[4], v0[4], vn[4], l0[4], l1[4], l2[4];
            UP4(xr[i], rp); UP4(xr[i + 1], r0); UP4(xr[i + 2], rn); UP4(xk[i], kp); UP4(xk[i + 1], k0); UP4(xk[i + 2], kn); UP4(xv[i], vp); UP4(xv[i + 1], v0); UP4(xv[i + 2], vn); UP4(lo0[i], l0); UP4(lo1[i], l1); UP4(lo2[i], l2);
            float rm[4], km[4], vm[4], ag[4], kk[4], kd[4], lf[4], lb[4]; float ss = 0.f;
#pragma unroll
            for (int e = 0; e < 4; ++e) { rm[e] = r0[e] + mur[e] * (0.5f * (rp[e] + rn[e]) - r0[e]); km[e] = k0[e] + muk[e] * (0.5f * (kp[e] + kn[e]) - k0[e]); vm[e] = v0[e] + muv[e] * (0.5f * (vp[e] + vn[e]) - v0[e]);
                ag[e] = sigmoidf_(a0v[e] + l2[e]); kk[e] = km[e] * kkw[e]; ss += kk[e] * kk[e]; kd[e] = km[e] * (1.0f + (ag[e] - 1.0f) * kaw[e]);
                lf[e] = -0.6065306597126334f * sigmoidf_(w0f[e] + l0[e]); lb[e] = -0.6065306597126334f * sigmoidf_(w0b[e] + l1[e]); }
            ss += shx<1>(ss); ss += shx<2>(ss); ss += shx<4>(ss); ss += shx<8>(ss);
            const float inv = fminf(__builtin_amdgcn_rsqf(ss), 1e12f); float ka[4];
#pragma unroll
            for (int e = 0; e < 4; ++e) { kk[e] *= inv; ka[e] = ag[e]; }
            const size_t o = (size_t)t * WB + c;
            *(u32x2*)(R + o) = PK4(rm); *(u32x2*)(KM + o) = PK4(kd); *(u32x2*)(V + o) = PK4(vm); *(u32x2*)(KK + o) = PK4(kk); *(u32x2*)(AG + o) = PK4(ka); *(u32x2*)(LWF + o) = PK4(lf); *(u32x2*)(LWB + o) = PK4(lb); }
    }
}
constexpr int P72 = 72, SLOT = 64 * P72;
__device__ __forceinline__ void mm2(f32x4 (&acc)[2], const LAS bf16* A, const LAS bf16* Bt, int wave, int lane) { asm volatile("" : "+v"(lane));
    mma_lds<2>(acc, A + (wave >> 1) * 16 * P72, P72, Bt + (wave & 1) * 32 * P72, P72, 64, lane); }
#define RW_FOREACH(acc) _Pragma("unroll") for (int nt = 0; nt < 2; ++nt) _Pragma("unroll") for (int j = 0; j < 4; ++j)
#define RW_BASE int rb_ = (F.wave >> 1) * 16 + (F.lane >> 4) * 4, cb_ = (F.wave & 1) * 32 + (F.lane & 15); asm volatile("" : "+v"(rb_), "+v"(cb_));
#define RW_ROW (rb_ + j)
#define RW_COL (cb_ + nt * 16)
__device__ __forceinline__ void ph_rwkv_chunk(const AP& a, const Frame& F) {
    unsigned char* S = a.ws + WS_SCR; bf16* CH = (bf16*)(S + SB_CH);
    const bf16* R = (const bf16*)(S + SB_R); const bf16* KM = (const bf16*)(S + SB_KM); const bf16* V = (const bf16*)(S + SB_V); const bf16* KK = (const bf16*)(S + SB_KK); const bf16* AG = (const bf16*)(S + SB_AG);
    LAS bf16* lb = (LAS bf16*)F.lds;
#define SL(i) (lb + (i) * SLOT)
    LAS float* NF = (LAS float*)SL(12);
    LAS float* GC = (LAS float*)(F.lds + 15 * SLOT * 2);
    LAS float* TOT = GC + 64;
    const f32x4 z4 = (f32x4){0.f, 0.f, 0.f, 0.f};
#ifndef CHUNK_REP
#define CHUNK_REP 1
#endif
    u32x4 pre0, pre1, pre2, pre3, pre4, pre5, pre6;
#define RAW_LOAD(it_, dir_) do { const int hd_ = (it_) & 15, cn_ = (it_) >> 4; const bf16* LW_ = (const bf16*)(S + ((dir_) ? SB_LWB : SB_LWF)); int tid_ = F.tid; asm volatile("" : "+v"(tid_)); \
        const int j_ = tid_ >> 3, c8_ = (tid_ & 7) * 8; const int t_ = cn_ * 64 + ((dir_) ? 63 - j_ : j_); const size_t o_ = (size_t)t_ * WB + hd_ * 64 + c8_; \
        pre0 = *(const u32x4*)(LW_ + o_); pre1 = *(const u32x4*)(KK + o_); pre2 = *(const u32x4*)(AG + o_); pre3 = *(const u32x4*)(KM + o_); pre4 = *(const u32x4*)(R + o_); \
        const int pp_ = tid_ & 31, v8_ = ((tid_ >> 5) & 7) * 8; const int ta_ = cn_ * 64 + ((dir_) ? 63 - 2 * pp_ : 2 * pp_), tb_ = cn_ * 64 + ((dir_) ? 62 - 2 * pp_ : 2 * pp_ + 1); \
        pre5 = *(const u32x4*)(V + (size_t)ta_ * WB + hd_ * 64 + v8_); pre6 = *(const u32x4*)(V + (size_t)tb_ * WB + hd_ * 64 + v8_); } while (0)
    for (int rep = 0; rep < CHUNK_REP; ++rep) {
    if ((int)blockIdx.x < (T / 64) * 16) RAW_LOAD((int)blockIdx.x, 0);
    for (int it = blockIdx.x; it < (T / 64) * 16; it += gridDim.x) { const int hd = it & 15, cn = it >> 4; (void)hd; (void)cn;
        for (int dir = 0; dir < 2; ++dir) {
            bf16* outb = CH + ((size_t)it * 2 + dir) * 4 * 4096;
            LBAR();
            { int tid_ = F.tid; asm volatile("" : "+v"(tid_)); const int j = tid_ >> 3, c8 = (tid_ & 7) * 8;
              *(LAS u32x4*)(SL(8) + j * P72 + c8) = pre0; *(LAS u32x4*)(SL(9) + j * P72 + c8) = pre1; *(LAS u32x4*)(SL(10) + j * P72 + c8) = pre2; *(LAS u32x4*)(SL(11) + j * P72 + c8) = pre3; *(LAS u32x4*)(SL(12) + j * P72 + c8) = pre4;
              if (tid_ < 256) { const int pp = tid_ & 31, v8 = (tid_ >> 5) * 8; const unsigned wa[4] = {pre5.x, pre5.y, pre5.z, pre5.w}, wb[4] = {pre6.x, pre6.y, pre6.z, pre6.w};
#pragma unroll
                  for (int i = 0; i < 4; ++i) { *(LAS unsigned*)(SL(7) + (v8 + 2 * i) * P72 + 2 * pp) = (wa[i] & 0xffffu) | (wb[i] << 16); *(LAS unsigned*)(SL(7) + (v8 + 2 * i + 1) * P72 + 2 * pp) = (wa[i] >> 16) | (wb[i] & 0xffff0000u); } }
              const int nit = dir ? it + (int)gridDim.x : it;
              if (nit < (T / 64) * 16) RAW_LOAD(nit, dir ^ 1); }
            LBAR();
            { int k = F.lane; asm volatile("" : "+v"(k)); const int seg = F.wave;
              float cum[8]; float run = 0.f;
#pragma unroll
              for (int i = 0; i < 8; ++i) { run += bf2f(SL(8)[(seg * 8 + i) * P72 + k]); cum[i] = run; }
              TOT[seg * 64 + k] = run;
              LBAR();
              float off = 0.f;
              for (int s2 = 0; s2 < seg; ++s2) off += TOT[s2 * 64 + k];
              unsigned ta[4], tb[4], tk[4]; float Gprev = __expf(off);
#pragma unroll
              for (int ip = 0; ip < 4; ++ip) { float fa[2], fb[2], fk[2], fr[2];
#pragma unroll
                  for (int u = 0; u < 2; ++u) { const int i = 2 * ip + u, t = seg * 8 + i; const float cl = off + cum[i];
                      const float kkv = bf2f(SL(9)[t * P72 + k]), agv = bf2f(SL(10)[t * P72 + k]), kmv = bf2f(SL(11)[t * P72 + k]), rv = bf2f(SL(12)[t * P72 + k]);
                      const float G = __expf(cl), Gi = __expf(-cl);
                      fa[u] = -kkv * Gprev; fb[u] = kkv * agv * Gi; fk[u] = kmv * Gi; fr[u] = rv * G; Gprev = G;
                      if (t == 63) GC[k] = G; }
                  const unsigned wa = pk2(fa[0], fa[1]), wb = pk2(fb[0], fb[1]), wk = pk2(fk[0], fk[1]), wr2 = pk2(fr[0], fr[1]); const int t0 = seg * 8 + 2 * ip;
                  SL(0)[t0 * P72 + k] = (bf16)wa; SL(0)[(t0 + 1) * P72 + k] = (bf16)(wa >> 16); SL(1)[t0 * P72 + k] = (bf16)wb; SL(1)[(t0 + 1) * P72 + k] = (bf16)(wb >> 16);
                  SL(2)[t0 * P72 + k] = (bf16)wk; SL(2)[(t0 + 1) * P72 + k] = (bf16)(wk >> 16); SL(6)[t0 * P72 + k] = (bf16)wr2; SL(6)[(t0 + 1) * P72 + k] = (bf16)(wr2 >> 16);
                  ta[ip] = wa; tb[ip] = wb; tk[ip] = wk; }
              *(LAS u32x4*)(SL(3) + k * P72 + seg * 8) = (u32x4){ta[0], ta[1], ta[2], ta[3]}; *(LAS u32x4*)(SL(4) + k * P72 + seg * 8) = (u32x4){tb[0], tb[1], tb[2], tb[3]}; *(LAS u32x4*)(SL(5) + k * P72 + seg * 8) = (u32x4){tk[0], tk[1], tk[2], tk[3]}; }
            LBAR();
#define PK4S(dst_, v0_, v1_, v2_, v3_) *(LAS u32x2*)(dst_) = (u32x2){pk2(v0_, v1_), pk2(v2_, v3_)}
            { f32x4 c1[2] = {z4, z4}, c2[2] = {z4, z4}, c3[2] = {z4, z4}, c4[2] = {z4, z4};
              mm2(c1, SL(1), SL(0), F.wave, F.lane);
              mm2(c2, SL(0), SL(2), F.wave, F.lane);
              mm2(c3, SL(1), SL(6), F.wave, F.lane);
              mm2(c4, SL(2), SL(6), F.wave, F.lane);
              RW_BASE
#pragma unroll
              for (int nt = 0; nt < 2; ++nt) { const int cc = cb_ + nt * 16, r0 = rb_;
                  { f32x4 v;
#pragma unroll
                    for (int j = 0; j < 4; ++j) v[j] = (r0 + j) < cc ? c1[nt][j] : 0.f;
                    *(LAS f32x4*)(NF + cc * 68 + r0) = v; }
                  PK4S(SL(8) + cc * P72 + r0, cc < r0 ? c2[nt][0] : 0.f, cc < r0 + 1 ? c2[nt][1] : 0.f, cc < r0 + 2 ? c2[nt][2] : 0.f, cc < r0 + 3 ? c2[nt][3] : 0.f);
                  PK4S(SL(9) + cc * P72 + r0, r0 <= cc ? c3[nt][0] : 0.f, r0 + 1 <= cc ? c3[nt][1] : 0.f, r0 + 2 <= cc ? c3[nt][2] : 0.f, r0 + 3 <= cc ? c3[nt][3] : 0.f);
                  PK4S(SL(10) + cc * P72 + r0, r0 <= cc ? c4[nt][0] : 0.f, r0 + 1 <= cc ? c4[nt][1] : 0.f, r0 + 2 <= cc ? c4[nt][2] : 0.f, r0 + 3 <= cc ? c4[nt][3] : 0.f); } }
            LBAR();
            {
              int tid2_ = F.tid; asm volatile("" : "+v"(tid2_)); const int t = tid2_ >> 3, j8 = (tid2_ & 7) * 8; const bool offd = (t >> 4) != (j8 >> 4);
              { const f32x4 n0 = *(const LAS f32x4*)(NF + t * 68 + j8), n1 = *(const LAS f32x4*)(NF + t * 68 + j8 + 4); u32x4 w = (u32x4){0u, 0u, 0u, 0u};
                if (offd) { w.x = pk2(n0[0], n0[1]); w.y = pk2(n0[2], n0[3]); w.z = pk2(n1[0], n1[1]); w.w = pk2(n1[2], n1[3]); }
                *(LAS u32x4*)(SL(0) + t * P72 + j8) = w;
                if (offd) { *(LAS u32x4*)(SL(1) + t * P72 + j8) = (u32x4){0u, 0u, 0u, 0u}; *(LAS u32x4*)(SL(2) + t * P72 + j8) = (u32x4){0u, 0u, 0u, 0u}; } }
              if (tid2_ < 64) { const int b0 = (tid2_ >> 4) * 16, i = tid2_ & 15; float tr[16];
#pragma unroll
                  for (int tt = 0; tt < 16; ++tt) { float val = (tt == i) ? 1.f : 0.f;
#pragma unroll
                      for (int jj = 0; jj < tt; ++jj) val += (jj >= i ? tr[jj] : 0.f) * NF[(b0 + tt) * 68 + b0 + jj];
                      tr[tt] = (tt < i) ? 0.f : val; }
#pragma unroll
                  for (int tt = 0; tt < 16; ++tt) { const bf16 x = (bf16)f2bf(tr[tt]); SL(1)[(b0 + i) * P72 + b0 + tt] = x; SL(2)[(b0 + tt) * P72 + b0 + i] = x; } } }
            LBAR();
            { f32x4 c1[2] = {z4, z4}, c2[2] = {z4, z4};
              mm2(c1, SL(1), SL(0), F.wave, F.lane);
              mm2(c2, SL(0), SL(1), F.wave, F.lane);
              RW_BASE
#pragma unroll
              for (int nt = 0; nt < 2; ++nt) { const int cc = cb_ + nt * 16, r0 = rb_;
                  PK4S(SL(14) + cc * P72 + r0, c1[nt][0], c1[nt][1], c1[nt][2], c1[nt][3]);
                  PK4S(SL(11) + cc * P72 + r0, c2[nt][0], c2[nt][1], c2[nt][2], c2[nt][3]);
                  PK4S(SL(13) + cc * P72 + r0, c2[nt][0] + (cc == r0 ? 1.f : 0.f), c2[nt][1] + (cc == r0 + 1 ? 1.f : 0.f), c2[nt][2] + (cc == r0 + 2 ? 1.f : 0.f), c2[nt][3] + (cc == r0 + 3 ? 1.f : 0.f)); } }
            LBAR();
            { f32x4 c[2] = {z4, z4}; mm2(c, SL(11), SL(14), F.wave, F.lane);
              RW_BASE
#pragma unroll
              for (int nt = 0; nt < 2; ++nt) { const int cc = cb_ + nt * 16, r0 = rb_;
                  PK4S(SL(12) + cc * P72 + r0, c[nt][0] + (cc == r0 ? 1.f : 0.f), c[nt][1] + (cc == r0 + 1 ? 1.f : 0.f), c[nt][2] + (cc == r0 + 2 ? 1.f : 0.f), c[nt][3] + (cc == r0 + 3 ? 1.f : 0.f)); } }
            LBAR();
            { f32x4 c[2] = {z4, z4}; mm2(c, SL(12), SL(13), F.wave, F.lane);
              RW_BASE
#pragma unroll
              for (int nt = 0; nt < 2; ++nt) PK4S(SL(1) + (cb_ + nt * 16) * P72 + rb_, c[nt][0], c[nt][1], c[nt][2], c[nt][3]); }
            LBAR();
            { f32x4 c[2] = {z4, z4}; mm2(c, SL(1), SL(2), F.wave, F.lane);
              RW_BASE
#pragma unroll
              for (int nt = 0; nt < 2; ++nt) PK4S(SL(0) + (cb_ + nt * 16) * P72 + rb_, c[nt][0], c[nt][1], c[nt][2], c[nt][3]); }
            LBAR();
            { f32x4 c1[2] = {z4, z4}, c2[2] = {z4, z4};
              mm2(c1, SL(0), SL(3), F.wave, F.lane);
              mm2(c2, SL(8), SL(0), F.wave, F.lane);
              RW_BASE
#pragma unroll
              for (int nt = 0; nt < 2; ++nt) { const int cc = cb_ + nt * 16, r0 = rb_; PK4S(SL(1) + cc * P72 + r0, c1[nt][0], c1[nt][1], c1[nt][2], c1[nt][3]); PK4S(SL(11) + cc * P72 + r0, c2[nt][0], c2[nt][1], c2[nt][2], c2[nt][3]); } }
            LBAR();
            { f32x4 c1[2] = {z4, z4}, c2[2] = {z4, z4};
              mm2(c1, SL(11), SL(7), F.wave, F.lane);
              mm2(c2, SL(1), SL(9), F.wave, F.lane);
              RW_BASE
#pragma unroll
              for (int nt = 0; nt < 2; ++nt) { const int cc = cb_ + nt * 16, r0 = rb_; PK4S(SL(12) + cc * P72 + r0, c1[nt][0], c1[nt][1], c1[nt][2], c1[nt][3]);
                  const u32x2 rw = *(const LAS u32x2*)(SL(6) + cc * P72 + r0);
                  PK4S(SL(13) + cc * P72 + r0, c2[nt][0] + __uint_as_float(rw.x << 16), c2[nt][1] + __uint_as_float(rw.x & 0xffff0000u), c2[nt][2] + __uint_as_float(rw.y << 16), c2[nt][3] + __uint_as_float(rw.y & 0xffff0000u)); } }
            LBAR();
            { f32x4 c1[2] = {z4, z4}, c2[2] = {z4, z4}, c3[2] = {z4, z4};
              mm2(c1, SL(12), SL(9), F.wave, F.lane); mm2(c1, SL(7), SL(10), F.wave, F.lane);
              mm2(c2, SL(1), SL(4), F.wave, F.lane);
              mm2(c3, SL(12), SL(4), F.wave, F.lane); mm2(c3, SL(7), SL(5), F.wave, F.lane);
              float qf[8]; RW_BASE
#pragma unroll
              for (int nt = 0; nt < 2; ++nt) { const int cc = cb_ + nt * 16, r0 = rb_; const float gc = GC[cc];
                  PK4S(SL(14) + cc * P72 + r0, c1[nt][0], c1[nt][1], c1[nt][2], c1[nt][3]);
                  PK4S(SL(0) + cc * P72 + r0, (c2[nt][0] + (cc == r0 ? 1.f : 0.f)) * gc, (c2[nt][1] + (cc == r0 + 1 ? 1.f : 0.f)) * gc, (c2[nt][2] + (cc == r0 + 2 ? 1.f : 0.f)) * gc, (c2[nt][3] + (cc == r0 + 3 ? 1.f : 0.f)) * gc);
#pragma unroll
                  for (int j = 0; j < 4; ++j) qf[nt * 4 + j] = c3[nt][j] * gc; }
              *(u32x4*)(outb + 1 * 4096 + (F.wave * 64 + F.lane) * 8) = pack8(qf); }
            LBAR();
#undef PK4S
            { int tid_ = F.tid; asm volatile("" : "+v"(tid_)); const int row = tid_ >> 3, sg = (tid_ & 7) * 8;
              *(u32x4*)(outb + 0 * 4096 + row * 64 + sg) = *(const LAS u32x4*)(SL(0) + row * P72 + sg);
              *(u32x4*)(outb + 2 * 4096 + row * 64 + sg) = *(const LAS u32x4*)(SL(13) + row * P72 + sg); *(u32x4*)(outb + 3 * 4096 + row * 64 + sg) = *(const LAS u32x4*)(SL(14) + row * P72 + sg); }
        }
    }
    }
#undef SL
}
__device__ __forceinline__ void ph_rwkv_seq(const AP& a, const Frame& F) {
    unsigned char* S = a.ws + WS_SCR; const bf16* CH = (const bf16*)(S + SB_CH); bf16* SS = (bf16*)(S + SB_SS);
    LAS bf16* Sb = (LAS bf16*)F.lds;
    const int r = F.lane & 15, q = F.lane >> 4, mt = F.wave >> 1, nb = (F.wave & 1) * 32;
    for (int chain = blockIdx.x; chain < 160; chain += gridDim.x) { const int dir = chain & 1, hd = (chain >> 1) & 15, sq = chain >> 5; const int c0 = sq == 0 ? 0 : 256 + (sq - 1) * 32, nc = sq == 0 ? 256 : 32;
        f32x4 acc[2] = {(f32x4){0.f, 0.f, 0.f, 0.f}, (f32x4){0.f, 0.f, 0.f, 0.f}};
        __syncthreads();
        u32x4 p0, p1, p2, p3, p4s, p5, p6, p7, q0, q1, q2, q3, q4s, q5, q6, q7;
        const int crow = F.tid >> 3, cseg = (F.tid & 7) * 8;
        LAS bf16* Pb = Sb + 2 * SLOT;
#define SEQ_LOAD(P_, Q_, s_) do { const int s1_ = (s_) < nc ? (s_) : nc - 1; const int cn1_ = c0 + (dir == 0 ? s1_ : nc - 1 - s1_); const bf16* PT_ = CH + (((size_t)cn1_ * 16 + hd) * 2 + dir) * 4 * 4096; \
            P_ = *(const u32x4*)(PT_ + F.tid * 8); Q_ = *(const u32x4*)(PT_ + 4096 + F.tid * 8); } while (0)
#define SEQ_STEP(P_, Q_, Pn_, Qn_, s_) do { const int cn_ = c0 + (dir == 0 ? (s_) : nc - 1 - (s_)); const size_t itd_ = ((size_t)cn_ * 16 + hd) * 2 + dir; \
            SEQ_LOAD(Pn_, Qn_, (s_) + 7); \
            LAS bf16* sb_ = Sb + ((s_) & 1) * SLOT; LAS bf16* pb_ = Pb + ((s_) & 1) * SLOT; \
            _Pragma("unroll") for (int nt = 0; nt < 2; ++nt) _Pragma("unroll") for (int j = 0; j < 4; ++j) sb_[(mt * 16 + q * 4 + j) * P72 + nb + nt * 16 + r] = (bf16)f2bf(acc[nt][j]); \
            *(LAS u32x4*)(pb_ + crow * P72 + cseg) = P_; \
            asm volatile("s_waitcnt lgkmcnt(0)" ::: "memory"); __builtin_amdgcn_s_barrier(); asm volatile("" ::: "memory"); \
            *(u32x4*)(SS + itd_ * 4096 + crow * 64 + cseg) = *(const LAS u32x4*)(sb_ + crow * P72 + cseg);            \
            { float qf_[8]; unpack8(Q_, qf_); acc[0] = (f32x4){qf_[0], qf_[1], qf_[2], qf_[3]}; acc[1] = (f32x4){qf_[4], qf_[5], qf_[6], qf_[7]}; } \
            _Pragma("unroll") for (int ks = 0; ks < 2; ++ks) { const bf16x8 av = *(const LAS bf16x8*)(sb_ + (mt * 16 + r) * P72 + ks * 32 + q * 8); \
                _Pragma("unroll") for (int nt = 0; nt < 2; ++nt) { const bf16x8 bv = *(const LAS bf16x8*)(pb_ + (nb + nt * 16 + r) * P72 + ks * 32 + q * 8); acc[nt] = __builtin_amdgcn_mfma_f32_16x16x32_bf16(av, bv, acc[nt], 0, 0, 0); } } } while (0)
        SEQ_LOAD(p0, q0, 0); SEQ_LOAD(p1, q1, 1); SEQ_LOAD(p2, q2, 2); SEQ_LOAD(p3, q3, 3); SEQ_LOAD(p4s, q4s, 4); SEQ_LOAD(p5, q5, 5); SEQ_LOAD(p6, q6, 6);
        for (int s = 0; s < nc; s += 8) { SEQ_STEP(p0, q0, p7, q7, s); SEQ_STEP(p1, q1, p0, q0, s + 1); SEQ_STEP(p2, q2, p1, q1, s + 2); SEQ_STEP(p3, q3, p2, q2, s + 3);
            SEQ_STEP(p4s, q4s, p3, q3, s + 4); SEQ_STEP(p5, q5, p4s, q4s, s + 5); SEQ_STEP(p6, q6, p5, q5, s + 6); SEQ_STEP(p7, q7, p6, q6, s + 7); }
#undef SEQ_LOAD
#undef SEQ_STEP
    }
}
__device__ __forceinline__ void ph_rwkv_out(const AP& a, const Frame& F, int l) {
    unsigned char* S = a.ws + WS_SCR; const bf16* CH = (const bf16*)(S + SB_CH); const bf16* SS = (const bf16*)(S + SB_SS); const bf16* PROJ = (const bf16*)(a.ws + WS_PROJ); bf16* Y = (bf16*)(a.ws + WS_Y);
    const bf16* R = (const bf16*)(S + SB_R); const bf16* KM = (const bf16*)(S + SB_KM); const bf16* V = (const bf16*)(S + SB_V);
    const float* rk = a.in(I_RK) + (size_t)l * WB; const float* lg = a.in(I_LNG) + (size_t)l * WB; const float* lbp = a.in(I_LNB) + (size_t)l * WB;
    const int r = F.lane & 15, q = F.lane >> 4;
    for (int it = F.gw; it < (T / 64) * 16; it += F.ngw) { const int hd = it & 15, cn = it >> 4; const size_t item = (size_t)cn * 16 + hd;
      bf16x8 bS[2][4][2];
#pragma unroll
      for (int dir = 0; dir < 2; ++dir) { const bf16* Sg = SS + (item * 2 + dir) * 4096;
#pragma unroll
          for (int nt = 0; nt < 4; ++nt)
#pragma unroll
              for (int ks = 0; ks < 2; ++ks) bS[dir][nt][ks] = *(const bf16x8*)(Sg + (4 * r + nt) * 64 + ks * 32 + q * 8); }
#pragma unroll 2
      for (int mt = 0; mt < 4; ++mt) {
        f32x4 acc[4];
#pragma unroll
        for (int nt = 0; nt < 4; ++nt) acc[nt] = (f32x4){0.f, 0.f, 0.f, 0.f};
#pragma unroll
        for (int dir = 0; dir < 2; ++dir) { const bf16* ob = CH + (item * 2 + dir) * 4 * 4096; const bf16* R2T = ob + 2 * 4096; const bf16* Y0 = ob + 3 * 4096;
            const int trow = dir ? 63 - (mt * 16 + r) : mt * 16 + r;
#pragma unroll
            for (int ks = 0; ks < 2; ++ks) { const bf16x8 av = *(const bf16x8*)(R2T + trow * 64 + ks * 32 + q * 8);
#pragma unroll
                for (int nt = 0; nt < 4; ++nt) acc[nt] = __builtin_amdgcn_mfma_f32_16x16x32_bf16(av, bS[dir][nt][ks], acc[nt], 0, 0, 0); }
#pragma unroll
            for (int j = 0; j < 4; ++j) { const int tl = mt * 16 + q * 4 + j; const u32x2 yw = *(const u32x2*)(Y0 + (dir ? 63 - tl : tl) * 64 + 4 * r);
                acc[0][j] += __uint_as_float(yw.x << 16); acc[1][j] += __uint_as_float(yw.x & 0xffff0000u); acc[2][j] += __uint_as_float(yw.y << 16); acc[3][j] += __uint_as_float(yw.y & 0xffff0000u); } }
        const int c = hd * 64 + 4 * r; const f32x4 rk4 = *(const f32x4*)(rk + c), lg4 = *(const f32x4*)(lg + c), lb4 = *(const f32x4*)(lbp + c);
        u32x2 wq[4][4];
#pragma unroll
        for (int j = 0; j < 4; ++j) { const int t = cn * 64 + mt * 16 + q * 4 + j; const size_t o = (size_t)t * WB + c; wq[j][0] = *(const u32x2*)(R + o); wq[j][1] = *(const u32x2*)(KM + o); wq[j][2] = *(const u32x2*)(V + o); wq[j][3] = *(const u32x2*)(PROJ + (size_t)t * NPJ + C_RWZ + c); }
#pragma unroll
        for (int j = 0; j < 4; ++j) { const int t = cn * 64 + mt * 16 + q * 4 + j; float s = (acc[0][j] + acc[1][j]) + (acc[2][j] + acc[3][j]);
            s += shx<1>(s); s += shx<2>(s); s += shx<4>(s); s += shx<8>(s); const float mean = s * (1.0f / 64.0f); float vs = 0.f, bs = 0.f;
            float rr[4], kk[4], vv[4], zz[4];
            { const u32x2 w1 = wq[j][0], w2 = wq[j][1], w3 = wq[j][2], w4 = wq[j][3];
              rr[0] = __uint_as_float(w1.x << 16); rr[1] = __uint_as_float(w1.x & 0xffff0000u); rr[2] = __uint_as_float(w1.y << 16); rr[3] = __uint_as_float(w1.y & 0xffff0000u);
              kk[0] = __uint_as_float(w2.x << 16); kk[1] = __uint_as_float(w2.x & 0xffff0000u); kk[2] = __uint_as_float(w2.y << 16); kk[3] = __uint_as_float(w2.y & 0xffff0000u);
              vv[0] = __uint_as_float(w3.x << 16); vv[1] = __uint_as_float(w3.x & 0xffff0000u); vv[2] = __uint_as_float(w3.y << 16); vv[3] = __uint_as_float(w3.y & 0xffff0000u);
              zz[0] = __uint_as_float(w4.x << 16); zz[1] = __uint_as_float(w4.x & 0xffff0000u); zz[2] = __uint_as_float(w4.y << 16); zz[3] = __uint_as_float(w4.y & 0xffff0000u); }
#pragma unroll
            for (int nt = 0; nt < 4; ++nt) { const float dl = acc[nt][j] - mean; vs += dl * dl; bs += rr[nt] * kk[nt] * rk4[nt]; }
            vs += shx<1>(vs); vs += shx<2>(vs); vs += shx<4>(vs); vs += shx<8>(vs); bs += shx<1>(bs); bs += shx<2>(bs); bs += shx<4>(bs); bs += shx<8>(bs);
            const float rstd = __builtin_amdgcn_rsqf(vs * (1.0f / 64.0f) + 64e-5f); float o4[4];
#pragma unroll
            for (int nt = 0; nt < 4; ++nt) { const float yn = (acc[nt][j] - mean) * rstd * lg4[nt] + lb4[nt]; o4[nt] = (yn + bs * vv[nt]) * siluf_(zz[nt]); }
            *(u32x2*)(Y + (size_t)t * 4096 + 1024 + c) = (u32x2){pk2(o4[0], o4[1]), pk2(o4[2], o4[3])}; }
      }
    }
}
constexpr int NPH_PRO = 3, NPH_LAYER = 21, NPH = NPH_PRO + DEPTH * NPH_LAYER + 1;

__global__ void __launch_bounds__(NTHR, 2) fwd(Args ka) {
    extern __shared__ __attribute__((aligned(16))) unsigned char lds_[];
    Frame F; F.lds = (LAS unsigned char*)lds_; F.tid = threadIdx.x; F.lane = F.tid & 63; F.wave = __builtin_amdgcn_readfirstlane(F.tid >> 6);
    F.gw = blockIdx.x * NWAVES + F.wave; F.ngw = gridDim.x * NWAVES; F.gt = blockIdx.x * NTHR + F.tid; F.ngt = gridDim.x * NTHR;
    volatile LAS unsigned* MISC = (volatile LAS unsigned*)(F.lds + LDS_MISC);
    if (F.tid < 64) MISC[F.tid] = 0u;
    { LAS unsigned long long* aq = (LAS unsigned long long*)(F.lds + LDS_ARGS);
#pragma unroll
      for (int i = 0; i < 35; ++i) if (F.tid == i) aq[i] = (unsigned long long)ka.in[i]; }
    __syncthreads();
    AP a; a.q = (const LAS unsigned long long*)(F.lds + LDS_ARGS); a.ws = ka.ws; a.out = ka.out;
    const int ph_lo = ka.ph_lo, ph_hi = ka.ph_hi;
    unsigned* barw = (unsigned*)(a.ws + WS_CTL) + 4096;
    const int wave0 = F.wave;
    XcdBarrier bar; bar.bar = barw; bar.x = 0; bar.st = MISC + 8;
    if (ph_hi - ph_lo > 1) bar = xcd_barrier_post(barw, MISC + 8);
    bar.wave = wave0;
    int gp = 0;
#ifndef PH_DBL
#define PH_DBL 0ull
#endif
#ifndef PH_ONLY
#define PH_ONLY -1
#endif
#define PHASE(pid, ...) do { int lo_ = ph_lo, hi_ = ph_hi; asm volatile("" : "+s"(lo_), "+s"(hi_)); if ((PH_ONLY < 0 || PH_ONLY == (pid)) && lo_ <= gp && gp < hi_) { F.lane = lane_id(); asm volatile("" : "+v"(F.lane)); F.wave = wave0; F.tid = F.wave * 64 + F.lane; F.gw = blockIdx.x * NWAVES + F.wave; F.ngw = gridDim.x * NWAVES; F.ngt = gridDim.x * NTHR; asm volatile("" : "+s"(F.gw), "+s"(F.ngw), "+s"(F.ngt)); F.gt = blockIdx.x * NTHR + F.tid; __VA_ARGS__; if ((PH_DBL >> (pid)) & 1ull) { xcd_barrier(bar); __VA_ARGS__; } if (gp + 1 < hi_) xcd_barrier(bar); } ++gp; } while (0)
    const int G = gridDim.x, cb = blockIdx.x;
    LAS unsigned char* lds = F.lds;
    unsigned char* ws = a.ws;

    PHASE(0, ph_tables(a, F));
    PHASE(1, ph_convert(a, F));
    PHASE(2, { ph_s5mats(a, F); ph_x0(a, F); });

    for (int l = 0; l < DEPTH; ++l) {
        const bf16* WALLT = (const bf16*)(ws + WS_WALLT) + (size_t)l * NALL * D;
        const float* rss_l = (const float*)(ws + WS_RSS) + (size_t)(l & 1) * T;
        PHASE(4, { pg8::Gemm g{(const bf16*)(ws + WS_H), WALLT, D, D, D}; pg8::Order S; S.init(T / 256, NPJ / 256, 1, G, cb, (size_t)256 * D * 2, 0, (size_t)256 * D * 2, 0);
                EpiBf16 E{(bf16*)(ws + WS_PROJ), NPJ, C_WDF / 256, rss_l}; pg8::gemm_phase(lds, g, S, E, F.tid); });
        PHASE(5, ph_lru_conv(a, F, l));
        PHASE(6, { pg8::Gemm g{(const bf16*)(ws + WS_SCR + SA_XC), (const bf16*)(ws + WS_LRUW) + (size_t)l * 4096 * 256, WB, 256, 256}; pg8::Order S; S.init(T / 256, 16, 1, G, cb, (size_t)256 * WB * 2, 0, (size_t)256 * 256 * 2, 0); S.kwin = 256 * 2;
                EpiLru E{a.in(I_BR) + (size_t)l * 2 * WB, a.in(I_BI) + (size_t)l * 2 * WB, a.in(I_LAM) + (size_t)l * 2 * WB, (const bf16*)(ws + WS_SCR + SA_XC), (bf16*)(ws + WS_SCR + SA_LA), (bf16*)(ws + WS_SCR + SA_BB)};
                pg8::gemm_phase(lds, g, S, E, F.tid); });
        PHASE(7, ph_lru_scan1(a, F));
        PHASE(8, ph_lru_scan2(a, F));
        PHASE(9, ph_lru_scan3(a, F));
        PHASE(10, ph_s5_rearr(a, F));
        PHASE(11, { pg8::Gemm g{(const bf16*)(ws + WS_SCR + SD_UC), (const bf16*)(ws + WS_S5INC) + (size_t)l * 64 * 256 * 256, 512, 256, 256}; pg8::Order S;
                S.init(NCH_S5 / 256, 1, 64, G, cb, (size_t)256 * 512 * 2, (size_t)NCH_S5 * 512 * 2, 0, (size_t)256 * 256 * 2);
                EpiF32 E{(float*)(ws + WS_SCR + SD_INC), 256, (size_t)NCH_S5 * 256}; pg8::gemm_phase(lds, g, S, E, F.tid); });
        PHASE(12, ph_s5_scan(a, F, l));
        PHASE(13, { pg8::Gemm g{(const bf16*)(ws + WS_SCR + SD_UC), (const bf16*)(ws + WS_S5MAIN) + (size_t)l * 64 * 256 * 512, 512, 512, 512}; pg8::Order S;
                S.init(NCH_S5 / 256, 1, 64, G, cb, (size_t)256 * 512 * 2, (size_t)NCH_S5 * 512 * 2, 0, (size_t)256 * 512 * 2);
                EpiS5Main E{(bf16*)(ws + WS_SCR + SD_YG)}; pg8::gemm_phase(lds, g, S, E, F.tid); });
        PHASE(14, { pg8::Gemm g{(const bf16*)(ws + WS_SCR + SD_YG), (const bf16*)(ws + WS_GLUT) + (size_t)l * WB * WB, WB, WB, WB}; pg8::Order S; S.init(T / 256, WB / 256, 1, G, cb, (size_t)256 * WB * 2, 0, (size_t)256 * WB * 2, 0);
                EpiGlu E{(const bf16*)(ws + WS_SCR + SD_YG), (const bf16*)(ws + WS_PROJ), a.in(I_GLUB) + (size_t)l * WB, (bf16*)(ws + WS_Y)}; pg8::gemm_phase(lds, g, S, E, F.tid); });
        PHASE(15, ph_ret_kv(a, F));
        PHASE(16, ph_ret_scan(a, F));
        PHASE(25, { pg8::Gemm g{(const bf16*)(ws + WS_PROJ) + C_WDF, (const bf16*)(ws + WS_W2ALL) + (size_t)l * 3072 * 256, NPJ, 256, 256}; pg8::Order S; S.init(T / 256, 3072 / 256, 1, G, cb, (size_t)256 * NPJ * 2, 0, (size_t)256 * 256 * 2, 0);
                EpiBf16 E{(bf16*)(ws + WS_SCR + SB_LO), 3072, -1, nullptr}; pg8::gemm_phase(lds, g, S, E, F.tid); });
        PHASE(18, ph_rwkv_prep(a, F, l));
        PHASE(19, ph_rwkv_chunk(a, F));
        PHASE(20, { ph_rwkv_seq(a, F); ph_ret_out(a, F, l); });
        PHASE(24, ph_rwkv_out(a, F, l));
        PHASE(21, { { pg8::Gemm g{(const bf16*)(ws + WS_H), WALLT + (size_t)NPJ * D, D, D, D}; pg8::Order S; S.init(T / 256, 4 * D / 256, 1, G, cb, (size_t)256 * D * 2, 0, (size_t)256 * D * 2, 0);
                      EpiGate E{(bf16*)(ws + WS_SCR + SM_GS), rss_l}; pg8::gemm_phase(lds, g, S, E, F.tid); }
                    xcd_barrier(bar);
                    { pg8::Gemm g{(const bf16*)(ws + WS_Y), (const bf16*)(ws + WS_WBRT) + (size_t)l * D * 4096, 4096, 4096, WB}; pg8::Order S; S.init(T / 256, D / 256, 4, G, cb, (size_t)256 * 4096 * 2, (size_t)WB * 2, (size_t)256 * 4096 * 2, (size_t)WB * 2); S.zfast = 1;
                      EpiBranchAll E{(const bf16*)(ws + WS_SCR + SM_GS), (bf16*)(ws + WS_SCR + SM_MG)}; pg8::gemm_phase(lds, g, S, E, F.tid); } });
        PHASE(22, { pg8::Gemm g{(const bf16*)(ws + WS_SCR + SM_MG), (const bf16*)(ws + WS_WOUTT) + (size_t)l * D * D, D, D, D}; pg8::Order S; S.init(T / 256, D / 256, 1, G, cb, (size_t)256 * D * 2, 0, (size_t)256 * D * 2, 0);
#ifdef OUT_DRY
                { EpiNull E0; pg8::gemm_phase(lds, g, S, E0, F.tid); }
#endif
                EpiOut E{a.in(I_XP), a.in(I_XS), a.out, (bf16*)(ws + WS_H), (float*)(ws + WS_RSP), l == 0 ? 1 : 0}; pg8::gemm_phase(lds, g, S, E, F.tid); });
        PHASE(26, ph_rss(a, F, l));
#ifdef XTRA_BAR
        for (int xb = 0; xb < XTRA_BAR; ++xb) xcd_barrier(bar);
#endif
    }
    PHASE(23, ph_final(a, F));
#undef PHASE
}

extern "C" void kernel_launch(void* const* d_in, const int* in_sizes, int n_in, void* d_out, int out_size, void* d_ws, size_t ws_size, hipStream_t stream) {
    static int grid = 0;
    if (grid == 0) {
        if (n_in != 35 || out_size != T * D || ws_size < WS_END) { fprintf(stderr, "kernel_launch: unexpected shapes (n_in %d out %d ws %zu need %zu)\n", n_in, out_size, ws_size, (size_t)WS_END); grid = -1; return; }
        int dev = 0, cus = 0, per_cu = 0;
        if (hipGetDevice(&dev) != hipSuccess || hipDeviceGetAttribute(&cus, hipDeviceAttributeMultiprocessorCount, dev) != hipSuccess) { grid = -1; return; }
        if (hipFuncSetAttribute((const void*)fwd, hipFuncAttributeMaxDynamicSharedMemorySize, LDS_BYTES) != hipSuccess) { fprintf(stderr, "kernel_launch: hipFuncSetAttribute failed\n"); grid = -1; return; }
        if (hipOccupancyMaxActiveBlocksPerMultiprocessor(&per_cu, (const void*)fwd, NTHR, LDS_BYTES) != hipSuccess || per_cu < 1) fprintf(stderr, "kernel_launch: occupancy query says %d\n", per_cu);
        (void)hipGetLastError();
        grid = cus;
    }
    if (grid < 0) return;
    (void)hipMemsetAsync((char*)d_ws + WS_CTL, 0, CTL_BYTES, stream);
    Args a{};
    for (int i = 0; i < 35; ++i) a.in[i] = (const float*)d_in[i];
    a.out = (float*)d_out; a.ws = (unsigned char*)d_ws;
#if MK_ONE_LAUNCH
    a.ph_lo = 0; a.ph_hi = NPH;
    hipLaunchKernelGGL(fwd, dim3(grid), dim3(NTHR), LDS_BYTES, stream, a);
#else
    for (int p = 0; p < NPH; ++p) { a.ph_lo = p; a.ph_hi = p + 1; hipLaunchKernelGGL(fwd, dim3(grid), dim3(NTHR), LDS_BYTES, stream, a); }
#endif
}
```

```cpp
#include <hip/hip_runtime.h>
#include <cstdio>
#include <cstdint>

#ifndef MK_ONE_LAUNCH
#define MK_ONE_LAUNCH 1
#endif

#define LAS __attribute__((address_space(3)))
#define GAS __attribute__((address_space(1)))
typedef unsigned short bf16;
typedef short bf16x8 __attribute__((ext_vector_type(8)));
typedef float f32x4 __attribute__((ext_vector_type(4)));
typedef float f32x2 __attribute__((ext_vector_type(2)));
typedef unsigned u32x4 __attribute__((ext_vector_type(4)));
typedef unsigned u32x2 __attribute__((ext_vector_type(2)));

constexpr int T = 24576, TP = 16384, LS = 2048, D = 2048, WB = 1024, DEPTH = 4;
constexpr int NPJ = 11520, NIN = 19648, GOFF = 11456, NALL = 19712;
constexpr int C_LRUX = 0, C_LRUZ = 1024, C_RWR = 2048, C_RWK = 3072, C_RWV = 4096, C_WDF = 5120, C_WDB = 5184, C_AD = 5248, C_RWZ = 5312,
              C_RQ = 6336, C_RK = 6848, C_RV = 7360, C_RZ = 8384, C_SU = 9408, C_SZ = 10432;
constexpr int NCH_S5 = T / 16;
constexpr int NCH_RET = T / 128;
constexpr int NCH_LRU = T / 128;

constexpr size_t al(size_t x) { return (x + 0xFFFFFu) & ~(size_t)0xFFFFFu; }
constexpr size_t WS_CTL = 0, CTL_BYTES = 1u << 20;
constexpr size_t WS_WALLT = al(WS_CTL + CTL_BYTES);
constexpr size_t WS_LRUW  = al(WS_WALLT + (size_t)DEPTH * NALL * D * 2);
constexpr size_t WS_GLUT  = al(WS_LRUW + (size_t)DEPTH * 4096 * 256 * 2);
constexpr size_t WS_WBRT  = al(WS_GLUT + (size_t)DEPTH * 1024 * 1024 * 2);
constexpr size_t WS_WOUTT = al(WS_WBRT + (size_t)DEPTH * 2048 * 4096 * 2);
constexpr size_t WS_S5MAIN= al(WS_WOUTT + (size_t)DEPTH * 2048 * 2048 * 2);
constexpr size_t WS_S5INC = al(WS_S5MAIN + (size_t)DEPTH * 64 * 256 * 512 * 2);
constexpr size_t WS_S5TAB = al(WS_S5INC + (size_t)DEPTH * 64 * 256 * 256 * 2);
constexpr size_t WS_W2ALL = al(WS_S5TAB + (size_t)DEPTH * 2 * 64 * 64 * 33 * 8);
constexpr size_t WS_ROT   = al(WS_W2ALL + (size_t)DEPTH * 3072 * 256 * 2);
constexpr size_t WS_RSS   = al(WS_ROT + (size_t)16384 * 64 * 8);
constexpr size_t WS_RSP   = al(WS_RSS + (size_t)2 * T * 4);
constexpr size_t WS_H     = al(WS_RSP + (size_t)T * 32 * 4);
constexpr size_t WS_PROJ  = al(WS_H + (size_t)T * D * 2);
constexpr size_t WS_Y     = al(WS_PROJ + (size_t)T * NPJ * 2);
constexpr size_t WS_STP   = al(WS_Y + (size_t)T * 4096 * 2);
constexpr size_t WS_SCR   = al(WS_STP + (size_t)2 * 768 * 256 * 128 * 2);
constexpr size_t TW4 = (size_t)T * WB * 4, TW2 = (size_t)T * WB * 2;
constexpr int NCH_L32 = T / 32;
constexpr size_t SA_XC = 0, SA_LA = al(SA_XC + TW2), SA_BB = al(SA_LA + 2 * TW2), SA_PA = al(SA_BB + 2 * TW2),
                 SA_PB = al(SA_PA + (size_t)NCH_L32 * 2 * WB * 4), SA_CAR = al(SA_PB + (size_t)NCH_L32 * 2 * WB * 4), SA_END = al(SA_CAR + (size_t)NCH_L32 * 2 * WB * 4);
constexpr size_t SD_UC = 0, SD_INC = al(SD_UC + (size_t)64 * NCH_S5 * 512 * 2), SD_YG = al(SD_INC + (size_t)64 * NCH_S5 * 256 * 4), SD_END = al(SD_YG + TW2);
constexpr size_t SC_KVT = 0, SC_END = al(SC_KVT + (size_t)2 * 768 * 256 * 128 * 4);
constexpr size_t SB_R = 0, SB_KM = al(SB_R + TW2), SB_V = al(SB_KM + TW2), SB_KK = al(SB_V + TW2), SB_AG = al(SB_KK + TW2), SB_LWF = al(SB_AG + TW2), SB_LWB = al(SB_LWF + TW2),
                 SB_CH = al(SB_LWB + TW2), SB_SS = al(SB_CH + (size_t)(T / 64) * 16 * 2 * 4 * 4096 * 2), SB_END = al(SB_SS + (size_t)(T / 64) * 16 * 2 * 4096 * 2), SB_LO = SB_CH;
constexpr size_t SM_GS = 0, SM_MG = al(SM_GS + (size_t)T * 4 * D * 2), SM_END = al(SM_MG + (size_t)T * D * 2);
constexpr size_t cmax(size_t a, size_t b) { return a > b ? a : b; }
constexpr size_t SCR_BYTES = cmax(cmax(cmax(SA_END, SD_END), cmax(SC_END, SB_END)), SM_END);
constexpr size_t WS_END = WS_SCR + SCR_BYTES;
static_assert(WS_END < (size_t)2500 * 1000 * 1000, "workspace budget");

__device__ __forceinline__ float ld_agent(const float* p) { return __hip_atomic_load(p, __ATOMIC_RELAXED, __HIP_MEMORY_SCOPE_AGENT); }
__device__ __forceinline__ void st_agent(float* p, float v) { __hip_atomic_store(p, v, __ATOMIC_RELAXED, __HIP_MEMORY_SCOPE_AGENT); }
__device__ __forceinline__ int lane_id() { unsigned m = ~0u; asm volatile("" : "+s"(m)); return (int)__builtin_amdgcn_mbcnt_hi(m, __builtin_amdgcn_mbcnt_lo(m, 0u)); }
__device__ __forceinline__ float bf2f(bf16 b) { return __uint_as_float(((unsigned)b) << 16); }
typedef __bf16 hwbf16x2 __attribute__((ext_vector_type(2)));
__device__ __forceinline__ unsigned pk2(float lo, float hi) { const f32x2 v = {lo, hi}; return __builtin_bit_cast(unsigned, __builtin_convertvector(v, hwbf16x2)); }
__device__ __forceinline__ unsigned f2bf(float f) { return pk2(f, 0.f) & 0xffffu; }
__device__ __forceinline__ float sigmoidf_(float x) { return __builtin_amdgcn_rcpf(1.0f + __expf(-x)); }
__device__ __forceinline__ float siluf_(float x) { return x * __builtin_amdgcn_rcpf(1.0f + __expf(-x)); }
__device__ __forceinline__ float tanhf_(float x) { const float e = __expf(2.0f * fminf(fmaxf(x, -15.f), 15.f)); return 1.0f - 2.0f * __builtin_amdgcn_rcpf(e + 1.0f); }
__device__ __forceinline__ float softplusf_(float x) { return fmaxf(x, 0.f) + __logf(1.0f + __expf(-fabsf(x))); }
__device__ __forceinline__ float gelu_tanh(float x) { const float u = 0.7978845608028654f * (x + 0.044715f * x * x * x); const float e = __expf(2.f * u); const float th = 1.f - 2.f * __builtin_amdgcn_rcpf(e + 1.f); return 0.5f * x * (1.f + th); }
template <int O> __device__ __forceinline__ float shx(float v) {
    if constexpr (O < 32) return __int_as_float(__builtin_amdgcn_ds_swizzle(__float_as_int(v), (O << 10) | 0x1f));
    else { const int lane = lane_id(); return __int_as_float(__builtin_amdgcn_ds_bpermute((lane ^ O) << 2, __float_as_int(v))); }
}
__device__ __forceinline__ float wave_sum(float v) { v += shx<1>(v); v += shx<2>(v); v += shx<4>(v); v += shx<8>(v); v += shx<16>(v); v += shx<32>(v); return v; }
__device__ __forceinline__ void seq_of(int t, int& pos, int& L) { if (t < TP) { pos = t; L = TP; } else { pos = (t - TP) & (LS - 1); L = LS; } }
__device__ __forceinline__ void unpack8(const u32x4 w, float (&x)[8]) {
    x[0] = __uint_as_float(w.x << 16); x[1] = __uint_as_float(w.x & 0xffff0000u); x[2] = __uint_as_float(w.y << 16); x[3] = __uint_as_float(w.y & 0xffff0000u);
    x[4] = __uint_as_float(w.z << 16); x[5] = __uint_as_float(w.z & 0xffff0000u); x[6] = __uint_as_float(w.w << 16); x[7] = __uint_as_float(w.w & 0xffff0000u);
}
__device__ __forceinline__ u32x4 pack8(const float (&x)[8]) { u32x4 w; w.x = pk2(x[0], x[1]); w.y = pk2(x[2], x[3]); w.z = pk2(x[4], x[5]); w.w = pk2(x[6], x[7]); return w; }

namespace pg8 {
#define PG8_LAS __attribute__((address_space(3)))
typedef unsigned short bf16_t;
constexpr int BM = 256, BK = 64, HALF = 128, HTB = HALF * BK * 2, STAGE_BYTES = 8 * HTB, NXCD = 8, WGM = 4;
__host__ __device__ __forceinline__ int lds_byte(int r, int c) { const int st = (r >> 4) * 2 + (c >> 5), rr = r & 15, cc = c & 31, ob = rr * 64 + cc * 2; return st * 1024 + (ob ^ (((ob >> 9) & 1) << 5)); }
__host__ __device__ __forceinline__ void stage_rc(int b, int& R, int& C) { const int st = b / 1024, sb = b % 1024, swz = sb ^ (((sb >> 9) & 1) << 5); R = (st >> 1) * 16 + swz / 64; C = (st & 1) * 32 + (swz % 64) / 2; }
__host__ __device__ __forceinline__ int perm32(int rho) { const int n = rho >> 4, i = rho & 15; return 8 * (i >> 2) + 4 * n + (i & 3); }

struct Unit { int pm, pn, z; size_t aoff, boff; };
struct Gemm { const bf16_t* A; const bf16_t* Bt; int lda, ldb, K; };

struct Order {
    int nM, nN, nZ, G, c; size_t a_pm, a_z, b_pn, b_z; int kwin = 0; int zfast = 0;
    __device__ __forceinline__ void init(int nM_, int nN_, int nZ_, int G_, int c_, size_t a_pm_, size_t a_z_, size_t b_pn_, size_t b_z_) { nM = nM_; nN = nN_; nZ = nZ_; G = G_; c = c_; a_pm = a_pm_; a_z = a_z_; b_pn = b_pn_; b_z = b_z_; }
    __device__ __forceinline__ bool next(int i, Unit& u) const {
        const int nwg = nM * nN; int z, wgid;
        if (zfast) { const long L = (long)(i / nZ) * G + c; if (L >= (long)nwg) return false; z = i % nZ; wgid = (int)L; }
        else { const long L = (long)i * G + c; if (L >= (long)nwg * nZ) return false; z = (int)(L / nwg); wgid = (int)(L % nwg); }
        { const int q = nwg / NXCD, r = nwg % NXCD, xcd = wgid % NXCD, off = wgid / NXCD; wgid = (xcd < r ? xcd * (q + 1) : r * (q + 1) + (xcd - r) * q) + off; }
        const int nig = WGM * nN, gid = wgid / nig, fm = gid * WGM, gsz = (nM - fm) < WGM ? (nM - fm) : WGM;
        u.pm = fm + ((wgid % nig) % gsz); u.pn = (wgid % nig) / gsz; u.z = z;
        u.aoff = (size_t)u.pm * a_pm + (size_t)z * a_z + (size_t)(((u.pn & 7) >> 1) * kwin); u.boff = (size_t)u.pn * b_pn + (size_t)z * b_z; return true;
    }
};

template <class Epi>
__device__ __forceinline__ void gemm_phase(PG8_LAS unsigned char* lds, const Gemm g, const Order& S, const Epi& E, int tid_in) {
    int tid_ = tid_in; asm volatile("" : "+v"(tid_));
    const int tid = tid_, wid = __builtin_amdgcn_readfirstlane(tid >> 6), lane = tid & 63, wr = wid >> 2, wc = wid & 3, fr = lane & 15, fq = lane >> 4;
    const int K = g.K, nt = K / BK;
    unsigned voffA[2], voffB[2];
#pragma unroll
    for (int i = 0; i < 2; ++i) { int R, C; stage_rc(tid * 16 + i * 8192, R, C); const int Rb = Epi::PERM ? ((R & ~31) + perm32(R & 31)) : R;
        voffA[i] = (unsigned)(R * g.lda + C) * 2u; voffB[i] = (unsigned)(Rb * g.ldb + C) * 2u; }
    const size_t kstep = (size_t)(BK * 2);
    const size_t hstepA = (size_t)HALF * g.lda * 2, hstepB = (size_t)HALF * g.ldb * 2;
    const unsigned ldsw = (unsigned)wid * 1024u;
    const int aoff = lds_byte(wr * 64 + fr, fq * 8), boff = lds_byte(wc * 32 + fr, fq * 8);
#define PG8_SA(b, h) (((b) * 2 + (h)) * HTB)
#define PG8_SB(b, h) ((4 + (b) * 2 + (h)) * HTB)
#define PG8_STAGE(bufoff, gbase, voff) do { _Pragma("unroll") for (int _i = 0; _i < 2; ++_i) \
        __builtin_amdgcn_global_load_lds((const unsigned*)((const char*)(gbase) + (voff)[_i]), (PG8_LAS unsigned*)(lds + (bufoff) + ldsw + _i * 8192), 16, 0, 0); } while (0)
#define PG8_LDA(dst, b, h) do { _Pragma("unroll") for (int m = 0; m < 4; ++m) _Pragma("unroll") for (int k = 0; k < 2; ++k) dst[m][k] = *(const PG8_LAS bf16x8*)(lds + PG8_SA(b, h) + aoff + m * 2048 + k * 1024); } while (0)
#define PG8_LDB(dst, b, h) do { _Pragma("unroll") for (int n = 0; n < 2; ++n) _Pragma("unroll") for (int k = 0; k < 2; ++k) dst[n][k] = *(const PG8_LAS bf16x8*)(lds + PG8_SB(b, h) + boff + n * 2048 + k * 1024); } while (0)
#define PG8_MMA(ai, bj, At, Bt) do { __builtin_amdgcn_s_setprio(1); _Pragma("unroll") for (int m = 0; m < 4; ++m) _Pragma("unroll") for (int n = 0; n < 2; ++n) _Pragma("unroll") for (int k = 0; k < 2; ++k) \
        acc[ai][bj][m][n] = __builtin_amdgcn_mfma_f32_16x16x32_bf16(Bt[n][k], At[m][k], acc[ai][bj][m][n], 0, 0, 0); __builtin_amdgcn_s_setprio(0); } while (0)
#define PG8_WAIT_V(n) asm volatile("s_waitcnt vmcnt(" #n ")" ::: "memory")
#define PG8_WAIT_L(n) asm volatile("s_waitcnt lgkmcnt(" #n ")" ::: "memory")
#define PG8_BAR __builtin_amdgcn_s_barrier()
#define PG8_SCHED __builtin_amdgcn_sched_barrier(0)
    Unit cur, nxt; int ui = 0;
    if (!S.next(0, cur)) return;
    f32x4 acc[2][2][4][2];
#pragma unroll
    for (int a = 0; a < 2; ++a)
#pragma unroll
        for (int b = 0; b < 2; ++b)
#pragma unroll
            for (int m = 0; m < 4; ++m)
#pragma unroll
                for (int n = 0; n < 2; ++n) acc[a][b][m][n] = (f32x4){0.f, 0.f, 0.f, 0.f};
    const char* cA = (const char*)g.A + cur.aoff; const char* cB = (const char*)g.Bt + cur.boff;
    PG8_STAGE(PG8_SB(0, 0), cB, voffB); PG8_STAGE(PG8_SB(0, 1), cB + hstepB, voffB); PG8_STAGE(PG8_SA(0, 0), cA, voffA); PG8_STAGE(PG8_SA(0, 1), cA + hstepA, voffA);
    if (wr == 1) PG8_BAR;
    PG8_WAIT_V(2); PG8_BAR;
    PG8_STAGE(PG8_SB(1, 0), cB + kstep, voffB); PG8_STAGE(PG8_SA(1, 0), cA + kstep, voffA); PG8_STAGE(PG8_SB(1, 1), cB + hstepB + kstep, voffB);
    PG8_WAIT_V(6); PG8_BAR;
    for (;;) {
        const bool has_next = S.next(ui + 1, nxt);
        const char* nA = has_next ? (const char*)g.A + nxt.aoff : cA; const char* nB = has_next ? (const char*)g.Bt + nxt.boff : cB;
#pragma unroll 1
        for (int t = 0; t < nt; t += 2) {
            const bool last = (t == nt - 2);
            const char* a1 = cA + (size_t)(t + 1) * kstep;
            const char* a2 = last ? nA : cA + (size_t)(t + 2) * kstep; const char* b2 = last ? nB : cB + (size_t)(t + 2) * kstep;
            const char* a3 = a2 + kstep; const char* b3 = b2 + kstep;
            bf16x8 At[4][2], B0[2][2], B1[2][2];
            PG8_LDB(B0, 0, 0); PG8_LDB(B1, 0, 1); PG8_SCHED; PG8_LDA(At, 0, 0); PG8_STAGE(PG8_SA(1, 1), a1 + hstepA, voffA);
            PG8_WAIT_V(8); PG8_WAIT_L(0); PG8_BAR; PG8_MMA(0, 0, At, B0); PG8_MMA(0, 1, At, B1); PG8_BAR; PG8_SCHED;
            PG8_LDA(At, 0, 1); PG8_STAGE(PG8_SB(0, 0), b2, voffB); PG8_STAGE(PG8_SB(0, 1), b2 + hstepB, voffB); PG8_STAGE(PG8_SA(0, 0), a2, voffA);
            PG8_WAIT_V(8); PG8_WAIT_L(0); PG8_BAR; PG8_MMA(1, 0, At, B0); PG8_MMA(1, 1, At, B1); PG8_BAR; PG8_SCHED;
            PG8_LDB(B0, 1, 0); PG8_LDB(B1, 1, 1); PG8_SCHED; PG8_LDA(At, 1, 0); PG8_STAGE(PG8_SA(0, 1), a2 + hstepA, voffA);
            PG8_WAIT_V(8); PG8_WAIT_L(0); PG8_BAR; PG8_MMA(0, 0, At, B0); PG8_MMA(0, 1, At, B1); PG8_BAR; PG8_SCHED;
            PG8_LDA(At, 1, 1); PG8_STAGE(PG8_SB(1, 0), b3, voffB); PG8_STAGE(PG8_SB(1, 1), b3 + hstepB, voffB); PG8_STAGE(PG8_SA(1, 0), a3, voffA);
            PG8_WAIT_V(8); PG8_WAIT_L(0); PG8_BAR; PG8_MMA(1, 0, At, B0); PG8_MMA(1, 1, At, B1); PG8_BAR; PG8_SCHED;
        }
        if (wr == 0) PG8_BAR;
        asm volatile("" ::: "memory");
        { const int ln_ = lane_id(); E(acc, cur, wr, wc, ln_ & 15, ln_ >> 4); }
        asm volatile("" ::: "memory");
        if (!has_next) break;
        if (!(Epi::KEEP && cur.z + 1 < S.nZ)) {
#pragma unroll
        for (int a = 0; a < 2; ++a)
#pragma unroll
            for (int b = 0; b < 2; ++b)
#pragma unroll
                for (int m = 0; m < 4; ++m)
#pragma unroll
                    for (int n = 0; n < 2; ++n) acc[a][b][m][n] = (f32x4){0.f, 0.f, 0.f, 0.f}; }
        cur = nxt; cA = nA; cB = nB; ++ui;
        if (wr == 1) PG8_BAR;
    }
    PG8_WAIT_V(0);
    PG8_BAR;
#undef PG8_SA
#undef PG8_SB
#undef PG8_STAGE
#undef PG8_LDA
#undef PG8_LDB
#undef PG8_MMA
#undef PG8_WAIT_V
#undef PG8_WAIT_L
#undef PG8_BAR
#undef PG8_SCHED
}
}
using pg8::Unit; using pg8::HALF; using pg8::BM;
typedef f32x4 AccT[2][2][4][2];

struct EpiBf16 {
    static constexpr bool PERM = true, KEEP = false;
    bf16* O; int ldc; int tanh_pn;
    const float* rss;
    __device__ __forceinline__ void operator()(const AccT& acc, const Unit& u, int wr, int wc, int fr, int fq) const {
        const int row0 = u.pm * BM + wr * 64 + fr, col0 = u.pn * BM + wc * 32 + 8 * fq;
        float rsv[2][4];
#pragma unroll
        for (int ai = 0; ai < 2; ++ai)
#pragma unroll
            for (int m = 0; m < 4; ++m) rsv[ai][m] = rss ? rss[row0 + ai * HALF + m * 16] : 0.f;
#pragma unroll
        for (int ai = 0; ai < 2; ++ai)
#pragma unroll
            for (int m = 0; m < 4; ++m) { bf16* rowp = O + (size_t)(row0 + ai * HALF + m * 16) * ldc + col0; const float rs = rss ? __builtin_amdgcn_rsqf(rsv[ai][m] * (1.0f / D) + 1e-6f) : 1.0f;
#pragma unroll
                for (int bj = 0; bj < 2; ++bj) { f32x4 v0 = acc[ai][bj][m][0] * rs, v1 = acc[ai][bj][m][1] * rs;
                    if (bj == 0 && u.pn == tanh_pn) {
#pragma unroll
                        for (int j = 0; j < 4; ++j) { v0[j] = tanhf_(v0[j]); v1[j] = tanhf_(v1[j]); } }
                    u32x4 w; w.x = pk2(v0[0], v0[1]); w.y = pk2(v0[2], v0[3]); w.z = pk2(v1[0], v1[1]); w.w = pk2(v1[2], v1[3]);
                    *(u32x4*)(rowp + bj * HALF) = w; } }
    }
};
struct EpiF32 {
    static constexpr bool PERM = false, KEEP = false;
    float* C; int ldc; size_t zstride;
    __device__ __forceinline__ void operator()(const AccT& acc, const Unit& u, int wr, int wc, int fr, int fq) const {
        const int row0 = u.pm * BM + wr * 64 + fr, col0 = u.pn * BM + wc * 32 + 4 * fq; float* Cz = C + (size_t)u.z * zstride;
#pragma unroll
        for (int ai = 0; ai < 2; ++ai)
#pragma unroll
            for (int m = 0; m < 4; ++m) { float* rowp = Cz + (size_t)(row0 + ai * HALF + m * 16) * ldc + col0;
#pragma unroll
                for (int bj = 0; bj < 2; ++bj)
#pragma unroll
                    for (int n = 0; n < 2; ++n) *(f32x4*)(rowp + bj * HALF + n * 16) = acc[ai][bj][m][n]; }
    }
};
struct EpiLru {
    static constexpr bool PERM = false, KEEP = false;
    const float *b_r, *b_i, *lam;
    const bf16* XC; bf16* LA; bf16* BB;
    __device__ __forceinline__ void operator()(const AccT& acc, const Unit& u, int wr, int wc, int fr, int fq) const {
        const int d = u.pn >> 3, h = u.pn & 7; const int row0 = u.pm * BM + wr * 64 + fr;
#pragma unroll
        for (int n = 0; n < 2; ++n) { const int ch0 = h * 128 + wc * 32 + n * 16 + fq * 4; float br[4], bi[4], sp[4];
#pragma unroll
            for (int j = 0; j < 4; ++j) { br[j] = b_r[d * WB + ch0 + j]; bi[j] = b_i[d * WB + ch0 + j]; sp[j] = -8.0f * softplusf_(-lam[d * WB + ch0 + j]); }
            u32x2 xwv[2][4];
#pragma unroll
            for (int ai = 0; ai < 2; ++ai)
#pragma unroll
                for (int m = 0; m < 4; ++m) xwv[ai][m] = *(const u32x2*)(XC + (size_t)(row0 + ai * HALF + m * 16) * WB + ch0);
#pragma unroll
            for (int ai = 0; ai < 2; ++ai)
#pragma unroll
                for (int m = 0; m < 4; ++m) { const int t = row0 + ai * HALF + m * 16; int pos, L; seq_of(t, pos, L); const bool first = (d == 0) ? (pos == 0) : (pos == L - 1);
                    const f32x4 ar = acc[ai][0][m][n], aiq = acc[ai][1][m][n];
                    const u32x2 xw = xwv[ai][m];
                    const float xc[4] = {__uint_as_float(xw.x << 16), __uint_as_float(xw.x & 0xffff0000u), __uint_as_float(xw.y << 16), __uint_as_float(xw.y & 0xffff0000u)};
                    float oa[4], ob[4];
#pragma unroll
                    for (int j = 0; j < 4; ++j) { const float rg = sigmoidf_(ar[j] + br[j]), ig = sigmoidf_(aiq[j] + bi[j]); const float la = rg * sp[j];
                        float mult = __builtin_amdgcn_sqrtf(fmaxf(1.0f - __expf(2.0f * la), 0.f)); if (first) mult = 1.0f; oa[j] = la; ob[j] = mult * ig * xc[j]; }
                    u32x2 wa, wb; wa.x = pk2(oa[0], oa[1]); wa.y = pk2(oa[2], oa[3]); wb.x = pk2(ob[0], ob[1]); wb.y = pk2(ob[2], ob[3]);
                    *(u32x2*)(LA + ((size_t)d * T + t) * WB + ch0) = wa; *(u32x2*)(BB + ((size_t)d * T + t) * WB + ch0) = wb; } }
    }
};
struct EpiS5Main {
    static constexpr bool PERM = true, KEEP = false;
    bf16* YG;
    __device__ __forceinline__ void operator()(const AccT& acc, const Unit& u, int wr, int wc, int fr, int fq) const {
        const int row0 = u.pm * BM + wr * 64 + fr; const int g = u.z;
#pragma unroll
        for (int ai = 0; ai < 2; ++ai)
#pragma unroll
            for (int m = 0; m < 4; ++m) { const int c = row0 + ai * HALF + m * 16;
#pragma unroll
                for (int bj = 0; bj < 2; ++bj) { const int cc = bj * HALF + wc * 32 + 8 * fq; const int tau = cc >> 4, p0 = cc & 15; const f32x4 v0 = acc[ai][bj][m][0], v1 = acc[ai][bj][m][1];
                    u32x4 w; w.x = pk2(gelu_tanh(v0[0]), gelu_tanh(v0[1])); w.y = pk2(gelu_tanh(v0[2]), gelu_tanh(v0[3])); w.z = pk2(gelu_tanh(v1[0]), gelu_tanh(v1[1])); w.w = pk2(gelu_tanh(v1[2]), gelu_tanh(v1[3]));
                    *(u32x4*)(YG + (size_t)(c * 16 + tau) * WB + g * 16 + p0) = w; } }
    }
};
struct EpiGlu {
    static constexpr bool PERM = true, KEEP = false;
    const bf16* YG; const bf16* PROJ; const float* glu_b; bf16* Y;
    __device__ __forceinline__ void operator()(const AccT& acc, const Unit& u, int wr, int wc, int fr, int fq) const {
        const int row0 = u.pm * BM + wr * 64 + fr, col0 = u.pn * BM + wc * 32 + 8 * fq;
#pragma unroll
        for (int ai = 0; ai < 2; ++ai)
#pragma unroll
            for (int m = 0; m < 4; m += 2) { u32x4 ygw[2][2], zzw[2][2];
#pragma unroll
              for (int mm = 0; mm < 2; ++mm)
#pragma unroll
                for (int bj = 0; bj < 2; ++bj) { const int t = row0 + ai * HALF + (m + mm) * 16, col = col0 + bj * HALF; ygw[mm][bj] = *(const u32x4*)(YG + (size_t)t * WB + col); zzw[mm][bj] = *(const u32x4*)(PROJ + (size_t)t * NPJ + C_SZ + col); }
#pragma unroll
              for (int mm = 0; mm < 2; ++mm) { const int t = row0 + ai * HALF + (m + mm) * 16;
#pragma unroll
                for (int bj = 0; bj < 2; ++bj) { const int col = col0 + bj * HALF; const f32x4 v0 = acc[ai][bj][m + mm][0], v1 = acc[ai][bj][m + mm][1];
                    float yg[8], zz[8], o[8]; unpack8(ygw[mm][bj], yg); unpack8(zzw[mm][bj], zz);
                    const f32x4 b0 = *(const f32x4*)(glu_b + col), b1 = *(const f32x4*)(glu_b + col + 4);
#pragma unroll
                    for (int j = 0; j < 4; ++j) { o[j] = yg[j] * sigmoidf_(v0[j] + b0[j]) * siluf_(zz[j]); o[4 + j] = yg[4 + j] * sigmoidf_(v1[j] + b1[j]) * siluf_(zz[4 + j]); }
                    *(u32x4*)(Y + (size_t)t * 4096 + 3072 + col) = pack8(o); } } }
    }
};
struct EpiGate {
    static constexpr bool PERM = false, KEEP = false;
    bf16* GR; const float* rss;
    __device__ __forceinline__ void operator()(const AccT& acc, const Unit& u, int wr, int wc, int fr, int fq) const {
        const int row0 = u.pm * BM + wr * 64 + fr, ch0 = u.pn * 64 + wc * 16 + 4 * fq;
        float rsv[2][4];
#pragma unroll
        for (int ai = 0; ai < 2; ++ai)
#pragma unroll
            for (int m = 0; m < 4; ++m) rsv[ai][m] = rss[row0 + ai * HALF + m * 16];
#pragma unroll
        for (int ai = 0; ai < 2; ++ai)
#pragma unroll
            for (int m = 0; m < 4; ++m) { const size_t t = (size_t)(row0 + ai * HALF + m * 16); const float rs = __builtin_amdgcn_rsqf(rsv[ai][m] * (1.0f / D) + 1e-6f);
                float e1[4][4], g[4][4];
#pragma unroll
                for (int z = 0; z < 4; ++z) { const f32x4 v = acc[ai][z >> 1][m][z & 1] * rs;
#pragma unroll
                    for (int j = 0; j < 4; ++j) { e1[z][j] = 1.0f + __expf(-__builtin_amdgcn_fmed3f(v[j], -30.0f, 30.0f)); g[z][j] = __builtin_amdgcn_rcpf(e1[z][j]); } }
#pragma unroll
                for (int z = 0; z < 4; ++z) { float f[4];
#pragma unroll
                    for (int j = 0; j < 4; ++j) f[j] = z < 3 ? g[z][j] * e1[z + 1][j] : g[3][j];
                    u32x2 w; w.x = pk2(f[0], f[1]); w.y = pk2(f[2], f[3]); *(u32x2*)(GR + ((size_t)z * T + t) * D + ch0) = w; } }
    }
};
struct EpiBranchAll {
    static constexpr bool PERM = false, KEEP = true;
    const bf16* GR; bf16* MG;
    __device__ __forceinline__ void operator()(AccT& acc, const Unit& u, int wr, int wc, int fr, int fq) const {
        const int row0 = u.pm * BM + wr * 64 + fr, col0 = u.pn * BM + wc * 32 + 4 * fq; const int z = u.z;
#pragma unroll
        for (int ai = 0; ai < 2; ++ai)
          { u32x2 gv[4][2][2];
#pragma unroll
            for (int m = 0; m < 4; ++m)
#pragma unroll
                for (int bj = 0; bj < 2; ++bj)
#pragma unroll
                    for (int n = 0; n < 2; ++n) gv[m][bj][n] = *(const u32x2*)(GR + ((size_t)z * T + (size_t)(row0 + ai * HALF + m * 16)) * D + col0 + bj * HALF + n * 16);
#pragma unroll
            for (int m = 0; m < 4; ++m) { const size_t t = (size_t)(row0 + ai * HALF + m * 16);
#pragma unroll
                for (int bj = 0; bj < 2; ++bj)
#pragma unroll
                    for (int n = 0; n < 2; ++n) { const int o = bj * HALF + n * 16; const u32x2 g0 = gv[m][bj][n]; f32x4& a = acc[ai][bj][m][n];
                        a[0] *= __uint_as_float(g0.x << 16); a[1] *= __uint_as_float(g0.x & 0xffff0000u); a[2] *= __uint_as_float(g0.y << 16); a[3] *= __uint_as_float(g0.y & 0xffff0000u);
                        if (z == 3) { u32x2 w; w.x = pk2(a[0], a[1]); w.y = pk2(a[2], a[3]); *(u32x2*)(MG + t * D + col0 + o) = w; } } } }
    }
};
struct EpiOut {
    static constexpr bool PERM = false, KEEP = false;
    const float* xp; const float* xs; float* out; bf16* XB; float* rsp; int first;
    __device__ __forceinline__ void operator()(const AccT& acc, const Unit& u, int wr, int wc, int fr, int fq) const {
        const int row0 = u.pm * BM + wr * 64 + fr, col0 = u.pn * BM + wc * 32 + 4 * fq;
#pragma unroll
        for (int ai = 0; ai < 2; ++ai)
#pragma unroll
            for (int m2 = 0; m2 < 4; m2 += 2) { f32x4 sv[2][2][2];
#pragma unroll
              for (int mm = 0; mm < 2; ++mm) { const int t = row0 + ai * HALF + (m2 + mm) * 16; const size_t ro = (size_t)t * D + col0; const float* src = first ? (t < TP ? xp + ro : xs + (ro - (size_t)TP * D)) : out + ro;
#pragma unroll
                for (int bj = 0; bj < 2; ++bj)
#pragma unroll
                    for (int n = 0; n < 2; ++n) sv[mm][bj][n] = *(const f32x4*)(src + bj * HALF + n * 16); }
#pragma unroll
              for (int mm = 0; mm < 2; ++mm) { const int m = m2 + mm; const int t = row0 + ai * HALF + m * 16; const size_t ro = (size_t)t * D + col0; float ss = 0.f;
#pragma unroll
                for (int bj = 0; bj < 2; ++bj)
#pragma unroll
                    for (int n = 0; n < 2; ++n) { const int o = bj * HALF + n * 16; const f32x4 v = sv[mm][bj][n] + acc[ai][bj][m][n]; *(f32x4*)(out + ro + o) = v;
                        u32x2 w; w.x = pk2(v[0], v[1]); w.y = pk2(v[2], v[3]); *(u32x2*)(XB + ro + o) = w; ss += (v[0] * v[0] + v[1] * v[1]) + (v[2] * v[2] + v[3] * v[3]); }
                ss += shx<16>(ss); ss += shx<32>(ss);
                if (fq == 0) rsp[(size_t)t * 32 + u.pn * 4 + wc] = ss; } }
    }
};

struct EpiNull { static constexpr bool PERM = false, KEEP = false; __device__ __forceinline__ void operator()(const AccT&, const Unit&, int, int, int, int) const {} };
#define XB_TMO      128
#define XB_XCNT(j)  (256  + 64 * (j))
#define XB_XSUB(j)  (1280 + 64 * (j))
#define XB_XGEN(j)  (2304 + 64 * (j))
#define XB_TOP      3328
#define XB_TOPGEN   3392
#define XCD_BAR_WORDS 3456
#define XB_SPIN_CAP (1u << 24)
__device__ __forceinline__ unsigned xb_ld(unsigned* p)              { return __hip_atomic_load(p, __ATOMIC_RELAXED, __HIP_MEMORY_SCOPE_AGENT); }
__device__ __forceinline__ unsigned xb_add(unsigned* p, unsigned v) { return __hip_atomic_fetch_add(p, v, __ATOMIC_RELAXED, __HIP_MEMORY_SCOPE_AGENT); }
__device__ __forceinline__ unsigned xb_xcc_id() { return (unsigned)__builtin_amdgcn_s_getreg((3 << 11) | 20) & 0xFu; }
#define XB_SPIN(cond, bar) do { unsigned _sp = 0; while (cond) { __builtin_amdgcn_s_sleep(1); \
    if ((++_sp & 255u) == 0u) { if (xb_ld(&(bar)[XB_TMO])) break; if (_sp > XB_SPIN_CAP) { atomicAdd(&(bar)[XB_TMO], 1u); break; } } } } while (0)
struct XcdBarrier { unsigned* bar; unsigned x; volatile LAS unsigned* st; int wave; };
__device__ __forceinline__ XcdBarrier xcd_barrier_post(unsigned* bar, volatile LAS unsigned* st) {
    XcdBarrier b; b.bar = bar; b.x = xb_xcc_id(); b.st = st;
    if (threadIdx.x == 0) (void)xb_add(&bar[XB_XCNT(b.x)], 1u);
    return b;
}
__device__ __forceinline__ void xcd_barrier_complete(unsigned* bar, unsigned x, unsigned& nloc, unsigned& nx) {
    const unsigned G = gridDim.x * gridDim.y * gridDim.z;
    unsigned sum, cnt, mine, sp = 0u;
    for (;;) {
        sum = 0u; cnt = 0u; mine = 0u;
#pragma unroll 1
        for (unsigned j = 0; j < 16; ++j) { const unsigned c = xb_ld(&bar[XB_XCNT(j)]); sum += c; cnt += (c > 0u) ? 1u : 0u; mine = (j == x) ? c : mine; }
        if (sum == G) break;
        __builtin_amdgcn_s_sleep(1);
        if ((++sp & 255u) == 0u) { if (xb_ld(&bar[XB_TMO])) break; if (sp > XB_SPIN_CAP) { atomicAdd(&bar[XB_TMO], 1u); break; } }
    }
    nloc = mine > 0u ? mine : 1u; nx = cnt > 0u ? cnt : 1u;
}
__device__ __forceinline__ void xcd_barrier(const XcdBarrier& b) {
    asm volatile("s_waitcnt vmcnt(0)" ::: "memory");
    __syncthreads();
    if (b.wave == 0 && lane_id() == 0) {
        unsigned* bar = b.bar;
        __builtin_amdgcn_s_waitcnt(0);
        unsigned nloc = b.st[0], nx = b.st[1];
        if (nloc == 0u) { xcd_barrier_complete(bar, b.x, nloc, nx); b.st[0] = nloc; b.st[1] = nx; }
        const unsigned old = xb_add(&bar[XB_XSUB(b.x)], 1u);
        const unsigned gen = old / nloc;
        if (old + 1u == (gen + 1u) * nloc) {
            __builtin_amdgcn_fence(__ATOMIC_RELEASE, "agent");
            asm volatile("s_waitcnt vmcnt(0)" ::: "memory");
            const unsigned og = xb_add(&bar[XB_TOP], 1u);
            const unsigned tg = og / nx;
            if (og + 1u == (tg + 1u) * nx) xb_add(&bar[XB_TOPGEN], 1u);
            else XB_SPIN(xb_ld(&bar[XB_TOPGEN]) == tg, bar);
            __builtin_amdgcn_fence(__ATOMIC_ACQUIRE, "agent");
            xb_add(&bar[XB_XGEN(b.x)], 1u);
            asm volatile("s_waitcnt vmcnt(0)" ::: "memory");
        } else {
            XB_SPIN(xb_ld(&bar[XB_XGEN(b.x)]) == gen, bar);
            __builtin_amdgcn_fence(__ATOMIC_ACQUIRE, "agent");
            asm volatile("s_waitcnt vmcnt(0)" ::: "memory");
        }
    }
    __syncthreads();
}
constexpr int NWAVES = 8, NTHR = 512;
constexpr int LDS_BYTES = 147456;
constexpr int LDS_MISC = LDS_BYTES - 256;
struct Args { const float* in[35]; float* out; unsigned char* ws; int ph_lo, ph_hi; };
constexpr int LDS_ARGS = LDS_BYTES - 1024;
struct AP { const LAS unsigned long long* q; unsigned char* ws; float* out;
    __device__ __forceinline__ const float* in(int i) const { const unsigned long long v = q[i]; const unsigned lo = __builtin_amdgcn_readfirstlane((unsigned)v), hi = __builtin_amdgcn_readfirstlane((unsigned)(v >> 32)); return (const float*)(((unsigned long long)hi << 32) | lo); } };
struct Frame { LAS unsigned char* lds; int tid, lane, wave, gw, ngw, gt, ngt; };
enum { I_XP = 0, I_XS, I_NORMG, I_WIN, I_CONVW, I_CONVB, I_WR, I_BR, I_WI, I_BI, I_LAM, I_MU, I_W0, I_W2, I_A0, I_A2, I_KK, I_KA, I_RK, I_LNG, I_LNB, I_GNG,
       I_SLRE, I_SLIM, I_SLOG, I_SBRE, I_SBIM, I_SCRE, I_SCIM, I_SD, I_GLUW, I_GLUB, I_WBR, I_WOUT, I_FING };

__device__ __forceinline__ float sin_rev(float x) { return __builtin_amdgcn_sinf(x); }
__device__ __forceinline__ float cos_rev(float x) { return __builtin_amdgcn_cosf(x); }
__device__ __forceinline__ f32x2 cexp_pow(float lre, float lim, float st, int k) {
    const float mag = __expf((float)k * lre * st); double ph = (double)k * (double)lim * (double)st * 0.15915494309189535; ph -= rint(ph);
    const float f = (float)ph; return (f32x2){mag * cos_rev(f), mag * sin_rev(f)};
}

__device__ __forceinline__ void ph_tables(const AP& a, const Frame& F) {
    f32x2* TAB = (f32x2*)(a.ws + WS_S5TAB); f32x2* ROT = (f32x2*)(a.ws + WS_ROT);
    for (int i = F.gt; i < DEPTH * 2 * 64 * 64; i += F.ngt) {
        const float lre = fminf(a.in(I_SLRE)[i], -1e-4f), lim = a.in(I_SLIM)[i]; const float st = __expf(a.in(I_SLOG)[i >> 6]);
        const f32x2 p1 = cexp_pow(lre, lim, st, 1); const float nr = p1.x - 1.f, ni = p1.y, den = lre * lre + lim * lim;
        const float gr = (nr * lre + ni * lim) / den, gi = (ni * lre - nr * lim) / den;
        for (int k = 0; k <= 16; ++k) { const f32x2 p = cexp_pow(lre, lim, st, k); TAB[(size_t)i * 33 + 16 + k] = p; if (k < 16) TAB[(size_t)i * 33 + k] = (f32x2){p.x * gr - p.y * gi, p.x * gi + p.y * gr}; }
    }
    for (int i = F.gt; i < 16384 * 64; i += F.ngt) { const int pos = i >> 6, j = i & 63;
        const double inv = exp(-(double)j * (9.210340371976184 / 64.0)); double ph = (double)pos * inv * 0.15915494309189535; ph -= rint(ph); const float f = (float)ph;
        ROT[i] = (f32x2){cos_rev(f), sin_rev(f)}; }
}
struct TrItem { const float* W; int ldw; bf16* WT; int ldt, k0, n0, drow0, dcol0; const float* ksc; int gmap; };
__device__ __forceinline__ TrItem tr_decode(const AP& a, int it) {
    bf16* WALLT = (bf16*)(a.ws + WS_WALLT); bf16* GLUT = (bf16*)(a.ws + WS_GLUT); bf16* WBRT = (bf16*)(a.ws + WS_WBRT); bf16* WOUTT = (bf16*)(a.ws + WS_WOUTT);
    constexpr int I_IN = 32 * (NIN / 32), I_GL = 16 * 32, I_BRI = 16 * 64, I_OUT = 32 * 64, PER = I_IN + I_GL + 4 * I_BRI + I_OUT;
    const int l = it / PER; int r = it % PER; TrItem d;
    if (r < I_IN) { const int kb = r / (NIN / 32), nb = r % (NIN / 32), n0 = nb * 32; d = TrItem{a.in(I_WIN) + (size_t)l * D * NIN, NIN, WALLT + (size_t)l * NALL * D, D, kb * 64, n0, 0, 0, a.in(I_NORMG) + (size_t)l * D, n0 >= GOFF ? 1 : 0}; return d; } r -= I_IN;
    if (r < I_GL) { const int kb = r / 32, nb = r % 32; d = TrItem{a.in(I_GLUW) + (size_t)l * WB * WB, WB, GLUT + (size_t)l * WB * WB, WB, kb * 64, nb * 32, 0, 0, nullptr, 0}; return d; } r -= I_GL;
    if (r < 4 * I_BRI) { const int br = r / I_BRI, q = r % I_BRI, kb = q / 64, nb = q % 64; d = TrItem{a.in(I_WBR) + ((size_t)l * 4 + br) * WB * D, D, WBRT + (size_t)l * D * 4096, 4096, kb * 64, nb * 32, 0, br * WB, nullptr, 0}; return d; } r -= 4 * I_BRI;
    { const int kb = r / 64, nb = r % 64; d = TrItem{a.in(I_WOUT) + (size_t)l * D * D, D, WOUTT + (size_t)l * D * D, D, kb * 64, nb * 32, 0, 0, nullptr, 0}; return d; }
}
__device__ __forceinline__ void tr_load(const TrItem& d, float (&x)[32], int lane) {
#pragma unroll
    for (int i = 0; i < 32; ++i) { const int kk = 2 * i + (lane >> 5); x[i] = d.W[(size_t)(d.k0 + kk) * d.ldw + d.n0 + (lane & 31)] * (d.ksc ? d.ksc[d.k0 + kk] : 1.0f); }
}
__device__ __forceinline__ void tr_store(const TrItem& d, const float (&x)[32], LAS float* scr, int lane) {
#pragma unroll
    for (int i = 0; i < 32; ++i) { const int kk = 2 * i + (lane >> 5); scr[kk * 33 + (lane & 31)] = x[i]; }
    asm volatile("s_waitcnt lgkmcnt(0)" ::: "memory");
    const int c = lane & 7;
#pragma unroll
    for (int j = 0; j < 4; ++j) { const int n = (lane >> 3) + 8 * j; const LAS float* s = scr + (8 * c) * 33 + n;
        u32x4 o; o.x = pk2(s[0 * 33], s[1 * 33]); o.y = pk2(s[2 * 33], s[3 * 33]); o.z = pk2(s[4 * 33], s[5 * 33]); o.w = pk2(s[6 * 33], s[7 * 33]);
        int drow = d.drow0 + d.n0 + n;
        if (d.gmap) { const int g0 = d.n0 + n - GOFF, z = g0 >> 11, nn = g0 & 2047, gp = nn >> 6, nl = nn & 63;
            drow = NPJ + gp * 256 + 128 * (z >> 1) + 16 * (z & 1) + 32 * (nl >> 4) + (nl & 15); }
        *(u32x4*)(d.WT + (size_t)drow * d.ldt + d.dcol0 + d.k0 + 8 * c) = o; }
    asm volatile("s_waitcnt lgkmcnt(0)" ::: "memory");
}
__device__ __forceinline__ void ph_convert(const AP& a, const Frame& F) {
    LAS float* scr = (LAS float*)(F.lds + F.wave * 16384);
    bf16* WALLT = (bf16*)(a.ws + WS_WALLT);
    constexpr int PERI = 32 * (NIN / 32) + 16 * 32 + 4 * 16 * 64 + 32 * 64; const int NIT = DEPTH * PERI;
    { float xa[32], xb[32]; int it = F.gw;
      if (it < NIT) { TrItem da = tr_decode(a, it); tr_load(da, xa, F.lane);
          for (;;) { const int itb = it + F.ngw; TrItem db; const bool hb = itb < NIT; if (hb) { db = tr_decode(a, itb); tr_load(db, xb, F.lane); }
              tr_store(da, xa, scr, F.lane); if (!hb) break;
              const int ita = itb + F.ngw; const bool ha = ita < NIT; if (ha) { da = tr_decode(a, ita); tr_load(da, xa, F.lane); }
              tr_store(db, xb, scr, F.lane); if (!ha) break; it = ita; } } }
    for (int i = F.gt; i < DEPTH * 64 * (D / 8); i += F.ngt) { const int l = i / (64 * (D / 8)), r = (i / (D / 8)) % 64, c8 = i % (D / 8); *(u32x4*)(WALLT + ((size_t)l * NALL + GOFF + r) * D + c8 * 8) = (u32x4){0u, 0u, 0u, 0u}; }
    bf16* LRUW = (bf16*)(a.ws + WS_LRUW);
    for (int i = F.gt; i < DEPTH * 4096 * 32; i += F.ngt) { const int k8 = i & 31, n = (i >> 5) & 4095, l = i >> 17; const int pn = n >> 8, d = pn >> 3, h = pn & 7, gate = (n >> 7) & 1, j = n & 127;
        u32x4 o = (u32x4){0u, 0u, 0u, 0u};
        if ((k8 >> 4) == (h & 1)) { const float* w = (gate ? a.in(I_WI) : a.in(I_WR)) + ((((size_t)l * 2 + d) * 8 + h) * 128) * 128 + j; const int i0 = (k8 & 15) * 8; float x[8];
#pragma unroll
            for (int q = 0; q < 8; ++q) x[q] = w[(size_t)(i0 + q) * 128]; o = pack8(x); }
        *(u32x4*)(LRUW + ((size_t)l * 4096 + n) * 256 + k8 * 8) = o; }
    bf16* W2ALL = (bf16*)(a.ws + WS_W2ALL);
    for (int i = F.gt; i < DEPTH * 3072 * 32; i += F.ngt) { const int k8 = i & 31, n = (i >> 5) % 3072, l = (i >> 5) / 3072; const int blk = n >> 10, c = n & 1023; u32x4 o = (u32x4){0u, 0u, 0u, 0u};
        if ((k8 >> 3) == blk) { const int j0 = (k8 & 7) * 8; const float* w = blk < 2 ? a.in(I_W2) + (((size_t)l * 2 + blk) * 64 + j0) * WB + c : a.in(I_A2) + ((size_t)l * 64 + j0) * WB + c; float x[8];
#pragma unroll
            for (int q = 0; q < 8; ++q) x[q] = w[(size_t)q * WB]; o = pack8(x); }
        *(u32x4*)(W2ALL + ((size_t)l * 3072 + n) * 256 + k8 * 8) = o; }
    float* KTAB = (float*)(a.ws + WS_PROJ); const f32x2* TAB = (const f32x2*)(a.ws + WS_S5TAB);
    for (int i = F.gt; i < DEPTH * 64 * 2 * 16 * 16; i += F.ngt) { const int p = i & 15, dl = (i >> 4) & 15, dir = (i >> 8) & 1, g = (i >> 9) & 63, l = i >> 15;
        const float* cre = a.in(I_SCRE) + (((size_t)l * 64 + g) * 16 + p) * 64; const float* cim = a.in(I_SCIM) + (((size_t)l * 64 + g) * 16 + p) * 64;
        const float* bre = a.in(I_SBRE) + ((size_t)l * 64 + g) * 64 * 16; const float* bim = a.in(I_SBIM) + ((size_t)l * 64 + g) * 64 * 16;
        const f32x2* tb = TAB + ((((size_t)l * 2 + dir) * 64 + g) * 64) * 33 + dl; f32x4 s[4] = {(f32x4){0.f, 0.f, 0.f, 0.f}, (f32x4){0.f, 0.f, 0.f, 0.f}, (f32x4){0.f, 0.f, 0.f, 0.f}, (f32x4){0.f, 0.f, 0.f, 0.f}};
        for (int n = 0; n < 64; ++n) { const f32x2 gk = tb[(size_t)n * 33]; const float cr = cre[n], ci = cim[n]; const float zr = cr * gk.x - ci * gk.y, zi = cr * gk.y + ci * gk.x;
#pragma unroll
            for (int q4 = 0; q4 < 4; ++q4) { const f32x4 br = *(const f32x4*)(bre + n * 16 + q4 * 4), bi = *(const f32x4*)(bim + n * 16 + q4 * 4); s[q4] += br * zr - bi * zi; } }
        float* o = KTAB + ((((size_t)(l * 64 + g) * 2 + dir) * 16 + dl) * 16 + p) * 16;
#pragma unroll
        for (int q4 = 0; q4 < 4; ++q4) *(f32x4*)(o + q4 * 4) = s[q4]; }
}
__device__ __forceinline__ void ph_s5mats(const AP& a, const Frame& F) {
    const float* KTAB = (const float*)(a.ws + WS_PROJ); const f32x2* TAB = (const f32x2*)(a.ws + WS_S5TAB);
    bf16* MAIN = (bf16*)(a.ws + WS_S5MAIN); bf16* INCM = (bf16*)(a.ws + WS_S5INC);
    for (int i = F.gt; i < DEPTH * 64 * 256 * 64; i += F.ngt) { const int c8 = i & 63, row = (i >> 6) & 255, g = (i >> 14) & 63, l = i >> 20; const int tau = row >> 4, p = row & 15; float x[8];
        if (c8 < 32) { const int sg = c8 >> 1, q0 = (c8 & 1) * 8; const float* kb = KTAB + ((size_t)l * 64 + g) * 2 * 16 * 256;
            if (sg < tau) { const float* k = kb + ((0 * 16 + (tau - sg)) * 16 + p) * 16 + q0;
#pragma unroll
                for (int q = 0; q < 8; ++q) x[q] = k[q]; }
            else if (sg > tau) { const float* k = kb + ((1 * 16 + (sg - tau)) * 16 + p) * 16 + q0;
#pragma unroll
                for (int q = 0; q < 8; ++q) x[q] = k[q]; }
            else { const float* k0 = kb + ((0 * 16 + 0) * 16 + p) * 16 + q0; const float* k1 = kb + ((1 * 16 + 0) * 16 + p) * 16 + q0; const float dsk = a.in(I_SD)[(size_t)l * WB + g * 16 + p];
#pragma unroll
                for (int q = 0; q < 8; ++q) x[q] = k0[q] + k1[q] + ((q0 + q) == p ? dsk : 0.f); }
        } else { const int part = (c8 - 32) >> 3, n0 = ((c8 - 32) & 7) * 8, dir = part >> 1; const int k = dir == 0 ? (tau + 1) : (16 - tau);
            const float* cre = a.in(I_SCRE) + (((size_t)l * 64 + g) * 16 + p) * 64 + n0; const float* cim = a.in(I_SCIM) + (((size_t)l * 64 + g) * 16 + p) * 64 + n0;
            const f32x2* tb = TAB + ((((size_t)l * 2 + dir) * 64 + g) * 64 + n0) * 33 + 16 + k;
#pragma unroll
            for (int q = 0; q < 8; ++q) { const f32x2 pw = tb[(size_t)q * 33]; const float zr = cre[q] * pw.x - cim[q] * pw.y, zi = cre[q] * pw.y + cim[q] * pw.x; x[q] = (part & 1) ? -zi : zr; } }
        *(u32x4*)(MAIN + ((((size_t)l * 64 + g) * 256 + row) * 512) + c8 * 8) = pack8(x); }
    for (int i = F.gt; i < DEPTH * 64 * 256 * 32; i += F.ngt) { const int c8 = i & 31, row = (i >> 5) & 255, g = (i >> 13) & 63, l = i >> 19; const int part = row >> 6, n = row & 63, dir = part >> 1, sg = c8 >> 1, q0 = (c8 & 1) * 8;
        const int k = dir == 0 ? (15 - sg) : sg; const f32x2 gk = TAB[((((size_t)l * 2 + dir) * 64 + g) * 64 + n) * 33 + k];
        const float* bre = a.in(I_SBRE) + (((size_t)l * 64 + g) * 64 + n) * 16 + q0; const float* bim = a.in(I_SBIM) + (((size_t)l * 64 + g) * 64 + n) * 16 + q0; float x[8];
#pragma unroll
        for (int q = 0; q < 8; ++q) { const float zr = gk.x * bre[q] - gk.y * bim[q], zi = gk.x * bim[q] + gk.y * bre[q]; x[q] = (part & 1) ? zi : zr; }
        *(u32x4*)(INCM + ((((size_t)l * 64 + g) * 256 + row) * 256) + c8 * 8) = pack8(x); }
}

__device__ __forceinline__ void ph_x0(const AP& a, const Frame& F) {
    bf16* H = (bf16*)(a.ws + WS_H); float* RSS = (float*)(a.ws + WS_RSS);
    for (int t = F.gw; t < T; t += F.ngw) { const float* xr = t < TP ? a.in(I_XP) + (size_t)t * D : a.in(I_XS) + (size_t)(t - TP) * D; float s = 0.f;
#pragma unroll
        for (int j = 0; j < 8; ++j) { const f32x4 v = *(const f32x4*)(xr + (F.lane + 64 * j) * 4); s += (v[0] * v[0] + v[1] * v[1]) + (v[2] * v[2] + v[3] * v[3]); u32x2 w; w.x = pk2(v[0], v[1]); w.y = pk2(v[2], v[3]); *(u32x2*)(H + (size_t)t * D + (F.lane + 64 * j) * 4) = w; }
        s = wave_sum(s); if (F.lane == 0) RSS[t] = s; }
}
__device__ __forceinline__ void ph_rss(const AP& a, const Frame& F, int l) {
    const float* P = (const float*)(a.ws + WS_RSP); float* R = (float*)(a.ws + WS_RSS) + (size_t)((l + 1) & 1) * T;
    for (int t = F.gt; t < T; t += F.ngt) { float s = 0.f;
#pragma unroll
        for (int j = 0; j < 8; ++j) { const f32x4 v = *(const f32x4*)(P + (size_t)t * 32 + j * 4); s += (v[0] + v[1]) + (v[2] + v[3]); }
        R[t] = s; }
}
__device__ __forceinline__ void ph_final(const AP& a, const Frame& F) {
    const float* RSS = (const float*)(a.ws + WS_RSS) + (size_t)(DEPTH & 1) * T; const float* g = a.in(I_FING);
#pragma unroll 4
    for (int i = F.gt; i < T * (D / 4); i += F.ngt) { const int t = i / (D / 4), c4 = (i % (D / 4)) * 4; const float rs = __builtin_amdgcn_rsqf(RSS[t] * (1.0f / D) + 1e-6f);
        float* p = a.out + (size_t)t * D + c4; *(f32x4*)p = *(const f32x4*)p * rs * *(const f32x4*)(g + c4); }
}
__device__ __forceinline__ void ph_lru_conv(const AP& a, const Frame& F, int l) {
    const bf16* PROJ = (const bf16*)(a.ws + WS_PROJ); bf16* XC = (bf16*)(a.ws + WS_SCR + SA_XC);
    const float* cw = a.in(I_CONVW) + (size_t)l * 4 * WB; const float* cb = a.in(I_CONVB) + (size_t)l * WB;
    if ((F.ngt & 127) == 0) {
        const int c8 = (F.gt & 127) * 8; float wv[4][8], bv[8];
#pragma unroll
        for (int q = 0; q < 8; ++q) { bv[q] = cb[c8 + q];
#pragma unroll
            for (int j = 0; j < 4; ++j) wv[j][q] = cw[j * WB + c8 + q]; }
#pragma unroll 2
        for (int i = F.gt; i < T * 128; i += F.ngt) { const int t = i >> 7; int pos, L; seq_of(t, pos, L); u32x4 xr[4];
#pragma unroll
            for (int j = 0; j < 4; ++j) { const int pp = pos + j - 2; xr[j] = (pp >= 0 && pp < L) ? *(const u32x4*)(PROJ + (size_t)(t + j - 2) * NPJ + C_LRUX + c8) : (u32x4){0u, 0u, 0u, 0u}; }
            float acc[8];
#pragma unroll
            for (int q = 0; q < 8; ++q) acc[q] = bv[q];
#pragma unroll
            for (int j = 0; j < 4; ++j) { float x[8]; unpack8(xr[j], x);
#pragma unroll
                for (int q = 0; q < 8; ++q) acc[q] += wv[j][q] * x[q]; }
            *(u32x4*)(XC + (size_t)t * WB + c8) = pack8(acc); }
        return; }
    for (int i = F.gt; i < T * 128; i += F.ngt) { const int t = i >> 7, c8 = (i & 127) * 8; int pos, L; seq_of(t, pos, L); float acc[8];
#pragma unroll
        for (int q = 0; q < 8; ++q) acc[q] = cb[c8 + q];
#pragma unroll
        for (int j = 0; j < 4; ++j) { const int pp = pos + j - 2; if (pp >= 0 && pp < L) { float x[8]; unpack8(*(const u32x4*)(PROJ + (size_t)(t + j - 2) * NPJ + C_LRUX + c8), x);
#pragma unroll
                for (int q = 0; q < 8; ++q) acc[q] += cw[j * WB + c8 + q] * x[q]; } }
        *(u32x4*)(XC + (size_t)t * WB + c8) = pack8(acc); }
}
#define LOF(x) __uint_as_float((x) << 16)
#define HIF(x) __uint_as_float((x) & 0xffff0000u)
__device__ __forceinline__ void ph_lru_scan1(const AP& a, const Frame& F) {
    const bf16* LA = (const bf16*)(a.ws + WS_SCR + SA_LA); const bf16* BB = (const bf16*)(a.ws + WS_SCR + SA_BB); float* PA = (float*)(a.ws + WS_SCR + SA_PA); float* PB = (float*)(a.ws + WS_SCR + SA_PB);
    for (int i = F.gt; i < NCH_L32 * 2 * 512; i += F.ngt) { const int ch = (i & 511) * 2, d = (i >> 9) & 1, c = i >> 10; float s0 = 0.f, s1 = 0.f, h0 = 0.f, h1 = 0.f;
        unsigned la[32], bb[32];
#pragma unroll
        for (int s = 0; s < 32; ++s) { const int t = c * 32 + (d == 0 ? s : 31 - s); const size_t o = ((size_t)d * T + t) * WB + ch; la[s] = *(const unsigned*)(LA + o); bb[s] = *(const unsigned*)(BB + o); }
#pragma unroll
        for (int s = 0; s < 32; ++s) { const float l0 = LOF(la[s]), l1 = HIF(la[s]); h0 = __expf(l0) * h0 + LOF(bb[s]); h1 = __expf(l1) * h1 + HIF(bb[s]); s0 += l0; s1 += l1; }
        const size_t o = ((size_t)c * 2 + d) * WB + ch; *(f32x2*)(PA + o) = (f32x2){__expf(s0), __expf(s1)}; *(f32x2*)(PB + o) = (f32x2){h0, h1}; }
}
__device__ __forceinline__ void ph_lru_scan2(const AP& a, const Frame& F) {
    const float* PA = (const float*)(a.ws + WS_SCR + SA_PA); const float* PB = (const float*)(a.ws + WS_SCR + SA_PB); float* CAR = (float*)(a.ws + WS_SCR + SA_CAR);
    LAS float* ex = (LAS float*)F.lds;
    for (int it = blockIdx.x; it < 5 * 2 * 16; it += gridDim.x) { const int slab = it & 15, d = (it >> 4) & 1, sq = it >> 5; const int c0 = sq == 0 ? 0 : 512 + (sq - 1) * 64, nc = sq == 0 ? 512 : 64, ns = nc / 8;
        const int ch = slab * 64 + F.lane, seg = F.wave; float p = 1.f, h = 0.f;
        for (int s0 = 0; s0 < ns; s0 += 8) { float pa[8], pb[8];
#pragma unroll
            for (int u = 0; u < 8; ++u) { const int sp = seg * ns + s0 + u, c = c0 + (d == 0 ? sp : nc - 1 - sp); const size_t o = ((size_t)c * 2 + d) * WB + ch; pa[u] = PA[o]; pb[u] = PB[o]; }
#pragma unroll
            for (int u = 0; u < 8; ++u) { h = pa[u] * h + pb[u]; p *= pa[u]; } }
        __syncthreads(); ex[(seg * 64 + F.lane) * 2] = p; ex[(seg * 64 + F.lane) * 2 + 1] = h; __syncthreads();
        float x = 0.f;
        for (int s2 = 0; s2 < seg; ++s2) x = ex[(s2 * 64 + F.lane) * 2] * x + ex[(s2 * 64 + F.lane) * 2 + 1];
        for (int s0 = 0; s0 < ns; s0 += 8) { float pa[8], pb[8];
#pragma unroll
            for (int u = 0; u < 8; ++u) { const int sp = seg * ns + s0 + u, c = c0 + (d == 0 ? sp : nc - 1 - sp); const size_t o = ((size_t)c * 2 + d) * WB + ch; pa[u] = PA[o]; pb[u] = PB[o]; }
#pragma unroll
            for (int u = 0; u < 8; ++u) { const int sp = seg * ns + s0 + u, c = c0 + (d == 0 ? sp : nc - 1 - sp); CAR[((size_t)c * 2 + d) * WB + ch] = x; x = pa[u] * x + pb[u]; } }
    }
}
__device__ __forceinline__ void ph_lru_scan3(const AP& a, const Frame& F) {
    const bf16* LA = (const bf16*)(a.ws + WS_SCR + SA_LA); const bf16* BB = (const bf16*)(a.ws + WS_SCR + SA_BB); const float* CAR = (const float*)(a.ws + WS_SCR + SA_CAR);
    const bf16* PROJ = (const bf16*)(a.ws + WS_PROJ); bf16* Y = (bf16*)(a.ws + WS_Y);
    for (int i = F.gt; i < NCH_L32 * 512; i += F.ngt) { const int ch = (i & 511) * 2, c = i >> 9;
        unsigned la[32], bb[32], hf[32];
#pragma unroll
        for (int s = 0; s < 32; ++s) { const size_t o = (size_t)(c * 32 + s) * WB + ch; la[s] = *(const unsigned*)(LA + o); bb[s] = *(const unsigned*)(BB + o); }
        f32x2 h = *(const f32x2*)(CAR + ((size_t)c * 2 + 0) * WB + ch);
#pragma unroll
        for (int s = 0; s < 32; ++s) { h[0] = __expf(LOF(la[s])) * h[0] + LOF(bb[s]); h[1] = __expf(HIF(la[s])) * h[1] + HIF(bb[s]); hf[s] = pk2(h[0], h[1]); }
        asm volatile("" ::: "memory");
#pragma unroll
        for (int s = 0; s < 32; ++s) { const size_t o = ((size_t)T + c * 32 + s) * WB + ch; la[s] = *(const unsigned*)(LA + o); bb[s] = *(const unsigned*)(BB + o); }
        h = *(const f32x2*)(CAR + ((size_t)c * 2 + 1) * WB + ch);
#pragma unroll
        for (int s0 = 16; s0 >= 0; s0 -= 16) { unsigned zq[16];
#pragma unroll
            for (int u = 0; u < 16; ++u) zq[u] = *(const unsigned*)(PROJ + (size_t)(c * 32 + s0 + u) * NPJ + C_LRUZ + ch);
#pragma unroll
            for (int u = 15; u >= 0; --u) { const int s = s0 + u; h[0] = __expf(LOF(la[s])) * h[0] + LOF(bb[s]); h[1] = __expf(HIF(la[s])) * h[1] + HIF(bb[s]); const unsigned zz = zq[u];
                *(unsigned*)(Y + (size_t)(c * 32 + s) * 4096 + ch) = pk2((LOF(hf[s]) + h[0]) * siluf_(LOF(zz)), (HIF(hf[s]) + h[1]) * siluf_(HIF(zz))); } } }
}
#undef LOF
#undef HIF

__device__ __forceinline__ void ph_s5_rearr(const AP& a, const Frame& F) {
    const bf16* PROJ = (const bf16*)(a.ws + WS_PROJ); bf16* UC = (bf16*)(a.ws + WS_SCR + SD_UC);
#pragma unroll 4
    for (int i = F.gt; i < T * 64; i += F.ngt) { const int g = i & 63, t = i >> 6, c = t >> 4, tau = t & 15; const u32x4* s = (const u32x4*)(PROJ + (size_t)t * NPJ + C_SU + g * 16);
        u32x4* d = (u32x4*)(UC + ((size_t)g * NCH_S5 + c) * 512 + tau * 16); d[0] = s[0]; d[1] = s[1]; }
}
__device__ __forceinline__ void ph_s5_scan(const AP& a, const Frame& F, int l) {
    const float* INC = (const float*)(a.ws + WS_SCR + SD_INC); bf16* UC = (bf16*)(a.ws + WS_SCR + SD_UC); const f32x2* TAB = (const f32x2*)(a.ws + WS_S5TAB);
    LAS float* ex = (LAS float*)F.lds;
    for (int it = blockIdx.x; it < 5 * 64 * 2; it += gridDim.x) { const int d = it & 1, g = (it >> 1) & 63, sq = it >> 7; const int c0 = sq == 0 ? 0 : 1024 + (sq - 1) * 128, nc = sq == 0 ? 1024 : 128, ns = nc / 8;
        const int n = F.lane, seg = F.wave; const f32x2 lc = TAB[((((size_t)l * 2 + d) * 64 + g) * 64 + n) * 33 + 32];
        float xr = 0.f, xi = 0.f, pr = 1.f, pi = 0.f;
        for (int s0 = 0; s0 < ns; s0 += 8) { float ir[8], ii[8];
#pragma unroll
            for (int u = 0; u < 8; ++u) { const int sp = seg * ns + s0 + u, c = c0 + (d == 0 ? sp : nc - 1 - sp); const size_t ro = (size_t)g * NCH_S5 + c; ir[u] = INC[ro * 256 + d * 128 + n]; ii[u] = INC[ro * 256 + d * 128 + 64 + n]; }
#pragma unroll
            for (int u = 0; u < 8; ++u) { const float nr = lc.x * xr - lc.y * xi + ir[u], ni = lc.x * xi + lc.y * xr + ii[u]; xr = nr; xi = ni; const float qr = lc.x * pr - lc.y * pi, qi = lc.x * pi + lc.y * pr; pr = qr; pi = qi; } }
        __syncthreads(); ex[(seg * 64 + n) * 2] = xr; ex[(seg * 64 + n) * 2 + 1] = xi; __syncthreads();
        xr = 0.f; xi = 0.f;
        for (int s2 = 0; s2 < seg; ++s2) { const float er = ex[(s2 * 64 + n) * 2], ei = ex[(s2 * 64 + n) * 2 + 1]; const float nr = pr * xr - pi * xi + er, ni = pr * xi + pi * xr + ei; xr = nr; xi = ni; }
        for (int s0 = 0; s0 < ns; s0 += 8) { float ir[8], ii[8];
#pragma unroll
            for (int u = 0; u < 8; ++u) { const int sp = seg * ns + s0 + u, c = c0 + (d == 0 ? sp : nc - 1 - sp); const size_t ro = (size_t)g * NCH_S5 + c; ir[u] = INC[ro * 256 + d * 128 + n]; ii[u] = INC[ro * 256 + d * 128 + 64 + n]; }
#pragma unroll
            for (int u = 0; u < 8; ++u) { const int sp = seg * ns + s0 + u, c = c0 + (d == 0 ? sp : nc - 1 - sp); const size_t ro = (size_t)g * NCH_S5 + c;
                UC[ro * 512 + 256 + d * 128 + n] = (bf16)f2bf(xr); UC[ro * 512 + 256 + d * 128 + 64 + n] = (bf16)f2bf(xi);
                const float nr = lc.x * xr - lc.y * xi + ir[u], ni = lc.x * xi + lc.y * xr + ii[u]; xr = nr; xi = ni; } }
    }
}
template <int NT> __device__ __forceinline__ void mma_lds(f32x4 (&acc)[NT], const LAS bf16* As, int pa, const LAS bf16* Bs, int pb, int K, int lane) {
    const int r = lane & 15, q = lane >> 4;
    for (int kk = 0; kk < K; kk += 32) { const bf16x8 av = *(const LAS bf16x8*)(As + r * pa + kk + q * 8);
#pragma unroll
        for (int nt = 0; nt < NT; ++nt) { const bf16x8 bv = *(const LAS bf16x8*)(Bs + (nt * 16 + r) * pb + kk + q * 8); acc[nt] = __builtin_amdgcn_mfma_f32_16x16x32_bf16(av, bv, acc[nt], 0, 0, 0); } }
}
template <int NT> __device__ __forceinline__ void mma_glb(f32x4 (&acc)[NT], const LAS bf16* As, int pa, const bf16* Bg, int pb, int K, int lane) {
    const int r = lane & 15, q = lane >> 4;
    for (int kk = 0; kk < K; kk += 32) { const bf16x8 av = *(const LAS bf16x8*)(As + r * pa + kk + q * 8);
#pragma unroll
        for (int n0 = 0; n0 < NT; n0 += 8) { bf16x8 bv[8];
#pragma unroll
            for (int u = 0; u < 8; ++u) bv[u] = *(const bf16x8*)(Bg + (size_t)((n0 + u) * 16 + r) * pb + kk + q * 8);
#pragma unroll
            for (int u = 0; u < 8; ++u) acc[n0 + u] = __builtin_amdgcn_mfma_f32_16x16x32_bf16(av, bv[u], acc[n0 + u], 0, 0, 0); } }
}
#define LBAR() do { asm volatile("s_waitcnt lgkmcnt(0)" ::: "memory"); __builtin_amdgcn_s_barrier(); asm volatile("" ::: "memory"); } while (0)
constexpr int RP = 136;
__device__ __forceinline__ float ret_log2g(int h) { return log2f(1.0f - exp2f(-5.0f - (float)h)); }

__device__ __forceinline__ void ph_ret_kv(const AP& a, const Frame& F) {
    const bf16* PROJ = (const bf16*)(a.ws + WS_PROJ); const f32x2* ROT = (const f32x2*)(a.ws + WS_ROT); bf16* KVT = (bf16*)(a.ws + WS_SCR + SC_KVT);
    LAS bf16* VT = (LAS bf16*)F.lds; LAS bf16* KTf = VT + 128 * RP; LAS bf16* KTb = KTf + 128 * RP;
    for (int it = blockIdx.x; it < NCH_RET * 4 * 2; it += gridDim.x) { const int eh = it & 1, h = (it >> 1) & 3, cn = it >> 3; const float l2g = ret_log2g(h);
        LBAR();
        { const int pp = F.lane, ta = cn * 128 + 2 * pp;
#pragma unroll
          for (int oc = 0; oc < 2; ++oc) { const int e8 = (F.wave * 2 + oc) * 8;
              const u32x4 va = *(const u32x4*)(PROJ + (size_t)ta * NPJ + C_RV + h * 256 + eh * 128 + e8), vb = *(const u32x4*)(PROJ + (size_t)(ta + 1) * NPJ + C_RV + h * 256 + eh * 128 + e8);
              const unsigned wa[4] = {va.x, va.y, va.z, va.w}, wb[4] = {vb.x, vb.y, vb.z, vb.w};
#pragma unroll
              for (int i = 0; i < 4; ++i) { *(LAS unsigned*)(VT + (e8 + 2 * i) * RP + 2 * pp) = (wa[i] & 0xffffu) | (wb[i] << 16); *(LAS unsigned*)(VT + (e8 + 2 * i + 1) * RP + 2 * pp) = (wa[i] >> 16) | (wb[i] & 0xffff0000u); } }
          { const int i8 = F.wave * 8; int posa, L; seq_of(ta, posa, L);
            float x1a[8], x2a[8], x1b[8], x2b[8];
            unpack8(*(const u32x4*)(PROJ + (size_t)ta * NPJ + C_RK + h * 128 + i8), x1a); unpack8(*(const u32x4*)(PROJ + (size_t)ta * NPJ + C_RK + h * 128 + 64 + i8), x2a);
            unpack8(*(const u32x4*)(PROJ + (size_t)(ta + 1) * NPJ + C_RK + h * 128 + i8), x1b); unpack8(*(const u32x4*)(PROJ + (size_t)(ta + 1) * NPJ + C_RK + h * 128 + 64 + i8), x2b);
            const f32x4* ra = (const f32x4*)(ROT + (size_t)posa * 64 + i8); const f32x4* rb = (const f32x4*)(ROT + (size_t)(posa + 1) * 64 + i8);
            const float sc = 0.08838834764831845f; const float dfa = __builtin_amdgcn_exp2f(l2g * (float)(127 - 2 * pp)) * sc, dba = __builtin_amdgcn_exp2f(l2g * (float)(2 * pp)) * sc, dfb = __builtin_amdgcn_exp2f(l2g * (float)(126 - 2 * pp)) * sc, dbb = __builtin_amdgcn_exp2f(l2g * (float)(2 * pp + 1)) * sc;
#pragma unroll
            for (int i2 = 0; i2 < 4; ++i2) { const f32x4 ca = ra[i2], cb2 = rb[i2];
#pragma unroll
                for (int u = 0; u < 2; ++u) { const int i = 2 * i2 + u; const float c_a = ca[2 * u], s_a = ca[2 * u + 1], c_b = cb2[2 * u], s_b = cb2[2 * u + 1];
                    const float o1a = x1a[i] * c_a - x2a[i] * s_a, o2a = x1a[i] * s_a + x2a[i] * c_a, o1b = x1b[i] * c_b - x2b[i] * s_b, o2b = x1b[i] * s_b + x2b[i] * c_b;
                    *(LAS unsigned*)(KTf + (i8 + i) * RP + 2 * pp) = pk2(o1a * dfa, o1b * dfb); *(LAS unsigned*)(KTf + (64 + i8 + i) * RP + 2 * pp) = pk2(o2a * dfa, o2b * dfb);
                    *(LAS unsigned*)(KTb + (i8 + i) * RP + 2 * pp) = pk2(o1a * dba, o1b * dbb); *(LAS unsigned*)(KTb + (64 + i8 + i) * RP + 2 * pp) = pk2(o2a * dba, o2b * dbb); } } } }
        LBAR();
        f32x4 af[8], ab[8];
#pragma unroll
        for (int n = 0; n < 8; ++n) { af[n] = (f32x4){0.f, 0.f, 0.f, 0.f}; ab[n] = (f32x4){0.f, 0.f, 0.f, 0.f}; }
        mma_lds<8>(af, KTf + F.wave * 16 * RP, RP, VT, RP, 128, F.lane); mma_lds<8>(ab, KTb + F.wave * 16 * RP, RP, VT, RP, 128, F.lane);
        const int r = F.lane & 15, q4 = F.lane >> 4; const size_t item = (size_t)cn * 4 + h;
#pragma unroll
        for (int n = 0; n < 8; ++n) { const int e = eh * 128 + n * 16 + r, d0 = F.wave * 16 + q4 * 4; *(u32x2*)(KVT + ((0 * 768 + item) * 256 + e) * 128 + d0) = (u32x2){pk2(af[n][0], af[n][1]), pk2(af[n][2], af[n][3])}; *(u32x2*)(KVT + ((768 + item) * 256 + e) * 128 + d0) = (u32x2){pk2(ab[n][0], ab[n][1]), pk2(ab[n][2], ab[n][3])}; }
    }
}
__device__ __forceinline__ void ph_ret_scan(const AP& a, const Frame& F) {
    const unsigned* KVT = (const unsigned*)(a.ws + WS_SCR + SC_KVT); unsigned* STP = (unsigned*)(a.ws + WS_STP);
    for (int i = F.gt; i < 5 * 2 * 4 * 16384; i += F.ngt) { const int ed = i & 16383, h = (i >> 14) & 3, dir = (i >> 16) & 1, sq = i >> 17; const int c0 = sq == 0 ? 0 : 128 + (sq - 1) * 16, nc = sq == 0 ? 128 : 16;
        const float g128 = __builtin_amdgcn_exp2f(ret_log2g(h) * 128.0f); float s0_ = 0.f, s1_ = 0.f;
        for (int s0 = 0; s0 < nc; s0 += 16) { unsigned kv[16];
#pragma unroll
            for (int u = 0; u < 16; ++u) { const int cn = c0 + (dir == 0 ? s0 + u : nc - 1 - s0 - u); kv[u] = KVT[(((size_t)dir * 768 + cn * 4 + h) * 16384) + ed]; }
#pragma unroll
            for (int u = 0; u < 16; ++u) { const int cn = c0 + (dir == 0 ? s0 + u : nc - 1 - s0 - u); STP[(((size_t)dir * 768 + cn * 4 + h) * 16384) + ed] = pk2(s0_, s1_);
                s0_ = g128 * s0_ + __uint_as_float(kv[u] << 16); s1_ = g128 * s1_ + __uint_as_float(kv[u] & 0xffff0000u); } } }
}
__device__ __forceinline__ void ph_ret_out(const AP& a, const Frame& F, int l) {
    const bf16* PROJ = (const bf16*)(a.ws + WS_PROJ); const f32x2* ROT = (const f32x2*)(a.ws + WS_ROT); const bf16* STP = (const bf16*)(a.ws + WS_STP); bf16* Y = (bf16*)(a.ws + WS_Y);
    const float* gn = a.in(I_GNG) + (size_t)l * WB;
    LAS bf16* Qs = (LAS bf16*)F.lds; LAS bf16* Ks = Qs + 128 * RP; LAS bf16* VT = Ks + 128 * RP;
    unsigned* cnt = (unsigned*)(a.ws + WS_CTL) + 16384 + 64 * l; volatile LAS unsigned* tick = (volatile LAS unsigned*)(F.lds + LDS_MISC) + 16;
    for (;;) { LBAR(); if (F.tid == 0) tick[0] = __hip_atomic_fetch_add(cnt, 1u, __ATOMIC_RELAXED, __HIP_MEMORY_SCOPE_AGENT); LBAR();
        const int it = (int)tick[0]; if (it >= NCH_RET * 4) break; const int h = it & 3, cn = it >> 2; const float l2g = ret_log2g(h);
        LBAR();
        { const int pp = F.lane, ta = cn * 128 + 2 * pp;
#pragma unroll
          for (int oc = 0; oc < 4; ++oc) { const int e8 = (F.wave * 4 + oc) * 8;
              const u32x4 va = *(const u32x4*)(PROJ + (size_t)ta * NPJ + C_RV + h * 256 + e8), vb = *(const u32x4*)(PROJ + (size_t)(ta + 1) * NPJ + C_RV + h * 256 + e8);
              const unsigned wa[4] = {va.x, va.y, va.z, va.w}, wb[4] = {vb.x, vb.y, vb.z, vb.w};
#pragma unroll
              for (int i = 0; i < 4; ++i) { *(LAS unsigned*)(VT + (e8 + 2 * i) * RP + 2 * pp) = (wa[i] & 0xffffu) | (wb[i] << 16); *(LAS unsigned*)(VT + (e8 + 2 * i + 1) * RP + 2 * pp) = (wa[i] >> 16) | (wb[i] & 0xffff0000u); } } }
#pragma unroll
        for (int rep2 = 0; rep2 < 2; ++rep2) { const int qq = F.tid + rep2 * NTHR, j = qq >> 3, i8 = (qq & 7) * 8; const int t = cn * 128 + j; int pos, L; seq_of(t, pos, L);
            float k1[8], k2[8], q1[8], q2[8], ok1[8], ok2[8], oq1[8], oq2[8];
            unpack8(*(const u32x4*)(PROJ + (size_t)t * NPJ + C_RK + h * 128 + i8), k1); unpack8(*(const u32x4*)(PROJ + (size_t)t * NPJ + C_RK + h * 128 + 64 + i8), k2);
            unpack8(*(const u32x4*)(PROJ + (size_t)t * NPJ + C_RQ + h * 128 + i8), q1); unpack8(*(const u32x4*)(PROJ + (size_t)t * NPJ + C_RQ + h * 128 + 64 + i8), q2);
            const f32x4* rr = (const f32x4*)(ROT + (size_t)pos * 64 + i8); const float sc = 0.08838834764831845f;
#pragma unroll
            for (int i2 = 0; i2 < 4; ++i2) { const f32x4 cs4 = rr[i2];
#pragma unroll
                for (int u = 0; u < 2; ++u) { const int i = 2 * i2 + u; const float c = cs4[2 * u], s = cs4[2 * u + 1];
                    ok1[i] = (k1[i] * c - k2[i] * s) * sc; ok2[i] = (k1[i] * s + k2[i] * c) * sc; oq1[i] = q1[i] * c - q2[i] * s; oq2[i] = q1[i] * s + q2[i] * c; } }
            *(LAS u32x4*)(Ks + j * RP + i8) = pack8(ok1); *(LAS u32x4*)(Ks + j * RP + 64 + i8) = pack8(ok2); *(LAS u32x4*)(Qs + j * RP + i8) = pack8(oq1); *(LAS u32x4*)(Qs + j * RP + 64 + i8) = pack8(oq2); }
        LBAR();
        const int r = F.lane & 15, q4 = F.lane >> 4, i0 = F.wave * 16 + q4 * 4;
        f32x4 sa[8];
#pragma unroll
        for (int n = 0; n < 8; ++n) sa[n] = (f32x4){0.f, 0.f, 0.f, 0.f};
        mma_lds<8>(sa, Qs + F.wave * 16 * RP, RP, Ks, RP, 128, F.lane);
        LBAR();
#pragma unroll
        for (int n = 0; n < 8; ++n)
#pragma unroll
            for (int j = 0; j < 4; ++j) { const int i = i0 + j, jj = n * 16 + r; const int dd = i > jj ? i - jj : jj - i; Ks[i * RP + jj] = (bf16)f2bf(sa[n][j] * __builtin_amdgcn_exp2f(l2g * (float)dd)); }
        asm volatile("s_waitcnt lgkmcnt(0)" ::: "memory");
        f32x4 o[16];
#pragma unroll
        for (int n = 0; n < 16; ++n) o[n] = (f32x4){0.f, 0.f, 0.f, 0.f};
        const size_t item = (size_t)cn * 4 + h;
        float r1[4], f2[4];
#pragma unroll
        for (int j = 0; j < 4; ++j) { r1[j] = __builtin_amdgcn_exp2f(l2g * (float)(2 * (i0 + j) - 127)); f2[j] = __builtin_amdgcn_exp2f(l2g * (float)(128 - i0 - j)); }
        mma_glb<16>(o, Qs + F.wave * 16 * RP, RP, STP + (0 * 768 + item) * 32768, 128, 128, F.lane);
#pragma unroll
        for (int n = 0; n < 16; ++n)
#pragma unroll
            for (int j = 0; j < 4; ++j) o[n][j] *= r1[j];
        mma_glb<16>(o, Qs + F.wave * 16 * RP, RP, STP + (768 + item) * 32768, 128, 128, F.lane);
#pragma unroll
        for (int n = 0; n < 16; ++n)
#pragma unroll
            for (int j = 0; j < 4; ++j) o[n][j] *= f2[j];
        mma_lds<16>(o, Ks + F.wave * 16 * RP, RP, VT, RP, 128, F.lane);
        float gnv[16];
#pragma unroll
        for (int n = 0; n < 16; ++n) gnv[n] = gn[h * 256 + n * 16 + r];
#pragma unroll
        for (int j = 0; j < 4; ++j) { float s = 0.f; unsigned short zz[16];
#pragma unroll
            for (int n = 0; n < 16; ++n) zz[n] = PROJ[(size_t)(cn * 128 + i0 + j) * NPJ + C_RZ + h * 256 + n * 16 + r];
#pragma unroll
            for (int n = 0; n < 16; ++n) s += o[n][j];
            s += shx<1>(s); s += shx<2>(s); s += shx<4>(s); s += shx<8>(s); const float mean = s * (1.0f / 256.0f); float v = 0.f;
#pragma unroll
            for (int n = 0; n < 16; ++n) { const float dlt = o[n][j] - mean; v += dlt * dlt; }
            v += shx<1>(v); v += shx<2>(v); v += shx<4>(v); v += shx<8>(v); const float rstd = __builtin_amdgcn_rsqf(v * (1.0f / 256.0f) + 1e-5f);
            const int t = cn * 128 + i0 + j;
#pragma unroll
            for (int n = 0; n < 16; ++n) { const int e = n * 16 + r; Y[(size_t)t * 4096 + 2048 + h * 256 + e] = (bf16)f2bf((o[n][j] - mean) * rstd * gnv[n] * siluf_(bf2f(zz[n]))); } }
    }
}

__device__ __forceinline__ float rdl(float x, int j) { return __int_as_float(__builtin_amdgcn_readlane(__float_as_int(x), j)); }
__device__ __forceinline__ void ph_rwkv_prep(const AP& a, const Frame& F, int l) {
    const bf16* PROJ = (const bf16*)(a.ws + WS_PROJ); unsigned char* S = a.ws + WS_SCR;
    bf16* R = (bf16*)(S + SB_R); bf16* KM = (bf16*)(S + SB_KM); bf16* V = (bf16*)(S + SB_V); bf16* KK = (bf16*)(S + SB_KK); bf16* AG = (bf16*)(S + SB_AG); bf16* LWF = (bf16*)(S + SB_LWF); bf16* LWB = (bf16*)(S + SB_LWB); const bf16* LO = (const bf16*)(S + SB_LO);
    const float* mu = a.in(I_MU) + (size_t)l * 3 * WB; const float* w0 = a.in(I_W0) + (size_t)l * 2 * WB;
    const float* a0 = a.in(I_A0) + (size_t)l * WB; const float* kkp = a.in(I_KK) + (size_t)l * WB; const float* kap = a.in(I_KA) + (size_t)l * WB;
#define UP4(W_, O_) do { const u32x2 w_ = (W_); O_[0] = __uint_as_float(w_[0] << 16); O_[1] = __uint_as_float(w_[0] & 0xffff0000u); O_[2] = __uint_as_float(w_[1] << 16); O_[3] = __uint_as_float(w_[1] & 0xffff0000u); } while (0)
#define PK4(O_) ((u32x2){pk2(O_[0], O_[1]), pk2(O_[2], O_[3])})
    for (int it = F.gw; it < (T / 4) * 4; it += F.ngw) { const int hq = it & 3, t0 = (it >> 2) * 4, c = hq * 256 + F.lane * 4; int pos0, L; seq_of(t0, pos0, L);
        u32x2 xr[6], xk[6], xv[6];
#pragma unroll
        for (int i = 0; i < 6; ++i) { const int pp = pos0 + i - 1; const bool ok = pp >= 0 && pp < L; const bf16* pr = PROJ + (size_t)(t0 + i - 1) * NPJ + c; const u32x2 z2 = (u32x2){0u, 0u};
            xr[i] = ok ? *(const u32x2*)(pr + C_RWR) : z2; xk[i] = ok ? *(const u32x2*)(pr + C_RWK) : z2; xv[i] = ok ? *(const u32x2*)(pr + C_RWV) : z2; }
        u32x2 lo0[4], lo1[4], lo2[4];
#pragma unroll
        for (int i = 0; i < 4; ++i) { const bf16* lo = LO + (size_t)(t0 + i) * 3072 + c; lo0[i] = *(const u32x2*)lo; lo1[i] = *(const u32x2*)(lo + 1024); lo2[i] = *(const u32x2*)(lo + 2048); }
        const f32x4 mur = *(const f32x4*)(mu + c), muk = *(const f32x4*)(mu + WB + c), muv = *(const f32x4*)(mu + 2 * WB + c), w0f = *(const f32x4*)(w0 + c), w0b = *(const f32x4*)(w0 + WB + c),
                    a0v = *(const f32x4*)(a0 + c), kkw = *(const f32x4*)(kkp + c), kaw = *(const f32x4*)(kap + c);
#pragma unroll
        for (int i = 0; i < 4; ++i) { const int t = t0 + i; float rp[4], r0[4], rn[4], kp[4], k0[4], kn[4], vp[4], v0[4], vn[4], l0[4], l1[4], l2[4];
            UP4(xr[i], rp); UP4(xr[i + 1], r0); UP4(xr[i + 2], rn); UP4(xk[i], kp); UP4(xk[i + 1], k0); UP4(xk[i + 2], kn); UP4(xv[i], vp); UP4(xv[i + 1], v0); UP4(xv[i + 2], vn); UP4(lo0[i], l0); UP4(lo1[i], l1); UP4(lo2[i], l2);
            float rm[4], km[4], vm[4], ag[4], kk[4], kd[4], lf[4], lb[4]; float ss = 0.f;
#pragma unroll
            for (int e = 0; e < 4; ++e) { rm[e] = r0[e] + mur[e] * (0.5f * (rp[e] + rn[e]) - r0[e]); km[e] = k0[e] + muk[e] * (0.5f * (kp[e] + kn[e]) - k0[e]); vm[e] = v0[e] + muv[e] * (0.5f * (vp[e] + vn[e]) - v0[e]);
                ag[e] = sigmoidf_(a0v[e] + l2[e]); kk[e] = km[e] * kkw[e]; ss += kk[e] * kk[e]; kd[e] = km[e] * (1.0f + (ag[e] - 1.0f) * kaw[e]);
                lf[e] = -0.6065306597126334f * sigmoidf_(w0f[e] + l0[e]); lb[e] = -0.6065306597126334f * sigmoidf_(w0b[e] + l1[e]); }
            ss += shx<1>(ss); ss += shx<2>(ss); ss += shx<4>(ss); ss += shx<8>(ss);
            const float inv = fminf(__builtin_amdgcn_rsqf(ss), 1e12f); float ka[4];
#pragma unroll
            for (int e = 0; e < 4; ++e) { kk[e] *= inv; ka[e] = ag[e]; }
            const size_t o = (size_t)t * WB + c;
            *(u32x2*)(R + o) = PK4(rm); *(u32x2*)(KM + o) = PK4(kd); *(u32x2*)(V + o) = PK4(vm); *(u32x2*)(KK + o) = PK4(kk); *(u32x2*)(AG + o) = PK4(ka); *(u32x2*)(LWF + o) = PK4(lf); *(u32x2*)(LWB + o) = PK4(lb); }
    }
}
constexpr int P72 = 72, SLOT = 64 * P72;
__device__ __forceinline__ void mm2(f32x4 (&acc)[2], const LAS bf16* A, const LAS bf16* Bt, int wave, int lane) { asm volatile("" : "+v"(lane));
    mma_lds<2>(acc, A + (wave >> 1) * 16 * P72, P72, Bt + (wave & 1) * 32 * P72, P72, 64, lane); }
#define RW_FOREACH(acc) _Pragma("unroll") for (int nt = 0; nt < 2; ++nt) _Pragma("unroll") for (int j = 0; j < 4; ++j)
#define RW_BASE int rb_ = (F.wave >> 1) * 16 + (F.lane >> 4) * 4, cb_ = (F.wave & 1) * 32 + (F.lane & 15); asm volatile("" : "+v"(rb_), "+v"(cb_));
#define RW_ROW (rb_ + j)
#define RW_COL (cb_ + nt * 16)
__device__ __forceinline__ void ph_rwkv_chunk(const AP& a, const Frame& F) {
    unsigned char* S = a.ws + WS_SCR; bf16* CH = (bf16*)(S + SB_CH);
    const bf16* R = (const bf16*)(S + SB_R); const bf16* KM = (const bf16*)(S + SB_KM); const bf16* V = (const bf16*)(S + SB_V); const bf16* KK = (const bf16*)(S + SB_KK); const bf16* AG = (const bf16*)(S + SB_AG);
    LAS bf16* lb = (LAS bf16*)F.lds;
#define SL(i) (lb + (i) * SLOT)
    LAS float* NF = (LAS float*)SL(12);
    LAS float* GC = (LAS float*)(F.lds + 15 * SLOT * 2);
    LAS float* TOT = GC + 64;
    const f32x4 z4 = (f32x4){0.f, 0.f, 0.f, 0.f};
#ifndef CHUNK_REP
#define CHUNK_REP 1
#endif
    u32x4 pre0, pre1, pre2, pre3, pre4, pre5, pre6;
#define RAW_LOAD(it_, dir_) do { const int hd_ = (it_) & 15, cn_ = (it_) >> 4; const bf16* LW_ = (const bf16*)(S + ((dir_) ? SB_LWB : SB_LWF)); int tid_ = F.tid; asm volatile("" : "+v"(tid_)); \
        const int j_ = tid_ >> 3, c8_ = (tid_ & 7) * 8; const int t_ = cn_ * 64 + ((dir_) ? 63 - j_ : j_); const size_t o_ = (size_t)t_ * WB + hd_ * 64 + c8_; \
        pre0 = *(const u32x4*)(LW_ + o_); pre1 = *(const u32x4*)(KK + o_); pre2 = *(const u32x4*)(AG + o_); pre3 = *(const u32x4*)(KM + o_); pre4 = *(const u32x4*)(R + o_); \
        const int pp_ = tid_ & 31, v8_ = ((tid_ >> 5) & 7) * 8; const int ta_ = cn_ * 64 + ((dir_) ? 63 - 2 * pp_ : 2 * pp_), tb_ = cn_ * 64 + ((dir_) ? 62 - 2 * pp_ : 2 * pp_ + 1); \
        pre5 = *(const u32x4*)(V + (size_t)ta_ * WB + hd_ * 64 + v8_); pre6 = *(const u32x4*)(V + (size_t)tb_ * WB + hd_ * 64 + v8_); } while (0)
    for (int rep = 0; rep < CHUNK_REP; ++rep) {
    if ((int)blockIdx.x < (T / 64) * 16) RAW_LOAD((int)blockIdx.x, 0);
    for (int it = blockIdx.x; it < (T / 64) * 16; it += gridDim.x) { const int hd = it & 15, cn = it >> 4; (void)hd; (void)cn;
        for (int dir = 0; dir < 2; ++dir) {
            bf16* outb = CH + ((size_t)it * 2 + dir) * 4 * 4096;
            LBAR();
            { int tid_ = F.tid; asm volatile("" : "+v"(tid_)); const int j = tid_ >> 3, c8 = (tid_ & 7) * 8;
              *(LAS u32x4*)(SL(8) + j * P72 + c8) = pre0; *(LAS u32x4*)(SL(9) + j * P72 + c8) = pre1; *(LAS u32x4*)(SL(10) + j * P72 + c8) = pre2; *(LAS u32x4*)(SL(11) + j * P72 + c8) = pre3; *(LAS u32x4*)(SL(12) + j * P72 + c8) = pre4;
              if (tid_ < 256) { const int pp = tid_ & 31, v8 = (tid_ >> 5) * 8; const unsigned wa[4] = {pre5.x, pre5.y, pre5.z, pre5.w}, wb[4] = {pre6.x, pre6.y, pre6.z, pre6.w};
#pragma unroll
                  for (int i = 0; i < 4; ++i) { *(LAS unsigned*)(SL(7) + (v8 + 2 * i) * P72 + 2 * pp) = (wa[i] & 0xffffu) | (wb[i] << 16); *(LAS unsigned*)(SL(7) + (v8 + 2 * i + 1) * P72 + 2 * pp) = (wa[i] >> 16) | (wb[i] & 0xffff0000u); } }
              const int nit = dir ? it + (int)gridDim.x : it;
              if (nit < (T / 64) * 16) RAW_LOAD(nit, dir ^ 1); }
            LBAR();
            { int k = F.lane; asm volatile("" : "+v"(k)); const int seg = F.wave;
              float cum[8]; float run = 0.f;
#pragma unroll
              for (int i = 0; i < 8; ++i) { run += bf2f(SL(8)[(seg * 8 + i) * P72 + k]); cum[i] = run; }
              TOT[seg * 64 + k] = run;
              LBAR();
              float off = 0.f;
              for (int s2 = 0; s2 < seg; ++s2) off += TOT[s2 * 64 + k];
              unsigned ta[4], tb[4], tk[4]; float Gprev = __expf(off);
#pragma unroll
              for (int ip = 0; ip < 4; ++ip) { float fa[2], fb[2], fk[2], fr[2];
#pragma unroll
                  for (int u = 0; u < 2; ++u) { const int i = 2 * ip + u, t = seg * 8 + i; const float cl = off + cum[i];
                      const float kkv = bf2f(SL(9)[t * P72 + k]), agv = bf2f(SL(10)[t * P72 + k]), kmv = bf2f(SL(11)[t * P72 + k]), rv = bf2f(SL(12)[t * P72 + k]);
                      const float G = __expf(cl), Gi = __expf(-cl);
                      fa[u] = -kkv * Gprev; fb[u] = kkv * agv * Gi; fk[u] = kmv * Gi; fr[u] = rv * G; Gprev = G;
                      if (t == 63) GC[k] = G; }
                  const unsigned wa = pk2(fa[0], fa[1]), wb = pk2(fb[0], fb[1]), wk = pk2(fk[0], fk[1]), wr2 = pk2(fr[0], fr[1]); const int t0 = seg * 8 + 2 * ip;
                  SL(0)[t0 * P72 + k] = (bf16)wa; SL(0)[(t0 + 1) * P72 + k] = (bf16)(wa >> 16); SL(1)[t0 * P72 + k] = (bf16)wb; SL(1)[(t0 + 1) * P72 + k] = (bf16)(wb >> 16);
                  SL(2)[t0 * P72 + k] = (bf16)wk; SL(2)[(t0 + 1) * P72 + k] = (bf16)(wk >> 16); SL(6)[t0 * P72 + k] = (bf16)wr2; SL(6)[(t0 + 1) * P72 + k] = (bf16)(wr2 >> 16);
                  ta[ip] = wa; tb[ip] = wb; tk[ip] = wk; }
              *(LAS u32x4*)(SL(3) + k * P72 + seg * 8) = (u32x4){ta[0], ta[1], ta[2], ta[3]}; *(LAS u32x4*)(SL(4) + k * P72 + seg * 8) = (u32x4){tb[0], tb[1], tb[2], tb[3]}; *(LAS u32x4*)(SL(5) + k * P72 + seg * 8) = (u32x4){tk[0], tk[1], tk[2], tk[3]}; }
            LBAR();
#define PK4S(dst_, v0_, v1_, v2_, v3_) *(LAS u32x2*)(dst_) = (u32x2){pk2(v0_, v1_), pk2(v2_, v3_)}
            { f32x4 c1[2] = {z4, z4}, c2[2] = {z4, z4}, c3[2] = {z4, z4}, c4[2] = {z4, z4};
              mm2(c1, SL(1), SL(0), F.wave, F.lane);
              mm2(c2, SL(0), SL(2), F.wave, F.lane);
              mm2(c3, SL(1), SL(6), F.wave, F.lane);
              mm2(c4, SL(2), SL(6), F.wave, F.lane);
              RW_BASE
#pragma unroll
              for (int nt = 0; nt < 2; ++nt) { const int cc = cb_ + nt * 16, r0 = rb_;
                  { f32x4 v;
#pragma unroll
                    for (int j = 0; j < 4; ++j) v[j] = (r0 + j) < cc ? c1[nt][j] : 0.f;
                    *(LAS f32x4*)(NF + cc * 68 + r0) = v; }
                  PK4S(SL(8) + cc * P72 + r0, cc < r0 ? c2[nt][0] : 0.f, cc < r0 + 1 ? c2[nt][1] : 0.f, cc < r0 + 2 ? c2[nt][2] : 0.f, cc < r0 + 3 ? c2[nt][3] : 0.f);
                  PK4S(SL(9) + cc * P72 + r0, r0 <= cc ? c3[nt][0] : 0.f, r0 + 1 <= cc ? c3[nt][1] : 0.f, r0 + 2 <= cc ? c3[nt][2] : 0.f, r0 + 3 <= cc ? c3[nt][3] : 0.f);
                  PK4S(SL(10) + cc * P72 + r0, r0 <= cc ? c4[nt][0] : 0.f, r0 + 1 <= cc ? c4[nt][1] : 0.f, r0 + 2 <= cc ? c4[nt][2] : 0.f, r0 + 3 <= cc ? c4[nt][3] : 0.f); } }
            LBAR();
            {
              int tid2_ = F.tid; asm volatile("" : "+v"(tid2_)); const int t = tid2_ >> 3, j8 = (tid2_ & 7) * 8; const bool offd = (t >> 4) != (j8 >> 4);
              { const f32x4 n0 = *(const LAS f32x4*)(NF + t * 68 + j8), n1 = *(const LAS f32x4*)(NF + t * 68 + j8 + 4); u32x4 w = (u32x4){0u, 0u, 0u, 0u};
                if (offd) { w.x = pk2(n0[0], n0[1]); w.y = pk2(n0[2], n0[3]); w.z = pk2(n1[0], n1[1]); w.w = pk2(n1[2], n1[3]); }
                *(LAS u32x4*)(SL(0) + t * P72 + j8) = w;
                if (offd) { *(LAS u32x4*)(SL(1) + t * P72 + j8) = (u32x4){0u, 0u, 0u, 0u}; *(LAS u32x4*)(SL(2) + t * P72 + j8) = (u32x4){0u, 0u, 0u, 0u}; } }
              if (tid2_ < 64) { const int b0 = (tid2_ >> 4) * 16, i = tid2_ & 15; float tr[16];
#pragma unroll
                  for (int tt = 0; tt < 16; ++tt) { float val = (tt == i) ? 1.f : 0.f;
#pragma unroll
                      for (int jj = 0; jj < tt; ++jj) val += (jj >= i ? tr[jj] : 0.f) * NF[(b0 + tt) * 68 + b0 + jj];
                      tr[tt] = (tt < i) ? 0.f : val; }
#pragma unroll
                  for (int tt = 0; tt < 16; ++tt) { const bf16 x = (bf16)f2bf(tr[tt]); SL(1)[(b0 + i) * P72 + b0 + tt] = x; SL(2)[(b0 + tt) * P72 + b0 + i] = x; } } }
            LBAR();
            { f32x4 c1[2] = {z4, z4}, c2[2] = {z4, z4};
              mm2(c1, SL(1), SL(0), F.wave, F.lane);
              mm2(c2, SL(0), SL(1), F.wave, F.lane);
              RW_BASE
#pragma unroll
              for (int nt = 0; nt < 2; ++nt) { const int cc = cb_ + nt * 16, r0 = rb_;
                  PK4S(SL(14) + cc * P72 + r0, c1[nt][0], c1[nt][1], c1[nt][2], c1[nt][3]);
                  PK4S(SL(11) + cc * P72 + r0, c2[nt][0], c2[nt][1], c2[nt][2], c2[nt][3]);
                  PK4S(SL(13) + cc * P72 + r0, c2[nt][0] + (cc == r0 ? 1.f : 0.f), c2[nt][1] + (cc == r0 + 1 ? 1.f : 0.f), c2[nt][2] + (cc == r0 + 2 ? 1.f : 0.f), c2[nt][3] + (cc == r0 + 3 ? 1.f : 0.f)); } }
            LBAR();
            { f32x4 c[2] = {z4, z4}; mm2(c, SL(11), SL(14), F.wave, F.lane);
              RW_BASE
#pragma unroll
              for (int nt = 0; nt < 2; ++nt) { const int cc = cb_ + nt * 16, r0 = rb_;
                  PK4S(SL(12) + cc * P72 + r0, c[nt][0] + (cc == r0 ? 1.f : 0.f), c[nt][1] + (cc == r0 + 1 ? 1.f : 0.f), c[nt][2] + (cc == r0 + 2 ? 1.f : 0.f), c[nt][3] + (cc == r0 + 3 ? 1.f : 0.f)); } }
            LBAR();
            { f32x4 c[2] = {z4, z4}; mm2(c, SL(12), SL(13), F.wave, F.lane);
              RW_BASE
#pragma unroll
              for (int nt = 0; nt < 2; ++nt) PK4S(SL(1) + (cb_ + nt * 16) * P72 + rb_, c[nt][0], c[nt][1], c[nt][2], c[nt][3]); }
            LBAR();
            { f32x4 c[2] = {z4, z4}; mm2(c, SL(1), SL(2), F.wave, F.lane);
              RW_BASE
#pragma unroll
              for (int nt = 0; nt < 2; ++nt) PK4S(SL(0) + (cb_ + nt * 16) * P72 + rb_, c[nt][0], c[nt][1], c[nt][2], c[nt][3]); }
            LBAR();
            { f32x4 c1[2] = {z4, z4}, c2[2] = {z4, z4};
              mm2(c1, SL(0), SL(3), F.wave, F.lane);
              mm2(c2, SL(8), SL(0), F.wave, F.lane);
              RW_BASE
#pragma unroll
              for (int nt = 0; nt < 2; ++nt) { const int cc = cb_ + nt * 16, r0 = rb_; PK4S(SL(1) + cc * P72 + r0, c1[nt][0], c1[nt][1], c1[nt][2], c1[nt][3]); PK4S(SL(11) + cc * P72 + r0, c2[nt][0], c2[nt][1], c2[nt][2], c2[nt][3]); } }
            LBAR();
            { f32x4 c1[2] = {z4, z4}, c2[2] = {z4, z4};
              mm2(c1, SL(11), SL(7), F.wave, F.lane);
              mm2(c2, SL(1), SL(9), F.wave, F.lane);
              RW_BASE
#pragma unroll
              for (int nt = 0; nt < 2; ++nt) { const int cc = cb_ + nt * 16, r0 = rb_; PK4S(SL(12) + cc * P72 + r0, c1[nt][0], c1[nt][1], c1[nt][2], c1[nt][3]);
                  const u32x2 rw = *(const LAS u32x2*)(SL(6) + cc * P72 + r0);
                  PK4S(SL(13) + cc * P72 + r0, c2[nt][0] + __uint_as_float(rw.x << 16), c2[nt][1] + __uint_as_float(rw.x & 0xffff0000u), c2[nt][2] + __uint_as_float(rw.y << 16), c2[nt][3] + __uint_as_float(rw.y & 0xffff0000u)); } }
            LBAR();
            { f32x4 c1[2] = {z4, z4}, c2[2] = {z4, z4}, c3[2] = {z4, z4};
              mm2(c1, SL(12), SL(9), F.wave, F.lane); mm2(c1, SL(7), SL(10), F.wave, F.lane);
              mm2(c2, SL(1), SL(4), F.wave, F.lane);
              mm2(c3, SL(12), SL(4), F.wave, F.lane); mm2(c3, SL(7), SL(5), F.wave, F.lane);
              float qf[8]; RW_BASE
#pragma unroll
              for (int nt = 0; nt < 2; ++nt) { const int cc = cb_ + nt * 16, r0 = rb_; const float gc = GC[cc];
                  PK4S(SL(14) + cc * P72 + r0, c1[nt][0], c1[nt][1], c1[nt][2], c1[nt][3]);
                  PK4S(SL(0) + cc * P72 + r0, (c2[nt][0] + (cc == r0 ? 1.f : 0.f)) * gc, (c2[nt][1] + (cc == r0 + 1 ? 1.f : 0.f)) * gc, (c2[nt][2] + (cc == r0 + 2 ? 1.f : 0.f)) * gc, (c2[nt][3] + (cc == r0 + 3 ? 1.f : 0.f)) * gc);
#pragma unroll
                  for (int j = 0; j < 4; ++j) qf[nt * 4 + j] = c3[nt][j] * gc; }
              *(u32x4*)(outb + 1 * 4096 + (F.wave * 64 + F.lane) * 8) = pack8(qf); }
            LBAR();
#undef PK4S
            { int tid_ = F.tid; asm volatile("" : "+v"(tid_)); const int row = tid_ >> 3, sg = (tid_ & 7) * 8;
              *(u32x4*)(outb + 0 * 4096 + row * 64 + sg) = *(const LAS u32x4*)(SL(0) + row * P72 + sg);
              *(u32x4*)(outb + 2 * 4096 + row * 64 + sg) = *(const LAS u32x4*)(SL(13) + row * P72 + sg); *(u32x4*)(outb + 3 * 4096 + row * 64 + sg) = *(const LAS u32x4*)(SL(14) + row * P72 + sg); }
        }
    }
    }
#undef SL
}
__device__ __forceinline__ void ph_rwkv_seq(const AP& a, const Frame& F) {
    unsigned char* S = a.ws + WS_SCR; const bf16* CH = (const bf16*)(S + SB_CH); bf16* SS = (bf16*)(S + SB_SS);
    LAS bf16* Sb = (LAS bf16*)F.lds;
    const int r = F.lane & 15, q = F.lane >> 4, mt = F.wave >> 1, nb = (F.wave & 1) * 32;
    for (int chain = blockIdx.x; chain < 160; chain += gridDim.x) { const int dir = chain & 1, hd = (chain >> 1) & 15, sq = chain >> 5; const int c0 = sq == 0 ? 0 : 256 + (sq - 1) * 32, nc = sq == 0 ? 256 : 32;
        f32x4 acc[2] = {(f32x4){0.f, 0.f, 0.f, 0.f}, (f32x4){0.f, 0.f, 0.f, 0.f}};
        __syncthreads();
        u32x4 p0, p1, p2, p3, p4s, p5, p6, p7, q0, q1, q2, q3, q4s, q5, q6, q7;
        const int crow = F.tid >> 3, cseg = (F.tid & 7) * 8;
        LAS bf16* Pb = Sb + 2 * SLOT;
#define SEQ_LOAD(P_, Q_, s_) do { const int s1_ = (s_) < nc ? (s_) : nc - 1; const int cn1_ = c0 + (dir == 0 ? s1_ : nc - 1 - s1_); const bf16* PT_ = CH + (((size_t)cn1_ * 16 + hd) * 2 + dir) * 4 * 4096; \
            P_ = *(const u32x4*)(PT_ + F.tid * 8); Q_ = *(const u32x4*)(PT_ + 4096 + F.tid * 8); } while (0)
#define SEQ_STEP(P_, Q_, Pn_, Qn_, s_) do { const int cn_ = c0 + (dir == 0 ? (s_) : nc - 1 - (s_)); const size_t itd_ = ((size_t)cn_ * 16 + hd) * 2 + dir; \
            SEQ_LOAD(Pn_, Qn_, (s_) + 7); \
            LAS bf16* sb_ = Sb + ((s_) & 1) * SLOT; LAS bf16* pb_ = Pb + ((s_) & 1) * SLOT; \
            _Pragma("unroll") for (int nt = 0; nt < 2; ++nt) _Pragma("unroll") for (int j = 0; j < 4; ++j) sb_[(mt * 16 + q * 4 + j) * P72 + nb + nt * 16 + r] = (bf16)f2bf(acc[nt][j]); \
            *(LAS u32x4*)(pb_ + crow * P72 + cseg) = P_; \
            asm volatile("s_waitcnt lgkmcnt(0)" ::: "memory"); __builtin_amdgcn_s_barrier(); asm volatile("" ::: "memory"); \
            *(u32x4*)(SS + itd_ * 4096 + crow * 64 + cseg) = *(const LAS u32x4*)(sb_ + crow * P72 + cseg);            \
            { float qf_[8]; unpack8(Q_, qf_); acc[0] = (f32x4){qf_[0], qf_[1], qf_[2], qf_[3]}; acc[1] = (f32x4){qf_[4], qf_[5], qf_[6], qf_[7]}; } \
            _Pragma("unroll") for (int ks = 0; ks < 2; ++ks) { const bf16x8 av = *(const LAS bf16x8*)(sb_ + (mt * 16 + r) * P72 + ks * 32 + q * 8); \
                _Pragma("unroll") for (int nt = 0; nt < 2; ++nt) { const bf16x8 bv = *(const LAS bf16x8*)(pb_ + (nb + nt * 16 + r) * P72 + ks * 32 + q * 8); acc[nt] = __builtin_amdgcn_mfma_f32_16x16x32_bf16(av, bv, acc[nt], 0, 0, 0); } } } while (0)
        SEQ_LOAD(p0, q0, 0); SEQ_LOAD(p1, q1, 1); SEQ_LOAD(p2, q2, 2); SEQ_LOAD(p3, q3, 3); SEQ_LOAD(p4s, q4s, 4); SEQ_LOAD(p5, q5, 5); SEQ_LOAD(p6, q6, 6);
        for (int s = 0; s < nc; s += 8) { SEQ_STEP(p0, q0, p7, q7, s); SEQ_STEP(p1, q1, p0, q0, s + 1); SEQ_STEP(p2, q2, p1, q1, s + 2); SEQ_STEP(p3, q3, p2, q2, s + 3);
            SEQ_STEP(p4s, q4s, p3, q3, s + 4); SEQ_STEP(p5, q5, p4s, q4s, s + 5); SEQ_STEP(p6, q6, p5, q5, s + 6); SEQ_STEP(p7, q7, p6, q6, s + 7); }
#undef SEQ_LOAD
#undef SEQ_STEP
    }
}
__device__ __forceinline__ void ph_rwkv_out(const AP& a, const Frame& F, int l) {
    unsigned char* S = a.ws + WS_SCR; const bf16* CH = (const bf16*)(S + SB_CH); const bf16* SS = (const bf16*)(S + SB_SS); const bf16* PROJ = (const bf16*)(a.ws + WS_PROJ); bf16* Y = (bf16*)(a.ws + WS_Y);
    const bf16* R = (const bf16*)(S + SB_R); const bf16* KM = (const bf16*)(S + SB_KM); const bf16* V = (const bf16*)(S + SB_V);
    const float* rk = a.in(I_RK) + (size_t)l * WB; const float* lg = a.in(I_LNG) + (size_t)l * WB; const float* lbp = a.in(I_LNB) + (size_t)l * WB;
    const int r = F.lane & 15, q = F.lane >> 4;
    for (int it = F.gw; it < (T / 64) * 16; it += F.ngw) { const int hd = it & 15, cn = it >> 4; const size_t item = (size_t)cn * 16 + hd;
      bf16x8 bS[2][4][2];
#pragma unroll
      for (int dir = 0; dir < 2; ++dir) { const bf16* Sg = SS + (item * 2 + dir) * 4096;
#pragma unroll
          for (int nt = 0; nt < 4; ++nt)
#pragma unroll
              for (int ks = 0; ks < 2; ++ks) bS[dir][nt][ks] = *(const bf16x8*)(Sg + (4 * r + nt) * 64 + ks * 32 + q * 8); }
#pragma unroll 2
      for (int mt = 0; mt < 4; ++mt) {
        f32x4 acc[4];
#pragma unroll
        for (int nt = 0; nt < 4; ++nt) acc[nt] = (f32x4){0.f, 0.f, 0.f, 0.f};
#pragma unroll
        for (int dir = 0; dir < 2; ++dir) { const bf16* ob = CH + (item * 2 + dir) * 4 * 4096; const bf16* R2T = ob + 2 * 4096; const bf16* Y0 = ob + 3 * 4096;
            const int trow = dir ? 63 - (mt * 16 + r) : mt * 16 + r;
#pragma unroll
            for (int ks = 0; ks < 2; ++ks) { const bf16x8 av = *(const bf16x8*)(R2T + trow * 64 + ks * 32 + q * 8);
#pragma unroll
                for (int nt = 0; nt < 4; ++nt) acc[nt] = __builtin_amdgcn_mfma_f32_16x16x32_bf16(av, bS[dir][nt][ks], acc[nt], 0, 0, 0); }
#pragma unroll
            for (int j = 0; j < 4; ++j) { const int tl = mt * 16 + q * 4 + j; const u32x2 yw = *(const u32x2*)(Y0 + (dir ? 63 - tl : tl) * 64 + 4 * r);
                acc[0][j] += __uint_as_float(yw.x << 16); acc[1][j] += __uint_as_float(yw.x & 0xffff0000u); acc[2][j] += __uint_as_float(yw.y << 16); acc[3][j] += __uint_as_float(yw.y & 0xffff0000u); } }
        const int c = hd * 64 + 4 * r; const f32x4 rk4 = *(const f32x4*)(rk + c), lg4 = *(const f32x4*)(lg + c), lb4 = *(const f32x4*)(lbp + c);
        u32x2 wq[4][4];
#pragma unroll
        for (int j = 0; j < 4; ++j) { const int t = cn * 64 + mt * 16 + q * 4 + j; const size_t o = (size_t)t * WB + c; wq[j][0] = *(const u32x2*)(R + o); wq[j][1] = *(const u32x2*)(KM + o); wq[j][2] = *(const u32x2*)(V + o); wq[j][3] = *(const u32x2*)(PROJ + (size_t)t * NPJ + C_RWZ + c); }
#pragma unroll
        for (int j = 0; j < 4; ++j) { const int t = cn * 64 + mt * 16 + q * 4 + j; float s = (acc[0][j] + acc[1][j]) + (acc[2][j] + acc[3][j]);
            s += shx<1>(s); s += shx<2>(s); s += shx<4>(s); s += shx<8>(s); const float mean = s * (1.0f / 64.0f); float vs = 0.f, bs = 0.f;
            float rr[4], kk[4], vv[4], zz[4];
            { const u32x2 w1 = wq[j][0], w2 = wq[j][1], w3 = wq[j][2], w4 = wq[j][3];
              rr[0] = __uint_as_float(w1.x << 16); rr[1] = __uint_as_float(w1.x & 0xffff0000u); rr[2] = __uint_as_float(w1.y << 16); rr[3] = __uint_as_float(w1.y & 0xffff0000u);
              kk[0] = __uint_as_float(w2.x << 16); kk[1] = __uint_as_float(w2.x & 0xffff0000u); kk[2] = __uint_as_float(w2.y << 16); kk[3] = __uint_as_float(w2.y & 0xffff0000u);
              vv[0] = __uint_as_float(w3.x << 16); vv[1] = __uint_as_float(w3.x & 0xffff0000u); vv[2] = __uint_as_float(w3.y << 16); vv[3] = __uint_as_float(w3.y & 0xffff0000u);
              zz[0] = __uint_as_float(w4.x << 16); zz[1] = __uint_as_float(w4.x & 0xffff0000u); zz[2] = __uint_as_float(w4.y << 16); zz[3] = __uint_as_float(w4.y & 0xffff0000u); }
#pragma unroll
            for (int nt = 0; nt < 4; ++nt) { const float dl = acc[nt][j] - mean; vs += dl * dl; bs += rr[nt] * kk[nt] * rk4[nt]; }
            vs += shx<1>(vs); vs += shx<2>(vs); vs += shx<4>(vs); vs += shx<8>(vs); bs += shx<1>(bs); bs += shx<2>(bs); bs += shx<4>(bs); bs += shx<8>(bs);
            const float rstd = __builtin_amdgcn_rsqf(vs * (1.0f / 64.0f) + 64e-5f); float o4[4];
#pragma unroll
            for (int nt = 0; nt < 4; ++nt) { const float yn = (acc[nt][j] - mean) * rstd * lg4[nt] + lb4[nt]; o4[nt] = (yn + bs * vv[nt]) * siluf_(zz[nt]); }
            *(u32x2*)(Y + (size_t)t * 4096 + 1024 + c) = (u32x2){pk2(o4[0], o4[1]), pk2(o4[2], o4[3])}; }
      }
    }
}
constexpr int NPH_PRO = 3, NPH_LAYER = 21, NPH = NPH_PRO + DEPTH * NPH_LAYER + 1;

__global__ void __launch_bounds__(NTHR, 2) fwd(Args ka) {
    extern __shared__ __attribute__((aligned(16))) unsigned char lds_[];
    Frame F; F.lds = (LAS unsigned char*)lds_; F.tid = threadIdx.x; F.lane = F.tid & 63; F.wave = __builtin_amdgcn_readfirstlane(F.tid >> 6);
    F.gw = blockIdx.x * NWAVES + F.wave; F.ngw = gridDim.x * NWAVES; F.gt = blockIdx.x * NTHR + F.tid; F.ngt = gridDim.x * NTHR;
    volatile LAS unsigned* MISC = (volatile LAS unsigned*)(F.lds + LDS_MISC);
    if (F.tid < 64) MISC[F.tid] = 0u;
    { LAS unsigned long long* aq = (LAS unsigned long long*)(F.lds + LDS_ARGS);
#pragma unroll
      for (int i = 0; i < 35; ++i) if (F.tid == i) aq[i] = (unsigned long long)ka.in[i]; }
    __syncthreads();
    AP a; a.q = (const LAS unsigned long long*)(F.lds + LDS_ARGS); a.ws = ka.ws; a.out = ka.out;
    const int ph_lo = ka.ph_lo, ph_hi = ka.ph_hi;
    unsigned* barw = (unsigned*)(a.ws + WS_CTL) + 4096;
    const int wave0 = F.wave;
    XcdBarrier bar; bar.bar = barw; bar.x = 0; bar.st = MISC + 8;
    if (ph_hi - ph_lo > 1) bar = xcd_barrier_post(barw, MISC + 8);
    bar.wave = wave0;
    int gp = 0;
#ifndef PH_DBL
#define PH_DBL 0ull
#endif
#ifndef PH_ONLY
#define PH_ONLY -1
#endif
#define PHASE(pid, ...) do { int lo_ = ph_lo, hi_ = ph_hi; asm volatile("" : "+s"(lo_), "+s"(hi_)); if ((PH_ONLY < 0 || PH_ONLY == (pid)) && lo_ <= gp && gp < hi_) { F.lane = lane_id(); asm volatile("" : "+v"(F.lane)); F.wave = wave0; F.tid = F.wave * 64 + F.lane; F.gw = blockIdx.x * NWAVES + F.wave; F.ngw = gridDim.x * NWAVES; F.ngt = gridDim.x * NTHR; asm volatile("" : "+s"(F.gw), "+s"(F.ngw), "+s"(F.ngt)); F.gt = blockIdx.x * NTHR + F.tid; __VA_ARGS__; if ((PH_DBL >> (pid)) & 1ull) { xcd_barrier(bar); __VA_ARGS__; } if (gp + 1 < hi_) xcd_barrier(bar); } ++gp; } while (0)
    const int G = gridDim.x, cb = blockIdx.x;
    LAS unsigned char* lds = F.lds;
    unsigned char* ws = a.ws;

    PHASE(0, ph_tables(a, F));
    PHASE(1, ph_convert(a, F));
    PHASE(2, { ph_s5mats(a, F); ph_x0(a, F); });

    for (int l = 0; l < DEPTH; ++l) {
        const bf16* WALLT = (const bf16*)(ws + WS_WALLT) + (size_t)l * NALL * D;
        const float* rss_l = (const float*)(ws + WS_RSS) + (size_t)(l & 1) * T;
        PHASE(4, { pg8::Gemm g{(const bf16*)(ws + WS_H), WALLT, D, D, D}; pg8::Order S; S.init(T / 256, NPJ / 256, 1, G, cb, (size_t)256 * D * 2, 0, (size_t)256 * D * 2, 0);
                EpiBf16 E{(bf16*)(ws + WS_PROJ), NPJ, C_WDF / 256, rss_l}; pg8::gemm_phase(lds, g, S, E, F.tid); });
        PHASE(5, ph_lru_conv(a, F, l));
        PHASE(6, { pg8::Gemm g{(const bf16*)(ws + WS_SCR + SA_XC), (const bf16*)(ws + WS_LRUW) + (size_t)l * 4096 * 256, WB, 256, 256}; pg8::Order S; S.init(T / 256, 16, 1, G, cb, (size_t)256 * WB * 2, 0, (size_t)256 * 256 * 2, 0); S.kwin = 256 * 2;
                EpiLru E{a.in(I_BR) + (size_t)l * 2 * WB, a.in(I_BI) + (size_t)l * 2 * WB, a.in(I_LAM) + (size_t)l * 2 * WB, (const bf16*)(ws + WS_SCR + SA_XC), (bf16*)(ws + WS_SCR + SA_LA), (bf16*)(ws + WS_SCR + SA_BB)};
                pg8::gemm_phase(lds, g, S, E, F.tid); });
        PHASE(7, ph_lru_scan1(a, F));
        PHASE(8, ph_lru_scan2(a, F));
        PHASE(9, ph_lru_scan3(a, F));
        PHASE(10, ph_s5_rearr(a, F));
        PHASE(11, { pg8::Gemm g{(const bf16*)(ws + WS_SCR + SD_UC), (const bf16*)(ws + WS_S5INC) + (size_t)l * 64 * 256 * 256, 512, 256, 256}; pg8::Order S;
                S.init(NCH_S5 / 256, 1, 64, G, cb, (size_t)256 * 512 * 2, (size_t)NCH_S5 * 512 * 2, 0, (size_t)256 * 256 * 2);
                EpiF32 E{(float*)(ws + WS_SCR + SD_INC), 256, (size_t)NCH_S5 * 256}; pg8::gemm_phase(lds, g, S, E, F.tid); });
        PHASE(12, ph_s5_scan(a, F, l));
        PHASE(13, { pg8::Gemm g{(const bf16*)(ws + WS_SCR + SD_UC), (const bf16*)(ws + WS_S5MAIN) + (size_t)l * 64 * 256 * 512, 512, 512, 512}; pg8::Order S;
                S.init(NCH_S5 / 256, 1, 64, G, cb, (size_t)256 * 512 * 2, (size_t)NCH_S5 * 512 * 2, 0, (size_t)256 * 512 * 2);
                EpiS5Main E{(bf16*)(ws + WS_SCR + SD_YG)}; pg8::gemm_phase(lds, g, S, E, F.tid); });
        PHASE(14, { pg8::Gemm g{(const bf16*)(ws + WS_SCR + SD_YG), (const bf16*)(ws + WS_GLUT) + (size_t)l * WB * WB, WB, WB, WB}; pg8::Order S; S.init(T / 256, WB / 256, 1, G, cb, (size_t)256 * WB * 2, 0, (size_t)256 * WB * 2, 0);
                EpiGlu E{(const bf16*)(ws + WS_SCR + SD_YG), (const bf16*)(ws + WS_PROJ), a.in(I_GLUB) + (size_t)l * WB, (bf16*)(ws + WS_Y)}; pg8::gemm_phase(lds, g, S, E, F.tid); });
        PHASE(15, ph_ret_kv(a, F));
        PHASE(16, ph_ret_scan(a, F));
        PHASE(25, { pg8::Gemm g{(const bf16*)(ws + WS_PROJ) + C_WDF, (const bf16*)(ws + WS_W2ALL) + (size_t)l * 3072 * 256, NPJ, 256, 256}; pg8::Order S; S.init(T / 256, 3072 / 256, 1, G, cb, (size_t)256 * NPJ * 2, 0, (size_t)256 * 256 * 2, 0);
                EpiBf16 E{(bf16*)(ws + WS_SCR + SB_LO), 3072, -1, nullptr}; pg8::gemm_phase(lds, g, S, E, F.tid); });
        PHASE(18, ph_rwkv_prep(a, F, l));
        PHASE(19, ph_rwkv_chunk(a, F));
        PHASE(20, { ph_rwkv_seq(a, F); ph_ret_out(a, F, l); });
        PHASE(24, ph_rwkv_out(a, F, l));
        PHASE(21, { { pg8::Gemm g{(const bf16*)(ws + WS_H), WALLT + (size_t)NPJ * D, D, D, D}; pg8::Order S; S.init(T / 256, 4 * D / 256, 1, G, cb, (size_t)256 * D * 2, 0, (size_t)256 * D * 2, 0);
                      EpiGate E{(bf16*)(ws + WS_SCR + SM_GS), rss_l}; pg8::gemm_phase(lds, g, S, E, F.tid); }
                    xcd_barrier(bar);
                    { pg8::Gemm g{(const bf16*)(ws + WS_Y), (const bf16*)(ws + WS_WBRT) + (size_t)l * D * 4096, 4096, 4096, WB}; pg8::Order S; S.init(T / 256, D / 256, 4, G, cb, (size_t)256 * 4096 * 2, (size_t)WB * 2, (size_t)256 * 4096 * 2, (size_t)WB * 2); S.zfast = 1;
                      EpiBranchAll E{(const bf16*)(ws + WS_SCR + SM_GS), (bf16*)(ws + WS_SCR + SM_MG)}; pg8::gemm_phase(lds, g, S, E, F.tid); } });
        PHASE(22, { pg8::Gemm g{(const bf16*)(ws + WS_SCR + SM_MG), (const bf16*)(ws + WS_WOUTT) + (size_t)l * D * D, D, D, D}; pg8::Order S; S.init(T / 256, D / 256, 1, G, cb, (size_t)256 * D * 2, 0, (size_t)256 * D * 2, 0);
#ifdef OUT_DRY
                { EpiNull E0; pg8::gemm_phase(lds, g, S, E0, F.tid); }
#endif
                EpiOut E{a.in(I_XP), a.in(I_XS), a.out, (bf16*)(ws + WS_H), (float*)(ws + WS_RSP), l == 0 ? 1 : 0}; pg8::gemm_phase(lds, g, S, E, F.tid); });
        PHASE(26, ph_rss(a, F, l));
#ifdef XTRA_BAR
        for (int xb = 0; xb < XTRA_BAR; ++xb) xcd_barrier(bar);
#endif
    }
    PHASE(23, ph_final(a, F));
#undef PHASE
}

extern "C" void kernel_launch(void* const* d_in, const int* in_sizes, int n_in, void* d_out, int out_size, void* d_ws, size_t ws_size, hipStream_t stream) {
    static int grid = 0;
    if (grid == 0) {
        if (n_in != 35 || out_size != T * D || ws_size < WS_END) { fprintf(stderr, "kernel_launch: unexpected shapes (n_in %d out %d ws %zu need %zu)\n", n_in, out_size, ws_size, (size_t)WS_END); grid = -1; return; }
        int dev = 0, cus = 0, per_cu = 0;
        if (hipGetDevice(&dev) != hipSuccess || hipDeviceGetAttribute(&cus, hipDeviceAttributeMultiprocessorCount, dev) != hipSuccess) { grid = -1; return; }
        if (hipFuncSetAttribute((const void*)fwd, hipFuncAttributeMaxDynamicSharedMemorySize, LDS_BYTES) != hipSuccess) { fprintf(stderr, "kernel_launch: hipFuncSetAttribute failed\n"); grid = -1; return; }
        if (hipOccupancyMaxActiveBlocksPerMultiprocessor(&per_cu, (const void*)fwd, NTHR, LDS_BYTES) != hipSuccess || per_cu < 1) fprintf(stderr, "kernel_launch: occupancy query says %d\n", per_cu);
        (void)hipGetLastError();
        grid = cus;
    }
    if (grid < 0) return;
    (void)hipMemsetAsync((char*)d_ws + WS_CTL, 0, CTL_BYTES, stream);
    Args a{};
    for (int i = 0; i < 35; ++i) a.in[i] = (const float*)d_in[i];
    a.out = (float*)d_out; a.ws = (unsigned char*)d_ws;
#if MK_ONE_LAUNCH
    a.ph_lo = 0; a.ph_hi = NPH;
    hipLaunchKernelGGL(fwd, dim3(grid), dim3(NTHR), LDS_BYTES, stream, a);
#else
    for (int p = 0; p < NPH; ++p) { a.ph_lo = p; a.ph_hi = p + 1; hipLaunchKernelGGL(fwd, dim3(grid), dim3(NTHR), LDS_BYTES, stream, a); }
#endif
}
```

```cpp
#include <hip/hip_runtime.h>
#include <cstdio>
#include <cstdint>

#ifndef MK_ONE_LAUNCH
#define MK_ONE_LAUNCH 1
#endif

#define LAS __attribute__((address_space(3)))
#define GAS __attribute__((address_space(1)))
typedef unsigned short bf16;
typedef short bf16x8 __attribute__((ext_vector_type(8)));
typedef float f32x4 __attribute__((ext_vector_type(4)));
typedef float f32x2 __attribute__((ext_vector_type(2)));
typedef unsigned u32x4 __attribute__((ext_vector_type(4)));
typedef unsigned u32x2 __attribute__((ext_vector_type(2)));

constexpr int T = 24576, TP = 16384, LS = 2048, D = 2048, WB = 1024, DEPTH = 4;
constexpr int NPJ = 11520, NIN = 19648, GOFF = 11456, NALL = 19712;
constexpr int C_LRUX = 0, C_LRUZ = 1024, C_RWR = 2048, C_RWK = 3072, C_RWV = 4096, C_WDF = 5120, C_WDB = 5184, C_AD = 5248, C_RWZ = 5312,
              C_RQ = 6336, C_RK = 6848, C_RV = 7360, C_RZ = 8384, C_SU = 9408, C_SZ = 10432;
constexpr int NCH_S5 = T / 16;
constexpr int NCH_RET = T / 128;
constexpr int NCH_LRU = T / 128;

constexpr size_t al(size_t x) { return (x + 0xFFFFFu) & ~(size_t)0xFFFFFu; }
constexpr size_t WS_CTL = 0, CTL_BYTES = 1u << 20;
constexpr size_t WS_WALLT = al(WS_CTL + CTL_BYTES);
constexpr size_t WS_LRUW  = al(WS_WALLT + (size_t)DEPTH * NALL * D * 2);
constexpr size_t WS_GLUT  = al(WS_LRUW + (size_t)DEPTH * 4096 * 256 * 2);
constexpr size_t WS_WBRT  = al(WS_GLUT + (size_t)DEPTH * 1024 * 1024 * 2);
constexpr size_t WS_WOUTT = al(WS_WBRT + (size_t)DEPTH * 2048 * 4096 * 2);
constexpr size_t WS_S5MAIN= al(WS_WOUTT + (size_t)DEPTH * 2048 * 2048 * 2);
constexpr size_t WS_S5INC = al(WS_S5MAIN + (size_t)DEPTH * 64 * 256 * 512 * 2);
constexpr size_t WS_S5TAB = al(WS_S5INC + (size_t)DEPTH * 64 * 256 * 256 * 2);
constexpr size_t WS_W2ALL = al(WS_S5TAB + (size_t)DEPTH * 2 * 64 * 64 * 33 * 8);
constexpr size_t WS_ROT   = al(WS_W2ALL + (size_t)DEPTH * 3072 * 256 * 2);
constexpr size_t WS_RSS   = al(WS_ROT + (size_t)16384 * 64 * 8);
constexpr size_t WS_RSP   = al(WS_RSS + (size_t)2 * T * 4);
constexpr size_t WS_H     = al(WS_RSP + (size_t)T * 32 * 4);
constexpr size_t WS_PROJ  = al(WS_H + (size_t)T * D * 2);
constexpr size_t WS_Y     = al(WS_PROJ + (size_t)T * NPJ * 2);
constexpr size_t WS_STP   = al(WS_Y + (size_t)T * 4096 * 2);
constexpr size_t WS_SCR   = al(WS_STP + (size_t)2 * 768 * 256 * 128 * 2);
constexpr size_t TW4 = (size_t)T * WB * 4, TW2 = (size_t)T * WB * 2;
constexpr int NCH_L32 = T / 32;
constexpr size_t SA_XC = 0, SA_LA = al(SA_XC + TW2), SA_BB = al(SA_LA + 2 * TW2), SA_PA = al(SA_BB + 2 * TW2),
                 SA_PB = al(SA_PA + (size_t)NCH_L32 * 2 * WB * 4), SA_CAR = al(SA_PB + (size_t)NCH_L32 * 2 * WB * 4), SA_END = al(SA_CAR + (size_t)NCH_L32 * 2 * WB * 4);
constexpr size_t SD_UC = 0, SD_INC = al(SD_UC + (size_t)64 * NCH_S5 * 512 * 2), SD_YG = al(SD_INC + (size_t)64 * NCH_S5 * 256 * 4), SD_END = al(SD_YG + TW2);
constexpr size_t SC_KVT = 0, SC_END = al(SC_KVT + (size_t)2 * 768 * 256 * 128 * 4);
constexpr size_t SB_R = 0, SB_KM = al(SB_R + TW2), SB_V = al(SB_KM + TW2), SB_KK = al(SB_V + TW2), SB_AG = al(SB_KK + TW2), SB_LWF = al(SB_AG + TW2), SB_LWB = al(SB_LWF + TW2),
                 SB_CH = al(SB_LWB + TW2), SB_SS = al(SB_CH + (size_t)(T / 64) * 16 * 2 * 4 * 4096 * 2), SB_END = al(SB_SS + (size_t)(T / 64) * 16 * 2 * 4096 * 2), SB_LO = SB_CH;
constexpr size_t SM_GS = 0, SM_MG = al(SM_GS + (size_t)T * 4 * D * 2), SM_END = al(SM_MG + (size_t)T * D * 2);
constexpr size_t cmax(size_t a, size_t b) { return a > b ? a : b; }
constexpr size_t SCR_BYTES = cmax(cmax(cmax(SA_END, SD_END), cmax(SC_END, SB_END)), SM_END);
constexpr size_t WS_END = WS_SCR + SCR_BYTES;
static_assert(WS_END < (size_t)2500 * 1000 * 1000, "workspace budget");

__device__ __forceinline__ float ld_agent(const float* p) { return __hip_atomic_load(p, __ATOMIC_RELAXED, __HIP_MEMORY_SCOPE_AGENT); }
__device__ __forceinline__ void st_agent(float* p, float v) { __hip_atomic_store(p, v, __ATOMIC_RELAXED, __HIP_MEMORY_SCOPE_AGENT); }
__device__ __forceinline__ int lane_id() { unsigned m = ~0u; asm volatile("" : "+s"(m)); return (int)__builtin_amdgcn_mbcnt_hi(m, __builtin_amdgcn_mbcnt_lo(m, 0u)); }
__device__ __forceinline__ float bf2f(bf16 b) { return __uint_as_float(((unsigned)b) << 16); }
typedef __bf16 hwbf16x2 __attribute__((ext_vector_type(2)));
__device__ __forceinline__ unsigned pk2(float lo, float hi) { const f32x2 v = {lo, hi}; return __builtin_bit_cast(unsigned, __builtin_convertvector(v, hwbf16x2)); }
__device__ __forceinline__ unsigned f2bf(float f) { return pk2(f, 0.f) & 0xffffu; }
__device__ __forceinline__ float sigmoidf_(float x) { return __builtin_amdgcn_rcpf(1.0f + __expf(-x)); }
__device__ __forceinline__ float siluf_(float x) { return x * __builtin_amdgcn_rcpf(1.0f + __expf(-x)); }
__device__ __forceinline__ float tanhf_(float x) { const float e = __expf(2.0f * fminf(fmaxf(x, -15.f), 15.f)); return 1.0f - 2.0f * __builtin_amdgcn_rcpf(e + 1.0f); }
__device__ __forceinline__ float softplusf_(float x) { return fmaxf(x, 0.f) + __logf(1.0f + __expf(-fabsf(x))); }
__device__ __forceinline__ float gelu_tanh(float x) { const float u = 0.7978845608028654f * (x + 0.044715f * x * x * x); const float e = __expf(2.f * u); const float th = 1.f - 2.f * __builtin_amdgcn_rcpf(e + 1.f); return 0.5f * x * (1.f + th); }
template <int O> __device__ __forceinline__ float shx(float v) {
    if constexpr (O < 32) return __int_as_float(__builtin_amdgcn_ds_swizzle(__float_as_int(v), (O << 10) | 0x1f));
    else { const int lane = lane_id(); return __int_as_float(__builtin_amdgcn_ds_bpermute((lane ^ O) << 2, __float_as_int(v))); }
}
__device__ __forceinline__ float wave_sum(float v) { v += shx<1>(v); v += shx<2>(v); v += shx<4>(v); v += shx<8>(v); v += shx<16>(v); v += shx<32>(v); return v; }
__device__ __forceinline__ void seq_of(int t, int& pos, int& L) { if (t < TP) { pos = t; L = TP; } else { pos = (t - TP) & (LS - 1); L = LS; } }
__device__ __forceinline__ void unpack8(const u32x4 w, float (&x)[8]) {
    x[0] = __uint_as_float(w.x << 16); x[1] = __uint_as_float(w.x & 0xffff0000u); x[2] = __uint_as_float(w.y << 16); x[3] = __uint_as_float(w.y & 0xffff0000u);
    x[4] = __uint_as_float(w.z << 16); x[5] = __uint_as_float(w.z & 0xffff0000u); x[6] = __uint_as_float(w.w << 16); x[7] = __uint_as_float(w.w & 0xffff0000u);
}
__device__ __forceinline__ u32x4 pack8(const float (&x)[8]) { u32x4 w; w.x = pk2(x[0], x[1]); w.y = pk2(x[2], x[3]); w.z = pk2(x[4], x[5]); w.w = pk2(x[6], x[7]); return w; }

namespace pg8 {
#define PG8_LAS __attribute__((address_space(3)))
typedef unsigned short bf16_t;
constexpr int BM = 256, BK = 64, HALF = 128, HTB = HALF * BK * 2, STAGE_BYTES = 8 * HTB, NXCD = 8, WGM = 4;
__host__ __device__ __forceinline__ int lds_byte(int r, int c) { const int st = (r >> 4) * 2 + (c >> 5), rr = r & 15, cc = c & 31, ob = rr * 64 + cc * 2; return st * 1024 + (ob ^ (((ob >> 9) & 1) << 5)); }
__host__ __device__ __forceinline__ void stage_rc(int b, int& R, int& C) { const int st = b / 1024, sb = b % 1024, swz = sb ^ (((sb >> 9) & 1) << 5); R = (st >> 1) * 16 + swz / 64; C = (st & 1) * 32 + (swz % 64) / 2; }
__host__ __device__ __forceinline__ int perm32(int rho) { const int n = rho >> 4, i = rho & 15; return 8 * (i >> 2) + 4 * n + (i & 3); }

struct Unit { int pm, pn, z; size_t aoff, boff; };
struct Gemm { const bf16_t* A; const bf16_t* Bt; int lda, ldb, K; };

struct Order {
    int nM, nN, nZ, G, c; size_t a_pm, a_z, b_pn, b_z; int kwin = 0; int zfast = 0;
    __device__ __forceinline__ void init(int nM_, int nN_, int nZ_, int G_, int c_, size_t a_pm_, size_t a_z_, size_t b_pn_, size_t b_z_) { nM = nM_; nN = nN_; nZ = nZ_; G = G_; c = c_; a_pm = a_pm_; a_z = a_z_; b_pn = b_pn_; b_z = b_z_; }
    __device__ __forceinline__ bool next(int i, Unit& u) const {
        const int nwg = nM * nN; int z, wgid;
        if (zfast) { const long L = (long)(i / nZ) * G + c; if (L >= (long)nwg) return false; z = i % nZ; wgid = (int)L; }
        else { const long L = (long)i * G + c; if (L >= (long)nwg * nZ) return false; z = (int)(L / nwg); wgid = (int)(L % nwg); }
        { const int q = nwg / NXCD, r = nwg % NXCD, xcd = wgid % NXCD, off = wgid / NXCD; wgid = (xcd < r ? xcd * (q + 1) : r * (q + 1) + (xcd - r) * q) + off; }
        const int nig = WGM * nN, gid = wgid / nig, fm = gid * WGM, gsz = (nM - fm) < WGM ? (nM - fm) : WGM;
        u.pm = fm + ((wgid % nig) % gsz); u.pn = (wgid % nig) / gsz; u.z = z;
        u.aoff = (size_t)u.pm * a_pm + (size_t)z * a_z + (size_t)(((u.pn & 7) >> 1) * kwin); u.boff = (size_t)u.pn * b_pn + (size_t)z * b_z; return true;
    }
};

template <class Epi>
__device__ __forceinline__ void gemm_phase(PG8_LAS unsigned char* lds, const Gemm g, const Order& S, const Epi& E, int tid_in) {
    int tid_ = tid_in; asm volatile("" : "+v"(tid_));
    const int tid = tid_, wid = __builtin_amdgcn_readfirstlane(tid >> 6), lane = tid & 63, wr = wid >> 2, wc = wid & 3, fr = lane & 15, fq = lane >> 4;
    const int K = g.K, nt = K / BK;
    unsigned voffA[2], voffB[2];
#pragma unroll
    for (int i = 0; i < 2; ++i) { int R, C; stage_rc(tid * 16 + i * 8192, R, C); const int Rb = Epi::PERM ? ((R & ~31) + perm32(R & 31)) : R;
        voffA[i] = (unsigned)(R * g.lda + C) * 2u; voffB[i] = (unsigned)(Rb * g.ldb + C) * 2u; }
    const size_t kstep = (size_t)(BK * 2);
    const size_t hstepA = (size_t)HALF * g.lda * 2, hstepB = (size_t)HALF * g.ldb * 2;
    const unsigned ldsw = (unsigned)wid * 1024u;
    const int aoff = lds_byte(wr * 64 + fr, fq * 8), boff = lds_byte(wc * 32 + fr, fq * 8);
#define PG8_SA(b, h) (((b) * 2 + (h)) * HTB)
#define PG8_SB(b, h) ((4 + (b) * 2 + (h)) * HTB)
#define PG8_STAGE(bufoff, gbase, voff) do { _Pragma("unroll") for (int _i = 0; _i < 2; ++_i) \
        __builtin_amdgcn_global_load_lds((const unsigned*)((const char*)(gbase) + (voff)[_i]), (PG8_LAS unsigned*)(lds + (bufoff) + ldsw + _i * 8192), 16, 0, 0); } while (0)
#define PG8_LDA(dst, b, h) do { _Pragma("unroll") for (int m = 0; m < 4; ++m) _Pragma("unroll") for (int k = 0; k < 2; ++k) dst[m][k] = *(const PG8_LAS bf16x8*)(lds + PG8_SA(b, h) + aoff + m * 2048 + k * 1024); } while (0)
#define PG8_LDB(dst, b, h) do { _Pragma("unroll") for (int n = 0; n < 2; ++n) _Pragma("unroll") for (int k = 0; k < 2; ++k) dst[n][k] = *(const PG8_LAS bf16x8*)(lds + PG8_SB(b, h) + boff + n * 2048 + k * 1024); } while (0)
#define PG8_MMA(ai, bj, At, Bt) do { __builtin_amdgcn_s_setprio(1); _Pragma("unroll") for (int m = 0; m < 4; ++m) _Pragma("unroll") for (int n = 0; n < 2; ++n) _Pragma("unroll") for (int k = 0; k < 2; ++k) \
        acc[ai][bj][m][n] = __builtin_amdgcn_mfma_f32_16x16x32_bf16(Bt[n][k], At[m][k], acc[ai][bj][m][n], 0, 0, 0); __builtin_amdgcn_s_setprio(0); } while (0)
#define PG8_WAIT_V(n) asm volatile("s_waitcnt vmcnt(" #n ")" ::: "memory")
#define PG8_WAIT_L(n) asm volatile("s_waitcnt lgkmcnt(" #n ")" ::: "memory")
#define PG8_BAR __builtin_amdgcn_s_barrier()
#define PG8_SCHED __builtin_amdgcn_sched_barrier(0)
    Unit cur, nxt; int ui = 0;
    if (!S.next(0, cur)) return;
    f32x4 acc[2][2][4][2];
#pragma unroll
    for (int a = 0; a < 2; ++a)
#pragma unroll
        for (int b = 0; b < 2; ++b)
#pragma unroll
            for (int m = 0; m < 4; ++m)
#pragma unroll
                for (int n = 0; n < 2; ++n) acc[a][b][m][n] = (f32x4){0.f, 0.f, 0.f, 0.f};
    const char* cA = (const char*)g.A + cur.aoff; const char* cB = (const char*)g.Bt + cur.boff;
    PG8_STAGE(PG8_SB(0, 0), cB, voffB); PG8_STAGE(PG8_SB(0, 1), cB + hstepB, voffB); PG8_STAGE(PG8_SA(0, 0), cA, voffA); PG8_STAGE(PG8_SA(0, 1), cA + hstepA, voffA);
    if (wr == 1) PG8_BAR;
    PG8_WAIT_V(2); PG8_BAR;
    PG8_STAGE(PG8_SB(1, 0), cB + kstep, voffB); PG8_STAGE(PG8_SA(1, 0), cA + kstep, voffA); PG8_STAGE(PG8_SB(1, 1), cB + hstepB + kstep, voffB);
    PG8_WAIT_V(6); PG8_BAR;
    for (;;) {
        const bool has_next = S.next(ui + 1, nxt);
        const char* nA = has_next ? (const char*)g.A + nxt.aoff : cA; const char* nB = has_next ? (const char*)g.Bt + nxt.boff : cB;
#pragma unroll 1
        for (int t = 0; t < nt; t += 2) {
            const bool last = (t == nt - 2);
            const char* a1 = cA + (size_t)(t + 1) * kstep;
            const char* a2 = last ? nA : cA + (size_t)(t + 2) * kstep; const char* b2 = last ? nB : cB + (size_t)(t + 2) * kstep;
            const char* a3 = a2 + kstep; const char* b3 = b2 + kstep;
            bf16x8 At[4][2], B0[2][2], B1[2][2];
            PG8_LDB(B0, 0, 0); PG8_LDB(B1, 0, 1); PG8_SCHED; PG8_LDA(At, 0, 0); PG8_STAGE(PG8_SA(1, 1), a1 + hstepA, voffA);
            PG8_WAIT_V(8); PG8_WAIT_L(0); PG8_BAR; PG8_MMA(0, 0, At, B0); PG8_MMA(0, 1, At, B1); PG8_BAR; PG8_SCHED;
            PG8_LDA(At, 0, 1); PG8_STAGE(PG8_SB(0, 0), b2, voffB); PG8_STAGE(PG8_SB(0, 1), b2 + hstepB, voffB); PG8_STAGE(PG8_SA(0, 0), a2, voffA);
            PG8_WAIT_V(8); PG8_WAIT_L(0); PG8_BAR; PG8_MMA(1, 0, At, B0); PG8_MMA(1, 1, At, B1); PG8_BAR; PG8_SCHED;
            PG8_LDB(B0, 1, 0); PG8_LDB(B1, 1, 1); PG8_SCHED; PG8_LDA(At, 1, 0); PG8_STAGE(PG8_SA(0, 1), a2 + hstepA, voffA);
            PG8_WAIT_V(8); PG8_WAIT_L(0); PG8_BAR; PG8_MMA(0, 0, At, B0); PG8_MMA(0, 1, At, B1); PG8_BAR; PG8_SCHED;
            PG8_LDA(At, 1, 1); PG8_STAGE(PG8_SB(1, 0), b3, voffB); PG8_STAGE(PG8_SB(1, 1), b3 + hstepB, voffB); PG8_STAGE(PG8_SA(1, 0), a3, voffA);
            PG8_WAIT_V(8); PG8_WAIT_L(0); PG8_BAR; PG8_MMA(1, 0, At, B0); PG8_MMA(1, 1, At, B1); PG8_BAR; PG8_SCHED;
        }
        if (wr == 0) PG8_BAR;
        asm volatile("" ::: "memory");
        { const int ln_ = lane_id(); E(acc, cur, wr, wc, ln_ & 15, ln_ >> 4); }
        asm volatile("" ::: "memory");
        if (!has_next) break;
        if (!(Epi::KEEP && cur.z + 1 < S.nZ)) {
#pragma unroll
        for (int a = 0; a < 2; ++a)
#pragma unroll
            for (int b = 0; b < 2; ++b)
#pragma unroll
                for (int m = 0; m < 4; ++m)
#pragma unroll
                    for (int n = 0; n < 2; ++n) acc[a][b][m][n] = (f32x4){0.f, 0.f, 0.f, 0.f}; }
        cur = nxt; cA = nA; cB = nB; ++ui;
        if (wr == 1) PG8_BAR;
    }
    PG8_WAIT_V(0);
    PG8_BAR;
#undef PG8_SA
#undef PG8_SB
#undef PG8_STAGE
#undef PG8_LDA
#undef PG8_LDB
#undef PG8_MMA
#undef PG8_WAIT_V
#undef PG8_WAIT_L
#undef PG8_BAR
#undef PG8_SCHED
}
}
using pg8::Unit; using pg8::HALF; using pg8::BM;
typedef f32x4 AccT[2][2][4][2];

struct EpiBf16 {
    static constexpr bool PERM = true, KEEP = false;
    bf16* O; int ldc; int tanh_pn;
    const float* rss;
    __device__ __forceinline__ void operator()(const AccT& acc, const Unit& u, int wr, int wc, int fr, int fq) const {
        const int row0 = u.pm * BM + wr * 64 + fr, col0 = u.pn * BM + wc * 32 + 8 * fq;
        float rsv[2][4];
#pragma unroll
        for (int ai = 0; ai < 2; ++ai)
#pragma unroll
            for (int m = 0; m < 4; ++m) rsv[ai][m] = rss ? rss[row0 + ai * HALF + m * 16] : 0.f;
#pragma unroll
        for (int ai = 0; ai < 2; ++ai)
#pragma unroll
            for (int m = 0; m < 4; ++m) { bf16* rowp = O + (size_t)(row0 + ai * HALF + m * 16) * ldc + col0; const float rs = rss ? __builtin_amdgcn_rsqf(rsv[ai][m] * (1.0f / D) + 1e-6f) : 1.0f;
#pragma unroll
                for (int bj = 0; bj < 2; ++bj) { f32x4 v0 = acc[ai][bj][m][0] * rs, v1 = acc[ai][bj][m][1] * rs;
                    if (bj == 0 && u.pn == tanh_pn) {
#pragma unroll
                        for (int j = 0; j < 4; ++j) { v0[j] = tanhf_(v0[j]); v1[j] = tanhf_(v1[j]); } }
                    u32x4 w; w.x = pk2(v0[0], v0[1]); w.y = pk2(v0[2], v0[3]); w.z = pk2(v1[0], v1[1]); w.w = pk2(v1[2], v1[3]);
                    *(u32x4*)(rowp + bj * HALF) = w; } }
    }
};
struct EpiF32 {
    static constexpr bool PERM = false, KEEP = false;
    float* C; int ldc; size_t zstride;
    __device__ __forceinline__ void operator()(const AccT& acc, const Unit& u, int wr, int wc, int fr, int fq) const {
        const int row0 = u.pm * BM + wr * 64 + fr, col0 = u.pn * BM + wc * 32 + 4 * fq; float* Cz = C + (size_t)u.z * zstride;
#pragma unroll
        for (int ai = 0; ai < 2; ++ai)
#pragma unroll
            for (int m = 0; m < 4; ++m) { float* rowp = Cz + (size_t)(row0 + ai * HALF + m * 16) * ldc + col0;
#pragma unroll
                for (int bj = 0; bj < 2; ++bj)
#pragma unroll
                    for (int n = 0; n < 2; ++n) *(f32x4*)(rowp + bj * HALF + n * 16) = acc[ai][bj][m][n]; }
    }
};
struct EpiLru {
    static constexpr bool PERM = false, KEEP = false;
    const float *b_r, *b_i, *lam;
    const bf16* XC; bf16* LA; bf16* BB;
    __device__ __forceinline__ void operator()(const AccT& acc, const Unit& u, int wr, int wc, int fr, int fq) const {
        const int d = u.pn >> 3, h = u.pn & 7; const int row0 = u.pm * BM + wr * 64 + fr;
#pragma unroll
        for (int n = 0; n < 2; ++n) { const int ch0 = h * 128 + wc * 32 + n * 16 + fq * 4; float br[4], bi[4], sp[4];
#pragma unroll
            for (int j = 0; j < 4; ++j) { br[j] = b_r[d * WB + ch0 + j]; bi[j] = b_i[d * WB + ch0 + j]; sp[j] = -8.0f * softplusf_(-lam[d * WB + ch0 + j]); }
            u32x2 xwv[2][4];
#pragma unroll
            for (int ai = 0; ai < 2; ++ai)
#pragma unroll
                for (int m = 0; m < 4; ++m) xwv[ai][m] = *(const u32x2*)(XC + (size_t)(row0 + ai * HALF + m * 16) * WB + ch0);
#pragma unroll
            for (int ai = 0; ai < 2; ++ai)
#pragma unroll
                for (int m = 0; m < 4; ++m) { const int t = row0 + ai * HALF + m * 16; int pos, L; seq_of(t, pos, L); const bool first = (d == 0) ? (pos == 0) : (pos == L - 1);
                    const f32x4 ar = acc[ai][0][m][n], aiq = acc[ai][1][m][n];
                    const u32x2 xw = xwv[ai][m];
                    const float xc[4] = {__uint_as_float(xw.x << 16), __uint_as_float(xw.x & 0xffff0000u), __uint_as_float(xw.y << 16), __uint_as_float(xw.y & 0xffff0000u)};
                    float oa[4], ob[4];
#pragma unroll
                    for (int j = 0; j < 4; ++j) { const float rg = sigmoidf_(ar[j] + br[j]), ig = sigmoidf_(aiq[j] + bi[j]); const float la = rg * sp[j];
                        float mult = __builtin_amdgcn_sqrtf(fmaxf(1.0f - __expf(2.0f * la), 0.f)); if (first) mult = 1.0f; oa[j] = la; ob[j] = mult * ig * xc[j]; }
                    u32x2 wa, wb; wa.x = pk2(oa[0], oa[1]); wa.y = pk2(oa[2], oa[3]); wb.x = pk2(ob[0], ob[1]); wb.y = pk2(ob[2], ob[3]);
                    *(u32x2*)(LA + ((size_t)d * T + t) * WB + ch0) = wa; *(u32x2*)(BB + ((size_t)d * T + t) * WB + ch0) = wb; } }
    }
};
struct EpiS5Main {
    static constexpr bool PERM = true, KEEP = false;
    bf16* YG;
    __device__ __forceinline__ void operator()(const AccT& acc, const Unit& u, int wr, int wc, int fr, int fq) const {
        const int row0 = u.pm * BM + wr * 64 + fr; const int g = u.z;
#pragma unroll
        for (int ai = 0; ai < 2; ++ai)
#pragma unroll
            for (int m = 0; m < 4; ++m) { const int c = row0 + ai * HALF + m * 16;
#pragma unroll
                for (int bj = 0; bj < 2; ++bj) { const int cc = bj * HALF + wc * 32 + 8 * fq; const int tau = cc >> 4, p0 = cc & 15; const f32x4 v0 = acc[ai][bj][m][0], v1 = acc[ai][bj][m][1];
                    u32x4 w; w.x = pk2(gelu_tanh(v0[0]), gelu_tanh(v0[1])); w.y = pk2(gelu_tanh(v0[2]), gelu_tanh(v0[3])); w.z = pk2(gelu_tanh(v1[0]), gelu_tanh(v1[1])); w.w = pk2(gelu_tanh(v1[2]), gelu_tanh(v1[3]));
                    *(u32x4*)(YG + (size_t)(c * 16 + tau) * WB + g * 16 + p0) = w; } }
    }
};
struct EpiGlu {
    static constexpr bool PERM = true, KEEP = false;
    const bf16* YG; const bf16* PROJ; const float* glu_b; bf16* Y;
    __device__ __forceinline__ void operator()(const AccT& acc, const Unit& u, int wr, int wc, int fr, int fq) const {
        const int row0 = u.pm * BM + wr * 64 + fr, col0 = u.pn * BM + wc * 32 + 8 * fq;
#pragma unroll
        for (int ai = 0; ai < 2; ++ai)
#pragma unroll
            for (int m = 0; m < 4; m += 2) { u32x4 ygw[2][2], zzw[2][2];
#pragma unroll
              for (int mm = 0; mm < 2; ++mm)
#pragma unroll
                for (int bj = 0; bj < 2; ++bj) { const int t = row0 + ai * HALF + (m + mm) * 16, col = col0 + bj * HALF; ygw[mm][bj] = *(const u32x4*)(YG + (size_t)t * WB + col); zzw[mm][bj] = *(const u32x4*)(PROJ + (size_t)t * NPJ + C_SZ + col); }
#pragma unroll
              for (int mm = 0; mm < 2; ++mm) { const int t = row0 + ai * HALF + (m + mm) * 16;
#pragma unroll
                for (int bj = 0; bj < 2; ++bj) { const int col = col0 + bj * HALF; const f32x4 v0 = acc[ai][bj][m + mm][0], v1 = acc[ai][bj][m + mm][1];
                    float yg[8], zz[8], o[8]; unpack8(ygw[mm][bj], yg); unpack8(zzw[mm][bj], zz);
                    const f32x4 b0 = *(const f32x4*)(glu_b + col), b1 = *(const f32x4*)(glu_b + col + 4);
#pragma unroll
                    for (int j = 0; j < 4; ++j) { o[j] = yg[j] * sigmoidf_(v0[j] + b0[j]) * siluf_(zz[j]); o[4 + j] = yg[4 + j] * sigmoidf_(v1[j] + b1[j]) * siluf_(zz[4 + j]); }
                    *(u32x4*)(Y + (size_t)t * 4096 + 3072 + col) = pack8(o); } } }
    }
};
struct EpiGate {
    static constexpr bool PERM = false, KEEP = false;
    bf16* GR; const float* rss;
    __device__ __forceinline__ void operator()(const AccT& acc, const Unit& u, int wr, int wc, int fr, int fq) const {
        const int row0 = u.pm * BM + wr * 64 + fr, ch0 = u.pn * 64 + wc * 16 + 4 * fq;
        float rsv[2][4];
#pragma unroll
        for (int ai = 0; ai < 2; ++ai)
#pragma unroll
            for (int m = 0; m < 4; ++m) rsv[ai][m] = rss[row0 + ai * HALF + m * 16];
#pragma unroll
        for (int ai = 0; ai < 2; ++ai)
#pragma unroll
            for (int m = 0; m < 4; ++m) { const size_t t = (size_t)(row0 + ai * HALF + m * 16); const float rs = __builtin_amdgcn_rsqf(rsv[ai][m] * (1.0f / D) + 1e-6f);
                float e1[4][4], g[4][4];
#pragma unroll
                for (int z = 0; z < 4; ++z) { const f32x4 v = acc[ai][z >> 1][m][z & 1] * rs;
#pragma unroll
                    for (int j = 0; j < 4; ++j) { e1[z][j] = 1.0f + __expf(-__builtin_amdgcn_fmed3f(v[j], -30.0f, 30.0f)); g[z][j] = __builtin_amdgcn_rcpf(e1[z][j]); } }
#pragma unroll
                for (int z = 0; z < 4; ++z) { float f[4];
#pragma unroll
                    for (int j = 0; j < 4; ++j) f[j] = z < 3 ? g[z][j] * e1[z + 1][j] : g[3][j];
                    u32x2 w; w.x = pk2(f[0], f[1]); w.y = pk2(f[2], f[3]); *(u32x2*)(GR + ((size_t)z * T + t) * D + ch0) = w; } }
    }
};
struct EpiBranchAll {
    static constexpr bool PERM = false, KEEP = true;
    const bf16* GR; bf16* MG;
    __device__ __forceinline__ void operator()(AccT& acc, const Unit& u, int wr, int wc, int fr, int fq) const {
        const int row0 = u.pm * BM + wr * 64 + fr, col0 = u.pn * BM + wc * 32 + 4 * fq; const int z = u.z;
#pragma unroll
        for (int ai = 0; ai < 2; ++ai)
          { u32x2 gv[4][2][2];
#pragma unroll
            for (int m = 0; m < 4; ++m)
#pragma unroll
                for (int bj = 0; bj < 2; ++bj)
#pragma unroll
                    for (int n = 0; n < 2; ++n) gv[m][bj][n] = *(const u32x2*)(GR + ((size_t)z * T + (size_t)(row0 + ai * HALF + m * 16)) * D + col0 + bj * HALF + n * 16);
#pragma unroll
            for (int m = 0; m < 4; ++m) { const size_t t = (size_t)(row0 + ai * HALF + m * 16);
#pragma unroll
                for (int bj = 0; bj < 2; ++bj)
#pragma unroll
                    for (int n = 0; n < 2; ++n) { const int o = bj * HALF + n * 16; const u32x2 g0 = gv[m][bj][n]; f32x4& a = acc[ai][bj][m][n];
                        a[0] *= __uint_as_float(g0.x << 16); a[1] *= __uint_as_float(g0.x & 0xffff0000u); a[2] *= __uint_as_float(g0.y << 16); a[3] *= __uint_as_float(g0.y & 0xffff0000u);
                        if (z == 3) { u32x2 w; w.x = pk2(a[0], a[1]); w.y = pk2(a[2], a[3]); *(u32x2*)(MG + t * D + col0 + o) = w; } } } }
    }
};
struct EpiOut {
    static constexpr bool PERM = false, KEEP = false;
    const float* xp; const float* xs; float* out; bf16* XB; float* rsp; int first;
    __device__ __forceinline__ void operator()(const AccT& acc, const Unit& u, int wr, int wc, int fr, int fq) const {
        const int row0 = u.pm * BM + wr * 64 + fr, col0 = u.pn * BM + wc * 32 + 4 * fq;
#pragma unroll
        for (int ai = 0; ai < 2; ++ai)
#pragma unroll
            for (int m2 = 0; m2 < 4; m2 += 2) { f32x4 sv[2][2][2];
#pragma unroll
              for (int mm = 0; mm < 2; ++mm) { const int t = row0 + ai * HALF + (m2 + mm) * 16; const size_t ro = (size_t)t * D + col0; const float* src = first ? (t < TP ? xp + ro : xs + (ro - (size_t)TP * D)) : out + ro;
#pragma unroll
                for (int bj = 0; bj < 2; ++bj)
#pragma unroll
                    for (int n = 0; n < 2; ++n) sv[mm][bj][n] = *(const f32x4*)(src + bj * HALF + n * 16); }
#pragma unroll
              for (int mm = 0; mm < 2; ++mm) { const int m = m2 + mm; const int t = row0 + ai * HALF + m * 16; const size_t ro = (size_t)t * D + col0; float ss = 0.f;
#pragma unroll
                for (int bj = 0; bj < 2; ++bj)
#pragma unroll
                    for (int n = 0; n < 2; ++n) { const int o = bj * HALF + n * 16; const f32x4 v = sv[mm][bj][n] + acc[ai][bj][m][n]; *(f32x4*)(out + ro + o) = v;
                        u32x2 w; w.x = pk2(v[0], v[1]); w.y = pk2(v[2], v[3]); *(u32x2*)(XB + ro + o) = w; ss += (v[0] * v[0] + v[1] * v[1]) + (v[2] * v[2] + v[3] * v[3]); }
                ss += shx<16>(ss); ss += shx<32>(ss);
                if (fq == 0) rsp[(size_t)t * 32 + u.pn * 4 + wc] = ss; } }
    }
};

struct EpiNull { static constexpr bool PERM = false, KEEP = false; __device__ __forceinline__ void operator()(const AccT&, const Unit&, int, int, int, int) const {} };
#define XB_TMO      128
#define XB_XCNT(j)  (256  + 64 * (j))
#define XB_XSUB(j)  (1280 + 64 * (j))
#define XB_XGEN(j)  (2304 + 64 * (j))
#define XB_TOP      3328
#define XB_TOPGEN   3392
#define XCD_BAR_WORDS 3456
#define XB_SPIN_CAP (1u << 24)
__device__ __forceinline__ unsigned xb_ld(unsigned* p)              { return __hip_atomic_load(p, __ATOMIC_RELAXED, __HIP_MEMORY_SCOPE_AGENT); }
__device__ __forceinline__ unsigned xb_add(unsigned* p, unsigned v) { return __hip_atomic_fetch_add(p, v, __ATOMIC_RELAXED, __HIP_MEMORY_SCOPE_AGENT); }
__device__ __forceinline__ unsigned xb_xcc_id() { return (unsigned)__builtin_amdgcn_s_getreg((3 << 11) | 20) & 0xFu; }
#define XB_SPIN(cond, bar) do { unsigned _sp = 0; while (cond) { __builtin_amdgcn_s_sleep(1); \
    if ((++_sp & 255u) == 0u) { if (xb_ld(&(bar)[XB_TMO])) break; if (_sp > XB_SPIN_CAP) { atomicAdd(&(bar)[XB_TMO], 1u); break; } } } } while (0)
struct XcdBarrier { unsigned* bar; unsigned x; volatile LAS unsigned* st; int wave; };
__device__ __forceinline__ XcdBarrier xcd_barrier_post(unsigned* bar, volatile LAS unsigned* st) {
    XcdBarrier b; b.bar = bar; b.x = xb_xcc_id(); b.st = st;
    if (threadIdx.x == 0) (void)xb_add(&bar[XB_XCNT(b.x)], 1u);
    return b;
}
__device__ __forceinline__ void xcd_barrier_complete(unsigned* bar, unsigned x, unsigned& nloc, unsigned& nx) {
    const unsigned G = gridDim.x * gridDim.y * gridDim.z;
    unsigned sum, cnt, mine, sp = 0u;
    for (;;) {
        sum = 0u; cnt = 0u; mine = 0u;
#pragma unroll 1
        for (unsigned j = 0; j < 16; ++j) { const unsigned c = xb_ld(&bar[XB_XCNT(j)]); sum += c; cnt += (c > 0u) ? 1u : 0u; mine = (j == x) ? c : mine; }
        if (sum == G) break;
        __builtin_amdgcn_s_sleep(1);
        if ((++sp & 255u) == 0u) { if (xb_ld(&bar[XB_TMO])) break; if (sp > XB_SPIN_CAP) { atomicAdd(&bar[XB_TMO], 1u); break; } }
    }
    nloc = mine > 0u ? mine : 1u; nx = cnt > 0u ? cnt : 1u;
}
__device__ __forceinline__ void xcd_barrier(const XcdBarrier& b) {
    asm volatile("s_waitcnt vmcnt(0)" ::: "memory");
    __syncthreads();
    if (b.wave == 0 && lane_id() == 0) {
        unsigned* bar = b.bar;
        __builtin_amdgcn_s_waitcnt(0);
        unsigned nloc = b.st[0], nx = b.st[1];
        if (nloc == 0u) { xcd_barrier_complete(bar, b.x, nloc, nx); b.st[0] = nloc; b.st[1] = nx; }
        const unsigned old = xb_add(&bar[XB_XSUB(b.x)], 1u);
        const unsigned gen = old / nloc;
        if (old + 1u == (gen + 1u) * nloc) {
            __builtin_amdgcn_fence(__ATOMIC_RELEASE, "agent");
            asm volatile("s_waitcnt vmcnt(0)" ::: "memory");
            const unsigned og = xb_add(&bar[XB_TOP], 1u);
            const unsigned tg = og / nx;
            if (og + 1u == (tg + 1u) * nx) xb_add(&bar[XB_TOPGEN], 1u);
            else XB_SPIN(xb_ld(&bar[XB_TOPGEN]) == tg, bar);
            __builtin_amdgcn_fence(__ATOMIC_ACQUIRE, "agent");
            xb_add(&bar[XB_XGEN(b.x)], 1u);
            asm volatile("s_waitcnt vmcnt(0)" ::: "memory");
        } else {
            XB_SPIN(xb_ld(&bar[XB_XGEN(b.x)]) == gen, bar);
            __builtin_amdgcn_fence(__ATOMIC_ACQUIRE, "agent");
            asm volatile("s_waitcnt vmcnt(0)" ::: "memory");
        }
    }
    __syncthreads();
}
constexpr int NWAVES = 8, NTHR = 512;
constexpr int LDS_BYTES = 147456;
constexpr int LDS_MISC = LDS_BYTES - 256;
struct Args { const float* in[35]; float* out; unsigned char* ws; int ph_lo, ph_hi; };
constexpr int LDS_ARGS = LDS_BYTES - 1024;
struct AP { const LAS unsigned long long* q; unsigned char* ws; float* out;
    __device__ __forceinline__ const float* in(int i) const { const unsigned long long v = q[i]; const unsigned lo = __builtin_amdgcn_readfirstlane((unsigned)v), hi = __builtin_amdgcn_readfirstlane((unsigned)(v >> 32)); return (const float*)(((unsigned long long)hi << 32) | lo); } };
struct Frame { LAS unsigned char* lds; int tid, lane, wave, gw, ngw, gt, ngt; };
enum { I_XP = 0, I_XS, I_NORMG, I_WIN, I_CONVW, I_CONVB, I_WR, I_BR, I_WI, I_BI, I_LAM, I_MU, I_W0, I_W2, I_A0, I_A2, I_KK, I_KA, I_RK, I_LNG, I_LNB, I_GNG,
       I_SLRE, I_SLIM, I_SLOG, I_SBRE, I_SBIM, I_SCRE, I_SCIM, I_SD, I_GLUW, I_GLUB, I_WBR, I_WOUT, I_FING };

__device__ __forceinline__ float sin_rev(float x) { return __builtin_amdgcn_sinf(x); }
__device__ __forceinline__ float cos_rev(float x) { return __builtin_amdgcn_cosf(x); }
__device__ __forceinline__ f32x2 cexp_pow(float lre, float lim, float st, int k) {
    const float mag = __expf((float)k * lre * st); double ph = (double)k * (double)lim * (double)st * 0.15915494309189535; ph -= rint(ph);
    const float f = (float)ph; return (f32x2){mag * cos_rev(f), mag * sin_rev(f)};
}

__device__ __forceinline__ void ph_tables(const AP& a, const Frame& F) {
    f32x2* TAB = (f32x2*)(a.ws + WS_S5TAB); f32x2* ROT = (f32x2*)(a.ws + WS_ROT);
    for (int i = F.gt; i < DEPTH * 2 * 64 * 64; i += F.ngt) {
        const float lre = fminf(a.in(I_SLRE)[i], -1e-4f), lim = a.in(I_SLIM)[i]; const float st = __expf(a.in(I_SLOG)[i >> 6]);
        const f32x2 p1 = cexp_pow(lre, lim, st, 1); const float nr = p1.x - 1.f, ni = p1.y, den = lre * lre + lim * lim;
        const float gr = (nr * lre + ni * lim) / den, gi = (ni * lre - nr * lim) / den;
        for (int k = 0; k <= 16; ++k) { const f32x2 p = cexp_pow(lre, lim, st, k); TAB[(size_t)i * 33 + 16 + k] = p; if (k < 16) TAB[(size_t)i * 33 + k] = (f32x2){p.x * gr - p.y * gi, p.x * gi + p.y * gr}; }
    }
    for (int i = F.gt; i < 16384 * 64; i += F.ngt) { const int pos = i >> 6, j = i & 63;
        const double inv = exp(-(double)j * (9.210340371976184 / 64.0)); double ph = (double)pos * inv * 0.15915494309189535; ph -= rint(ph); const float f = (float)ph;
        ROT[i] = (f32x2){cos_rev(f), sin_rev(f)}; }
}
struct TrItem { const float* W; int ldw; bf16* WT; int ldt, k0, n0, drow0, dcol0; const float* ksc; int gmap; };
__device__ __forceinline__ TrItem tr_decode(const AP& a, int it) {
    bf16* WALLT = (bf16*)(a.ws + WS_WALLT); bf16* GLUT = (bf16*)(a.ws + WS_GLUT); bf16* WBRT = (bf16*)(a.ws + WS_WBRT); bf16* WOUTT = (bf16*)(a.ws + WS_WOUTT);
    constexpr int I_IN = 32 * (NIN / 32), I_GL = 16 * 32, I_BRI = 16 * 64, I_OUT = 32 * 64, PER = I_IN + I_GL + 4 * I_BRI + I_OUT;
    const int l = it / PER; int r = it % PER; TrItem d;
    if (r < I_IN) { const int kb = r / (NIN / 32), nb = r % (NIN / 32), n0 = nb * 32; d = TrItem{a.in(I_WIN) + (size_t)l * D * NIN, NIN, WALLT + (size_t)l * NALL * D, D, kb * 64, n0, 0, 0, a.in(I_NORMG) + (size_t)l * D, n0 >= GOFF ? 1 : 0}; return d; } r -= I_IN;
    if (r < I_GL) { const int kb = r / 32, nb = r % 32; d = TrItem{a.in(I_GLUW) + (size_t)l * WB * WB, WB, GLUT + (size_t)l * WB * WB, WB, kb * 64, nb * 32, 0, 0, nullptr, 0}; return d; } r -= I_GL;
    if (r < 4 * I_BRI) { const int br = r / I_BRI, q = r % I_BRI, kb = q / 64, nb = q % 64; d = TrItem{a.in(I_WBR) + ((size_t)l * 4 + br) * WB * D, D, WBRT + (size_t)l * D * 4096, 4096, kb * 64, nb * 32, 0, br * WB, nullptr, 0}; return d; } r -= 4 * I_BRI;
    { const int kb = r / 64, nb = r % 64; d = TrItem{a.in(I_WOUT) + (size_t)l * D * D, D, WOUTT + (size_t)l * D * D, D, kb * 64, nb * 32, 0, 0, nullptr, 0}; return d; }
}
__device__ __forceinline__ void tr_load(const TrItem& d, float (&x)[32], int lane) {
#pragma unroll
    for (int i = 0; i < 32; ++i) { const int kk = 2 * i + (lane >> 5); x[i] = d.W[(size_t)(d.k0 + kk) * d.ldw + d.n0 + (lane & 31)] * (d.ksc ? d.ksc[d.k0 + kk] : 1.0f); }
}
__device__ __forceinline__ void tr_store(const TrItem& d, const float (&x)[32], LAS float* scr, int lane) {
#pragma unroll
    for (int i = 0; i < 32; ++i) { const int kk = 2 * i + (lane >> 5); scr[kk * 33 + (lane & 31)] = x[i]; }
    asm volatile("s_waitcnt lgkmcnt(0)" ::: "memory");
    const int c = lane & 7;
#pragma unroll
    for (int j = 0; j < 4; ++j) { const int n = (lane >> 3) + 8 * j; const LAS float* s = scr + (8 * c) * 33 + n;
        u32x4 o; o.x = pk2(s[0 * 33], s[1 * 33]); o.y = pk2(s[2 * 33], s[3 * 33]); o.z = pk2(s[4 * 33], s[5 * 33]); o.w = pk2(s[6 * 33], s[7 * 33]);
        int drow = d.drow0 + d.n0 + n;
        if (d.gmap) { const int g0 = d.n0 + n - GOFF, z = g0 >> 11, nn = g0 & 2047, gp = nn >> 6, nl = nn & 63;
            drow = NPJ + gp * 256 + 128 * (z >> 1) + 16 * (z & 1) + 32 * (nl >> 4) + (nl & 15); }
        *(u32x4*)(d.WT + (size_t)drow * d.ldt + d.dcol0 + d.k0 + 8 * c) = o; }
    asm volatile("s_waitcnt lgkmcnt(0)" ::: "memory");
}
__device__ __forceinline__ void ph_convert(const AP& a, const Frame& F) {
    LAS float* scr = (LAS float*)(F.lds + F.wave * 16384);
    bf16* WALLT = (bf16*)(a.ws + WS_WALLT);
    constexpr int PERI = 32 * (NIN / 32) + 16 * 32 + 4 * 16 * 64 + 32 * 64; const int NIT = DEPTH * PERI;
    { float xa[32], xb[32]; int it = F.gw;
      if (it < NIT) { TrItem da = tr_decode(a, it); tr_load(da, xa, F.lane);
          for (;;) { const int itb = it + F.ngw; TrItem db; const bool hb = itb < NIT; if (hb) { db = tr_decode(a, itb); tr_load(db, xb, F.lane); }
              tr_store(da, xa, scr, F.lane); if (!hb) break;
              const int ita = itb + F.ngw; const bool ha = ita < NIT; if (ha) { da = tr_decode(a, ita); tr_load(da, xa, F.lane); }
              tr_store(db, xb, scr, F.lane); if (!ha) break; it = ita; } } }
    for (int i = F.gt; i < DEPTH * 64 * (D / 8); i += F.ngt) { const int l = i / (64 * (D / 8)), r = (i / (D / 8)) % 64, c8 = i % (D / 8); *(u32x4*)(WALLT + ((size_t)l * NALL + GOFF + r) * D + c8 * 8) = (u32x4){0u, 0u, 0u, 0u}; }
    bf16* LRUW = (bf16*)(a.ws + WS_LRUW);
    for (int i = F.gt; i < DEPTH * 4096 * 32; i += F.ngt) { const int k8 = i & 31, n = (i >> 5) & 4095, l = i >> 17; const int pn = n >> 8, d = pn >> 3, h = pn & 7, gate = (n >> 7) & 1, j = n & 127;
        u32x4 o = (u32x4){0u, 0u, 0u, 0u};
        if ((k8 >> 4) == (h & 1)) { const float* w = (gate ? a.in(I_WI) : a.in(I_WR)) + ((((size_t)l * 2 + d) * 8 + h) * 128) * 128 + j; const int i0 = (k8 & 15) * 8; float x[8];
#pragma unroll
            for (int q = 0; q < 8; ++q) x[q] = w[(size_t)(i0 + q) * 128]; o = pack8(x); }
        *(u32x4*)(LRUW + ((size_t)l * 4096 + n) * 256 + k8 * 8) = o; }
    bf16* W2ALL = (bf16*)(a.ws + WS_W2ALL);
    for (int i = F.gt; i < DEPTH * 3072 * 32; i += F.ngt) { const int k8 = i & 31, n = (i >> 5) % 3072, l = (i >> 5) / 3072; const int blk = n >> 10, c = n & 1023; u32x4 o = (u32x4){0u, 0u, 0u, 0u};
        if ((k8 >> 3) == blk) { const int j0 = (k8 & 7) * 8; const float* w = blk < 2 ? a.in(I_W2) + (((size_t)l * 2 + blk) * 64 + j0) * WB + c : a.in(I_A2) + ((size_t)l * 64 + j0) * WB + c; float x[8];
#pragma unroll
            for (int q = 0; q < 8; ++q) x[q] = w[(size_t)q * WB]; o = pack8(x); }
        *(u32x4*)(W2ALL + ((size_t)l * 3072 + n) * 256 + k8 * 8) = o; }
    float* KTAB = (float*)(a.ws + WS_PROJ); const f32x2* TAB = (const f32x2*)(a.ws + WS_S5TAB);
    for (int i = F.gt; i < DEPTH * 64 * 2 * 16 * 16; i += F.ngt) { const int p = i & 15, dl = (i >> 4) & 15, dir = (i >> 8) & 1, g = (i >> 9) & 63, l = i >> 15;
        const float* cre = a.in(I_SCRE) + (((size_t)l * 64 + g) * 16 + p) * 64; const float* cim = a.in(I_SCIM) + (((size_t)l * 64 + g) * 16 + p) * 64;
        const float* bre = a.in(I_SBRE) + ((size_t)l * 64 + g) * 64 * 16; const float* bim = a.in(I_SBIM) + ((size_t)l * 64 + g) * 64 * 16;
        const f32x2* tb = TAB + ((((size_t)l * 2 + dir) * 64 + g) * 64) * 33 + dl; f32x4 s[4] = {(f32x4){0.f, 0.f, 0.f, 0.f}, (f32x4){0.f, 0.f, 0.f, 0.f}, (f32x4){0.f, 0.f, 0.f, 0.f}, (f32x4){0.f, 0.f, 0.f, 0.f}};
        for (int n = 0; n < 64; ++n) { const f32x2 gk = tb[(size_t)n * 33]; const float cr = cre[n], ci = cim[n]; const float zr = cr * gk.x - ci * gk.y, zi = cr * gk.y + ci * gk.x;
#pragma unroll
            for (int q4 = 0; q4 < 4; ++q4) { const f32x4 br = *(const f32x4*)(bre + n * 16 + q4 * 4), bi = *(const f32x4*)(bim + n * 16 + q4 * 4); s[q4] += br * zr - bi * zi; } }
        float* o = KTAB + ((((size_t)(l * 64 + g) * 2 + dir) * 16 + dl) * 16 + p) * 16;
#pragma unroll
        for (int q4 = 0; q4 < 4; ++q4) *(f32x4*)(o + q4 * 4) = s[q4]; }
}
__device__ __forceinline__ void ph_s5mats(const AP& a, const Frame& F) {
    const float* KTAB = (const float*)(a.ws + WS_PROJ); const f32x2* TAB = (const f32x2*)(a.ws + WS_S5TAB);
    bf16* MAIN = (bf16*)(a.ws + WS_S5MAIN); bf16* INCM = (bf16*)(a.ws + WS_S5INC);
    for (int i = F.gt; i < DEPTH * 64 * 256 * 64; i += F.ngt) { const int c8 = i & 63, row = (i >> 6) & 255, g = (i >> 14) & 63, l = i >> 20; const int tau = row >> 4, p = row & 15; float x[8];
        if (c8 < 32) { const int sg = c8 >> 1, q0 = (c8 & 1) * 8; const float* kb = KTAB + ((size_t)l * 64 + g) * 2 * 16 * 256;
            if (sg < tau) { const float* k = kb + ((0 * 16 + (tau - sg)) * 16 + p) * 16 + q0;
#pragma unroll
                for (int q = 0; q < 8; ++q) x[q] = k[q]; }
            else if (sg > tau) { const float* k = kb + ((1 * 16 + (sg - tau)) * 16 + p) * 16 + q0;
#pragma unroll
                for (int q = 0; q < 8; ++q) x[q] = k[q]; }
            else { const float* k0 = kb + ((0 * 16 + 0) * 16 + p) * 16 + q0; const float* k1 = kb + ((1 * 16 + 0) * 16 + p) * 16 + q0; const float dsk = a.in(I_SD)[(size_t)l * WB + g * 16 + p];
#pragma unroll
                for (int q = 0; q < 8; ++q) x[q] = k0[q] + k1[q] + ((q0 + q) == p ? dsk : 0.f); }
        } else { const int part = (c8 - 32) >> 3, n0 = ((c8 - 32) & 7) * 8, dir = part >> 1; const int k = dir == 0 ? (tau + 1) : (16 - tau);
            const float* cre = a.in(I_SCRE) + (((size_t)l * 64 + g) * 16 + p) * 64 + n0; const float* cim = a.in(I_SCIM) + (((size_t)l * 64 + g) * 16 + p) * 64 + n0;
            const f32x2* tb = TAB + ((((size_t)l * 2 + dir) * 64 + g) * 64 + n0) * 33 + 16 + k;
#pragma unroll
            for (int q = 0; q < 8; ++q) { const f32x2 pw = tb[(size_t)q * 33]; const float zr = cre[q] * pw.x - cim[q] * pw.y, zi = cre[q] * pw.y + cim[q] * pw.x; x[q] = (part & 1) ? -zi : zr; } }
        *(u32x4*)(MAIN + ((((size_t)l * 64 + g) * 256 + row) * 512) + c8 * 8) = pack8(x); }
    for (int i = F.gt; i < DEPTH * 64 * 256 * 32; i += F.ngt) { const int c8 = i & 31, row = (i >> 5) & 255, g = (i >> 13) & 63, l = i >> 19; const int part = row >> 6, n = row & 63, dir = part >> 1, sg = c8 >> 1, q0 = (c8 & 1) * 8;
        const int k = dir == 0 ? (15 - sg) : sg; const f32x2 gk = TAB[((((size_t)l * 2 + dir) * 64 + g) * 64 + n) * 33 + k];
        const float* bre = a.in(I_SBRE) + (((size_t)l * 64 + g) * 64 + n) * 16 + q0; const float* bim = a.in(I_SBIM) + (((size_t)l * 64 + g) * 64 + n) * 16 + q0; float x[8];
#pragma unroll
        for (int q = 0; q < 8; ++q) { const float zr = gk.x * bre[q] - gk.y * bim[q], zi = gk.x * bim[q] + gk.y * bre[q]; x[q] = (part & 1) ? zi : zr; }
        *(u32x4*)(INCM + ((((size_t)l * 64 + g) * 256 + row) * 256) + c8 * 8) = pack8(x); }
}

__device__ __forceinline__ void ph_x0(const AP& a, const Frame& F) {
    bf16* H = (bf16*)(a.ws + WS_H); float* RSS = (float*)(a.ws + WS_RSS);
    for (int t = F.gw; t < T; t += F.ngw) { const float* xr = t < TP ? a.in(I_XP) + (size_t)t * D : a.in(I_XS) + (size_t)(t - TP) * D; float s = 0.f;
#pragma unroll
        for (int j = 0; j < 8; ++j) { const f32x4 v = *(const f32x4*)(xr + (F.lane + 64 * j) * 4); s += (v[0] * v[0] + v[1] * v[1]) + (v[2] * v[2] + v[3] * v[3]); u32x2 w; w.x = pk2(v[0], v[1]); w.y = pk2(v[2], v[3]); *(u32x2*)(H + (size_t)t * D + (F.lane + 64 * j) * 4) = w; }
        s = wave_sum(s); if (F.lane == 0) RSS[t] = s; }
}
__device__ __forceinline__ void ph_rss(const AP& a, const Frame& F, int l) {
    const float* P = (const float*)(a.ws + WS_RSP); float* R = (float*)(a.ws + WS_RSS) + (size_t)((l + 1) & 1) * T;
    for (int t = F.gt; t < T; t += F.ngt) { float s = 0.f;
#pragma unroll
        for (int j = 0; j < 8; ++j) { const f32x4 v = *(const f32x4*)(P + (size_t)t * 32 + j * 4); s += (v[0] + v[1]) + (v[2] + v[3]); }
        R[t] = s; }
}
__device__ __forceinline__ void ph_final(const AP& a, const Frame& F) {
    const float* RSS = (const float*)(a.ws + WS_RSS) + (size_t)(DEPTH & 1) * T; const float* g = a.in(I_FING);
#pragma unroll 4
    for (int i = F.gt; i < T * (D / 4); i += F.ngt) { const int t = i / (D / 4), c4 = (i % (D / 4)) * 4; const float rs = __builtin_amdgcn_rsqf(RSS[t] * (1.0f / D) + 1e-6f);
        float* p = a.out + (size_t)t * D + c4; *(f32x4*)p = *(const f32x4*)p * rs * *(const f32x4*)(g + c4); }
}
__device__ __forceinline__ void ph_lru_conv(const AP& a, const Frame& F, int l) {
    const bf16* PROJ = (const bf16*)(a.ws + WS_PROJ); bf16* XC = (bf16*)(a.ws + WS_SCR + SA_XC);
    const float* cw = a.in(I_CONVW) + (size_t)l * 4 * WB; const float* cb = a.in(I_CONVB) + (size_t)l * WB;
    if ((F.ngt & 127) == 0) {
        const int c8 = (F.gt & 127) * 8; float wv[4][8], bv[8];
#pragma unroll
        for (int q = 0; q < 8; ++q) { bv[q] = cb[c8 + q];
#pragma unroll
            for (int j = 0; j < 4; ++j) wv[j][q] = cw[j * WB + c8 + q]; }
#pragma unroll 2
        for (int i = F.gt; i < T * 128; i += F.ngt) { const int t = i >> 7; int pos, L; seq_of(t, pos, L); u32x4 xr[4];
#pragma unroll
            for (int j = 0; j < 4; ++j) { const int pp = pos + j - 2; xr[j] = (pp >= 0 && pp < L) ? *(const u32x4*)(PROJ + (size_t)(t + j - 2) * NPJ + C_LRUX + c8) : (u32x4){0u, 0u, 0u, 0u}; }
            float acc[8];
#pragma unroll
            for (int q = 0; q < 8; ++q) acc[q] = bv[q];
#pragma unroll
            for (int j = 0; j < 4; ++j) { float x[8]; unpack8(xr[j], x);
#pragma unroll
                for (int q = 0; q < 8; ++q) acc[q] += wv[j][q] * x[q]; }
            *(u32x4*)(XC + (size_t)t * WB + c8) = pack8(acc); }
        return; }
    for (int i = F.gt; i < T * 128; i += F.ngt) { const int t = i >> 7, c8 = (i & 127) * 8; int pos, L; seq_of(t, pos, L); float acc[8];
#pragma unroll
        for (int q = 0; q < 8; ++q) acc[q] = cb[c8 + q];
#pragma unroll
        for (int j = 0; j < 4; ++j) { const int pp = pos + j - 2; if (pp >= 0 && pp < L) { float x[8]; unpack8(*(const u32x4*)(PROJ + (size_t)(t + j - 2) * NPJ + C_LRUX + c8), x);
#pragma unroll
                for (int q = 0; q < 8; ++q) acc[q] += cw[j * WB + c8 + q] * x[q]; } }
        *(u32x4*)(XC + (size_t)t * WB + c8) = pack8(acc); }
}
#define LOF(x) __uint_as_float((x) << 16)
#define HIF(x) __uint_as_float((x) & 0xffff0000u)
__device__ __forceinline__ void ph_lru_scan1(const AP& a, const Frame& F) {
    const bf16* LA = (const bf16*)(a.ws + WS_SCR + SA_LA); const bf16* BB = (const bf16*)(a.ws + WS_SCR + SA_BB); float* PA = (float*)(a.ws + WS_SCR + SA_PA); float* PB = (float*)(a.ws + WS_SCR + SA_PB);
    for (int i = F.gt; i < NCH_L32 * 2 * 512; i += F.ngt) { const int ch = (i & 511) * 2, d = (i >> 9) & 1, c = i >> 10; float s0 = 0.f, s1 = 0.f, h0 = 0.f, h1 = 0.f;
        unsigned la[32], bb[32];
#pragma unroll
        for (int s = 0; s < 32; ++s) { const int t = c * 32 + (d == 0 ? s : 31 - s); const size_t o = ((size_t)d * T + t) * WB + ch; la[s] = *(const unsigned*)(LA + o); bb[s] = *(const unsigned*)(BB + o); }
#pragma unroll
        for (int s = 0; s < 32; ++s) { const float l0 = LOF(la[s]), l1 = HIF(la[s]); h0 = __expf(l0) * h0 + LOF(bb[s]); h1 = __expf(l1) * h1 + HIF(bb[s]); s0 += l0; s1 += l1; }
        const size_t o = ((size_t)c * 2 + d) * WB + ch; *(f32x2*)(PA + o) = (f32x2){__expf(s0), __expf(s1)}; *(f32x2*)(PB + o) = (f32x2){h0, h1}; }
}
__device__ __forceinline__ void ph_lru_scan2(const AP& a, const Frame& F) {
    const float* PA = (const float*)(a.ws + WS_SCR + SA_PA); const float* PB = (const float*)(a.ws + WS_SCR + SA_PB); float* CAR = (float*)(a.ws + WS_SCR + SA_CAR);
    LAS float* ex = (LAS float*)F.lds;
    for (int it = blockIdx.x; it < 5 * 2 * 16; it += gridDim.x) { const int slab = it & 15, d = (it >> 4) & 1, sq = it >> 5; const int c0 = sq == 0 ? 0 : 512 + (sq - 1) * 64, nc = sq == 0 ? 512 : 64, ns = nc / 8;
        const int ch = slab * 64 + F.lane, seg = F.wave; float p = 1.f, h = 0.f;
        for (int s0 = 0; s0 < ns; s0 += 8) { float pa[8], pb[8];
#pragma unroll
            for (int u = 0; u < 8; ++u) { const int sp = seg * ns + s0 + u, c = c0 + (d == 0 ? sp : nc - 1 - sp); const size_t o = ((size_t)c * 2 + d) * WB + ch; pa[u] = PA[o]; pb[u] = PB[o]; }
#pragma unroll
            for (int u = 0; u < 8; ++u) { h = pa[u] * h + pb[u]; p *= pa[u]; } }
        __syncthreads(); ex[(seg * 64 + F.lane) * 2] = p; ex[(seg * 64 + F.lane) * 2 + 1] = h; __syncthreads();
        float x = 0.f;
        for (int s2 = 0; s2 < seg; ++s2) x = ex[(s2 * 64 + F.lane) * 2] * x + ex[(s2 * 64 + F.lane) * 2 + 1];
        for (int s0 = 0; s0 < ns; s0 += 8) { float pa[8], pb[8];
#pragma unroll
            for (int u = 0; u < 8; ++u) { const int sp = seg * ns + s0 + u, c = c0 + (d == 0 ? sp : nc - 1 - sp); const size_t o = ((size_t)c * 2 + d) * WB + ch; pa[u] = PA[o]; pb[u] = PB[o]; }
#pragma unroll
            for (int u = 0; u < 8; ++u) { const int sp = seg * ns + s0 + u, c = c0 + (d == 0 ? sp : nc - 1 - sp); CAR[((size_t)c * 2 + d) * WB + ch] = x; x = pa[u] * x + pb[u]; } }
    }
}
__device__ __forceinline__ void ph_lru_scan3(const AP& a, const Frame& F) {
    const bf16* LA = (const bf16*)(a.ws + WS_SCR + SA_LA); const bf16* BB = (const bf16*)(a.ws + WS_SCR + SA_BB); const float* CAR = (const float*)(a.ws + WS_SCR + SA_CAR);
    const bf16* PROJ = (const bf16*)(a.ws + WS_PROJ); bf16* Y = (bf16*)(a.ws + WS_Y);
    for (int i = F.gt; i < NCH_L32 * 512; i += F.ngt) { const int ch = (i & 511) * 2, c = i >> 9;
        unsigned la[32], bb[32], hf[32];
#pragma unroll
        for (int s = 0; s < 32; ++s) { const size_t o = (size_t)(c * 32 + s) * WB + ch; la[s] = *(const unsigned*)(LA + o); bb[s] = *(const unsigned*)(BB + o); }
        f32x2 h = *(const f32x2*)(CAR + ((size_t)c * 2 + 0) * WB + ch);
#pragma unroll
        for (int s = 0; s < 32; ++s) { h[0] = __expf(LOF(la[s])) * h[0] + LOF(bb[s]); h[1] = __expf(HIF(la[s])) * h[1] + HIF(bb[s]); hf[s] = pk2(h[0], h[1]); }
        asm volatile("" ::: "memory");
#pragma unroll
        for (int s = 0; s < 32; ++s) { const size_t o = ((size_t)T + c * 32 + s) * WB + ch; la[s] = *(const unsigned*)(LA + o); bb[s] = *(const unsigned*)(BB + o); }
        h = *(const f32x2*)(CAR + ((size_t)c * 2 + 1) * WB + ch);
#pragma unroll
        for (int s0 = 16; s0 >= 0; s0 -= 16) { unsigned zq[16];
#pragma unroll
            for (int u = 0; u < 16; ++u) zq[u] = *(const unsigned*)(PROJ + (size_t)(c * 32 + s0 + u) * NPJ + C_LRUZ + ch);
#pragma unroll
            for (int u = 15; u >= 0; --u) { const int s = s0 + u; h[0] = __expf(LOF(la[s])) * h[0] + LOF(bb[s]); h[1] = __expf(HIF(la[s])) * h[1] + HIF(bb[s]); const unsigned zz = zq[u];
                *(unsigned*)(Y + (size_t)(c * 32 + s) * 4096 + ch) = pk2((LOF(hf[s]) + h[0]) * siluf_(LOF(zz)), (HIF(hf[s]) + h[1]) * siluf_(HIF(zz))); } } }
}
#undef LOF
#undef HIF

__device__ __forceinline__ void ph_s5_rearr(const AP& a, const Frame& F) {
    const bf16* PROJ = (const bf16*)(a.ws + WS_PROJ); bf16* UC = (bf16*)(a.ws + WS_SCR + SD_UC);
#pragma unroll 4
    for (int i = F.gt; i < T * 64; i += F.ngt) { const int g = i & 63, t = i >> 6, c = t >> 4, tau = t & 15; const u32x4* s = (const u32x4*)(PROJ + (size_t)t * NPJ + C_SU + g * 16);
        u32x4* d = (u32x4*)(UC + ((size_t)g * NCH_S5 + c) * 512 + tau * 16); d[0] = s[0]; d[1] = s[1]; }
}
__device__ __forceinline__ void ph_s5_scan(const AP& a, const Frame& F, int l) {
    const float* INC = (const float*)(a.ws + WS_SCR + SD_INC); bf16* UC = (bf16*)(a.ws + WS_SCR + SD_UC); const f32x2* TAB = (const f32x2*)(a.ws + WS_S5TAB);
    LAS float* ex = (LAS float*)F.lds;
    for (int it = blockIdx.x; it < 5 * 64 * 2; it += gridDim.x) { const int d = it & 1, g = (it >> 1) & 63, sq = it >> 7; const int c0 = sq == 0 ? 0 : 1024 + (sq - 1) * 128, nc = sq == 0 ? 1024 : 128, ns = nc / 8;
        const int n = F.lane, seg = F.wave; const f32x2 lc = TAB[((((size_t)l * 2 + d) * 64 + g) * 64 + n) * 33 + 32];
        float xr = 0.f, xi = 0.f, pr = 1.f, pi = 0.f;
        for (int s0 = 0; s0 < ns; s0 += 8) { float ir[8], ii[8];
#pragma unroll
            for (int u = 0; u < 8; ++u) { const int sp = seg * ns + s0 + u, c = c0 + (d == 0 ? sp : nc - 1 - sp); const size_t ro = (size_t)g * NCH_S5 + c; ir[u] = INC[ro * 256 + d * 128 + n]; ii[u] = INC[ro * 256 + d * 128 + 64 + n]; }
#pragma unroll
            for (int u = 0; u < 8; ++u) { const float nr = lc.x * xr - lc.y * xi + ir[u], ni = lc.x * xi + lc.y * xr + ii[u]; xr = nr; xi = ni; const float qr = lc.x * pr - lc.y * pi, qi = lc.x * pi + lc.y * pr; pr = qr; pi = qi; } }
        __syncthreads(); ex[(seg * 64 + n) * 2] = xr; ex[(seg * 64 + n) * 2 + 1] = xi; __syncthreads();
        xr = 0.f; xi = 0.f;
        for (int s2 = 0; s2 < seg; ++s2) { const float er = ex[(s2 * 64 + n) * 2], ei = ex[(s2 * 64 + n) * 2 + 1]; const float nr = pr * xr - pi * xi + er, ni = pr * xi + pi * xr + ei; xr = nr; xi = ni; }
        for (int s0 = 0; s0 < ns; s0 += 8) { float ir[8], ii[8];
#pragma unroll
            for (int u = 0; u < 8; ++u) { const int sp = seg * ns + s0 + u, c = c0 + (d == 0 ? sp : nc - 1 - sp); const size_t ro = (size_t)g * NCH_S5 + c; ir[u] = INC[ro * 256 + d * 128 + n]; ii[u] = INC[ro * 256 + d * 128 + 64 + n]; }
#pragma unroll
            for (int u = 0; u < 8; ++u) { const int sp = seg * ns + s0 + u, c = c0 + (d == 0 ? sp : nc - 1 - sp); const size_t ro = (size_t)g * NCH_S5 + c;
                UC[ro * 512 + 256 + d * 128 + n] = (bf16)f2bf(xr); UC[ro * 512 + 256 + d * 128 + 64 + n] = (bf16)f2bf(xi);
                const float nr = lc.x * xr - lc.y * xi + ir[u], ni = lc.x * xi + lc.y * xr + ii[u]; xr = nr; xi = ni; } }
    }
}
template <int NT> __device__ __forceinline__ void mma_lds(f32x4 (&acc)[NT], const LAS bf16* As, int pa, const LAS bf16* Bs, int pb, int K, int lane) {
    const int r = lane & 15, q = lane >> 4;
    for (int kk = 0; kk < K; kk += 32) { const bf16x8 av = *(const LAS bf16x8*)(As + r * pa + kk + q * 8);
#pragma unroll
        for (int nt = 0; nt < NT; ++nt) { const bf16x8 bv = *(const LAS bf16x8*)(Bs + (nt * 16 + r) * pb + kk + q * 8); acc[nt] = __builtin_amdgcn_mfma_f32_16x16x32_bf16(av, bv, acc[nt], 0, 0, 0); } }
}
template <int NT> __device__ __forceinline__ void mma_glb(f32x4 (&acc)[NT], const LAS bf16* As, int pa, const bf16* Bg, int pb, int K, int lane) {
    const int r = lane & 15, q = lane >> 4;
    for (int kk = 0; kk < K; kk += 32) { const bf16x8 av = *(const LAS bf16x8*)(As + r * pa + kk + q * 8);
#pragma unroll
        for (int n0 = 0; n0 < NT; n0 += 8) { bf16x8 bv[8];
#pragma unroll
            for (int u = 0; u < 8; ++u) bv[u] = *(const bf16x8*)(Bg + (size_t)((n0 + u) * 16 + r) * pb + kk + q * 8);
#pragma unroll
            for (int u = 0; u < 8; ++u) acc[n0 + u] = __builtin_amdgcn_mfma_f32_16x16x32_bf16(av, bv[u], acc[n0 + u], 0, 0, 0); } }
}
#define LBAR() do { asm volatile("s_waitcnt lgkmcnt(0)" ::: "memory"); __builtin_amdgcn_s_barrier(); asm volatile("" ::: "memory"); } while (0)
constexpr int RP = 136;
__device__ __forceinline__ float ret_log2g(int h) { return log2f(1.0f - exp2f(-5.0f - (float)h)); }

__device__ __forceinline__ void ph_ret_kv(const AP& a, const Frame& F) {
    const bf16* PROJ = (const bf16*)(a.ws + WS_PROJ); const f32x2* ROT = (const f32x2*)(a.ws + WS_ROT); bf16* KVT = (bf16*)(a.ws + WS_SCR + SC_KVT);
    LAS bf16* VT = (LAS bf16*)F.lds; LAS bf16* KTf = VT + 128 * RP; LAS bf16* KTb = KTf + 128 * RP;
    for (int it = blockIdx.x; it < NCH_RET * 4 * 2; it += gridDim.x) { const int eh = it & 1, h = (it >> 1) & 3, cn = it >> 3; const float l2g = ret_log2g(h);
        LBAR();
        { const int pp = F.lane, ta = cn * 128 + 2 * pp;
#pragma unroll
          for (int oc = 0; oc < 2; ++oc) { const int e8 = (F.wave * 2 + oc) * 8;
              const u32x4 va = *(const u32x4*)(PROJ + (size_t)ta * NPJ + C_RV + h * 256 + eh * 128 + e8), vb = *(const u32x4*)(PROJ + (size_t)(ta + 1) * NPJ + C_RV + h * 256 + eh * 128 + e8);
              const unsigned wa[4] = {va.x, va.y, va.z, va.w}, wb[4] = {vb.x, vb.y, vb.z, vb.w};
#pragma unroll
              for (int i = 0; i < 4; ++i) { *(LAS unsigned*)(VT + (e8 + 2 * i) * RP + 2 * pp) = (wa[i] & 0xffffu) | (wb[i] << 16); *(LAS unsigned*)(VT + (e8 + 2 * i + 1) * RP + 2 * pp) = (wa[i] >> 16) | (wb[i] & 0xffff0000u); } }
          { const int i8 = F.wave * 8; int posa, L; seq_of(ta, posa, L);
            float x1a[8], x2a[8], x1b[8], x2b[8];
            unpack8(*(const u32x4*)(PROJ + (size_t)ta * NPJ + C_RK + h * 128 + i8), x1a); unpack8(*(const u32x4*)(PROJ + (size_t)ta * NPJ + C_RK + h * 128 + 64 + i8), x2a);
            unpack8(*(const u32x4*)(PROJ + (size_t)(ta + 1) * NPJ + C_RK + h * 128 + i8), x1b); unpack8(*(const u32x4*)(PROJ + (size_t)(ta + 1) * NPJ + C_RK + h * 128 + 64 + i8), x2b);
            const f32x4* ra = (const f32x4*)(ROT + (size_t)posa * 64 + i8); const f32x4* rb = (const f32x4*)(ROT + (size_t)(posa + 1) * 64 + i8);
            const float sc = 0.08838834764831845f; const float dfa = __builtin_amdgcn_exp2f(l2g * (float)(127 - 2 * pp)) * sc, dba = __builtin_amdgcn_exp2f(l2g * (float)(2 * pp)) * sc, dfb = __builtin_amdgcn_exp2f(l2g * (float)(126 - 2 * pp)) * sc, dbb = __builtin_amdgcn_exp2f(l2g * (float)(2 * pp + 1)) * sc;
#pragma unroll
            for (int i2 = 0; i2 < 4; ++i2) { const f32x4 ca = ra[i2], cb2 = rb[i2];
#pragma unroll
                for (int u = 0; u < 2; ++u) { const int i = 2 * i2 + u; const float c_a = ca[2 * u], s_a = ca[2 * u + 1], c_b = cb2[2 * u], s_b = cb2[2 * u + 1];
                    const float o1a = x1a[i] * c_a - x2a[i] * s_a, o2a = x1a[i] * s_a + x2a[i] * c_a, o1b = x1b[i] * c_b - x2b[i] * s_b, o2b = x1b[i] * s_b + x2b[i] * c_b;
                    *(LAS unsigned*)(KTf + (i8 + i) * RP + 2 * pp) = pk2(o1a * dfa, o1b * dfb); *(LAS unsigned*)(KTf + (64 + i8 + i) * RP + 2 * pp) = pk2(o2a * dfa, o2b * dfb);
                    *(LAS unsigned*)(KTb + (i8 + i) * RP + 2 * pp) = pk2(o1a * dba, o1b * dbb); *(LAS unsigned*)(KTb + (64 + i8 + i) * RP + 2 * pp) = pk2(o2a * dba, o2b * dbb); } } } }
        LBAR();
        f32x4 af[8], ab[8];
#pragma unroll
        for (int n = 0; n < 8; ++n) { af[n] = (f32x4){0.f, 0.f, 0.f, 0.f}; ab[n] = (f32x4){0.f, 0.f, 0.f, 0.f}; }
        mma_lds<8>(af, KTf + F.wave * 16 * RP, RP, VT, RP, 128, F.lane); mma_lds<8>(ab, KTb + F.wave * 16 * RP, RP, VT, RP, 128, F.lane);
        const int r = F.lane & 15, q4 = F.lane >> 4; const size_t item = (size_t)cn * 4 + h;
#pragma unroll
        for (int n = 0; n < 8; ++n) { const int e = eh * 128 + n * 16 + r, d0 = F.wave * 16 + q4 * 4; *(u32x2*)(KVT + ((0 * 768 + item) * 256 + e) * 128 + d0) = (u32x2){pk2(af[n][0], af[n][1]), pk2(af[n][2], af[n][3])}; *(u32x2*)(KVT + ((768 + item) * 256 + e) * 128 + d0) = (u32x2){pk2(ab[n][0], ab[n][1]), pk2(ab[n][2], ab[n][3])}; }
    }
}
__device__ __forceinline__ void ph_ret_scan(const AP& a, const Frame& F) {
    const unsigned* KVT = (const unsigned*)(a.ws + WS_SCR + SC_KVT); unsigned* STP = (unsigned*)(a.ws + WS_STP);
    for (int i = F.gt; i < 5 * 2 * 4 * 16384; i += F.ngt) { const int ed = i & 16383, h = (i >> 14) & 3, dir = (i >> 16) & 1, sq = i >> 17; const int c0 = sq == 0 ? 0 : 128 + (sq - 1) * 16, nc = sq == 0 ? 128 : 16;
        const float g128 = __builtin_amdgcn_exp2f(ret_log2g(h) * 128.0f); float s0_ = 0.f, s1_ = 0.f;
        for (int s0 = 0; s0 < nc; s0 += 16) { unsigned kv[16];
#pragma unroll
            for (int u = 0; u < 16; ++u) { const int cn = c0 + (dir == 0 ? s0 + u : nc - 1 - s0 - u); kv[u] = KVT[(((size_t)dir * 768 + cn * 4 + h) * 16384) + ed]; }
#pragma unroll
            for (int u = 0; u < 16; ++u) { const int cn = c0 + (dir == 0 ? s0 + u : nc - 1 - s0 - u); STP[(((size_t)dir * 768 + cn * 4 + h) * 16384) + ed] = pk2(s0_, s1_);
                s0_ = g128 * s0_ + __uint_as_float(kv[u] << 16); s1_ = g128 * s1_ + __uint_as_float(kv[u] & 0xffff0000u); } } }
}
__device__ __forceinline__ void ph_ret_out(const AP& a, const Frame& F, int l) {
    const bf16* PROJ = (const bf16*)(a.ws + WS_PROJ); const f32x2* ROT = (const f32x2*)(a.ws + WS_ROT); const bf16* STP = (const bf16*)(a.ws + WS_STP); bf16* Y = (bf16*)(a.ws + WS_Y);
    const float* gn = a.in(I_GNG) + (size_t)l * WB;
    LAS bf16* Qs = (LAS bf16*)F.lds; LAS bf16* Ks = Qs + 128 * RP; LAS bf16* VT = Ks + 128 * RP;
    unsigned* cnt = (unsigned*)(a.ws + WS_CTL) + 16384 + 64 * l; volatile LAS unsigned* tick = (volatile LAS unsigned*)(F.lds + LDS_MISC) + 16;
    for (;;) { LBAR(); if (F.tid == 0) tick[0] = __hip_atomic_fetch_add(cnt, 1u, __ATOMIC_RELAXED, __HIP_MEMORY_SCOPE_AGENT); LBAR();
        const int it = __builtin_amdgcn_readfirstlane((int)tick[0]); if (it >= NCH_RET * 4) break; const int h = it & 3, cn = it >> 2; const float l2g = ret_log2g(h);
        int ln_ = F.lane, td_ = F.tid; asm volatile("" : "+v"(ln_), "+v"(td_));
        LBAR();
        { const int pp = ln_, ta = cn * 128 + 2 * pp;
#pragma unroll
          for (int oc = 0; oc < 4; ++oc) { const int e8 = (F.wave * 4 + oc) * 8;
              const u32x4 va = *(const u32x4*)(PROJ + (size_t)ta * NPJ + C_RV + h * 256 + e8), vb = *(const u32x4*)(PROJ + (size_t)(ta + 1) * NPJ + C_RV + h * 256 + e8);
              const unsigned wa[4] = {va.x, va.y, va.z, va.w}, wb[4] = {vb.x, vb.y, vb.z, vb.w};
#pragma unroll
              for (int i = 0; i < 4; ++i) { *(LAS unsigned*)(VT + (e8 + 2 * i) * RP + 2 * pp) = (wa[i] & 0xffffu) | (wb[i] << 16); *(LAS unsigned*)(VT + (e8 + 2 * i + 1) * RP + 2 * pp) = (wa[i] >> 16) | (wb[i] & 0xffff0000u); } } }
#pragma unroll
        for (int rep2 = 0; rep2 < 2; ++rep2) { const int qq = td_ + rep2 * NTHR, j = qq >> 3, i8 = (qq & 7) * 8; const int t = cn * 128 + j; int pos, L; seq_of(t, pos, L);
            float k1[8], k2[8], q1[8], q2[8], ok1[8], ok2[8], oq1[8], oq2[8];
            unpack8(*(const u32x4*)(PROJ + (size_t)t * NPJ + C_RK + h * 128 + i8), k1); unpack8(*(const u32x4*)(PROJ + (size_t)t * NPJ + C_RK + h * 128 + 64 + i8), k2);
            unpack8(*(const u32x4*)(PROJ + (size_t)t * NPJ + C_RQ + h * 128 + i8), q1); unpack8(*(const u32x4*)(PROJ + (size_t)t * NPJ + C_RQ + h * 128 + 64 + i8), q2);
            const f32x4* rr = (const f32x4*)(ROT + (size_t)pos * 64 + i8); const float sc = 0.08838834764831845f;
#pragma unroll
            for (int i2 = 0; i2 < 4; ++i2) { const f32x4 cs4 = rr[i2];
#pragma unroll
                for (int u = 0; u < 2; ++u) { const int i = 2 * i2 + u; const float c = cs4[2 * u], s = cs4[2 * u + 1];
                    ok1[i] = (k1[i] * c - k2[i] * s) * sc; ok2[i] = (k1[i] * s + k2[i] * c) * sc; oq1[i] = q1[i] * c - q2[i] * s; oq2[i] = q1[i] * s + q2[i] * c; } }
            *(LAS u32x4*)(Ks + j * RP + i8) = pack8(ok1); *(LAS u32x4*)(Ks + j * RP + 64 + i8) = pack8(ok2); *(LAS u32x4*)(Qs + j * RP + i8) = pack8(oq1); *(LAS u32x4*)(Qs + j * RP + 64 + i8) = pack8(oq2); }
        LBAR();
        const int r = ln_ & 15, q4 = ln_ >> 4, i0 = F.wave * 16 + q4 * 4;
        f32x4 sa[8];
#pragma unroll
        for (int n = 0; n < 8; ++n) sa[n] = (f32x4){0.f, 0.f, 0.f, 0.f};
        mma_lds<8>(sa, Qs + F.wave * 16 * RP, RP, Ks, RP, 128, ln_);
        LBAR();
#pragma unroll
        for (int n = 0; n < 8; ++n)
#pragma unroll
            for (int j = 0; j < 4; ++j) { const int i = i0 + j, jj = n * 16 + r; const int dd = i > jj ? i - jj : jj - i; Ks[i * RP + jj] = (bf16)f2bf(sa[n][j] * __builtin_amdgcn_exp2f(l2g * (float)dd)); }
        asm volatile("s_waitcnt lgkmcnt(0)" ::: "memory");
        f32x4 o[16];
#pragma unroll
        for (int n = 0; n < 16; ++n) o[n] = (f32x4){0.f, 0.f, 0.f, 0.f};
        const size_t item = (size_t)cn * 4 + h;
        float r1[4], f2[4];
#pragma unroll
        for (int j = 0; j < 4; ++j) { r1[j] = __builtin_amdgcn_exp2f(l2g * (float)(2 * (i0 + j) - 127)); f2[j] = __builtin_amdgcn_exp2f(l2g * (float)(128 - i0 - j)); }
        { const bf16* Bd0 = STP + (0 * 768 + item) * 32768 + (size_t)r * 128 + q4 * 8; const bf16* Bd1 = STP + (768 + item) * 32768 + (size_t)r * 128 + q4 * 8;
          const LAS bf16* Aq = Qs + (F.wave * 16 + r) * RP + q4 * 8;
          bf16x8 b0[8], b1[8], b2[8];
#define RO_LOAD(dst_, b_) do { const bf16* bp_ = ((b_) < 8 ? Bd0 : Bd1) + (((b_) >> 1) & 3) * 32 + ((b_) & 1) * 8 * 2048; _Pragma("unroll") for (int u = 0; u < 8; ++u) dst_[u] = *(const bf16x8*)(bp_ + u * 2048); } while (0)
#define RO_MMA(src_, b_) do { const bf16x8 av_ = *(const LAS bf16x8*)(Aq + (((b_) >> 1) & 3) * 32); _Pragma("unroll") for (int u = 0; u < 8; ++u) o[((b_) & 1) * 8 + u] = __builtin_amdgcn_mfma_f32_16x16x32_bf16(av_, src_[u], o[((b_) & 1) * 8 + u], 0, 0, 0); } while (0)
          RO_LOAD(b0, 0); RO_LOAD(b1, 1); RO_LOAD(b2, 2);
          RO_MMA(b0, 0); RO_LOAD(b0, 3);
          RO_MMA(b1, 1); RO_LOAD(b1, 4);
          RO_MMA(b2, 2); RO_LOAD(b2, 5);
          RO_MMA(b0, 3); RO_LOAD(b0, 6);
          RO_MMA(b1, 4); RO_LOAD(b1, 7);
          RO_MMA(b2, 5); RO_LOAD(b2, 8);
          RO_MMA(b0, 6); RO_LOAD(b0, 9);
          RO_MMA(b1, 7); RO_LOAD(b1, 10);
#pragma unroll
          for (int n = 0; n < 16; ++n)
#pragma unroll
              for (int j = 0; j < 4; ++j) o[n][j] *= r1[j];
          RO_MMA(b2, 8); RO_LOAD(b2, 11);
          RO_MMA(b0, 9); RO_LOAD(b0, 12);
          RO_MMA(b1, 10); RO_LOAD(b1, 13);
          RO_MMA(b2, 11); RO_LOAD(b2, 14);
          RO_MMA(b0, 12); RO_LOAD(b0, 15);
          RO_MMA(b1, 13);
          RO_MMA(b2, 14);
          RO_MMA(b0, 15);
#undef RO_LOAD
#undef RO_MMA
        }
#pragma unroll
        for (int n = 0; n < 16; ++n)
#pragma unroll
            for (int j = 0; j < 4; ++j) o[n][j] *= f2[j];
        mma_lds<16>(o, Ks + F.wave * 16 * RP, RP, VT, RP, 128, ln_);
        float gnv[16];
#pragma unroll
        for (int n = 0; n < 16; ++n) gnv[n] = gn[h * 256 + n * 16 + r];
#pragma unroll
        for (int j = 0; j < 4; ++j) { float s = 0.f; unsigned short zz[16];
#pragma unroll
            for (int n = 0; n < 16; ++n) zz[n] = PROJ[(size_t)(cn * 128 + i0 + j) * NPJ + C_RZ + h * 256 + n * 16 + r];
#pragma unroll
            for (int n = 0; n < 16; ++n) s += o[n][j];
            s += shx<1>(s); s += shx<2>(s); s += shx<4>(s); s += shx<8>(s); const float mean = s * (1.0f / 256.0f); float v = 0.f;
#pragma unroll
            for (int n = 0; n < 16; ++n) { const float dlt = o[n][j] - mean; v += dlt * dlt; }
            v += shx<1>(v); v += shx<2>(v); v += shx<4>(v); v += shx<8>(v); const float rstd = __builtin_amdgcn_rsqf(v * (1.0f / 256.0f) + 1e-5f);
            const int t = cn * 128 + i0 + j;
#pragma unroll
            for (int n = 0; n < 16; ++n) { const int e = n * 16 + r; Y[(size_t)t * 4096 + 2048 + h * 256 + e] = (bf16)f2bf((o[n][j] - mean) * rstd * gnv[n] * siluf_(bf2f(zz[n]))); } }
    }
}

__device__ __forceinline__ float rdl(float x, int j) { return __int_as_float(__builtin_amdgcn_readlane(__float_as_int(x), j)); }
__device__ __forceinline__ void ph_rwkv_prep(const AP& a, const Frame& F, int l) {
    const bf16* PROJ = (const bf16*)(a.ws + WS_PROJ); unsigned char* S = a.ws + WS_SCR;
    bf16* R = (bf16*)(S + SB_R); bf16* KM = (bf16*)(S + SB_KM); bf16* V = (bf16*)(S + SB_V); bf16* KK = (bf16*)(S + SB_KK); bf16* AG = (bf16*)(S + SB_AG); bf16* LWF = (bf16*)(S + SB_LWF); bf16* LWB = (bf16*)(S + SB_LWB); const bf16* LO = (const bf16*)(S + SB_LO);
    const float* mu = a.in(I_MU) + (size_t)l * 3 * WB; const float* w0 = a.in(I_W0) + (size_t)l * 2 * WB;
    const float* a0 = a.in(I_A0) + (size_t)l * WB; const float* kkp = a.in(I_KK) + (size_t)l * WB; const float* kap = a.in(I_KA) + (size_t)l * WB;
#define UP4(W_, O_) do { const u32x2 w_ = (W_); O_[0] = __uint_as_float(w_[0] << 16); O_[1] = __uint_as_float(w_[0] & 0xffff0000u); O_[2] = __uint_as_float(w_[1] << 16); O_[3] = __uint_as_float(w_[1] & 0xffff0000u); } while (0)
#define PK4(O_) ((u32x2){pk2(O_[0], O_[1]), pk2(O_[2], O_[3])})
    for (int it = F.gw; it < (T / 4) * 4; it += F.ngw) { const int hq = it & 3, t0 = (it >> 2) * 4, c = hq * 256 + F.lane * 4; int pos0, L; seq_of(t0, pos0, L);
        u32x2 xr[6], xk[6], xv[6];
#pragma unroll
        for (int i = 0; i < 6; ++i) { const int pp = pos0 + i - 1; const bool ok = pp >= 0 && pp < L; const bf16* pr = PROJ + (size_t)(t0 + i - 1) * NPJ + c; const u32x2 z2 = (u32x2){0u, 0u};
            xr[i] = ok ? *(const u32x2*)(pr + C_RWR) : z2; xk[i] = ok ? *(const u32x2*)(pr + C_RWK) : z2; xv[i] = ok ? *(const u32x2*)(pr + C_RWV) : z2; }
        u32x2 lo0[4], lo1[4], lo2[4];
#pragma unroll
        for (int i = 0; i < 4; ++i) { const bf16* lo = LO + (size_t)(t0 + i) * 3072 + c; lo0[i] = *(const u32x2*)lo; lo1[i] = *(const u32x2*)(lo + 1024); lo2[i] = *(const u32x2*)(lo + 2048); }
        const f32x4 mur = *(const f32x4*)(mu + c), muk = *(const f32x4*)(mu + WB + c), muv = *(const f32x4*)(mu + 2 * WB + c), w0f = *(const f32x4*)(w0 + c), w0b = *(const f32x4*)(w0 + WB + c),
                    a0v = *(const f32x4*)(a0 + c), kkw = *(const f32x4*)(kkp + c), kaw = *(const f32x4*)(kap + c);
#pragma unroll
        for (int i = 0; i < 4; ++i) { const int t = t0 + i; float rp[4], r0[4], rn[4], kp[4], k0[4], kn[4], vp[4], v0[4], vn[4], l0[4], l1[4], l2[4];
            UP4(xr[i], rp); UP4(xr[i + 1], r0); UP4(xr[i + 2], rn); UP4(xk[i], kp); UP4(xk[i + 1], k0); UP4(xk[i + 2], kn); UP4(xv[i], vp); UP4(xv[i + 1], v0); UP4(xv[i + 2], vn); UP4(lo0[i], l0); UP4(lo1[i], l1); UP4(lo2[i], l2);
            float rm[4], km[4], vm[4], ag[4], kk[4], kd[4], lf[4], lb[4]; float ss = 0.f;
#pragma unroll
            for (int e = 0; e < 4; ++e) { rm[e] = r0[e] + mur[e] * (0.5f * (rp[e] + rn[e]) - r0[e]); km[e] = k0[e] + muk[e] * (0.5f * (kp[e] + kn[e]) - k0[e]); vm[e] = v0[e] + muv[e] * (0.5f * (vp[e] + vn[e]) - v0[e]);
                ag[e] = sigmoidf_(a0v[e] + l2[e]); kk[e] = km[e] * kkw[e]; ss += kk[e] * kk[e]; kd[e] = km[e] * (1.0f + (ag[e] - 1.0f) * kaw[e]);
                lf[e] = -0.6065306597126334f * sigmoidf_(w0f[e] + l0[e]); lb[e] = -0.6065306597126334f * sigmoidf_(w0b[e] + l1[e]); }
            ss += shx<1>(ss); ss += shx<2>(ss); ss += shx<4>(ss); ss += shx<8>(ss);
            const float inv = fminf(__builtin_amdgcn_rsqf(ss), 1e12f); float ka[4];
#pragma unroll
            for (int e = 0; e < 4; ++e) { kk[e] *= inv; ka[e] = ag[e]; }
            const size_t o = (size_t)t * WB + c;
            *(u32x2*)(R + o) = PK4(rm); *(u32x2*)(KM + o) = PK4(kd); *(u32x2*)(V + o) = PK4(vm); *(u32x2*)(KK + o) = PK4(kk); *(u32x2*)(AG + o) = PK4(ka); *(u32x2*)(LWF + o) = PK4(lf); *(u32x2*)(LWB + o) = PK4(lb); }
    }
}
constexpr int P72 = 72, SLOT = 64 * P72;
__device__ __forceinline__ void mm2(f32x4 (&acc)[2], const LAS bf16* A, const LAS bf16* Bt, int wave, int lane) { asm volatile("" : "+v"(lane));
    mma_lds<2>(acc, A + (wave >> 1) * 16 * P72, P72, Bt + (wave & 1) * 32 * P72, P72, 64, lane); }
#define RW_FOREACH(acc) _Pragma("unroll") for (int nt = 0; nt < 2; ++nt) _Pragma("unroll") for (int j = 0; j < 4; ++j)
#define RW_BASE int rb_ = (F.wave >> 1) * 16 + (F.lane >> 4) * 4, cb_ = (F.wave & 1) * 32 + (F.lane & 15); asm volatile("" : "+v"(rb_), "+v"(cb_));
#define RW_ROW (rb_ + j)
#define RW_COL (cb_ + nt * 16)
__device__ __forceinline__ void ph_rwkv_chunk(const AP& a, const Frame& F) {
    unsigned char* S = a.ws + WS_SCR; bf16* CH = (bf16*)(S + SB_CH);
    const bf16* R = (const bf16*)(S + SB_R); const bf16* KM = (const bf16*)(S + SB_KM); const bf16* V = (const bf16*)(S + SB_V); const bf16* KK = (const bf16*)(S + SB_KK); const bf16* AG = (const bf16*)(S + SB_AG);
    LAS bf16* lb = (LAS bf16*)F.lds;
#define SL(i) (lb + (i) * SLOT)
    LAS float* NF = (LAS float*)SL(12);
    LAS float* GC = (LAS float*)(F.lds + 15 * SLOT * 2);
    LAS float* TOT = GC + 64;
    const f32x4 z4 = (f32x4){0.f, 0.f, 0.f, 0.f};
#ifndef CHUNK_REP
#define CHUNK_REP 1
#endif
    u32x4 pre0, pre1, pre2, pre3, pre4, pre5, pre6;
#define RAW_LOAD(it_, dir_) do { const int hd_ = (it_) & 15, cn_ = (it_) >> 4; const bf16* LW_ = (const bf16*)(S + ((dir_) ? SB_LWB : SB_LWF)); int tid_ = F.tid; asm volatile("" : "+v"(tid_)); \
        const int j_ = tid_ >> 3, c8_ = (tid_ & 7) * 8; const int t_ = cn_ * 64 + ((dir_) ? 63 - j_ : j_); const size_t o_ = (size_t)t_ * WB + hd_ * 64 + c8_; \
        pre0 = *(const u32x4*)(LW_ + o_); pre1 = *(const u32x4*)(KK + o_); pre2 = *(const u32x4*)(AG + o_); pre3 = *(const u32x4*)(KM + o_); pre4 = *(const u32x4*)(R + o_); \
        const int pp_ = tid_ & 31, v8_ = ((tid_ >> 5) & 7) * 8; const int ta_ = cn_ * 64 + ((dir_) ? 63 - 2 * pp_ : 2 * pp_), tb_ = cn_ * 64 + ((dir_) ? 62 - 2 * pp_ : 2 * pp_ + 1); \
        pre5 = *(const u32x4*)(V + (size_t)ta_ * WB + hd_ * 64 + v8_); pre6 = *(const u32x4*)(V + (size_t)tb_ * WB + hd_ * 64 + v8_); } while (0)
    for (int rep = 0; rep < CHUNK_REP; ++rep) {
    if ((int)blockIdx.x < (T / 64) * 16) RAW_LOAD((int)blockIdx.x, 0);
    for (int it = blockIdx.x; it < (T / 64) * 16; it += gridDim.x) { const int hd = it & 15, cn = it >> 4; (void)hd; (void)cn;
        for (int dir = 0; dir < 2; ++dir) {
            bf16* outb = CH + ((size_t)it * 2 + dir) * 4 * 4096;
            LBAR();
            { int tid_ = F.tid; asm volatile("" : "+v"(tid_)); const int j = tid_ >> 3, c8 = (tid_ & 7) * 8;
              *(LAS u32x4*)(SL(8) + j * P72 + c8) = pre0; *(LAS u32x4*)(SL(9) + j * P72 + c8) = pre1; *(LAS u32x4*)(SL(10) + j * P72 + c8) = pre2; *(LAS u32x4*)(SL(11) + j * P72 + c8) = pre3; *(LAS u32x4*)(SL(12) + j * P72 + c8) = pre4;
              if (tid_ < 256) { const int pp = tid_ & 31, v8 = (tid_ >> 5) * 8; const unsigned wa[4] = {pre5.x, pre5.y, pre5.z, pre5.w}, wb[4] = {pre6.x, pre6.y, pre6.z, pre6.w};
#pragma unroll
                  for (int i = 0; i < 4; ++i) { *(LAS unsigned*)(SL(7) + (v8 + 2 * i) * P72 + 2 * pp) = (wa[i] & 0xffffu) | (wb[i] << 16); *(LAS unsigned*)(SL(7) + (v8 + 2 * i + 1) * P72 + 2 * pp) = (wa[i] >> 16) | (wb[i] & 0xffff0000u); } }
              const int nit = dir ? it + (int)gridDim.x : it;
              if (nit < (T / 64) * 16) RAW_LOAD(nit, dir ^ 1); }
            LBAR();
            { int k = F.lane; asm volatile("" : "+v"(k)); const int seg = F.wave;
              float cum[8]; float run = 0.f;
#pragma unroll
              for (int i = 0; i < 8; ++i) { run += bf2f(SL(8)[(seg * 8 + i) * P72 + k]); cum[i] = run; }
              TOT[seg * 64 + k] = run;
              LBAR();
              float off = 0.f;
              for (int s2 = 0; s2 < seg; ++s2) off += TOT[s2 * 64 + k];
              unsigned ta[4], tb[4], tk[4]; float Gprev = __expf(off);
#pragma unroll
              for (int ip = 0; ip < 4; ++ip) { float fa[2], fb[2], fk[2], fr[2];
#pragma unroll
                  for (int u = 0; u < 2; ++u) { const int i = 2 * ip + u, t = seg * 8 + i; const float cl = off + cum[i];
                      const float kkv = bf2f(SL(9)[t * P72 + k]), agv = bf2f(SL(10)[t * P72 + k]), kmv = bf2f(SL(11)[t * P72 + k]), rv = bf2f(SL(12)[t * P72 + k]);
                      const float G = __expf(cl), Gi = __expf(-cl);
                      fa[u] = -kkv * Gprev; fb[u] = kkv * agv * Gi; fk[u] = kmv * Gi; fr[u] = rv * G; Gprev = G;
                      if (t == 63) GC[k] = G; }
                  const unsigned wa = pk2(fa[0], fa[1]), wb = pk2(fb[0], fb[1]), wk = pk2(fk[0], fk[1]), wr2 = pk2(fr[0], fr[1]); const int t0 = seg * 8 + 2 * ip;
                  SL(0)[t0 * P72 + k] = (bf16)wa; SL(0)[(t0 + 1) * P72 + k] = (bf16)(wa >> 16); SL(1)[t0 * P72 + k] = (bf16)wb; SL(1)[(t0 + 1) * P72 + k] = (bf16)(wb >> 16);
                  SL(2)[t0 * P72 + k] = (bf16)wk; SL(2)[(t0 + 1) * P72 + k] = (bf16)(wk >> 16); SL(6)[t0 * P72 + k] = (bf16)wr2; SL(6)[(t0 + 1) * P72 + k] = (bf16)(wr2 >> 16);
                  ta[ip] = wa; tb[ip] = wb; tk[ip] = wk; }
              *(LAS u32x4*)(SL(3) + k * P72 + seg * 8) = (u32x4){ta[0], ta[1], ta[2], ta[3]}; *(LAS u32x4*)(SL(4) + k * P72 + seg * 8) = (u32x4){tb[0], tb[1], tb[2], tb[3]}; *(LAS u32x4*)(SL(5) + k * P72 + seg * 8) = (u32x4){tk[0], tk[1], tk[2], tk[3]}; }
            LBAR();
#define PK4S(dst_, v0_, v1_, v2_, v3_) *(LAS u32x2*)(dst_) = (u32x2){pk2(v0_, v1_), pk2(v2_, v3_)}
            { f32x4 c1[2] = {z4, z4}, c2[2] = {z4, z4}, c3[2] = {z4, z4}, c4[2] = {z4, z4};
              mm2(c1, SL(1), SL(0), F.wave, F.lane);
              mm2(c2, SL(0), SL(2), F.wave, F.lane);
              mm2(c3, SL(1), SL(6), F.wave, F.lane);
              mm2(c4, SL(2), SL(6), F.wave, F.lane);
              RW_BASE
#pragma unroll
              for (int nt = 0; nt < 2; ++nt) { const int cc = cb_ + nt * 16, r0 = rb_;
                  { f32x4 v;
#pragma unroll
                    for (int j = 0; j < 4; ++j) v[j] = (r0 + j) < cc ? c1[nt][j] : 0.f;
                    *(LAS f32x4*)(NF + cc * 68 + r0) = v; }
                  PK4S(SL(8) + cc * P72 + r0, cc < r0 ? c2[nt][0] : 0.f, cc < r0 + 1 ? c2[nt][1] : 0.f, cc < r0 + 2 ? c2[nt][2] : 0.f, cc < r0 + 3 ? c2[nt][3] : 0.f);
                  PK4S(SL(9) + cc * P72 + r0, r0 <= cc ? c3[nt][0] : 0.f, r0 + 1 <= cc ? c3[nt][1] : 0.f, r0 + 2 <= cc ? c3[nt][2] : 0.f, r0 + 3 <= cc ? c3[nt][3] : 0.f);
                  PK4S(SL(10) + cc * P72 + r0, r0 <= cc ? c4[nt][0] : 0.f, r0 + 1 <= cc ? c4[nt][1] : 0.f, r0 + 2 <= cc ? c4[nt][2] : 0.f, r0 + 3 <= cc ? c4[nt][3] : 0.f); } }
            LBAR();
            {
              int tid2_ = F.tid; asm volatile("" : "+v"(tid2_)); const int t = tid2_ >> 3, j8 = (tid2_ & 7) * 8; const bool offd = (t >> 4) != (j8 >> 4);
              { const f32x4 n0 = *(const LAS f32x4*)(NF + t * 68 + j8), n1 = *(const LAS f32x4*)(NF + t * 68 + j8 + 4); u32x4 w = (u32x4){0u, 0u, 0u, 0u};
                if (offd) { w.x = pk2(n0[0], n0[1]); w.y = pk2(n0[2], n0[3]); w.z = pk2(n1[0], n1[1]); w.w = pk2(n1[2], n1[3]); }
                *(LAS u32x4*)(SL(0) + t * P72 + j8) = w;
                if (offd) { *(LAS u32x4*)(SL(1) + t * P72 + j8) = (u32x4){0u, 0u, 0u, 0u}; *(LAS u32x4*)(SL(2) + t * P72 + j8) = (u32x4){0u, 0u, 0u, 0u}; } }
              if (tid2_ < 64) { const int b0 = (tid2_ >> 4) * 16, i = tid2_ & 15; float tr[16];
#pragma unroll
                  for (int tt = 0; tt < 16; ++tt) { float val = (tt == i) ? 1.f : 0.f;
#pragma unroll
                      for (int jj = 0; jj < tt; ++jj) val += (jj >= i ? tr[jj] : 0.f) * NF[(b0 + tt) * 68 + b0 + jj];
                      tr[tt] = (tt < i) ? 0.f : val; }
#pragma unroll
                  for (int tt = 0; tt < 16; ++tt) { const bf16 x = (bf16)f2bf(tr[tt]); SL(1)[(b0 + i) * P72 + b0 + tt] = x; SL(2)[(b0 + tt) * P72 + b0 + i] = x; } } }
            LBAR();
            { f32x4 c1[2] = {z4, z4}, c2[2] = {z4, z4};
              mm2(c1, SL(1), SL(0), F.wave, F.lane);
              mm2(c2, SL(0), SL(1), F.wave, F.lane);
              RW_BASE
#pragma unroll
              for (int nt = 0; nt < 2; ++nt) { const int cc = cb_ + nt * 16, r0 = rb_;
                  PK4S(SL(14) + cc * P72 + r0, c1[nt][0], c1[nt][1], c1[nt][2], c1[nt][3]);
                  PK4S(SL(11) + cc * P72 + r0, c2[nt][0], c2[nt][1], c2[nt][2], c2[nt][3]);
                  PK4S(SL(13) + cc * P72 + r0, c2[nt][0] + (cc == r0 ? 1.f : 0.f), c2[nt][1] + (cc == r0 + 1 ? 1.f : 0.f), c2[nt][2] + (cc == r0 + 2 ? 1.f : 0.f), c2[nt][3] + (cc == r0 + 3 ? 1.f : 0.f)); } }
            LBAR();
            { f32x4 c[2] = {z4, z4}; mm2(c, SL(11), SL(14), F.wave, F.lane);
              RW_BASE
#pragma unroll
              for (int nt = 0; nt < 2; ++nt) { const int cc = cb_ + nt * 16, r0 = rb_;
                  PK4S(SL(12) + cc * P72 + r0, c[nt][0] + (cc == r0 ? 1.f : 0.f), c[nt][1] + (cc == r0 + 1 ? 1.f : 0.f), c[nt][2] + (cc == r0 + 2 ? 1.f : 0.f), c[nt][3] + (cc == r0 + 3 ? 1.f : 0.f)); } }
            LBAR();
            { f32x4 c[2] = {z4, z4}; mm2(c, SL(12), SL(13), F.wave, F.lane);
              RW_BASE
#pragma unroll
              for (int nt = 0; nt < 2; ++nt) PK4S(SL(1) + (cb_ + nt * 16) * P72 + rb_, c[nt][0], c[nt][1], c[nt][2], c[nt][3]); }
            LBAR();
            { f32x4 c[2] = {z4, z4}; mm2(c, SL(1), SL(2), F.wave, F.lane);
              RW_BASE
#pragma unroll
              for (int nt = 0; nt < 2; ++nt) PK4S(SL(0) + (cb_ + nt * 16) * P72 + rb_, c[nt][0], c[nt][1], c[nt][2], c[nt][3]); }
            LBAR();
            { f32x4 c1[2] = {z4, z4}, c2[2] = {z4, z4};
              mm2(c1, SL(0), SL(3), F.wave, F.lane);
              mm2(c2, SL(8), SL(0), F.wave, F.lane);
              RW_BASE
#pragma unroll
              for (int nt = 0; nt < 2; ++nt) { const int cc = cb_ + nt * 16, r0 = rb_; PK4S(SL(1) + cc * P72 + r0, c1[nt][0], c1[nt][1], c1[nt][2], c1[nt][3]); PK4S(SL(11) + cc * P72 + r0, c2[nt][0], c2[nt][1], c2[nt][2], c2[nt][3]); } }
            LBAR();
            { f32x4 c1[2] = {z4, z4}, c2[2] = {z4, z4};
              mm2(c1, SL(11), SL(7), F.wave, F.lane);
              mm2(c2, SL(1), SL(9), F.wave, F.lane);
              RW_BASE
#pragma unroll
              for (int nt = 0; nt < 2; ++nt) { const int cc = cb_ + nt * 16, r0 = rb_; PK4S(SL(12) + cc * P72 + r0, c1[nt][0], c1[nt][1], c1[nt][2], c1[nt][3]);
                  const u32x2 rw = *(const LAS u32x2*)(SL(6) + cc * P72 + r0);
                  PK4S(SL(13) + cc * P72 + r0, c2[nt][0] + __uint_as_float(rw.x << 16), c2[nt][1] + __uint_as_float(rw.x & 0xffff0000u), c2[nt][2] + __uint_as_float(rw.y << 16), c2[nt][3] + __uint_as_float(rw.y & 0xffff0000u)); } }
            LBAR();
            { f32x4 c1[2] = {z4, z4}, c2[2] = {z4, z4}, c3[2] = {z4, z4};
              mm2(c1, SL(12), SL(9), F.wave, F.lane); mm2(c1, SL(7), SL(10), F.wave, F.lane);
              mm2(c2, SL(1), SL(4), F.wave, F.lane);
              mm2(c3, SL(12), SL(4), F.wave, F.lane); mm2(c3, SL(7), SL(5), F.wave, F.lane);
              float qf[8]; RW_BASE
#pragma unroll
              for (int nt = 0; nt < 2; ++nt) { const int cc = cb_ + nt * 16, r0 = rb_; const float gc = GC[cc];
                  PK4S(SL(14) + cc * P72 + r0, c1[nt][0], c1[nt][1], c1[nt][2], c1[nt][3]);
                  PK4S(SL(0) + cc * P72 + r0, (c2[nt][0] + (cc == r0 ? 1.f : 0.f)) * gc, (c2[nt][1] + (cc == r0 + 1 ? 1.f : 0.f)) * gc, (c2[nt][2] + (cc == r0 + 2 ? 1.f : 0.f)) * gc, (c2[nt][3] + (cc == r0 + 3 ? 1.f : 0.f)) * gc);
#pragma unroll
                  for (int j = 0; j < 4; ++j) qf[nt * 4 + j] = c3[nt][j] * gc; }
              *(u32x4*)(outb + 1 * 4096 + (F.wave * 64 + F.lane) * 8) = pack8(qf); }
            LBAR();
#undef PK4S
            { int tid_ = F.tid; asm volatile("" : "+v"(tid_)); const int row = tid_ >> 3, sg = (tid_ & 7) * 8;
              *(u32x4*)(outb + 0 * 4096 + row * 64 + sg) = *(const LAS u32x4*)(SL(0) + row * P72 + sg);
              *(u32x4*)(outb + 2 * 4096 + row * 64 + sg) = *(const LAS u32x4*)(SL(13) + row * P72 + sg); *(u32x4*)(outb + 3 * 4096 + row * 64 + sg) = *(const LAS u32x4*)(SL(14) + row * P72 + sg); }
        }
    }
    }
#undef SL
}
__device__ __forceinline__ void ph_rwkv_seq(const AP& a, const Frame& F) {
    unsigned char* S = a.ws + WS_SCR; const bf16* CH = (const bf16*)(S + SB_CH); bf16* SS = (bf16*)(S + SB_SS);
    LAS bf16* Sb = (LAS bf16*)F.lds;
    const int r = F.lane & 15, q = F.lane >> 4, mt = F.wave >> 1, nb = (F.wave & 1) * 32;
    for (int chain = blockIdx.x; chain < 160; chain += gridDim.x) { const int dir = chain & 1, hd = (chain >> 1) & 15, sq = chain >> 5; const int c0 = sq == 0 ? 0 : 256 + (sq - 1) * 32, nc = sq == 0 ? 256 : 32;
        f32x4 acc[2] = {(f32x4){0.f, 0.f, 0.f, 0.f}, (f32x4){0.f, 0.f, 0.f, 0.f}};
        __syncthreads();
        u32x4 p0, p1, p2, p3, p4s, p5, p6, p7, p8, p9, p10, p11, p12, p13, p14, p15, q0, q1, q2, q3, q4s, q5, q6, q7, q8, q9, q10, q11, q12, q13, q14, q15;
        const int crow = F.tid >> 3, cseg = (F.tid & 7) * 8;
        LAS bf16* Pb = Sb + 2 * SLOT;
#define SEQ_LOAD(P_, Q_, s_) do { const int s1_ = (s_) < nc ? (s_) : nc - 1; const int cn1_ = c0 + (dir == 0 ? s1_ : nc - 1 - s1_); const bf16* PT_ = CH + (((size_t)cn1_ * 16 + hd) * 2 + dir) * 4 * 4096; \
            P_ = *(const u32x4*)(PT_ + F.tid * 8); Q_ = *(const u32x4*)(PT_ + 4096 + F.tid * 8); } while (0)
#define SEQ_STEP(P_, Q_, Pn_, Qn_, s_) do { const int cn_ = c0 + (dir == 0 ? (s_) : nc - 1 - (s_)); const size_t itd_ = ((size_t)cn_ * 16 + hd) * 2 + dir; \
            SEQ_LOAD(Pn_, Qn_, (s_) + 15); \
            LAS bf16* sb_ = Sb + ((s_) & 1) * SLOT; LAS bf16* pb_ = Pb + ((s_) & 1) * SLOT; \
            _Pragma("unroll") for (int nt = 0; nt < 2; ++nt) _Pragma("unroll") for (int j = 0; j < 4; ++j) sb_[(mt * 16 + q * 4 + j) * P72 + nb + nt * 16 + r] = (bf16)f2bf(acc[nt][j]); \
            *(LAS u32x4*)(pb_ + crow * P72 + cseg) = P_; \
            asm volatile("s_waitcnt lgkmcnt(0)" ::: "memory"); __builtin_amdgcn_s_barrier(); asm volatile("" ::: "memory"); \
            *(u32x4*)(SS + itd_ * 4096 + crow * 64 + cseg) = *(const LAS u32x4*)(sb_ + crow * P72 + cseg);            \
            { float qf_[8]; unpack8(Q_, qf_); acc[0] = (f32x4){qf_[0], qf_[1], qf_[2], qf_[3]}; acc[1] = (f32x4){qf_[4], qf_[5], qf_[6], qf_[7]}; } \
            _Pragma("unroll") for (int ks = 0; ks < 2; ++ks) { const bf16x8 av = *(const LAS bf16x8*)(sb_ + (mt * 16 + r) * P72 + ks * 32 + q * 8); \
                _Pragma("unroll") for (int nt = 0; nt < 2; ++nt) { const bf16x8 bv = *(const LAS bf16x8*)(pb_ + (nb + nt * 16 + r) * P72 + ks * 32 + q * 8); acc[nt] = __builtin_amdgcn_mfma_f32_16x16x32_bf16(av, bv, acc[nt], 0, 0, 0); } } } while (0)
        SEQ_LOAD(p0, q0, 0); SEQ_LOAD(p1, q1, 1); SEQ_LOAD(p2, q2, 2); SEQ_LOAD(p3, q3, 3); SEQ_LOAD(p4s, q4s, 4); SEQ_LOAD(p5, q5, 5); SEQ_LOAD(p6, q6, 6); SEQ_LOAD(p7, q7, 7); SEQ_LOAD(p8, q8, 8); SEQ_LOAD(p9, q9, 9); SEQ_LOAD(p10, q10, 10); SEQ_LOAD(p11, q11, 11); SEQ_LOAD(p12, q12, 12); SEQ_LOAD(p13, q13, 13); SEQ_LOAD(p14, q14, 14);
        for (int s = 0; s < nc; s += 16) {
            SEQ_STEP(p0, q0, p15, q15, s + 0);
            SEQ_STEP(p1, q1, p0, q0, s + 1);
            SEQ_STEP(p2, q2, p1, q1, s + 2);
            SEQ_STEP(p3, q3, p2, q2, s + 3);
            SEQ_STEP(p4s, q4s, p3, q3, s + 4);
            SEQ_STEP(p5, q5, p4s, q4s, s + 5);
            SEQ_STEP(p6, q6, p5, q5, s + 6);
            SEQ_STEP(p7, q7, p6, q6, s + 7);
            SEQ_STEP(p8, q8, p7, q7, s + 8);
            SEQ_STEP(p9, q9, p8, q8, s + 9);
            SEQ_STEP(p10, q10, p9, q9, s + 10);
            SEQ_STEP(p11, q11, p10, q10, s + 11);
            SEQ_STEP(p12, q12, p11, q11, s + 12);
            SEQ_STEP(p13, q13, p12, q12, s + 13);
            SEQ_STEP(p14, q14, p13, q13, s + 14);
            SEQ_STEP(p15, q15, p14, q14, s + 15);
        }
#undef SEQ_LOAD
#undef SEQ_STEP
    }
}
__device__ __forceinline__ void ph_rwkv_out(const AP& a, const Frame& F, int l) {
    unsigned char* S = a.ws + WS_SCR; const bf16* CH = (const bf16*)(S + SB_CH); const bf16* SS = (const bf16*)(S + SB_SS); const bf16* PROJ = (const bf16*)(a.ws + WS_PROJ); bf16* Y = (bf16*)(a.ws + WS_Y);
    const bf16* R = (const bf16*)(S + SB_R); const bf16* KM = (const bf16*)(S + SB_KM); const bf16* V = (const bf16*)(S + SB_V);
    const float* rk = a.in(I_RK) + (size_t)l * WB; const float* lg = a.in(I_LNG) + (size_t)l * WB; const float* lbp = a.in(I_LNB) + (size_t)l * WB;
    const int r = F.lane & 15, q = F.lane >> 4;
    for (int it = F.gw; it < (T / 64) * 16; it += F.ngw) { const int hd = it & 15, cn = it >> 4; const size_t item = (size_t)cn * 16 + hd;
      bf16x8 bS[2][4][2];
#pragma unroll
      for (int dir = 0; dir < 2; ++dir) { const bf16* Sg = SS + (item * 2 + dir) * 4096;
#pragma unroll
          for (int nt = 0; nt < 4; ++nt)
#pragma unroll
              for (int ks = 0; ks < 2; ++ks) bS[dir][nt][ks] = *(const bf16x8*)(Sg + (4 * r + nt) * 64 + ks * 32 + q * 8); }
#pragma unroll 2
      for (int mt = 0; mt < 4; ++mt) {
        f32x4 acc[4];
#pragma unroll
        for (int nt = 0; nt < 4; ++nt) acc[nt] = (f32x4){0.f, 0.f, 0.f, 0.f};
#pragma unroll
        for (int dir = 0; dir < 2; ++dir) { const bf16* ob = CH + (item * 2 + dir) * 4 * 4096; const bf16* R2T = ob + 2 * 4096; const bf16* Y0 = ob + 3 * 4096;
            const int trow = dir ? 63 - (mt * 16 + r) : mt * 16 + r;
#pragma unroll
            for (int ks = 0; ks < 2; ++ks) { const bf16x8 av = *(const bf16x8*)(R2T + trow * 64 + ks * 32 + q * 8);
#pragma unroll
                for (int nt = 0; nt < 4; ++nt) acc[nt] = __builtin_amdgcn_mfma_f32_16x16x32_bf16(av, bS[dir][nt][ks], acc[nt], 0, 0, 0); }
#pragma unroll
            for (int j = 0; j < 4; ++j) { const int tl = mt * 16 + q * 4 + j; const u32x2 yw = *(const u32x2*)(Y0 + (dir ? 63 - tl : tl) * 64 + 4 * r);
                acc[0][j] += __uint_as_float(yw.x << 16); acc[1][j] += __uint_as_float(yw.x & 0xffff0000u); acc[2][j] += __uint_as_float(yw.y << 16); acc[3][j] += __uint_as_float(yw.y & 0xffff0000u); } }
        const int c = hd * 64 + 4 * r; const f32x4 rk4 = *(const f32x4*)(rk + c), lg4 = *(const f32x4*)(lg + c), lb4 = *(const f32x4*)(lbp + c);
        u32x2 wq[4][4];
#pragma unroll
        for (int j = 0; j < 4; ++j) { const int t = cn * 64 + mt * 16 + q * 4 + j; const size_t o = (size_t)t * WB + c; wq[j][0] = *(const u32x2*)(R + o); wq[j][1] = *(const u32x2*)(KM + o); wq[j][2] = *(const u32x2*)(V + o); wq[j][3] = *(const u32x2*)(PROJ + (size_t)t * NPJ + C_RWZ + c); }
#pragma unroll
        for (int j = 0; j < 4; ++j) { const int t = cn * 64 + mt * 16 + q * 4 + j; float s = (acc[0][j] + acc[1][j]) + (acc[2][j] + acc[3][j]);
            s += shx<1>(s); s += shx<2>(s); s += shx<4>(s); s += shx<8>(s); const float mean = s * (1.0f / 64.0f); float vs = 0.f, bs = 0.f;
            float rr[4], kk[4], vv[4], zz[4];
            { const u32x2 w1 = wq[j][0], w2 = wq[j][1], w3 = wq[j][2], w4 = wq[j][3];
              rr[0] = __uint_as_float(w1.x << 16); rr[1] = __uint_as_float(w1.x & 0xffff0000u); rr[2] = __uint_as_float(w1.y << 16); rr[3] = __uint_as_float(w1.y & 0xffff0000u);
              kk[0] = __uint_as_float(w2.x << 16); kk[1] = __uint_as_float(w2.x & 0xffff0000u); kk[2] = __uint_as_float(w2.y << 16); kk[3] = __uint_as_float(w2.y & 0xffff0000u);
              vv[0] = __uint_as_float(w3.x << 16); vv[1] = __uint_as_float(w3.x & 0xffff0000u); vv[2] = __uint_as_float(w3.y << 16); vv[3] = __uint_as_float(w3.y & 0xffff0000u);
              zz[0] = __uint_as_float(w4.x << 16); zz[1] = __uint_as_float(w4.x & 0xffff0000u); zz[2] = __uint_as_float(w4.y << 16); zz[3] = __uint_as_float(w4.y & 0xffff0000u); }
#pragma unroll
            for (int nt = 0; nt < 4; ++nt) { const float dl = acc[nt][j] - mean; vs += dl * dl; bs += rr[nt] * kk[nt] * rk4[nt]; }
            vs += shx<1>(vs); vs += shx<2>(vs); vs += shx<4>(vs); vs += shx<8>(vs); bs += shx<1>(bs); bs += shx<2>(bs); bs += shx<4>(bs); bs += shx<8>(bs);
            const float rstd = __builtin_amdgcn_rsqf(vs * (1.0f / 64.0f) + 64e-5f); float o4[4];
#pragma unroll
            for (int nt = 0; nt < 4; ++nt) { const float yn = (acc[nt][j] - mean) * rstd * lg4[nt] + lb4[nt]; o4[nt] = (yn + bs * vv[nt]) * siluf_(zz[nt]); }
            *(u32x2*)(Y + (size_t)t * 4096 + 1024 + c) = (u32x2){pk2(o4[0], o4[1]), pk2(o4[2], o4[3])}; }
      }
    }
}
constexpr int NPH_PRO = 3, NPH_LAYER = 21, NPH = NPH_PRO + DEPTH * NPH_LAYER + 1;

__global__ void __launch_bounds__(NTHR, 2) fwd(Args ka) {
    extern __shared__ __attribute__((aligned(16))) unsigned char lds_[];
    Frame F; F.lds = (LAS unsigned char*)lds_; F.tid = threadIdx.x; F.lane = F.tid & 63; F.wave = __builtin_amdgcn_readfirstlane(F.tid >> 6);
    F.gw = blockIdx.x * NWAVES + F.wave; F.ngw = gridDim.x * NWAVES; F.gt = blockIdx.x * NTHR + F.tid; F.ngt = gridDim.x * NTHR;
    volatile LAS unsigned* MISC = (volatile LAS unsigned*)(F.lds + LDS_MISC);
    if (F.tid < 64) MISC[F.tid] = 0u;
    { LAS unsigned long long* aq = (LAS unsigned long long*)(F.lds + LDS_ARGS);
#pragma unroll
      for (int i = 0; i < 35; ++i) if (F.tid == i) aq[i] = (unsigned long long)ka.in[i]; }
    __syncthreads();
    AP a; a.q = (const LAS unsigned long long*)(F.lds + LDS_ARGS); a.ws = ka.ws; a.out = ka.out;
    const int ph_lo = ka.ph_lo, ph_hi = ka.ph_hi;
    unsigned* barw = (unsigned*)(a.ws + WS_CTL) + 4096;
    const int wave0 = F.wave;
    XcdBarrier bar; bar.bar = barw; bar.x = 0; bar.st = MISC + 8;
    if (ph_hi - ph_lo > 1) bar = xcd_barrier_post(barw, MISC + 8);
    bar.wave = wave0;
    int gp = 0;
#ifndef PH_DBL
#define PH_DBL 0ull
#endif
#ifndef PH_ONLY
#define PH_ONLY -1
#endif
#define PHASE(pid, ...) do { int lo_ = ph_lo, hi_ = ph_hi; asm volatile("" : "+s"(lo_), "+s"(hi_)); if ((PH_ONLY < 0 || PH_ONLY == (pid)) && lo_ <= gp && gp < hi_) { F.lane = lane_id(); asm volatile("" : "+v"(F.lane)); F.wave = wave0; F.tid = F.wave * 64 + F.lane; F.gw = blockIdx.x * NWAVES + F.wave; F.ngw = gridDim.x * NWAVES; F.ngt = gridDim.x * NTHR; asm volatile("" : "+s"(F.gw), "+s"(F.ngw), "+s"(F.ngt)); F.gt = blockIdx.x * NTHR + F.tid; __VA_ARGS__; if ((PH_DBL >> (pid)) & 1ull) { xcd_barrier(bar); __VA_ARGS__; } if (gp + 1 < hi_) xcd_barrier(bar); } ++gp; } while (0)
    const int G = gridDim.x, cb = blockIdx.x;
    LAS unsigned char* lds = F.lds;
    unsigned char* ws = a.ws;

    PHASE(0, ph_tables(a, F));
    PHASE(1, ph_convert(a, F));
    PHASE(2, { ph_s5mats(a, F); ph_x0(a, F); });

    for (int l = 0; l < DEPTH; ++l) {
        const bf16* WALLT = (const bf16*)(ws + WS_WALLT) + (size_t)l * NALL * D;
        const float* rss_l = (const float*)(ws + WS_RSS) + (size_t)(l & 1) * T;
        PHASE(4, { pg8::Gemm g{(const bf16*)(ws + WS_H), WALLT, D, D, D}; pg8::Order S; S.init(T / 256, NPJ / 256, 1, G, cb, (size_t)256 * D * 2, 0, (size_t)256 * D * 2, 0);
                EpiBf16 E{(bf16*)(ws + WS_PROJ), NPJ, C_WDF / 256, rss_l}; pg8::gemm_phase(lds, g, S, E, F.tid); });
        PHASE(5, ph_lru_conv(a, F, l));
        PHASE(6, { pg8::Gemm g{(const bf16*)(ws + WS_SCR + SA_XC), (const bf16*)(ws + WS_LRUW) + (size_t)l * 4096 * 256, WB, 256, 256}; pg8::Order S; S.init(T / 256, 16, 1, G, cb, (size_t)256 * WB * 2, 0, (size_t)256 * 256 * 2, 0); S.kwin = 256 * 2;
                EpiLru E{a.in(I_BR) + (size_t)l * 2 * WB, a.in(I_BI) + (size_t)l * 2 * WB, a.in(I_LAM) + (size_t)l * 2 * WB, (const bf16*)(ws + WS_SCR + SA_XC), (bf16*)(ws + WS_SCR + SA_LA), (bf16*)(ws + WS_SCR + SA_BB)};
                pg8::gemm_phase(lds, g, S, E, F.tid); });
        PHASE(7, ph_lru_scan1(a, F));
        PHASE(8, ph_lru_scan2(a, F));
        PHASE(9, ph_lru_scan3(a, F));
        PHASE(10, ph_s5_rearr(a, F));
        PHASE(11, { pg8::Gemm g{(const bf16*)(ws + WS_SCR + SD_UC), (const bf16*)(ws + WS_S5INC) + (size_t)l * 64 * 256 * 256, 512, 256, 256}; pg8::Order S;
                S.init(NCH_S5 / 256, 1, 64, G, cb, (size_t)256 * 512 * 2, (size_t)NCH_S5 * 512 * 2, 0, (size_t)256 * 256 * 2);
                EpiF32 E{(float*)(ws + WS_SCR + SD_INC), 256, (size_t)NCH_S5 * 256}; pg8::gemm_phase(lds, g, S, E, F.tid); });
        PHASE(12, ph_s5_scan(a, F, l));
        PHASE(13, { pg8::Gemm g{(const bf16*)(ws + WS_SCR + SD_UC), (const bf16*)(ws + WS_S5MAIN) + (size_t)l * 64 * 256 * 512, 512, 512, 512}; pg8::Order S;
                S.init(NCH_S5 / 256, 1, 64, G, cb, (size_t)256 * 512 * 2, (size_t)NCH_S5 * 512 * 2, 0, (size_t)256 * 512 * 2);
                EpiS5Main E{(bf16*)(ws + WS_SCR + SD_YG)}; pg8::gemm_phase(lds, g, S, E, F.tid); });
        PHASE(14, { pg8::Gemm g{(const bf16*)(ws + WS_SCR + SD_YG), (const bf16*)(ws + WS_GLUT) + (size_t)l * WB * WB, WB, WB, WB}; pg8::Order S; S.init(T / 256, WB / 256, 1, G, cb, (size_t)256 * WB * 2, 0, (size_t)256 * WB * 2, 0);
                EpiGlu E{(const bf16*)(ws + WS_SCR + SD_YG), (const bf16*)(ws + WS_PROJ), a.in(I_GLUB) + (size_t)l * WB, (bf16*)(ws + WS_Y)}; pg8::gemm_phase(lds, g, S, E, F.tid); });
        PHASE(15, ph_ret_kv(a, F));
        PHASE(16, ph_ret_scan(a, F));
        PHASE(25, { pg8::Gemm g{(const bf16*)(ws + WS_PROJ) + C_WDF, (const bf16*)(ws + WS_W2ALL) + (size_t)l * 3072 * 256, NPJ, 256, 256}; pg8::Order S; S.init(T / 256, 3072 / 256, 1, G, cb, (size_t)256 * NPJ * 2, 0, (size_t)256 * 256 * 2, 0);
                EpiBf16 E{(bf16*)(ws + WS_SCR + SB_LO), 3072, -1, nullptr}; pg8::gemm_phase(lds, g, S, E, F.tid); });
        PHASE(18, ph_rwkv_prep(a, F, l));
        PHASE(19, ph_rwkv_chunk(a, F));
        PHASE(20, { ph_rwkv_seq(a, F); ph_ret_out(a, F, l); });
        PHASE(24, ph_rwkv_out(a, F, l));
        PHASE(21, { { pg8::Gemm g{(const bf16*)(ws + WS_H), WALLT + (size_t)NPJ * D, D, D, D}; pg8::Order S; S.init(T / 256, 4 * D / 256, 1, G, cb, (size_t)256 * D * 2, 0, (size_t)256 * D * 2, 0);
                      EpiGate E{(bf16*)(ws + WS_SCR + SM_GS), rss_l}; pg8::gemm_phase(lds, g, S, E, F.tid); }
                    xcd_barrier(bar);
                    { pg8::Gemm g{(const bf16*)(ws + WS_Y), (const bf16*)(ws + WS_WBRT) + (size_t)l * D * 4096, 4096, 4096, WB}; pg8::Order S; S.init(T / 256, D / 256, 4, G, cb, (size_t)256 * 4096 * 2, (size_t)WB * 2, (size_t)256 * 4096 * 2, (size_t)WB * 2); S.zfast = 1;
                      EpiBranchAll E{(const bf16*)(ws + WS_SCR + SM_GS), (bf16*)(ws + WS_SCR + SM_MG)}; pg8::gemm_phase(lds, g, S, E, F.tid); } });
        PHASE(22, { pg8::Gemm g{(const bf16*)(ws + WS_SCR + SM_MG), (const bf16*)(ws + WS_WOUTT) + (size_t)l * D * D, D, D, D}; pg8::Order S; S.init(T / 256, D / 256, 1, G, cb, (size_t)256 * D * 2, 0, (size_t)256 * D * 2, 0);
#ifdef OUT_DRY
                { EpiNull E0; pg8::gemm_phase(lds, g, S, E0, F.tid); }
#endif
                EpiOut E{a.in(I_XP), a.in(I_XS), a.out, (bf16*)(ws + WS_H), (float*)(ws + WS_RSP), l == 0 ? 1 : 0}; pg8::gemm_phase(lds, g, S, E, F.tid); });
        PHASE(26, ph_rss(a, F, l));
#ifdef XTRA_BAR
        for (int xb = 0; xb < XTRA_BAR; ++xb) xcd_barrier(bar);
#endif
    }
    PHASE(23, ph_final(a, F));
#undef PHASE
}

extern "C" void kernel_launch(void* const* d_in, const int* in_sizes, int n_in, void* d_out, int out_size, void* d_ws, size_t ws_size, hipStream_t stream) {
    static int grid = 0;
    if (grid == 0) {
        if (n_in != 35 || out_size != T * D || ws_size < WS_END) { fprintf(stderr, "kernel_launch: unexpected shapes (n_in %d out %d ws %zu need %zu)\n", n_in, out_size, ws_size, (size_t)WS_END); grid = -1; return; }
        int dev = 0, cus = 0, per_cu = 0;
        if (hipGetDevice(&dev) != hipSuccess || hipDeviceGetAttribute(&cus, hipDeviceAttributeMultiprocessorCount, dev) != hipSuccess) { grid = -1; return; }
        if (hipFuncSetAttribute((const void*)fwd, hipFuncAttributeMaxDynamicSharedMemorySize, LDS_BYTES) != hipSuccess) { fprintf(stderr, "kernel_launch: hipFuncSetAttribute failed\n"); grid = -1; return; }
        if (hipOccupancyMaxActiveBlocksPerMultiprocessor(&per_cu, (const void*)fwd, NTHR, LDS_BYTES) != hipSuccess || per_cu < 1) fprintf(stderr, "kernel_launch: occupancy query says %d\n", per_cu);
        (void)hipGetLastError();
        grid = cus;
    }
    if (grid < 0) return;
    (void)hipMemsetAsync((char*)d_ws + WS_CTL, 0, CTL_BYTES, stream);
    Args a{};
    for (int i = 0; i < 35; ++i) a.in[i] = (const float*)d_in[i];
    a.out = (float*)d_out; a.ws = (unsigned char*)d_ws;
#if MK_ONE_LAUNCH
    a.ph_lo = 0; a.ph_hi = NPH;
    hipLaunchKernelGGL(fwd, dim3(grid), dim3(NTHR), LDS_BYTES, stream, a);
#else
    for (int p = 0; p < NPH; ++p) { a.ph_lo = p; a.ph_hi = p + 1; hipLaunchKernelGGL(fwd, dim3(grid), dim3(NTHR), LDS_BYTES, stream, a); }
#endif
}
```

```cpp
#include <hip/hip_runtime.h>
#include <cstdio>
#include <cstdint>

#ifndef MK_ONE_LAUNCH
#define MK_ONE_LAUNCH 1
#endif

#define LAS __attribute__((address_space(3)))
#define GAS __attribute__((address_space(1)))
typedef unsigned short bf16;
typedef short bf16x8 __attribute__((ext_vector_type(8)));
typedef float f32x4 __attribute__((ext_vector_type(4)));
typedef float f32x2 __attribute__((ext_vector_type(2)));
typedef unsigned u32x4 __attribute__((ext_vector_type(4)));
typedef unsigned u32x2 __attribute__((ext_vector_type(2)));

constexpr int T = 24576, TP = 16384, LS = 2048, D = 2048, WB = 1024, DEPTH = 4;
constexpr int NPJ = 11520, NIN = 19648, GOFF = 11456, NALL = 19712;
constexpr int C_LRUX = 0, C_LRUZ = 1024, C_RWR = 2048, C_RWK = 3072, C_RWV = 4096, C_WDF = 5120, C_WDB = 5184, C_AD = 5248, C_RWZ = 5312,
              C_RQ = 6336, C_RK = 6848, C_RV = 7360, C_RZ = 8384, C_SU = 9408, C_SZ = 10432;
constexpr int NCH_S5 = T / 16;
constexpr int NCH_RET = T / 128;
constexpr int NCH_LRU = T / 128;

constexpr size_t al(size_t x) { return (x + 0xFFFFFu) & ~(size_t)0xFFFFFu; }
constexpr size_t WS_CTL = 0, CTL_BYTES = 1u << 20;
constexpr size_t WS_WALLT = al(WS_CTL + CTL_BYTES);
constexpr size_t WS_LRUW  = al(WS_WALLT + (size_t)DEPTH * NALL * D * 2);
constexpr size_t WS_GLUT  = al(WS_LRUW + (size_t)DEPTH * 4096 * 256 * 2);
constexpr size_t WS_WBRT  = al(WS_GLUT + (size_t)DEPTH * 1024 * 1024 * 2);
constexpr size_t WS_WOUTT = al(WS_WBRT + (size_t)DEPTH * 2048 * 4096 * 2);
constexpr size_t WS_S5MAIN= al(WS_WOUTT + (size_t)DEPTH * 2048 * 2048 * 2);
constexpr size_t WS_S5INC = al(WS_S5MAIN + (size_t)DEPTH * 64 * 256 * 512 * 2);
constexpr size_t WS_S5TAB = al(WS_S5INC + (size_t)DEPTH * 64 * 256 * 256 * 2);
constexpr size_t WS_W2ALL = al(WS_S5TAB + (size_t)DEPTH * 2 * 64 * 64 * 33 * 8);
constexpr size_t WS_ROT   = al(WS_W2ALL + (size_t)DEPTH * 3072 * 256 * 2);
constexpr size_t WS_RSS   = al(WS_ROT + (size_t)16384 * 64 * 8);
constexpr size_t WS_RSP   = al(WS_RSS + (size_t)2 * T * 4);
constexpr size_t WS_H     = al(WS_RSP + (size_t)T * 32 * 4);
constexpr size_t WS_PROJ  = al(WS_H + (size_t)T * D * 2);
constexpr size_t WS_Y     = al(WS_PROJ + (size_t)T * NPJ * 2);
constexpr size_t WS_STP   = al(WS_Y + (size_t)T * 4096 * 2);
constexpr size_t WS_SCR   = al(WS_STP + (size_t)2 * 768 * 256 * 128 * 2);
constexpr size_t TW4 = (size_t)T * WB * 4, TW2 = (size_t)T * WB * 2;
constexpr int NCH_L32 = T / 32;
constexpr size_t SA_XC = 0, SA_LA = al(SA_XC + TW2), SA_BB = al(SA_LA + 2 * TW2), SA_PA = al(SA_BB + 2 * TW2),
                 SA_PB = al(SA_PA + (size_t)NCH_L32 * 2 * WB * 4), SA_CAR = al(SA_PB + (size_t)NCH_L32 * 2 * WB * 4), SA_END = al(SA_CAR + (size_t)NCH_L32 * 2 * WB * 4);
constexpr size_t SD_UC = 0, SD_INC = al(SD_UC + (size_t)64 * NCH_S5 * 512 * 2), SD_YG = al(SD_INC + (size_t)64 * NCH_S5 * 256 * 4), SD_END = al(SD_YG + TW2);
constexpr size_t SC_KVT = 0, SC_END = al(SC_KVT + (size_t)2 * 768 * 256 * 128 * 4);
constexpr size_t SB_R = 0, SB_KM = al(SB_R + TW2), SB_V = al(SB_KM + TW2), SB_KK = al(SB_V + TW2), SB_AG = al(SB_KK + TW2), SB_LWF = al(SB_AG + TW2), SB_LWB = al(SB_LWF + TW2),
                 SB_CH = al(SB_LWB + TW2), SB_SS = al(SB_CH + (size_t)(T / 64) * 16 * 2 * 4 * 4096 * 2), SB_END = al(SB_SS + (size_t)(T / 64) * 16 * 2 * 4096 * 2), SB_LO = SB_CH;
constexpr size_t SM_GS = 0, SM_MG = al(SM_GS + (size_t)T * 4 * D * 2), SM_END = al(SM_MG + (size_t)T * D * 2);
constexpr size_t cmax(size_t a, size_t b) { return a > b ? a : b; }
constexpr size_t SCR_BYTES = cmax(cmax(cmax(SA_END, SD_END), cmax(SC_END, SB_END)), SM_END);
constexpr size_t WS_END = WS_SCR + SCR_BYTES;
static_assert(WS_END < (size_t)2500 * 1000 * 1000, "workspace budget");

__device__ __forceinline__ float ld_agent(const float* p) { return __hip_atomic_load(p, __ATOMIC_RELAXED, __HIP_MEMORY_SCOPE_AGENT); }
__device__ __forceinline__ void st_agent(float* p, float v) { __hip_atomic_store(p, v, __ATOMIC_RELAXED, __HIP_MEMORY_SCOPE_AGENT); }
__device__ __forceinline__ int lane_id() { unsigned m = ~0u; asm volatile("" : "+s"(m)); return (int)__builtin_amdgcn_mbcnt_hi(m, __builtin_amdgcn_mbcnt_lo(m, 0u)); }
__device__ __forceinline__ float bf2f(bf16 b) { return __uint_as_float(((unsigned)b) << 16); }
typedef __bf16 hwbf16x2 __attribute__((ext_vector_type(2)));
__device__ __forceinline__ unsigned pk2(float lo, float hi) { const f32x2 v = {lo, hi}; return __builtin_bit_cast(unsigned, __builtin_convertvector(v, hwbf16x2)); }
__device__ __forceinline__ unsigned f2bf(float f) { return pk2(f, 0.f) & 0xffffu; }
__device__ __forceinline__ float sigmoidf_(float x) { return __builtin_amdgcn_rcpf(1.0f + __expf(-x)); }
__device__ __forceinline__ float siluf_(float x) { return x * __builtin_amdgcn_rcpf(1.0f + __expf(-x)); }
__device__ __forceinline__ float tanhf_(float x) { const float e = __expf(2.0f * fminf(fmaxf(x, -15.f), 15.f)); return 1.0f - 2.0f * __builtin_amdgcn_rcpf(e + 1.0f); }
__device__ __forceinline__ float softplusf_(float x) { return fmaxf(x, 0.f) + __logf(1.0f + __expf(-fabsf(x))); }
__device__ __forceinline__ float gelu_tanh(float x) { const float u = 0.7978845608028654f * (x + 0.044715f * x * x * x); const float e = __expf(2.f * u); const float th = 1.f - 2.f * __builtin_amdgcn_rcpf(e + 1.f); return 0.5f * x * (1.f + th); }
template <int O> __device__ __forceinline__ float shx(float v) {
    if constexpr (O < 32) return __int_as_float(__builtin_amdgcn_ds_swizzle(__float_as_int(v), (O << 10) | 0x1f));
    else { const int lane = lane_id(); return __int_as_float(__builtin_amdgcn_ds_bpermute((lane ^ O) << 2, __float_as_int(v))); }
}
__device__ __forceinline__ float wave_sum(float v) { v += shx<1>(v); v += shx<2>(v); v += shx<4>(v); v += shx<8>(v); v += shx<16>(v); v += shx<32>(v); return v; }
__device__ __forceinline__ void seq_of(int t, int& pos, int& L) { if (t < TP) { pos = t; L = TP; } else { pos = (t - TP) & (LS - 1); L = LS; } }
__device__ __forceinline__ void unpack8(const u32x4 w, float (&x)[8]) {
    x[0] = __uint_as_float(w.x << 16); x[1] = __uint_as_float(w.x & 0xffff0000u); x[2] = __uint_as_float(w.y << 16); x[3] = __uint_as_float(w.y & 0xffff0000u);
    x[4] = __uint_as_float(w.z << 16); x[5] = __uint_as_float(w.z & 0xffff0000u); x[6] = __uint_as_float(w.w << 16); x[7] = __uint_as_float(w.w & 0xffff0000u);
}
__device__ __forceinline__ u32x4 pack8(const float (&x)[8]) { u32x4 w; w.x = pk2(x[0], x[1]); w.y = pk2(x[2], x[3]); w.z = pk2(x[4], x[5]); w.w = pk2(x[6], x[7]); return w; }

namespace pg8 {
#define PG8_LAS __attribute__((address_space(3)))
typedef unsigned short bf16_t;
constexpr int BM = 256, BK = 64, HALF = 128, HTB = HALF * BK * 2, STAGE_BYTES = 8 * HTB, NXCD = 8, WGM = 4;
__host__ __device__ __forceinline__ int lds_byte(int r, int c) { const int st = (r >> 4) * 2 + (c >> 5), rr = r & 15, cc = c & 31, ob = rr * 64 + cc * 2; return st * 1024 + (ob ^ (((ob >> 9) & 1) << 5)); }
__host__ __device__ __forceinline__ void stage_rc(int b, int& R, int& C) { const int st = b / 1024, sb = b % 1024, swz = sb ^ (((sb >> 9) & 1) << 5); R = (st >> 1) * 16 + swz / 64; C = (st & 1) * 32 + (swz % 64) / 2; }
__host__ __device__ __forceinline__ int perm32(int rho) { const int n = rho >> 4, i = rho & 15; return 8 * (i >> 2) + 4 * n + (i & 3); }

struct Unit { int pm, pn, z; size_t aoff, boff; };
struct Gemm { const bf16_t* A; const bf16_t* Bt; int lda, ldb, K; };

struct Order {
    int nM, nN, nZ, G, c; size_t a_pm, a_z, b_pn, b_z; int kwin = 0; int zfast = 0;
    __device__ __forceinline__ void init(int nM_, int nN_, int nZ_, int G_, int c_, size_t a_pm_, size_t a_z_, size_t b_pn_, size_t b_z_) { nM = nM_; nN = nN_; nZ = nZ_; G = G_; c = c_; a_pm = a_pm_; a_z = a_z_; b_pn = b_pn_; b_z = b_z_; }
    __device__ __forceinline__ bool next(int i, Unit& u) const {
        const int nwg = nM * nN; int z, wgid;
        if (zfast) { const long L = (long)(i / nZ) * G + c; if (L >= (long)nwg) return false; z = i % nZ; wgid = (int)L; }
        else { const long L = (long)i * G + c; if (L >= (long)nwg * nZ) return false; z = (int)(L / nwg); wgid = (int)(L % nwg); }
        { const int q = nwg / NXCD, r = nwg % NXCD, xcd = wgid % NXCD, off = wgid / NXCD; wgid = (xcd < r ? xcd * (q + 1) : r * (q + 1) + (xcd - r) * q) + off; }
        const int nig = WGM * nN, gid = wgid / nig, fm = gid * WGM, gsz = (nM - fm) < WGM ? (nM - fm) : WGM;
        u.pm = fm + ((wgid % nig) % gsz); u.pn = (wgid % nig) / gsz; u.z = z;
        u.aoff = (size_t)u.pm * a_pm + (size_t)z * a_z + (size_t)(((u.pn & 7) >> 1) * kwin); u.boff = (size_t)u.pn * b_pn + (size_t)z * b_z; return true;
    }
};

template <class Epi>
__device__ __forceinline__ void gemm_phase(PG8_LAS unsigned char* lds, const Gemm g, const Order& S, const Epi& E, int tid_in) {
    int tid_ = tid_in; asm volatile("" : "+v"(tid_));
    const int tid = tid_, wid = __builtin_amdgcn_readfirstlane(tid >> 6), lane = tid & 63, wr = wid >> 2, wc = wid & 3, fr = lane & 15, fq = lane >> 4;
    const int K = g.K, nt = K / BK;
    unsigned voffA[2], voffB[2];
#pragma unroll
    for (int i = 0; i < 2; ++i) { int R, C; stage_rc(tid * 16 + i * 8192, R, C); const int Rb = Epi::PERM ? ((R & ~31) + perm32(R & 31)) : R;
        voffA[i] = (unsigned)(R * g.lda + C) * 2u; voffB[i] = (unsigned)(Rb * g.ldb + C) * 2u; }
    const size_t kstep = (size_t)(BK * 2);
    const size_t hstepA = (size_t)HALF * g.lda * 2, hstepB = (size_t)HALF * g.ldb * 2;
    const unsigned ldsw = (unsigned)wid * 1024u;
    const int aoff = lds_byte(wr * 64 + fr, fq * 8), boff = lds_byte(wc * 32 + fr, fq * 8);
#define PG8_SA(b, h) (((b) * 2 + (h)) * HTB)
#define PG8_SB(b, h) ((4 + (b) * 2 + (h)) * HTB)
#define PG8_STAGE(bufoff, gbase, voff) do { _Pragma("unroll") for (int _i = 0; _i < 2; ++_i) \
        __builtin_amdgcn_global_load_lds((const unsigned*)((const char*)(gbase) + (voff)[_i]), (PG8_LAS unsigned*)(lds + (bufoff) + ldsw + _i * 8192), 16, 0, 0); } while (0)
#define PG8_LDA(dst, b, h) do { _Pragma("unroll") for (int m = 0; m < 4; ++m) _Pragma("unroll") for (int k = 0; k < 2; ++k) dst[m][k] = *(const PG8_LAS bf16x8*)(lds + PG8_SA(b, h) + aoff + m * 2048 + k * 1024); } while (0)
#define PG8_LDB(dst, b, h) do { _Pragma("unroll") for (int n = 0; n < 2; ++n) _Pragma("unroll") for (int k = 0; k < 2; ++k) dst[n][k] = *(const PG8_LAS bf16x8*)(lds + PG8_SB(b, h) + boff + n * 2048 + k * 1024); } while (0)
#define PG8_MMA(ai, bj, At, Bt) do { __builtin_amdgcn_s_setprio(1); _Pragma("unroll") for (int m = 0; m < 4; ++m) _Pragma("unroll") for (int n = 0; n < 2; ++n) _Pragma("unroll") for (int k = 0; k < 2; ++k) \
        acc[ai][bj][m][n] = __builtin_amdgcn_mfma_f32_16x16x32_bf16(Bt[n][k], At[m][k], acc[ai][bj][m][n], 0, 0, 0); __builtin_amdgcn_s_setprio(0); } while (0)
#define PG8_WAIT_V(n) asm volatile("s_waitcnt vmcnt(" #n ")" ::: "memory")
#define PG8_WAIT_L(n) asm volatile("s_waitcnt lgkmcnt(" #n ")" ::: "memory")
#define PG8_BAR __builtin_amdgcn_s_barrier()
#define PG8_SCHED __builtin_amdgcn_sched_barrier(0)
    Unit cur, nxt; int ui = 0;
    if (!S.next(0, cur)) return;
    f32x4 acc[2][2][4][2];
#pragma unroll
    for (int a = 0; a < 2; ++a)
#pragma unroll
        for (int b = 0; b < 2; ++b)
#pragma unroll
            for (int m = 0; m < 4; ++m)
#pragma unroll
                for (int n = 0; n < 2; ++n) acc[a][b][m][n] = (f32x4){0.f, 0.f, 0.f, 0.f};
    const char* cA = (const char*)g.A + cur.aoff; const char* cB = (const char*)g.Bt + cur.boff;
    PG8_STAGE(PG8_SB(0, 0), cB, voffB); PG8_STAGE(PG8_SB(0, 1), cB + hstepB, voffB); PG8_STAGE(PG8_SA(0, 0), cA, voffA); PG8_STAGE(PG8_SA(0, 1), cA + hstepA, voffA);
    if (wr == 1) PG8_BAR;
    PG8_WAIT_V(2); PG8_BAR;
    PG8_STAGE(PG8_SB(1, 0), cB + kstep, voffB); PG8_STAGE(PG8_SA(1, 0), cA + kstep, voffA); PG8_STAGE(PG8_SB(1, 1), cB + hstepB + kstep, voffB);
    PG8_WAIT_V(6); PG8_BAR;
    for (;;) {
        const bool has_next = S.next(ui + 1, nxt);
        const char* nA = has_next ? (const char*)g.A + nxt.aoff : cA; const char* nB = has_next ? (const char*)g.Bt + nxt.boff : cB;
#pragma unroll 1
        for (int t = 0; t < nt; t += 2) {
            const bool last = (t == nt - 2);
            const char* a1 = cA + (size_t)(t + 1) * kstep;
            const char* a2 = last ? nA : cA + (size_t)(t + 2) * kstep; const char* b2 = last ? nB : cB + (size_t)(t + 2) * kstep;
            const char* a3 = a2 + kstep; const char* b3 = b2 + kstep;
            bf16x8 At[4][2], B0[2][2], B1[2][2];
            PG8_LDB(B0, 0, 0); PG8_LDB(B1, 0, 1); PG8_SCHED; PG8_LDA(At, 0, 0); PG8_STAGE(PG8_SA(1, 1), a1 + hstepA, voffA);
            PG8_WAIT_V(8); PG8_WAIT_L(0); PG8_BAR; PG8_MMA(0, 0, At, B0); PG8_MMA(0, 1, At, B1); PG8_BAR; PG8_SCHED;
            PG8_LDA(At, 0, 1); PG8_STAGE(PG8_SB(0, 0), b2, voffB); PG8_STAGE(PG8_SB(0, 1), b2 + hstepB, voffB); PG8_STAGE(PG8_SA(0, 0), a2, voffA);
            PG8_WAIT_V(8); PG8_WAIT_L(0); PG8_BAR; PG8_MMA(1, 0, At, B0); PG8_MMA(1, 1, At, B1); PG8_BAR; PG8_SCHED;
            PG8_LDB(B0, 1, 0); PG8_LDB(B1, 1, 1); PG8_SCHED; PG8_LDA(At, 1, 0); PG8_STAGE(PG8_SA(0, 1), a2 + hstepA, voffA);
            PG8_WAIT_V(8); PG8_WAIT_L(0); PG8_BAR; PG8_MMA(0, 0, At, B0); PG8_MMA(0, 1, At, B1); PG8_BAR; PG8_SCHED;
            PG8_LDA(At, 1, 1); PG8_STAGE(PG8_SB(1, 0), b3, voffB); PG8_STAGE(PG8_SB(1, 1), b3 + hstepB, voffB); PG8_STAGE(PG8_SA(1, 0), a3, voffA);
            PG8_WAIT_V(8); PG8_WAIT_L(0); PG8_BAR; PG8_MMA(1, 0, At, B0); PG8_MMA(1, 1, At, B1); PG8_BAR; PG8_SCHED;
        }
        if (wr == 0) PG8_BAR;
        asm volatile("" ::: "memory");
        { const int ln_ = lane_id(); E(acc, cur, wr, wc, ln_ & 15, ln_ >> 4); }
        asm volatile("" ::: "memory");
        if (!has_next) break;
        if (!(Epi::KEEP && cur.z + 1 < S.nZ)) {
#pragma unroll
        for (int a = 0; a < 2; ++a)
#pragma unroll
            for (int b = 0; b < 2; ++b)
#pragma unroll
                for (int m = 0; m < 4; ++m)
#pragma unroll
                    for (int n = 0; n < 2; ++n) acc[a][b][m][n] = (f32x4){0.f, 0.f, 0.f, 0.f}; }
        cur = nxt; cA = nA; cB = nB; ++ui;
        if (wr == 1) PG8_BAR;
    }
    PG8_WAIT_V(0);
    PG8_BAR;
#undef PG8_SA
#undef PG8_SB
#undef PG8_STAGE
#undef PG8_LDA
#undef PG8_LDB
#undef PG8_MMA
#undef PG8_WAIT_V
#undef PG8_WAIT_L
#undef PG8_BAR
#undef PG8_SCHED
}
}
using pg8::Unit; using pg8::HALF; using pg8::BM;
typedef f32x4 AccT[2][2][4][2];

struct EpiBf16 {
    static constexpr bool PERM = true, KEEP = false;
    bf16* O; int ldc; int tanh_pn;
    const float* rss;
    __device__ __forceinline__ void operator()(const AccT& acc, const Unit& u, int wr, int wc, int fr, int fq) const {
        const int row0 = u.pm * BM + wr * 64 + fr, col0 = u.pn * BM + wc * 32 + 8 * fq;
        float rsv[2][4];
#pragma unroll
        for (int ai = 0; ai < 2; ++ai)
#pragma unroll
            for (int m = 0; m < 4; ++m) rsv[ai][m] = rss ? rss[row0 + ai * HALF + m * 16] : 0.f;
#pragma unroll
        for (int ai = 0; ai < 2; ++ai)
#pragma unroll
            for (int m = 0; m < 4; ++m) { bf16* rowp = O + (size_t)(row0 + ai * HALF + m * 16) * ldc + col0; const float rs = rss ? __builtin_amdgcn_rsqf(rsv[ai][m] * (1.0f / D) + 1e-6f) : 1.0f;
#pragma unroll
                for (int bj = 0; bj < 2; ++bj) { f32x4 v0 = acc[ai][bj][m][0] * rs, v1 = acc[ai][bj][m][1] * rs;
                    if (bj == 0 && u.pn == tanh_pn) {
#pragma unroll
                        for (int j = 0; j < 4; ++j) { v0[j] = tanhf_(v0[j]); v1[j] = tanhf_(v1[j]); } }
                    u32x4 w; w.x = pk2(v0[0], v0[1]); w.y = pk2(v0[2], v0[3]); w.z = pk2(v1[0], v1[1]); w.w = pk2(v1[2], v1[3]);
                    *(u32x4*)(rowp + bj * HALF) = w; } }
    }
};
struct EpiF32 {
    static constexpr bool PERM = false, KEEP = false;
    float* C; int ldc; size_t zstride;
    __device__ __forceinline__ void operator()(const AccT& acc, const Unit& u, int wr, int wc, int fr, int fq) const {
        const int row0 = u.pm * BM + wr * 64 + fr, col0 = u.pn * BM + wc * 32 + 4 * fq; float* Cz = C + (size_t)u.z * zstride;
#pragma unroll
        for (int ai = 0; ai < 2; ++ai)
#pragma unroll
            for (int m = 0; m < 4; ++m) { float* rowp = Cz + (size_t)(row0 + ai * HALF + m * 16) * ldc + col0;
#pragma unroll
                for (int bj = 0; bj < 2; ++bj)
#pragma unroll
                    for (int n = 0; n < 2; ++n) *(f32x4*)(rowp + bj * HALF + n * 16) = acc[ai][bj][m][n]; }
    }
};
struct EpiLru {
    static constexpr bool PERM = false, KEEP = false;
    const float *b_r, *b_i, *lam;
    const bf16* XC; bf16* LA; bf16* BB;
    __device__ __forceinline__ void operator()(const AccT& acc, const Unit& u, int wr, int wc, int fr, int fq) const {
        const int d = u.pn >> 3, h = u.pn & 7; const int row0 = u.pm * BM + wr * 64 + fr;
#pragma unroll
        for (int n = 0; n < 2; ++n) { const int ch0 = h * 128 + wc * 32 + n * 16 + fq * 4; float br[4], bi[4], sp[4];
#pragma unroll
            for (int j = 0; j < 4; ++j) { br[j] = b_r[d * WB + ch0 + j]; bi[j] = b_i[d * WB + ch0 + j]; sp[j] = -8.0f * softplusf_(-lam[d * WB + ch0 + j]); }
            u32x2 xwv[2][4];
#pragma unroll
            for (int ai = 0; ai < 2; ++ai)
#pragma unroll
                for (int m = 0; m < 4; ++m) xwv[ai][m] = *(const u32x2*)(XC + (size_t)(row0 + ai * HALF + m * 16) * WB + ch0);
#pragma unroll
            for (int ai = 0; ai < 2; ++ai)
#pragma unroll
                for (int m = 0; m < 4; ++m) { const int t = row0 + ai * HALF + m * 16; int pos, L; seq_of(t, pos, L); const bool first = (d == 0) ? (pos == 0) : (pos == L - 1);
                    const f32x4 ar = acc[ai][0][m][n], aiq = acc[ai][1][m][n];
                    const u32x2 xw = xwv[ai][m];
                    const float xc[4] = {__uint_as_float(xw.x << 16), __uint_as_float(xw.x & 0xffff0000u), __uint_as_float(xw.y << 16), __uint_as_float(xw.y & 0xffff0000u)};
                    float oa[4], ob[4];
#pragma unroll
                    for (int j = 0; j < 4; ++j) { const float rg = sigmoidf_(ar[j] + br[j]), ig = sigmoidf_(aiq[j] + bi[j]); const float la = rg * sp[j];
                        float mult = __builtin_amdgcn_sqrtf(fmaxf(1.0f - __expf(2.0f * la), 0.f)); if (first) mult = 1.0f; oa[j] = la; ob[j] = mult * ig * xc[j]; }
                    u32x2 wa, wb; wa.x = pk2(oa[0], oa[1]); wa.y = pk2(oa[2], oa[3]); wb.x = pk2(ob[0], ob[1]); wb.y = pk2(ob[2], ob[3]);
                    *(u32x2*)(LA + ((size_t)d * T + t) * WB + ch0) = wa; *(u32x2*)(BB + ((size_t)d * T + t) * WB + ch0) = wb; } }
    }
};
struct EpiS5Main {
    static constexpr bool PERM = true, KEEP = false;
    bf16* YG;
    __device__ __forceinline__ void operator()(const AccT& acc, const Unit& u, int wr, int wc, int fr, int fq) const {
        const int row0 = u.pm * BM + wr * 64 + fr; const int g = u.z;
#pragma unroll
        for (int ai = 0; ai < 2; ++ai)
#pragma unroll
            for (int m = 0; m < 4; ++m) { const int c = row0 + ai * HALF + m * 16;
#pragma unroll
                for (int bj = 0; bj < 2; ++bj) { const int cc = bj * HALF + wc * 32 + 8 * fq; const int tau = cc >> 4, p0 = cc & 15; const f32x4 v0 = acc[ai][bj][m][0], v1 = acc[ai][bj][m][1];
                    u32x4 w; w.x = pk2(gelu_tanh(v0[0]), gelu_tanh(v0[1])); w.y = pk2(gelu_tanh(v0[2]), gelu_tanh(v0[3])); w.z = pk2(gelu_tanh(v1[0]), gelu_tanh(v1[1])); w.w = pk2(gelu_tanh(v1[2]), gelu_tanh(v1[3]));
                    *(u32x4*)(YG + (size_t)(c * 16 + tau) * WB + g * 16 + p0) = w; } }
    }
};
struct EpiGlu {
    static constexpr bool PERM = true, KEEP = false;
    const bf16* YG; const bf16* PROJ; const float* glu_b; bf16* Y;
    __device__ __forceinline__ void operator()(const AccT& acc, const Unit& u, int wr, int wc, int fr, int fq) const {
        const int row0 = u.pm * BM + wr * 64 + fr, col0 = u.pn * BM + wc * 32 + 8 * fq;
#pragma unroll
        for (int ai = 0; ai < 2; ++ai)
#pragma unroll
            for (int m = 0; m < 4; m += 2) { u32x4 ygw[2][2], zzw[2][2];
#pragma unroll
              for (int mm = 0; mm < 2; ++mm)
#pragma unroll
                for (int bj = 0; bj < 2; ++bj) { const int t = row0 + ai * HALF + (m + mm) * 16, col = col0 + bj * HALF; ygw[mm][bj] = *(const u32x4*)(YG + (size_t)t * WB + col); zzw[mm][bj] = *(const u32x4*)(PROJ + (size_t)t * NPJ + C_SZ + col); }
#pragma unroll
              for (int mm = 0; mm < 2; ++mm) { const int t = row0 + ai * HALF + (m + mm) * 16;
#pragma unroll
                for (int bj = 0; bj < 2; ++bj) { const int col = col0 + bj * HALF; const f32x4 v0 = acc[ai][bj][m + mm][0], v1 = acc[ai][bj][m + mm][1];
                    float yg[8], zz[8], o[8]; unpack8(ygw[mm][bj], yg); unpack8(zzw[mm][bj], zz);
                    const f32x4 b0 = *(const f32x4*)(glu_b + col), b1 = *(const f32x4*)(glu_b + col + 4);
#pragma unroll
                    for (int j = 0; j < 4; ++j) { o[j] = yg[j] * sigmoidf_(v0[j] + b0[j]) * siluf_(zz[j]); o[4 + j] = yg[4 + j] * sigmoidf_(v1[j] + b1[j]) * siluf_(zz[4 + j]); }
                    *(u32x4*)(Y + (size_t)t * 4096 + 3072 + col) = pack8(o); } } }
    }
};
struct EpiGate {
    static constexpr bool PERM = false, KEEP = false;
    bf16* GR; const float* rss;
    __device__ __forceinline__ void operator()(const AccT& acc, const Unit& u, int wr, int wc, int fr, int fq) const {
        const int row0 = u.pm * BM + wr * 64 + fr, ch0 = u.pn * 64 + wc * 16 + 4 * fq;
        float rsv[2][4];
#pragma unroll
        for (int ai = 0; ai < 2; ++ai)
#pragma unroll
            for (int m = 0; m < 4; ++m) rsv[ai][m] = rss[row0 + ai * HALF + m * 16];
#pragma unroll
        for (int ai = 0; ai < 2; ++ai)
#pragma unroll
            for (int m = 0; m < 4; ++m) { const size_t t = (size_t)(row0 + ai * HALF + m * 16); const float rs = __builtin_amdgcn_rsqf(rsv[ai][m] * (1.0f / D) + 1e-6f);
                float e1[4][4], g[4][4];
#pragma unroll
                for (int z = 0; z < 4; ++z) { const f32x4 v = acc[ai][z >> 1][m][z & 1] * rs;
#pragma unroll
                    for (int j = 0; j < 4; ++j) { e1[z][j] = 1.0f + __expf(-__builtin_amdgcn_fmed3f(v[j], -30.0f, 30.0f)); g[z][j] = __builtin_amdgcn_rcpf(e1[z][j]); } }
#pragma unroll
                for (int z = 0; z < 4; ++z) { float f[4];
#pragma unroll
                    for (int j = 0; j < 4; ++j) f[j] = z < 3 ? g[z][j] * e1[z + 1][j] : g[3][j];
                    u32x2 w; w.x = pk2(f[0], f[1]); w.y = pk2(f[2], f[3]); *(u32x2*)(GR + ((size_t)z * T + t) * D + ch0) = w; } }
    }
};
struct EpiBranchAll {
    static constexpr bool PERM = false, KEEP = true;
    const bf16* GR; bf16* MG;
    __device__ __forceinline__ void operator()(AccT& acc, const Unit& u, int wr, int wc, int fr, int fq) const {
        const int row0 = u.pm * BM + wr * 64 + fr, col0 = u.pn * BM + wc * 32 + 4 * fq; const int z = u.z;
#pragma unroll
        for (int ai = 0; ai < 2; ++ai)
          { u32x2 gv[4][2][2];
#pragma unroll
            for (int m = 0; m < 4; ++m)
#pragma unroll
                for (int bj = 0; bj < 2; ++bj)
#pragma unroll
                    for (int n = 0; n < 2; ++n) gv[m][bj][n] = *(const u32x2*)(GR + ((size_t)z * T + (size_t)(row0 + ai * HALF + m * 16)) * D + col0 + bj * HALF + n * 16);
#pragma unroll
            for (int m = 0; m < 4; ++m) { const size_t t = (size_t)(row0 + ai * HALF + m * 16);
#pragma unroll
                for (int bj = 0; bj < 2; ++bj)
#pragma unroll
                    for (int n = 0; n < 2; ++n) { const int o = bj * HALF + n * 16; const u32x2 g0 = gv[m][bj][n]; f32x4& a = acc[ai][bj][m][n];
                        a[0] *= __uint_as_float(g0.x << 16); a[1] *= __uint_as_float(g0.x & 0xffff0000u); a[2] *= __uint_as_float(g0.y << 16); a[3] *= __uint_as_float(g0.y & 0xffff0000u);
                        if (z == 3) { u32x2 w; w.x = pk2(a[0], a[1]); w.y = pk2(a[2], a[3]); *(u32x2*)(MG + t * D + col0 + o) = w; } } } }
    }
};
struct EpiOut {
    static constexpr bool PERM = false, KEEP = false;
    const float* xp; const float* xs; float* out; bf16* XB; float* rsp; int first;
    __device__ __forceinline__ void operator()(const AccT& acc, const Unit& u, int wr, int wc, int fr, int fq) const {
        const int row0 = u.pm * BM + wr * 64 + fr, col0 = u.pn * BM + wc * 32 + 4 * fq;
#pragma unroll
        for (int ai = 0; ai < 2; ++ai)
#pragma unroll
            for (int m2 = 0; m2 < 4; m2 += 2) { f32x4 sv[2][2][2];
#pragma unroll
              for (int mm = 0; mm < 2; ++mm) { const int t = row0 + ai * HALF + (m2 + mm) * 16; const size_t ro = (size_t)t * D + col0; const float* src = first ? (t < TP ? xp + ro : xs + (ro - (size_t)TP * D)) : out + ro;
#pragma unroll
                for (int bj = 0; bj < 2; ++bj)
#pragma unroll
                    for (int n = 0; n < 2; ++n) sv[mm][bj][n] = *(const f32x4*)(src + bj * HALF + n * 16); }
#pragma unroll
              for (int mm = 0; mm < 2; ++mm) { const int m = m2 + mm; const int t = row0 + ai * HALF + m * 16; const size_t ro = (size_t)t * D + col0; float ss = 0.f;
#pragma unroll
                for (int bj = 0; bj < 2; ++bj)
#pragma unroll
                    for (int n = 0; n < 2; ++n) { const int o = bj * HALF + n * 16; const f32x4 v = sv[mm][bj][n] + acc[ai][bj][m][n]; *(f32x4*)(out + ro + o) = v;
                        u32x2 w; w.x = pk2(v[0], v[1]); w.y = pk2(v[2], v[3]); *(u32x2*)(XB + ro + o) = w; ss += (v[0] * v[0] + v[1] * v[1]) + (v[2] * v[2] + v[3] * v[3]); }
                ss += shx<16>(ss); ss += shx<32>(ss);
                if (fq == 0) rsp[(size_t)t * 32 + u.pn * 4 + wc] = ss; } }
    }
};

struct EpiNull { static constexpr bool PERM = false, KEEP = false; __device__ __forceinline__ void operator()(const AccT&, const Unit&, int, int, int, int) const {} };
#define XB_TMO      128
#define XB_XCNT(j)  (256  + 64 * (j))
#define XB_XSUB(j)  (1280 + 64 * (j))
#define XB_XGEN(j)  (2304 + 64 * (j))
#define XB_TOP      3328
#define XB_TOPGEN   3392
#define XCD_BAR_WORDS 3456
#define XB_SPIN_CAP (1u << 24)
__device__ __forceinline__ unsigned xb_ld(unsigned* p)              { return __hip_atomic_load(p, __ATOMIC_RELAXED, __HIP_MEMORY_SCOPE_AGENT); }
__device__ __forceinline__ unsigned xb_add(unsigned* p, unsigned v) { return __hip_atomic_fetch_add(p, v, __ATOMIC_RELAXED, __HIP_MEMORY_SCOPE_AGENT); }
__device__ __forceinline__ unsigned xb_xcc_id() { return (unsigned)__builtin_amdgcn_s_getreg((3 << 11) | 20) & 0xFu; }
#define XB_SPIN(cond, bar) do { unsigned _sp = 0; while (cond) { __builtin_amdgcn_s_sleep(1); \
    if ((++_sp & 255u) == 0u) { if (xb_ld(&(bar)[XB_TMO])) break; if (_sp > XB_SPIN_CAP) { atomicAdd(&(bar)[XB_TMO], 1u); break; } } } } while (0)
struct XcdBarrier { unsigned* bar; unsigned x; volatile LAS unsigned* st; int wave; };
__device__ __forceinline__ XcdBarrier xcd_barrier_post(unsigned* bar, volatile LAS unsigned* st) {
    XcdBarrier b; b.bar = bar; b.x = xb_xcc_id(); b.st = st;
    if (threadIdx.x == 0) (void)xb_add(&bar[XB_XCNT(b.x)], 1u);
    return b;
}
__device__ __forceinline__ void xcd_barrier_complete(unsigned* bar, unsigned x, unsigned& nloc, unsigned& nx) {
    const unsigned G = gridDim.x * gridDim.y * gridDim.z;
    unsigned sum, cnt, mine, sp = 0u;
    for (;;) {
        sum = 0u; cnt = 0u; mine = 0u;
#pragma unroll 1
        for (unsigned j = 0; j < 16; ++j) { const unsigned c = xb_ld(&bar[XB_XCNT(j)]); sum += c; cnt += (c > 0u) ? 1u : 0u; mine = (j == x) ? c : mine; }
        if (sum == G) break;
        __builtin_amdgcn_s_sleep(1);
        if ((++sp & 255u) == 0u) { if (xb_ld(&bar[XB_TMO])) break; if (sp > XB_SPIN_CAP) { atomicAdd(&bar[XB_TMO], 1u); break; } }
    }
    nloc = mine > 0u ? mine : 1u; nx = cnt > 0u ? cnt : 1u;
}
__device__ __forceinline__ void xcd_barrier(const XcdBarrier& b) {
    asm volatile("s_waitcnt vmcnt(0)" ::: "memory");
    __syncthreads();
    if (b.wave == 0 && lane_id() == 0) {
        unsigned* bar = b.bar;
        __builtin_amdgcn_s_waitcnt(0);
        unsigned nloc = b.st[0], nx = b.st[1];
        if (nloc == 0u) { xcd_barrier_complete(bar, b.x, nloc, nx); b.st[0] = nloc; b.st[1] = nx; }
        const unsigned old = xb_add(&bar[XB_XSUB(b.x)], 1u);
        const unsigned gen = old / nloc;
        if (old + 1u == (gen + 1u) * nloc) {
            __builtin_amdgcn_fence(__ATOMIC_RELEASE, "agent");
            asm volatile("s_waitcnt vmcnt(0)" ::: "memory");
            const unsigned og = xb_add(&bar[XB_TOP], 1u);
            const unsigned tg = og / nx;
            if (og + 1u == (tg + 1u) * nx) xb_add(&bar[XB_TOPGEN], 1u);
            else XB_SPIN(xb_ld(&bar[XB_TOPGEN]) == tg, bar);
            __builtin_amdgcn_fence(__ATOMIC_ACQUIRE, "agent");
            xb_add(&bar[XB_XGEN(b.x)], 1u);
            asm volatile("s_waitcnt vmcnt(0)" ::: "memory");
        } else {
            XB_SPIN(xb_ld(&bar[XB_XGEN(b.x)]) == gen, bar);
            __builtin_amdgcn_fence(__ATOMIC_ACQUIRE, "agent");
            asm volatile("s_waitcnt vmcnt(0)" ::: "memory");
        }
    }
    __syncthreads();
}
constexpr int NWAVES = 8, NTHR = 512;
constexpr int LDS_BYTES = 147456;
constexpr int LDS_MISC = LDS_BYTES - 256;
struct Args { const float* in[35]; float* out; unsigned char* ws; int ph_lo, ph_hi; };
constexpr int LDS_ARGS = LDS_BYTES - 1024;
struct AP { const LAS unsigned long long* q; unsigned char* ws; float* out;
    __device__ __forceinline__ const float* in(int i) const { const unsigned long long v = q[i]; const unsigned lo = __builtin_amdgcn_readfirstlane((unsigned)v), hi = __builtin_amdgcn_readfirstlane((unsigned)(v >> 32)); return (const float*)(((unsigned long long)hi << 32) | lo); } };
struct Frame { LAS unsigned char* lds; int tid, lane, wave, gw, ngw, gt, ngt; };
enum { I_XP = 0, I_XS, I_NORMG, I_WIN, I_CONVW, I_CONVB, I_WR, I_BR, I_WI, I_BI, I_LAM, I_MU, I_W0, I_W2, I_A0, I_A2, I_KK, I_KA, I_RK, I_LNG, I_LNB, I_GNG,
       I_SLRE, I_SLIM, I_SLOG, I_SBRE, I_SBIM, I_SCRE, I_SCIM, I_SD, I_GLUW, I_GLUB, I_WBR, I_WOUT, I_FING };

__device__ __forceinline__ float sin_rev(float x) { return __builtin_amdgcn_sinf(x); }
__device__ __forceinline__ float cos_rev(float x) { return __builtin_amdgcn_cosf(x); }
__device__ __forceinline__ f32x2 cexp_pow(float lre, float lim, float st, int k) {
    const float mag = __expf((float)k * lre * st); double ph = (double)k * (double)lim * (double)st * 0.15915494309189535; ph -= rint(ph);
    const float f = (float)ph; return (f32x2){mag * cos_rev(f), mag * sin_rev(f)};
}

__device__ __forceinline__ void ph_tables(const AP& a, const Frame& F) {
    f32x2* TAB = (f32x2*)(a.ws + WS_S5TAB); f32x2* ROT = (f32x2*)(a.ws + WS_ROT);
    for (int i = F.gt; i < DEPTH * 2 * 64 * 64; i += F.ngt) {
        const float lre = fminf(a.in(I_SLRE)[i], -1e-4f), lim = a.in(I_SLIM)[i]; const float st = __expf(a.in(I_SLOG)[i >> 6]);
        const f32x2 p1 = cexp_pow(lre, lim, st, 1); const float nr = p1.x - 1.f, ni = p1.y, den = lre * lre + lim * lim;
        const float gr = (nr * lre + ni * lim) / den, gi = (ni * lre - nr * lim) / den;
        for (int k = 0; k <= 16; ++k) { const f32x2 p = cexp_pow(lre, lim, st, k); TAB[(size_t)i * 33 + 16 + k] = p; if (k < 16) TAB[(size_t)i * 33 + k] = (f32x2){p.x * gr - p.y * gi, p.x * gi + p.y * gr}; }
    }
    for (int i = F.gt; i < 16384 * 64; i += F.ngt) { const int pos = i >> 6, j = i & 63;
        const double inv = exp(-(double)j * (9.210340371976184 / 64.0)); double ph = (double)pos * inv * 0.15915494309189535; ph -= rint(ph); const float f = (float)ph;
        ROT[i] = (f32x2){cos_rev(f), sin_rev(f)}; }
}
struct TrItem { const float* W; int ldw; bf16* WT; int ldt, k0, n0, drow0, dcol0; const float* ksc; int gmap; };
__device__ __forceinline__ TrItem tr_decode(const AP& a, int it) {
    bf16* WALLT = (bf16*)(a.ws + WS_WALLT); bf16* GLUT = (bf16*)(a.ws + WS_GLUT); bf16* WBRT = (bf16*)(a.ws + WS_WBRT); bf16* WOUTT = (bf16*)(a.ws + WS_WOUTT);
    constexpr int I_IN = 32 * (NIN / 32), I_GL = 16 * 32, I_BRI = 16 * 64, I_OUT = 32 * 64, PER = I_IN + I_GL + 4 * I_BRI + I_OUT;
    const int l = it / PER; int r = it % PER; TrItem d;
    if (r < I_IN) { const int kb = r / (NIN / 32), nb = r % (NIN / 32), n0 = nb * 32; d = TrItem{a.in(I_WIN) + (size_t)l * D * NIN, NIN, WALLT + (size_t)l * NALL * D, D, kb * 64, n0, 0, 0, a.in(I_NORMG) + (size_t)l * D, n0 >= GOFF ? 1 : 0}; return d; } r -= I_IN;
    if (r < I_GL) { const int kb = r / 32, nb = r % 32; d = TrItem{a.in(I_GLUW) + (size_t)l * WB * WB, WB, GLUT + (size_t)l * WB * WB, WB, kb * 64, nb * 32, 0, 0, nullptr, 0}; return d; } r -= I_GL;
    if (r < 4 * I_BRI) { const int br = r / I_BRI, q = r % I_BRI, kb = q / 64, nb = q % 64; d = TrItem{a.in(I_WBR) + ((size_t)l * 4 + br) * WB * D, D, WBRT + (size_t)l * D * 4096, 4096, kb * 64, nb * 32, 0, br * WB, nullptr, 0}; return d; } r -= 4 * I_BRI;
    { const int kb = r / 64, nb = r % 64; d = TrItem{a.in(I_WOUT) + (size_t)l * D * D, D, WOUTT + (size_t)l * D * D, D, kb * 64, nb * 32, 0, 0, nullptr, 0}; return d; }
}
__device__ __forceinline__ void tr_load(const TrItem& d, float (&x)[32], int lane) {
#pragma unroll
    for (int i = 0; i < 32; ++i) { const int kk = 2 * i + (lane >> 5); x[i] = d.W[(size_t)(d.k0 + kk) * d.ldw + d.n0 + (lane & 31)] * (d.ksc ? d.ksc[d.k0 + kk] : 1.0f); }
}
__device__ __forceinline__ void tr_store(const TrItem& d, const float (&x)[32], LAS float* scr, int lane) {
#pragma unroll
    for (int i = 0; i < 32; ++i) { const int kk = 2 * i + (lane >> 5); scr[kk * 33 + (lane & 31)] = x[i]; }
    asm volatile("s_waitcnt lgkmcnt(0)" ::: "memory");
    const int c = lane & 7;
#pragma unroll
    for (int j = 0; j < 4; ++j) { const int n = (lane >> 3) + 8 * j; const LAS float* s = scr + (8 * c) * 33 + n;
        u32x4 o; o.x = pk2(s[0 * 33], s[1 * 33]); o.y = pk2(s[2 * 33], s[3 * 33]); o.z = pk2(s[4 * 33], s[5 * 33]); o.w = pk2(s[6 * 33], s[7 * 33]);
        int drow = d.drow0 + d.n0 + n;
        if (d.gmap) { const int g0 = d.n0 + n - GOFF, z = g0 >> 11, nn = g0 & 2047, gp = nn >> 6, nl = nn & 63;
            drow = NPJ + gp * 256 + 128 * (z >> 1) + 16 * (z & 1) + 32 * (nl >> 4) + (nl & 15); }
        *(u32x4*)(d.WT + (size_t)drow * d.ldt + d.dcol0 + d.k0 + 8 * c) = o; }
    asm volatile("s_waitcnt lgkmcnt(0)" ::: "memory");
}
__device__ __forceinline__ void ph_convert(const AP& a, const Frame& F) {
    LAS float* scr = (LAS float*)(F.lds + F.wave * 16384);
    bf16* WALLT = (bf16*)(a.ws + WS_WALLT);
    constexpr int PERI = 32 * (NIN / 32) + 16 * 32 + 4 * 16 * 64 + 32 * 64; const int NIT = DEPTH * PERI;
    { float xa[32], xb[32]; int it = F.gw;
      if (it < NIT) { TrItem da = tr_decode(a, it); tr_load(da, xa, F.lane);
          for (;;) { const int itb = it + F.ngw; TrItem db; const bool hb = itb < NIT; if (hb) { db = tr_decode(a, itb); tr_load(db, xb, F.lane); }
              tr_store(da, xa, scr, F.lane); if (!hb) break;
              const int ita = itb + F.ngw; const bool ha = ita < NIT; if (ha) { da = tr_decode(a, ita); tr_load(da, xa, F.lane); }
              tr_store(db, xb, scr, F.lane); if (!ha) break; it = ita; } } }
    for (int i = F.gt; i < DEPTH * 64 * (D / 8); i += F.ngt) { const int l = i / (64 * (D / 8)), r = (i / (D / 8)) % 64, c8 = i % (D / 8); *(u32x4*)(WALLT + ((size_t)l * NALL + GOFF + r) * D + c8 * 8) = (u32x4){0u, 0u, 0u, 0u}; }
    bf16* LRUW = (bf16*)(a.ws + WS_LRUW);
    for (int i = F.gt; i < DEPTH * 4096 * 32; i += F.ngt) { const int k8 = i & 31, n = (i >> 5) & 4095, l = i >> 17; const int pn = n >> 8, d = pn >> 3, h = pn & 7, gate = (n >> 7) & 1, j = n & 127;
        u32x4 o = (u32x4){0u, 0u, 0u, 0u};
        if ((k8 >> 4) == (h & 1)) { const float* w = (gate ? a.in(I_WI) : a.in(I_WR)) + ((((size_t)l * 2 + d) * 8 + h) * 128) * 128 + j; const int i0 = (k8 & 15) * 8; float x[8];
#pragma unroll
            for (int q = 0; q < 8; ++q) x[q] = w[(size_t)(i0 + q) * 128]; o = pack8(x); }
        *(u32x4*)(LRUW + ((size_t)l * 4096 + n) * 256 + k8 * 8) = o; }
    bf16* W2ALL = (bf16*)(a.ws + WS_W2ALL);
    for (int i = F.gt; i < DEPTH * 3072 * 32; i += F.ngt) { const int k8 = i & 31, n = (i >> 5) % 3072, l = (i >> 5) / 3072; const int blk = n >> 10, c = n & 1023; u32x4 o = (u32x4){0u, 0u, 0u, 0u};
        if ((k8 >> 3) == blk) { const int j0 = (k8 & 7) * 8; const float* w = blk < 2 ? a.in(I_W2) + (((size_t)l * 2 + blk) * 64 + j0) * WB + c : a.in(I_A2) + ((size_t)l * 64 + j0) * WB + c; float x[8];
#pragma unroll
            for (int q = 0; q < 8; ++q) x[q] = w[(size_t)q * WB]; o = pack8(x); }
        *(u32x4*)(W2ALL + ((size_t)l * 3072 + n) * 256 + k8 * 8) = o; }
    float* KTAB = (float*)(a.ws + WS_PROJ); const f32x2* TAB = (const f32x2*)(a.ws + WS_S5TAB);
    for (int i = F.gt; i < DEPTH * 64 * 2 * 16 * 16; i += F.ngt) { const int p = i & 15, dl = (i >> 4) & 15, dir = (i >> 8) & 1, g = (i >> 9) & 63, l = i >> 15;
        const float* cre = a.in(I_SCRE) + (((size_t)l * 64 + g) * 16 + p) * 64; const float* cim = a.in(I_SCIM) + (((size_t)l * 64 + g) * 16 + p) * 64;
        const float* bre = a.in(I_SBRE) + ((size_t)l * 64 + g) * 64 * 16; const float* bim = a.in(I_SBIM) + ((size_t)l * 64 + g) * 64 * 16;
        const f32x2* tb = TAB + ((((size_t)l * 2 + dir) * 64 + g) * 64) * 33 + dl; f32x4 s[4] = {(f32x4){0.f, 0.f, 0.f, 0.f}, (f32x4){0.f, 0.f, 0.f, 0.f}, (f32x4){0.f, 0.f, 0.f, 0.f}, (f32x4){0.f, 0.f, 0.f, 0.f}};
        for (int n = 0; n < 64; ++n) { const f32x2 gk = tb[(size_t)n * 33]; const float cr = cre[n], ci = cim[n]; const float zr = cr * gk.x - ci * gk.y, zi = cr * gk.y + ci * gk.x;
#pragma unroll
            for (int q4 = 0; q4 < 4; ++q4) { const f32x4 br = *(const f32x4*)(bre + n * 16 + q4 * 4), bi = *(const f32x4*)(bim + n * 16 + q4 * 4); s[q4] += br * zr - bi * zi; } }
        float* o = KTAB + ((((size_t)(l * 64 + g) * 2 + dir) * 16 + dl) * 16 + p) * 16;
#pragma unroll
        for (int q4 = 0; q4 < 4; ++q4) *(f32x4*)(o + q4 * 4) = s[q4]; }
}
__device__ __forceinline__ void ph_s5mats(const AP& a, const Frame& F) {
    const float* KTAB = (const float*)(a.ws + WS_PROJ); const f32x2* TAB = (const f32x2*)(a.ws + WS_S5TAB);
    bf16* MAIN = (bf16*)(a.ws + WS_S5MAIN); bf16* INCM = (bf16*)(a.ws + WS_S5INC);
    for (int i = F.gt; i < DEPTH * 64 * 256 * 64; i += F.ngt) { const int c8 = i & 63, row = (i >> 6) & 255, g = (i >> 14) & 63, l = i >> 20; const int tau = row >> 4, p = row & 15; float x[8];
        if (c8 < 32) { const int sg = c8 >> 1, q0 = (c8 & 1) * 8; const float* kb = KTAB + ((size_t)l * 64 + g) * 2 * 16 * 256;
            if (sg < tau) { const float* k = kb + ((0 * 16 + (tau - sg)) * 16 + p) * 16 + q0;
#pragma unroll
                for (int q = 0; q < 8; ++q) x[q] = k[q]; }
            else if (sg > tau) { const float* k = kb + ((1 * 16 + (sg - tau)) * 16 + p) * 16 + q0;
#pragma unroll
                for (int q = 0; q < 8; ++q) x[q] = k[q]; }
            else { const float* k0 = kb + ((0 * 16 + 0) * 16 + p) * 16 + q0; const float* k1 = kb + ((1 * 16 + 0) * 16 + p) * 16 + q0; const float dsk = a.in(I_SD)[(size_t)l * WB + g * 16 + p];
#pragma unroll
                for (int q = 0; q < 8; ++q) x[q] = k0[q] + k1[q] + ((q0 + q) == p ? dsk : 0.f); }
        } else { const int part = (c8 - 32) >> 3, n0 = ((c8 - 32) & 7) * 8, dir = part >> 1; const int k = dir == 0 ? (tau + 1) : (16 - tau);
            const float* cre = a.in(I_SCRE) + (((size_t)l * 64 + g) * 16 + p) * 64 + n0; const float* cim = a.in(I_SCIM) + (((size_t)l * 64 + g) * 16 + p) * 64 + n0;
            const f32x2* tb = TAB + ((((size_t)l * 2 + dir) * 64 + g) * 64 + n0) * 33 + 16 + k;
#pragma unroll
            for (int q = 0; q < 8; ++q) { const f32x2 pw = tb[(size_t)q * 33]; const float zr = cre[q] * pw.x - cim[q] * pw.y, zi = cre[q] * pw.y + cim[q] * pw.x; x[q] = (part & 1) ? -zi : zr; } }
        *(u32x4*)(MAIN + ((((size_t)l * 64 + g) * 256 + row) * 512) + c8 * 8) = pack8(x); }
    for (int i = F.gt; i < DEPTH * 64 * 256 * 32; i += F.ngt) { const int c8 = i & 31, row = (i >> 5) & 255, g = (i >> 13) & 63, l = i >> 19; const int part = row >> 6, n = row & 63, dir = part >> 1, sg = c8 >> 1, q0 = (c8 & 1) * 8;
        const int k = dir == 0 ? (15 - sg) : sg; const f32x2 gk = TAB[((((size_t)l * 2 + dir) * 64 + g) * 64 + n) * 33 + k];
        const float* bre = a.in(I_SBRE) + (((size_t)l * 64 + g) * 64 + n) * 16 + q0; const float* bim = a.in(I_SBIM) + (((size_t)l * 64 + g) * 64 + n) * 16 + q0; float x[8];
#pragma unroll
        for (int q = 0; q < 8; ++q) { const float zr = gk.x * bre[q] - gk.y * bim[q], zi = gk.x * bim[q] + gk.y * bre[q]; x[q] = (part & 1) ? zi : zr; }
        *(u32x4*)(INCM + ((((size_t)l * 64 + g) * 256 + row) * 256) + c8 * 8) = pack8(x); }
}

__device__ __forceinline__ void ph_x0(const AP& a, const Frame& F) {
    bf16* H = (bf16*)(a.ws + WS_H); float* RSS = (float*)(a.ws + WS_RSS);
    for (int t = F.gw; t < T; t += F.ngw) { const float* xr = t < TP ? a.in(I_XP) + (size_t)t * D : a.in(I_XS) + (size_t)(t - TP) * D; float s = 0.f;
#pragma unroll
        for (int j = 0; j < 8; ++j) { const f32x4 v = *(const f32x4*)(xr + (F.lane + 64 * j) * 4); s += (v[0] * v[0] + v[1] * v[1]) + (v[2] * v[2] + v[3] * v[3]); u32x2 w; w.x = pk2(v[0], v[1]); w.y = pk2(v[2], v[3]); *(u32x2*)(H + (size_t)t * D + (F.lane + 64 * j) * 4) = w; }
        s = wave_sum(s); if (F.lane == 0) RSS[t] = s; }
}
__device__ __forceinline__ void ph_rss(const AP& a, const Frame& F, int l) {
    const float* P = (const float*)(a.ws + WS_RSP); float* R = (float*)(a.ws + WS_RSS) + (size_t)((l + 1) & 1) * T;
    for (int t = F.gt; t < T; t += F.ngt) { float s = 0.f;
#pragma unroll
        for (int j = 0; j < 8; ++j) { const f32x4 v = *(const f32x4*)(P + (size_t)t * 32 + j * 4); s += (v[0] + v[1]) + (v[2] + v[3]); }
        R[t] = s; }
}
__device__ __forceinline__ void ph_final(const AP& a, const Frame& F) {
    const float* RSS = (const float*)(a.ws + WS_RSS) + (size_t)(DEPTH & 1) * T; const float* g = a.in(I_FING);
#pragma unroll 4
    for (int i = F.gt; i < T * (D / 4); i += F.ngt) { const int t = i / (D / 4), c4 = (i % (D / 4)) * 4; const float rs = __builtin_amdgcn_rsqf(RSS[t] * (1.0f / D) + 1e-6f);
        float* p = a.out + (size_t)t * D + c4; *(f32x4*)p = *(const f32x4*)p * rs * *(const f32x4*)(g + c4); }
}
__device__ __forceinline__ void ph_lru_conv(const AP& a, const Frame& F, int l) {
    const bf16* PROJ = (const bf16*)(a.ws + WS_PROJ); bf16* XC = (bf16*)(a.ws + WS_SCR + SA_XC);
    const float* cw = a.in(I_CONVW) + (size_t)l * 4 * WB; const float* cb = a.in(I_CONVB) + (size_t)l * WB;
    if ((F.ngt & 127) == 0) {
        const int c8 = (F.gt & 127) * 8; float wv[4][8], bv[8];
#pragma unroll
        for (int q = 0; q < 8; ++q) { bv[q] = cb[c8 + q];
#pragma unroll
            for (int j = 0; j < 4; ++j) wv[j][q] = cw[j * WB + c8 + q]; }
#pragma unroll 2
        for (int i = F.gt; i < T * 128; i += F.ngt) { const int t = i >> 7; int pos, L; seq_of(t, pos, L); u32x4 xr[4];
#pragma unroll
            for (int j = 0; j < 4; ++j) { const int pp = pos + j - 2; xr[j] = (pp >= 0 && pp < L) ? *(const u32x4*)(PROJ + (size_t)(t + j - 2) * NPJ + C_LRUX + c8) : (u32x4){0u, 0u, 0u, 0u}; }
            float acc[8];
#pragma unroll
            for (int q = 0; q < 8; ++q) acc[q] = bv[q];
#pragma unroll
            for (int j = 0; j < 4; ++j) { float x[8]; unpack8(xr[j], x);
#pragma unroll
                for (int q = 0; q < 8; ++q) acc[q] += wv[j][q] * x[q]; }
            *(u32x4*)(XC + (size_t)t * WB + c8) = pack8(acc); }
        return; }
    for (int i = F.gt; i < T * 128; i += F.ngt) { const int t = i >> 7, c8 = (i & 127) * 8; int pos, L; seq_of(t, pos, L); float acc[8];
#pragma unroll
        for (int q = 0; q < 8; ++q) acc[q] = cb[c8 + q];
#pragma unroll
        for (int j = 0; j < 4; ++j) { const int pp = pos + j - 2; if (pp >= 0 && pp < L) { float x[8]; unpack8(*(const u32x4*)(PROJ + (size_t)(t + j - 2) * NPJ + C_LRUX + c8), x);
#pragma unroll
                for (int q = 0; q < 8; ++q) acc[q] += cw[j * WB + c8 + q] * x[q]; } }
        *(u32x4*)(XC + (size_t)t * WB + c8) = pack8(acc); }
}
#define LOF(x) __uint_as_float((x) << 16)
#define HIF(x) __uint_as_float((x) & 0xffff0000u)
__device__ __forceinline__ void ph_lru_scan1(const AP& a, const Frame& F) {
    const bf16* LA = (const bf16*)(a.ws + WS_SCR + SA_LA); const bf16* BB = (const bf16*)(a.ws + WS_SCR + SA_BB); float* PA = (float*)(a.ws + WS_SCR + SA_PA); float* PB = (float*)(a.ws + WS_SCR + SA_PB);
    for (int i = F.gt; i < NCH_L32 * 2 * 512; i += F.ngt) { const int ch = (i & 511) * 2, d = (i >> 9) & 1, c = i >> 10; float s0 = 0.f, s1 = 0.f, h0 = 0.f, h1 = 0.f;
        unsigned la[32], bb[32];
#pragma unroll
        for (int s = 0; s < 32; ++s) { const int t = c * 32 + (d == 0 ? s : 31 - s); const size_t o = ((size_t)d * T + t) * WB + ch; la[s] = *(const unsigned*)(LA + o); bb[s] = *(const unsigned*)(BB + o); }
#pragma unroll
        for (int s = 0; s < 32; ++s) { const float l0 = LOF(la[s]), l1 = HIF(la[s]); h0 = __expf(l0) * h0 + LOF(bb[s]); h1 = __expf(l1) * h1 + HIF(bb[s]); s0 += l0; s1 += l1; }
        const size_t o = ((size_t)c * 2 + d) * WB + ch; *(f32x2*)(PA + o) = (f32x2){__expf(s0), __expf(s1)}; *(f32x2*)(PB + o) = (f32x2){h0, h1}; }
}
__device__ __forceinline__ void ph_lru_scan2(const AP& a, const Frame& F) {
    const float* PA = (const float*)(a.ws + WS_SCR + SA_PA); const float* PB = (const float*)(a.ws + WS_SCR + SA_PB); float* CAR = (float*)(a.ws + WS_SCR + SA_CAR);
    LAS float* ex = (LAS float*)F.lds;
    for (int it = blockIdx.x; it < 5 * 2 * 16; it += gridDim.x) { const int slab = it & 15, d = (it >> 4) & 1, sq = it >> 5; const int c0 = sq == 0 ? 0 : 512 + (sq - 1) * 64, nc = sq == 0 ? 512 : 64, ns = nc / 8;
        const int ch = slab * 64 + F.lane, seg = F.wave; float p = 1.f, h = 0.f;
        for (int s0 = 0; s0 < ns; s0 += 8) { float pa[8], pb[8];
#pragma unroll
            for (int u = 0; u < 8; ++u) { const int sp = seg * ns + s0 + u, c = c0 + (d == 0 ? sp : nc - 1 - sp); const size_t o = ((size_t)c * 2 + d) * WB + ch; pa[u] = PA[o]; pb[u] = PB[o]; }
#pragma unroll
            for (int u = 0; u < 8; ++u) { h = pa[u] * h + pb[u]; p *= pa[u]; } }
        __syncthreads(); ex[(seg * 64 + F.lane) * 2] = p; ex[(seg * 64 + F.lane) * 2 + 1] = h; __syncthreads();
        float x = 0.f;
        for (int s2 = 0; s2 < seg; ++s2) x = ex[(s2 * 64 + F.lane) * 2] * x + ex[(s2 * 64 + F.lane) * 2 + 1];
        for (int s0 = 0; s0 < ns; s0 += 8) { float pa[8], pb[8];
#pragma unroll
            for (int u = 0; u < 8; ++u) { const int sp = seg * ns + s0 + u, c = c0 + (d == 0 ? sp : nc - 1 - sp); const size_t o = ((size_t)c * 2 + d) * WB + ch; pa[u] = PA[o]; pb[u] = PB[o]; }
#pragma unroll
            for (int u = 0; u < 8; ++u) { const int sp = seg * ns + s0 + u, c = c0 + (d == 0 ? sp : nc - 1 - sp); CAR[((size_t)c * 2 + d) * WB + ch] = x; x = pa[u] * x + pb[u]; } }
    }
}
__device__ __forceinline__ void ph_lru_scan3(const AP& a, const Frame& F) {
    const bf16* LA = (const bf16*)(a.ws + WS_SCR + SA_LA); const bf16* BB = (const bf16*)(a.ws + WS_SCR + SA_BB); const float* CAR = (const float*)(a.ws + WS_SCR + SA_CAR);
    const bf16* PROJ = (const bf16*)(a.ws + WS_PROJ); bf16* Y = (bf16*)(a.ws + WS_Y);
    for (int i = F.gt; i < NCH_L32 * 512; i += F.ngt) { const int ch = (i & 511) * 2, c = i >> 9;
        unsigned la[32], bb[32], hf[32];
#pragma unroll
        for (int s = 0; s < 32; ++s) { const size_t o = (size_t)(c * 32 + s) * WB + ch; la[s] = *(const unsigned*)(LA + o); bb[s] = *(const unsigned*)(BB + o); }
        f32x2 h = *(const f32x2*)(CAR + ((size_t)c * 2 + 0) * WB + ch);
#pragma unroll
        for (int s = 0; s < 32; ++s) { h[0] = __expf(LOF(la[s])) * h[0] + LOF(bb[s]); h[1] = __expf(HIF(la[s])) * h[1] + HIF(bb[s]); hf[s] = pk2(h[0], h[1]); }
        asm volatile("" ::: "memory");
#pragma unroll
        for (int s = 0; s < 32; ++s) { const size_t o = ((size_t)T + c * 32 + s) * WB + ch; la[s] = *(const unsigned*)(LA + o); bb[s] = *(const unsigned*)(BB + o); }
        h = *(const f32x2*)(CAR + ((size_t)c * 2 + 1) * WB + ch);
#pragma unroll
        for (int s0 = 16; s0 >= 0; s0 -= 16) { unsigned zq[16];
#pragma unroll
            for (int u = 0; u < 16; ++u) zq[u] = *(const unsigned*)(PROJ + (size_t)(c * 32 + s0 + u) * NPJ + C_LRUZ + ch);
#pragma unroll
            for (int u = 15; u >= 0; --u) { const int s = s0 + u; h[0] = __expf(LOF(la[s])) * h[0] + LOF(bb[s]); h[1] = __expf(HIF(la[s])) * h[1] + HIF(bb[s]); const unsigned zz = zq[u];
                *(unsigned*)(Y + (size_t)(c * 32 + s) * 4096 + ch) = pk2((LOF(hf[s]) + h[0]) * siluf_(LOF(zz)), (HIF(hf[s]) + h[1]) * siluf_(HIF(zz))); } } }
}
#undef LOF
#undef HIF

__device__ __forceinline__ void ph_s5_rearr(const AP& a, const Frame& F) {
    const bf16* PROJ = (const bf16*)(a.ws + WS_PROJ); bf16* UC = (bf16*)(a.ws + WS_SCR + SD_UC);
#pragma unroll 4
    for (int i = F.gt; i < T * 64; i += F.ngt) { const int g = i & 63, t = i >> 6, c = t >> 4, tau = t & 15; const u32x4* s = (const u32x4*)(PROJ + (size_t)t * NPJ + C_SU + g * 16);
        u32x4* d = (u32x4*)(UC + ((size_t)g * NCH_S5 + c) * 512 + tau * 16); d[0] = s[0]; d[1] = s[1]; }
}
__device__ __forceinline__ void ph_s5_scan(const AP& a, const Frame& F, int l) {
    const float* INC = (const float*)(a.ws + WS_SCR + SD_INC); bf16* UC = (bf16*)(a.ws + WS_SCR + SD_UC); const f32x2* TAB = (const f32x2*)(a.ws + WS_S5TAB);
    LAS float* ex = (LAS float*)F.lds;
    for (int it = blockIdx.x; it < 5 * 64 * 2; it += gridDim.x) { const int d = it & 1, g = (it >> 1) & 63, sq = it >> 7; const int c0 = sq == 0 ? 0 : 1024 + (sq - 1) * 128, nc = sq == 0 ? 1024 : 128, ns = nc / 8;
        const int n = F.lane, seg = F.wave; const f32x2 lc = TAB[((((size_t)l * 2 + d) * 64 + g) * 64 + n) * 33 + 32];
        float xr = 0.f, xi = 0.f, pr = 1.f, pi = 0.f;
        for (int s0 = 0; s0 < ns; s0 += 8) { float ir[8], ii[8];
#pragma unroll
            for (int u = 0; u < 8; ++u) { const int sp = seg * ns + s0 + u, c = c0 + (d == 0 ? sp : nc - 1 - sp); const size_t ro = (size_t)g * NCH_S5 + c; ir[u] = INC[ro * 256 + d * 128 + n]; ii[u] = INC[ro * 256 + d * 128 + 64 + n]; }
#pragma unroll
            for (int u = 0; u < 8; ++u) { const float nr = lc.x * xr - lc.y * xi + ir[u], ni = lc.x * xi + lc.y * xr + ii[u]; xr = nr; xi = ni; const float qr = lc.x * pr - lc.y * pi, qi = lc.x * pi + lc.y * pr; pr = qr; pi = qi; } }
        __syncthreads(); ex[(seg * 64 + n) * 2] = xr; ex[(seg * 64 + n) * 2 + 1] = xi; __syncthreads();
        xr = 0.f; xi = 0.f;
        for (int s2 = 0; s2 < seg; ++s2) { const float er = ex[(s2 * 64 + n) * 2], ei = ex[(s2 * 64 + n) * 2 + 1]; const float nr = pr * xr - pi * xi + er, ni = pr * xi + pi * xr + ei; xr = nr; xi = ni; }
        for (int s0 = 0; s0 < ns; s0 += 8) { float ir[8], ii[8];
#pragma unroll
            for (int u = 0; u < 8; ++u) { const int sp = seg * ns + s0 + u, c = c0 + (d == 0 ? sp : nc - 1 - sp); const size_t ro = (size_t)g * NCH_S5 + c; ir[u] = INC[ro * 256 + d * 128 + n]; ii[u] = INC[ro * 256 + d * 128 + 64 + n]; }
#pragma unroll
            for (int u = 0; u < 8; ++u) { const int sp = seg * ns + s0 + u, c = c0 + (d == 0 ? sp : nc - 1 - sp); const size_t ro = (size_t)g * NCH_S5 + c;
                UC[ro * 512 + 256 + d * 128 + n] = (bf16)f2bf(xr); UC[ro * 512 + 256 + d * 128 + 64 + n] = (bf16)f2bf(xi);
                const float nr = lc.x * xr - lc.y * xi + ir[u], ni = lc.x * xi + lc.y * xr + ii[u]; xr = nr; xi = ni; } }
    }
}
template <int NT> __device__ __forceinline__ void mma_lds(f32x4 (&acc)[NT], const LAS bf16* As, int pa, const LAS bf16* Bs, int pb, int K, int lane) {
    const int r = lane & 15, q = lane >> 4;
    for (int kk = 0; kk < K; kk += 32) { const bf16x8 av = *(const LAS bf16x8*)(As + r * pa + kk + q * 8);
#pragma unroll
        for (int nt = 0; nt < NT; ++nt) { const bf16x8 bv = *(const LAS bf16x8*)(Bs + (nt * 16 + r) * pb + kk + q * 8); acc[nt] = __builtin_amdgcn_mfma_f32_16x16x32_bf16(av, bv, acc[nt], 0, 0, 0); } }
}
template <int NT> __device__ __forceinline__ void mma_glb(f32x4 (&acc)[NT], const LAS bf16* As, int pa, const bf16* Bg, int pb, int K, int lane) {
    const int r = lane & 15, q = lane >> 4;
    for (int kk = 0; kk < K; kk += 32) { const bf16x8 av = *(const LAS bf16x8*)(As + r * pa + kk + q * 8);
#pragma unroll
        for (int n0 = 0; n0 < NT; n0 += 8) { bf16x8 bv[8];
#pragma unroll
            for (int u = 0; u < 8; ++u) bv[u] = *(const bf16x8*)(Bg + (size_t)((n0 + u) * 16 + r) * pb + kk + q * 8);
#pragma unroll
            for (int u = 0; u < 8; ++u) acc[n0 + u] = __builtin_amdgcn_mfma_f32_16x16x32_bf16(av, bv[u], acc[n0 + u], 0, 0, 0); } }
}
#define LBAR() do { asm volatile("s_waitcnt lgkmcnt(0)" ::: "memory"); __builtin_amdgcn_s_barrier(); asm volatile("" ::: "memory"); } while (0)
constexpr int RP = 136;
__device__ __forceinline__ float ret_log2g(int h) { return log2f(1.0f - exp2f(-5.0f - (float)h)); }

__device__ __forceinline__ void ph_ret_kv(const AP& a, const Frame& F) {
    const bf16* PROJ = (const bf16*)(a.ws + WS_PROJ); const f32x2* ROT = (const f32x2*)(a.ws + WS_ROT); bf16* KVT = (bf16*)(a.ws + WS_SCR + SC_KVT);
    LAS bf16* VT = (LAS bf16*)F.lds; LAS bf16* KTf = VT + 128 * RP; LAS bf16* KTb = KTf + 128 * RP;
    for (int it = blockIdx.x; it < NCH_RET * 4 * 2; it += gridDim.x) { const int eh = it & 1, h = (it >> 1) & 3, cn = it >> 3; const float l2g = ret_log2g(h);
        LBAR();
        { const int pp = F.lane, ta = cn * 128 + 2 * pp;
#pragma unroll
          for (int oc = 0; oc < 2; ++oc) { const int e8 = (F.wave * 2 + oc) * 8;
              const u32x4 va = *(const u32x4*)(PROJ + (size_t)ta * NPJ + C_RV + h * 256 + eh * 128 + e8), vb = *(const u32x4*)(PROJ + (size_t)(ta + 1) * NPJ + C_RV + h * 256 + eh * 128 + e8);
              const unsigned wa[4] = {va.x, va.y, va.z, va.w}, wb[4] = {vb.x, vb.y, vb.z, vb.w};
#pragma unroll
              for (int i = 0; i < 4; ++i) { *(LAS unsigned*)(VT + (e8 + 2 * i) * RP + 2 * pp) = (wa[i] & 0xffffu) | (wb[i] << 16); *(LAS unsigned*)(VT + (e8 + 2 * i + 1) * RP + 2 * pp) = (wa[i] >> 16) | (wb[i] & 0xffff0000u); } }
          { const int i8 = F.wave * 8; int posa, L; seq_of(ta, posa, L);
            float x1a[8], x2a[8], x1b[8], x2b[8];
            unpack8(*(const u32x4*)(PROJ + (size_t)ta * NPJ + C_RK + h * 128 + i8), x1a); unpack8(*(const u32x4*)(PROJ + (size_t)ta * NPJ + C_RK + h * 128 + 64 + i8), x2a);
            unpack8(*(const u32x4*)(PROJ + (size_t)(ta + 1) * NPJ + C_RK + h * 128 + i8), x1b); unpack8(*(const u32x4*)(PROJ + (size_t)(ta + 1) * NPJ + C_RK + h * 128 + 64 + i8), x2b);
            const f32x4* ra = (const f32x4*)(ROT + (size_t)posa * 64 + i8); const f32x4* rb = (const f32x4*)(ROT + (size_t)(posa + 1) * 64 + i8);
            const float sc = 0.08838834764831845f; const float dfa = __builtin_amdgcn_exp2f(l2g * (float)(127 - 2 * pp)) * sc, dba = __builtin_amdgcn_exp2f(l2g * (float)(2 * pp)) * sc, dfb = __builtin_amdgcn_exp2f(l2g * (float)(126 - 2 * pp)) * sc, dbb = __builtin_amdgcn_exp2f(l2g * (float)(2 * pp + 1)) * sc;
#pragma unroll
            for (int i2 = 0; i2 < 4; ++i2) { const f32x4 ca = ra[i2], cb2 = rb[i2];
#pragma unroll
                for (int u = 0; u < 2; ++u) { const int i = 2 * i2 + u; const float c_a = ca[2 * u], s_a = ca[2 * u + 1], c_b = cb2[2 * u], s_b = cb2[2 * u + 1];
                    const float o1a = x1a[i] * c_a - x2a[i] * s_a, o2a = x1a[i] * s_a + x2a[i] * c_a, o1b = x1b[i] * c_b - x2b[i] * s_b, o2b = x1b[i] * s_b + x2b[i] * c_b;
                    *(LAS unsigned*)(KTf + (i8 + i) * RP + 2 * pp) = pk2(o1a * dfa, o1b * dfb); *(LAS unsigned*)(KTf + (64 + i8 + i) * RP + 2 * pp) = pk2(o2a * dfa, o2b * dfb);
                    *(LAS unsigned*)(KTb + (i8 + i) * RP + 2 * pp) = pk2(o1a * dba, o1b * dbb); *(LAS unsigned*)(KTb + (64 + i8 + i) * RP + 2 * pp) = pk2(o2a * dba, o2b * dbb); } } } }
        LBAR();
        f32x4 af[8], ab[8];
#pragma unroll
        for (int n = 0; n < 8; ++n) { af[n] = (f32x4){0.f, 0.f, 0.f, 0.f}; ab[n] = (f32x4){0.f, 0.f, 0.f, 0.f}; }
        mma_lds<8>(af, KTf + F.wave * 16 * RP, RP, VT, RP, 128, F.lane); mma_lds<8>(ab, KTb + F.wave * 16 * RP, RP, VT, RP, 128, F.lane);
        const int r = F.lane & 15, q4 = F.lane >> 4; const size_t item = (size_t)cn * 4 + h;
#pragma unroll
        for (int n = 0; n < 8; ++n) { const int e = eh * 128 + n * 16 + r, d0 = F.wave * 16 + q4 * 4; *(u32x2*)(KVT + ((0 * 768 + item) * 256 + e) * 128 + d0) = (u32x2){pk2(af[n][0], af[n][1]), pk2(af[n][2], af[n][3])}; *(u32x2*)(KVT + ((768 + item) * 256 + e) * 128 + d0) = (u32x2){pk2(ab[n][0], ab[n][1]), pk2(ab[n][2], ab[n][3])}; }
    }
}
__device__ __forceinline__ void ph_ret_scan(const AP& a, const Frame& F) {
    const unsigned* KVT = (const unsigned*)(a.ws + WS_SCR + SC_KVT); unsigned* STP = (unsigned*)(a.ws + WS_STP);
    for (int i = F.gt; i < 5 * 2 * 4 * 16384; i += F.ngt) { const int ed = i & 16383, h = (i >> 14) & 3, dir = (i >> 16) & 1, sq = i >> 17; const int c0 = sq == 0 ? 0 : 128 + (sq - 1) * 16, nc = sq == 0 ? 128 : 16;
        const float g128 = __builtin_amdgcn_exp2f(ret_log2g(h) * 128.0f); float s0_ = 0.f, s1_ = 0.f;
        for (int s0 = 0; s0 < nc; s0 += 16) { unsigned kv[16];
#pragma unroll
            for (int u = 0; u < 16; ++u) { const int cn = c0 + (dir == 0 ? s0 + u : nc - 1 - s0 - u); kv[u] = KVT[(((size_t)dir * 768 + cn * 4 + h) * 16384) + ed]; }
#pragma unroll
            for (int u = 0; u < 16; ++u) { const int cn = c0 + (dir == 0 ? s0 + u : nc - 1 - s0 - u); STP[(((size_t)dir * 768 + cn * 4 + h) * 16384) + ed] = pk2(s0_, s1_);
                s0_ = g128 * s0_ + __uint_as_float(kv[u] << 16); s1_ = g128 * s1_ + __uint_as_float(kv[u] & 0xffff0000u); } } }
}
__device__ __forceinline__ void ph_ret_out(const AP& a, const Frame& F, int l) {
    const bf16* PROJ = (const bf16*)(a.ws + WS_PROJ); const f32x2* ROT = (const f32x2*)(a.ws + WS_ROT); const bf16* STP = (const bf16*)(a.ws + WS_STP); bf16* Y = (bf16*)(a.ws + WS_Y);
    const float* gn = a.in(I_GNG) + (size_t)l * WB;
    LAS bf16* Qs = (LAS bf16*)F.lds; LAS bf16* Ks = Qs + 128 * RP; LAS bf16* VT = Ks + 128 * RP;
    unsigned* cnt = (unsigned*)(a.ws + WS_CTL) + 16384 + 64 * l; volatile LAS unsigned* tick = (volatile LAS unsigned*)(F.lds + LDS_MISC) + 16;
    for (;;) { LBAR(); if (F.tid == 0) tick[0] = __hip_atomic_fetch_add(cnt, 1u, __ATOMIC_RELAXED, __HIP_MEMORY_SCOPE_AGENT); LBAR();
        const int it = __builtin_amdgcn_readfirstlane((int)tick[0]); if (it >= NCH_RET * 4) break; const int h = it & 3, cn = it >> 2; const float l2g = ret_log2g(h);
        int ln_ = F.lane, td_ = F.tid; asm volatile("" : "+v"(ln_), "+v"(td_));
        LBAR();
        { const int pp = ln_, ta = cn * 128 + 2 * pp;
#pragma unroll
          for (int oc = 0; oc < 4; ++oc) { const int e8 = (F.wave * 4 + oc) * 8;
              const u32x4 va = *(const u32x4*)(PROJ + (size_t)ta * NPJ + C_RV + h * 256 + e8), vb = *(const u32x4*)(PROJ + (size_t)(ta + 1) * NPJ + C_RV + h * 256 + e8);
              const unsigned wa[4] = {va.x, va.y, va.z, va.w}, wb[4] = {vb.x, vb.y, vb.z, vb.w};
#pragma unroll
              for (int i = 0; i < 4; ++i) { *(LAS unsigned*)(VT + (e8 + 2 * i) * RP + 2 * pp) = (wa[i] & 0xffffu) | (wb[i] << 16); *(LAS unsigned*)(VT + (e8 + 2 * i + 1) * RP + 2 * pp) = (wa[i] >> 16) | (wb[i] & 0xffff0000u); } } }
#pragma unroll
        for (int rep2 = 0; rep2 < 2; ++rep2) { const int qq = td_ + rep2 * NTHR, j = qq >> 3, i8 = (qq & 7) * 8; const int t = cn * 128 + j; int pos, L; seq_of(t, pos, L);
            float k1[8], k2[8], q1[8], q2[8], ok1[8], ok2[8], oq1[8], oq2[8];
            unpack8(*(const u32x4*)(PROJ + (size_t)t * NPJ + C_RK + h * 128 + i8), k1); unpack8(*(const u32x4*)(PROJ + (size_t)t * NPJ + C_RK + h * 128 + 64 + i8), k2);
            unpack8(*(const u32x4*)(PROJ + (size_t)t * NPJ + C_RQ + h * 128 + i8), q1); unpack8(*(const u32x4*)(PROJ + (size_t)t * NPJ + C_RQ + h * 128 + 64 + i8), q2);
            const f32x4* rr = (const f32x4*)(ROT + (size_t)pos * 64 + i8); const float sc = 0.08838834764831845f;
#pragma unroll
            for (int i2 = 0; i2 < 4; ++i2) { const f32x4 cs4 = rr[i2];
#pragma unroll
                for (int u = 0; u < 2; ++u) { const int i = 2 * i2 + u; const float c = cs4[2 * u], s = cs4[2 * u + 1];
                    ok1[i] = (k1[i] * c - k2[i] * s) * sc; ok2[i] = (k1[i] * s + k2[i] * c) * sc; oq1[i] = q1[i] * c - q2[i] * s; oq2[i] = q1[i] * s + q2[i] * c; } }
            *(LAS u32x4*)(Ks + j * RP + i8) = pack8(ok1); *(LAS u32x4*)(Ks + j * RP + 64 + i8) = pack8(ok2); *(LAS u32x4*)(Qs + j * RP + i8) = pack8(oq1); *(LAS u32x4*)(Qs + j * RP + 64 + i8) = pack8(oq2); }
        LBAR();
        const int r = ln_ & 15, q4 = ln_ >> 4, i0 = F.wave * 16 + q4 * 4;
        f32x4 sa[8];
#pragma unroll
        for (int n = 0; n < 8; ++n) sa[n] = (f32x4){0.f, 0.f, 0.f, 0.f};
        mma_lds<8>(sa, Qs + F.wave * 16 * RP, RP, Ks, RP, 128, ln_);
        LBAR();
#pragma unroll
        for (int n = 0; n < 8; ++n)
#pragma unroll
            for (int j = 0; j < 4; ++j) { const int i = i0 + j, jj = n * 16 + r; const int dd = i > jj ? i - jj : jj - i; Ks[i * RP + jj] = (bf16)f2bf(sa[n][j] * __builtin_amdgcn_exp2f(l2g * (float)dd)); }
        asm volatile("s_waitcnt lgkmcnt(0)" ::: "memory");
        f32x4 o[16];
#pragma unroll
        for (int n = 0; n < 16; ++n) o[n] = (f32x4){0.f, 0.f, 0.f, 0.f};
        const size_t item = (size_t)cn * 4 + h;
        float r1[4], f2[4];
#pragma unroll
        for (int j = 0; j < 4; ++j) { r1[j] = __builtin_amdgcn_exp2f(l2g * (float)(2 * (i0 + j) - 127)); f2[j] = __builtin_amdgcn_exp2f(l2g * (float)(128 - i0 - j)); }
        { const bf16* Bd0 = STP + (0 * 768 + item) * 32768 + (size_t)r * 128 + q4 * 8; const bf16* Bd1 = STP + (768 + item) * 32768 + (size_t)r * 128 + q4 * 8;
          const LAS bf16* Aq = Qs + (F.wave * 16 + r) * RP + q4 * 8;
          bf16x8 b0[8], b1[8], b2[8];
#define RO_LOAD(dst_, b_) do { const bf16* bp_ = ((b_) < 8 ? Bd0 : Bd1) + (((b_) >> 1) & 3) * 32 + ((b_) & 1) * 8 * 2048; _Pragma("unroll") for (int u = 0; u < 8; ++u) dst_[u] = *(const bf16x8*)(bp_ + u * 2048); } while (0)
#define RO_MMA(src_, b_) do { const bf16x8 av_ = *(const LAS bf16x8*)(Aq + (((b_) >> 1) & 3) * 32); _Pragma("unroll") for (int u = 0; u < 8; ++u) o[((b_) & 1) * 8 + u] = __builtin_amdgcn_mfma_f32_16x16x32_bf16(av_, src_[u], o[((b_) & 1) * 8 + u], 0, 0, 0); } while (0)
          RO_LOAD(b0, 0); RO_LOAD(b1, 1); RO_LOAD(b2, 2);
          RO_MMA(b0, 0); RO_LOAD(b0, 3);
          RO_MMA(b1, 1); RO_LOAD(b1, 4);
          RO_MMA(b2, 2); RO_LOAD(b2, 5);
          RO_MMA(b0, 3); RO_LOAD(b0, 6);
          RO_MMA(b1, 4); RO_LOAD(b1, 7);
          RO_MMA(b2, 5); RO_LOAD(b2, 8);
          RO_MMA(b0, 6); RO_LOAD(b0, 9);
          RO_MMA(b1, 7); RO_LOAD(b1, 10);
#pragma unroll
          for (int n = 0; n < 16; ++n)
#pragma unroll
              for (int j = 0; j < 4; ++j) o[n][j] *= r1[j];
          RO_MMA(b2, 8); RO_LOAD(b2, 11);
          RO_MMA(b0, 9); RO_LOAD(b0, 12);
          RO_MMA(b1, 10); RO_LOAD(b1, 13);
          RO_MMA(b2, 11); RO_LOAD(b2, 14);
          RO_MMA(b0, 12); RO_LOAD(b0, 15);
          RO_MMA(b1, 13);
          RO_MMA(b2, 14);
          RO_MMA(b0, 15);
#undef RO_LOAD
#undef RO_MMA
        }
#pragma unroll
        for (int n = 0; n < 16; ++n)
#pragma unroll
            for (int j = 0; j < 4; ++j) o[n][j] *= f2[j];
        mma_lds<16>(o, Ks + F.wave * 16 * RP, RP, VT, RP, 128, ln_);
        float gnv[16];
#pragma unroll
        for (int n = 0; n < 16; ++n) gnv[n] = gn[h * 256 + n * 16 + r];
#pragma unroll
        for (int j = 0; j < 4; ++j) { float s = 0.f; unsigned short zz[16];
#pragma unroll
            for (int n = 0; n < 16; ++n) zz[n] = PROJ[(size_t)(cn * 128 + i0 + j) * NPJ + C_RZ + h * 256 + n * 16 + r];
#pragma unroll
            for (int n = 0; n < 16; ++n) s += o[n][j];
            s += shx<1>(s); s += shx<2>(s); s += shx<4>(s); s += shx<8>(s); const float mean = s * (1.0f / 256.0f); float v = 0.f;
#pragma unroll
            for (int n = 0; n < 16; ++n) { const float dlt = o[n][j] - mean; v += dlt * dlt; }
            v += shx<1>(v); v += shx<2>(v); v += shx<4>(v); v += shx<8>(v); const float rstd = __builtin_amdgcn_rsqf(v * (1.0f / 256.0f) + 1e-5f);
            const int t = cn * 128 + i0 + j;
#pragma unroll
            for (int n = 0; n < 16; ++n) { const int e = n * 16 + r; Y[(size_t)t * 4096 + 2048 + h * 256 + e] = (bf16)f2bf((o[n][j] - mean) * rstd * gnv[n] * siluf_(bf2f(zz[n]))); } }
    }
}

__device__ __forceinline__ float rdl(float x, int j) { return __int_as_float(__builtin_amdgcn_readlane(__float_as_int(x), j)); }
__device__ __forceinline__ void ph_rwkv_prep(const AP& a, const Frame& F, int l) {
    const bf16* PROJ = (const bf16*)(a.ws + WS_PROJ); unsigned char* S = a.ws + WS_SCR;
    bf16* R = (bf16*)(S + SB_R); bf16* KM = (bf16*)(S + SB_KM); bf16* V = (bf16*)(S + SB_V); bf16* KK = (bf16*)(S + SB_KK); bf16* AG = (bf16*)(S + SB_AG); bf16* LWF = (bf16*)(S + SB_LWF); bf16* LWB = (bf16*)(S + SB_LWB); const bf16* LO = (const bf16*)(S + SB_LO);
    const float* mu = a.in(I_MU) + (size_t)l * 3 * WB; const float* w0 = a.in(I_W0) + (size_t)l * 2 * WB;
    const float* a0 = a.in(I_A0) + (size_t)l * WB; const float* kkp = a.in(I_KK) + (size_t)l * WB; const float* kap = a.in(I_KA) + (size_t)l * WB;
#define UP4(W_, O_) do { const u32x2 w_ = (W_); O_[0] = __uint_as_float(w_[0] << 16); O_[1] = __uint_as_float(w_[0] & 0xffff0000u); O_[2] = __uint_as_float(w_[1] << 16); O_[3] = __uint_as_float(w_[1] & 0xffff0000u); } while (0)
#define PK4(O_) ((u32x2){pk2(O_[0], O_[1]), pk2(O_[2], O_[3])})
    for (int it = F.gw; it < (T / 4) * 4; it += F.ngw) { const int hq = it & 3, t0 = (it >> 2) * 4, c = hq * 256 + F.lane * 4; int pos0, L; seq_of(t0, pos0, L);
        u32x2 xr[6], xk[6], xv[6];
#pragma unroll
        for (int i = 0; i < 6; ++i) { const int pp = pos0 + i - 1; const bool ok = pp >= 0 && pp < L; const bf16* pr = PROJ + (size_t)(t0 + i - 1) * NPJ + c; const u32x2 z2 = (u32x2){0u, 0u};
            xr[i] = ok ? *(const u32x2*)(pr + C_RWR) : z2; xk[i] = ok ? *(const u32x2*)(pr + C_RWK) : z2; xv[i] = ok ? *(const u32x2*)(pr + C_RWV) : z2; }
        u32x2 lo0[4], lo1[4], lo2[4];
#pragma unroll
        for (int i = 0; i < 4; ++i) { const bf16* lo = LO + (size_t)(t0 + i) * 3072 + c; lo0[i] = *(const u32x2*)lo; lo1[i] = *(const u32x2*)(lo + 1024); lo2[i] = *(const u32x2*)(lo + 2048); }
        const f32x4 mur = *(const f32x4*)(mu + c), muk = *(const f32x4*)(mu + WB + c), muv = *(const f32x4*)(mu + 2 * WB + c), w0f = *(const f32x4*)(w0 + c), w0b = *(const f32x4*)(w0 + WB + c),
                    a0v = *(const f32x4*)(a0 + c), kkw = *(const f32x4*)(kkp + c), kaw = *(const f32x4*)(kap + c);
#pragma unroll
        for (int i = 0; i < 4; ++i) { const int t = t0 + i; float rp[4], r0[4], rn[4], kp[4], k0[4], kn[4], vp[4], v0[4], vn[4], l0[4], l1[4], l2[4];
            UP4(xr[i], rp); UP4(xr[i + 1], r0); UP4(xr[i + 2], rn); UP4(xk[i], kp); UP4(xk[i + 1], k0); UP4(xk[i + 2], kn); UP4(xv[i], vp); UP4(xv[i + 1], v0); UP4(xv[i + 2], vn); UP4(lo0[i], l0); UP4(lo1[i], l1); UP4(lo2[i], l2);
            float rm[4], km[4], vm[4], ag[4], kk[4], kd[4], lf[4], lb[4]; float ss = 0.f;
#pragma unroll
            for (int e = 0; e < 4; ++e) { rm[e] = r0[e] + mur[e] * (0.5f * (rp[e] + rn[e]) - r0[e]); km[e] = k0[e] + muk[e] * (0.5f * (kp[e] + kn[e]) - k0[e]); vm[e] = v0[e] + muv[e] * (0.5f * (vp[e] + vn[e]) - v0[e]);
                ag[e] = sigmoidf_(a0v[e] + l2[e]); kk[e] = km[e] * kkw[e]; ss += kk[e] * kk[e]; kd[e] = km[e] * (1.0f + (ag[e] - 1.0f) * kaw[e]);
                lf[e] = -0.6065306597126334f * sigmoidf_(w0f[e] + l0[e]); lb[e] = -0.6065306597126334f * sigmoidf_(w0b[e] + l1[e]); }
            ss += shx<1>(ss); ss += shx<2>(ss); ss += shx<4>(ss); ss += shx<8>(ss);
            const float inv = fminf(__builtin_amdgcn_rsqf(ss), 1e12f); float ka[4];
#pragma unroll
            for (int e = 0; e < 4; ++e) { kk[e] *= inv; ka[e] = ag[e]; }
            const size_t o = (size_t)t * WB + c;
            *(u32x2*)(R + o) = PK4(rm); *(u32x2*)(KM + o) = PK4(kd); *(u32x2*)(V + o) = PK4(vm); *(u32x2*)(KK + o) = PK4(kk); *(u32x2*)(AG + o) = PK4(ka); *(u32x2*)(LWF + o) = PK4(lf); *(u32x2*)(LWB + o) = PK4(lb); }
    }
}
constexpr int P72 = 72, SLOT = 64 * P72;
__device__ __forceinline__ void mm2(f32x4 (&acc)[2], const LAS bf16* A, const LAS bf16* Bt, int wave, int lane) { asm volatile("" : "+v"(lane));
    mma_lds<2>(acc, A + (wave >> 1) * 16 * P72, P72, Bt + (wave & 1) * 32 * P72, P72, 64, lane); }
#define RW_FOREACH(acc) _Pragma("unroll") for (int nt = 0; nt < 2; ++nt) _Pragma("unroll") for (int j = 0; j < 4; ++j)
#define RW_BASE int rb_ = (F.wave >> 1) * 16 + (F.lane >> 4) * 4, cb_ = (F.wave & 1) * 32 + (F.lane & 15); asm volatile("" : "+v"(rb_), "+v"(cb_));
#define RW_ROW (rb_ + j)
#define RW_COL (cb_ + nt * 16)
__device__ __forceinline__ void ph_rwkv_chunk(const AP& a, const Frame& F, int l) {
    unsigned char* S = a.ws + WS_SCR; bf16* CH = (bf16*)(S + SB_CH);
    const bf16* R = (const bf16*)(S + SB_R); const bf16* KM = (const bf16*)(S + SB_KM); const bf16* V = (const bf16*)(S + SB_V); const bf16* KK = (const bf16*)(S + SB_KK); const bf16* AG = (const bf16*)(S + SB_AG);
    LAS bf16* lb = (LAS bf16*)F.lds;
#define SL(i) (lb + (i) * SLOT)
    LAS float* NF = (LAS float*)SL(12);
    LAS float* GC = (LAS float*)(F.lds + 15 * SLOT * 2);
    LAS float* TOT = GC + 64;
    const f32x4 z4 = (f32x4){0.f, 0.f, 0.f, 0.f};
#ifndef CHUNK_REP
#define CHUNK_REP 1
#endif
    u32x4 pre0, pre1, pre2, pre3, pre4, pre5, pre6;
#define RAW_LOAD(it_, dir_) do { const int hd_ = (it_) & 15, cn_ = (it_) >> 4; const bf16* LW_ = (const bf16*)(S + ((dir_) ? SB_LWB : SB_LWF)); int tid_ = F.tid; asm volatile("" : "+v"(tid_)); \
        const int j_ = tid_ >> 3, c8_ = (tid_ & 7) * 8; const int t_ = cn_ * 64 + ((dir_) ? 63 - j_ : j_); const size_t o_ = (size_t)t_ * WB + hd_ * 64 + c8_; \
        pre0 = *(const u32x4*)(LW_ + o_); pre1 = *(const u32x4*)(KK + o_); pre2 = *(const u32x4*)(AG + o_); pre3 = *(const u32x4*)(KM + o_); pre4 = *(const u32x4*)(R + o_); \
        const int pp_ = tid_ & 31, v8_ = ((tid_ >> 5) & 7) * 8; const int ta_ = cn_ * 64 + ((dir_) ? 63 - 2 * pp_ : 2 * pp_), tb_ = cn_ * 64 + ((dir_) ? 62 - 2 * pp_ : 2 * pp_ + 1); \
        pre5 = *(const u32x4*)(V + (size_t)ta_ * WB + hd_ * 64 + v8_); pre6 = *(const u32x4*)(V + (size_t)tb_ * WB + hd_ * 64 + v8_); } while (0)
    for (int rep = 0; rep < CHUNK_REP; ++rep) {
    if ((int)blockIdx.x < (T / 64) * 16) RAW_LOAD((int)blockIdx.x, 0);
    for (int it = blockIdx.x; it < (T / 64) * 16; it += gridDim.x) { const int hd = it & 15, cn = it >> 4; (void)hd; (void)cn;
        for (int dir = 0; dir < 2; ++dir) {
            bf16* outb = CH + ((size_t)it * 2 + dir) * 4 * 4096;
            LBAR();
            { int tid_ = F.tid; asm volatile("" : "+v"(tid_)); const int j = tid_ >> 3, c8 = (tid_ & 7) * 8;
              *(LAS u32x4*)(SL(8) + j * P72 + c8) = pre0; *(LAS u32x4*)(SL(9) + j * P72 + c8) = pre1; *(LAS u32x4*)(SL(10) + j * P72 + c8) = pre2; *(LAS u32x4*)(SL(11) + j * P72 + c8) = pre3; *(LAS u32x4*)(SL(12) + j * P72 + c8) = pre4;
              if (tid_ < 256) { const int pp = tid_ & 31, v8 = (tid_ >> 5) * 8; const unsigned wa[4] = {pre5.x, pre5.y, pre5.z, pre5.w}, wb[4] = {pre6.x, pre6.y, pre6.z, pre6.w};
#pragma unroll
                  for (int i = 0; i < 4; ++i) { *(LAS unsigned*)(SL(7) + (v8 + 2 * i) * P72 + 2 * pp) = (wa[i] & 0xffffu) | (wb[i] << 16); *(LAS unsigned*)(SL(7) + (v8 + 2 * i + 1) * P72 + 2 * pp) = (wa[i] >> 16) | (wb[i] & 0xffff0000u); } }
              if (dir == 0) {
                  float kmf_[8], rf_[8]; unpack8(pre3, kmf_); unpack8(pre4, rf_); const float* rkp_ = a.in(I_RK) + (size_t)l * WB + hd * 64 + c8; const f32x4 ra_ = *(const f32x4*)rkp_, rb_ = *(const f32x4*)(rkp_ + 4);
                  float s_ = ((rf_[0] * kmf_[0] * ra_[0] + rf_[1] * kmf_[1] * ra_[1]) + (rf_[2] * kmf_[2] * ra_[2] + rf_[3] * kmf_[3] * ra_[3])) + ((rf_[4] * kmf_[4] * rb_[0] + rf_[5] * kmf_[5] * rb_[1]) + (rf_[6] * kmf_[6] * rb_[2] + rf_[7] * kmf_[7] * rb_[3]));
                  s_ += shx<1>(s_); s_ += shx<2>(s_); s_ += shx<4>(s_);
                  if ((tid_ & 7) == 0) ((float*)(a.ws + WS_RSP))[(size_t)(cn * 64 + j) * 16 + hd] = s_; }
              const int nit = dir ? it + (int)gridDim.x : it;
              if (nit < (T / 64) * 16) RAW_LOAD(nit, dir ^ 1); }
            LBAR();
            { int k = F.lane; asm volatile("" : "+v"(k)); const int seg = F.wave;
              float cum[8]; float run = 0.f;
#pragma unroll
              for (int i = 0; i < 8; ++i) { run += bf2f(SL(8)[(seg * 8 + i) * P72 + k]); cum[i] = run; }
              TOT[seg * 64 + k] = run;
              LBAR();
              float off = 0.f;
              for (int s2 = 0; s2 < seg; ++s2) off += TOT[s2 * 64 + k];
              unsigned ta[4], tb[4], tk[4]; float Gprev = __expf(off);
#pragma unroll
              for (int ip = 0; ip < 4; ++ip) { float fa[2], fb[2], fk[2], fr[2];
#pragma unroll
                  for (int u = 0; u < 2; ++u) { const int i = 2 * ip + u, t = seg * 8 + i; const float cl = off + cum[i];
                      const float kkv = bf2f(SL(9)[t * P72 + k]), agv = bf2f(SL(10)[t * P72 + k]), kmv = bf2f(SL(11)[t * P72 + k]), rv = bf2f(SL(12)[t * P72 + k]);
                      const float G = __expf(cl), Gi = __expf(-cl);
                      fa[u] = -kkv * Gprev; fb[u] = kkv * agv * Gi; fk[u] = kmv * Gi; fr[u] = rv * G; Gprev = G;
                      if (t == 63) GC[k] = G; }
                  const unsigned wa = pk2(fa[0], fa[1]), wb = pk2(fb[0], fb[1]), wk = pk2(fk[0], fk[1]), wr2 = pk2(fr[0], fr[1]); const int t0 = seg * 8 + 2 * ip;
                  SL(0)[t0 * P72 + k] = (bf16)wa; SL(0)[(t0 + 1) * P72 + k] = (bf16)(wa >> 16); SL(1)[t0 * P72 + k] = (bf16)wb; SL(1)[(t0 + 1) * P72 + k] = (bf16)(wb >> 16);
                  SL(2)[t0 * P72 + k] = (bf16)wk; SL(2)[(t0 + 1) * P72 + k] = (bf16)(wk >> 16); SL(6)[t0 * P72 + k] = (bf16)wr2; SL(6)[(t0 + 1) * P72 + k] = (bf16)(wr2 >> 16);
                  ta[ip] = wa; tb[ip] = wb; tk[ip] = wk; }
              *(LAS u32x4*)(SL(3) + k * P72 + seg * 8) = (u32x4){ta[0], ta[1], ta[2], ta[3]}; *(LAS u32x4*)(SL(4) + k * P72 + seg * 8) = (u32x4){tb[0], tb[1], tb[2], tb[3]}; *(LAS u32x4*)(SL(5) + k * P72 + seg * 8) = (u32x4){tk[0], tk[1], tk[2], tk[3]}; }
            LBAR();
#define PK4S(dst_, v0_, v1_, v2_, v3_) *(LAS u32x2*)(dst_) = (u32x2){pk2(v0_, v1_), pk2(v2_, v3_)}
            { f32x4 c1[2] = {z4, z4}, c2[2] = {z4, z4}, c3[2] = {z4, z4}, c4[2] = {z4, z4};
              mm2(c1, SL(1), SL(0), F.wave, F.lane);
              mm2(c2, SL(0), SL(2), F.wave, F.lane);
              mm2(c3, SL(1), SL(6), F.wave, F.lane);
              mm2(c4, SL(2), SL(6), F.wave, F.lane);
              RW_BASE
#pragma unroll
              for (int nt = 0; nt < 2; ++nt) { const int cc = cb_ + nt * 16, r0 = rb_;
                  { f32x4 v;
#pragma unroll
                    for (int j = 0; j < 4; ++j) v[j] = (r0 + j) < cc ? c1[nt][j] : 0.f;
                    *(LAS f32x4*)(NF + cc * 68 + r0) = v; }
                  PK4S(SL(8) + cc * P72 + r0, cc < r0 ? c2[nt][0] : 0.f, cc < r0 + 1 ? c2[nt][1] : 0.f, cc < r0 + 2 ? c2[nt][2] : 0.f, cc < r0 + 3 ? c2[nt][3] : 0.f);
                  PK4S(SL(9) + cc * P72 + r0, r0 <= cc ? c3[nt][0] : 0.f, r0 + 1 <= cc ? c3[nt][1] : 0.f, r0 + 2 <= cc ? c3[nt][2] : 0.f, r0 + 3 <= cc ? c3[nt][3] : 0.f);
                  PK4S(SL(10) + cc * P72 + r0, r0 <= cc ? c4[nt][0] : 0.f, r0 + 1 <= cc ? c4[nt][1] : 0.f, r0 + 2 <= cc ? c4[nt][2] : 0.f, r0 + 3 <= cc ? c4[nt][3] : 0.f); } }
            LBAR();
            {
              int tid2_ = F.tid; asm volatile("" : "+v"(tid2_)); const int t = tid2_ >> 3, j8 = (tid2_ & 7) * 8; const bool offd = (t >> 4) != (j8 >> 4);
              { const f32x4 n0 = *(const LAS f32x4*)(NF + t * 68 + j8), n1 = *(const LAS f32x4*)(NF + t * 68 + j8 + 4); u32x4 w = (u32x4){0u, 0u, 0u, 0u};
                if (offd) { w.x = pk2(n0[0], n0[1]); w.y = pk2(n0[2], n0[3]); w.z = pk2(n1[0], n1[1]); w.w = pk2(n1[2], n1[3]); }
                *(LAS u32x4*)(SL(0) + t * P72 + j8) = w;
                if (offd) { *(LAS u32x4*)(SL(1) + t * P72 + j8) = (u32x4){0u, 0u, 0u, 0u}; *(LAS u32x4*)(SL(2) + t * P72 + j8) = (u32x4){0u, 0u, 0u, 0u}; } }
              if (tid2_ < 64) { const int b0 = (tid2_ >> 4) * 16, i = tid2_ & 15; float tr[16];
#pragma unroll
                  for (int tt = 0; tt < 16; ++tt) { float val = (tt == i) ? 1.f : 0.f;
#pragma unroll
                      for (int jj = 0; jj < tt; ++jj) val += (jj >= i ? tr[jj] : 0.f) * NF[(b0 + tt) * 68 + b0 + jj];
                      tr[tt] = (tt < i) ? 0.f : val; }
#pragma unroll
                  for (int tt = 0; tt < 16; ++tt) { const bf16 x = (bf16)f2bf(tr[tt]); SL(1)[(b0 + i) * P72 + b0 + tt] = x; SL(2)[(b0 + tt) * P72 + b0 + i] = x; } } }
            LBAR();
            { f32x4 c1[2] = {z4, z4}, c2[2] = {z4, z4};
              mm2(c1, SL(1), SL(0), F.wave, F.lane);
              mm2(c2, SL(0), SL(1), F.wave, F.lane);
              RW_BASE
#pragma unroll
              for (int nt = 0; nt < 2; ++nt) { const int cc = cb_ + nt * 16, r0 = rb_;
                  PK4S(SL(14) + cc * P72 + r0, c1[nt][0], c1[nt][1], c1[nt][2], c1[nt][3]);
                  PK4S(SL(11) + cc * P72 + r0, c2[nt][0], c2[nt][1], c2[nt][2], c2[nt][3]);
                  PK4S(SL(13) + cc * P72 + r0, c2[nt][0] + (cc == r0 ? 1.f : 0.f), c2[nt][1] + (cc == r0 + 1 ? 1.f : 0.f), c2[nt][2] + (cc == r0 + 2 ? 1.f : 0.f), c2[nt][3] + (cc == r0 + 3 ? 1.f : 0.f)); } }
            LBAR();
            { f32x4 c[2] = {z4, z4}; mm2(c, SL(11), SL(14), F.wave, F.lane);
              RW_BASE
#pragma unroll
              for (int nt = 0; nt < 2; ++nt) { const int cc = cb_ + nt * 16, r0 = rb_;
                  PK4S(SL(12) + cc * P72 + r0, c[nt][0] + (cc == r0 ? 1.f : 0.f), c[nt][1] + (cc == r0 + 1 ? 1.f : 0.f), c[nt][2] + (cc == r0 + 2 ? 1.f : 0.f), c[nt][3] + (cc == r0 + 3 ? 1.f : 0.f)); } }
            LBAR();
            { f32x4 c[2] = {z4, z4}; mm2(c, SL(12), SL(13), F.wave, F.lane);
              RW_BASE
#pragma unroll
              for (int nt = 0; nt < 2; ++nt) PK4S(SL(1) + (cb_ + nt * 16) * P72 + rb_, c[nt][0], c[nt][1], c[nt][2], c[nt][3]); }
            LBAR();
            { f32x4 c[2] = {z4, z4}; mm2(c, SL(1), SL(2), F.wave, F.lane);
              RW_BASE
#pragma unroll
              for (int nt = 0; nt < 2; ++nt) PK4S(SL(0) + (cb_ + nt * 16) * P72 + rb_, c[nt][0], c[nt][1], c[nt][2], c[nt][3]); }
            LBAR();
            { f32x4 c1[2] = {z4, z4}, c2[2] = {z4, z4};
              mm2(c1, SL(0), SL(3), F.wave, F.lane);
              mm2(c2, SL(8), SL(0), F.wave, F.lane);
              RW_BASE
#pragma unroll
              for (int nt = 0; nt < 2; ++nt) { const int cc = cb_ + nt * 16, r0 = rb_; PK4S(SL(1) + cc * P72 + r0, c1[nt][0], c1[nt][1], c1[nt][2], c1[nt][3]); PK4S(SL(11) + cc * P72 + r0, c2[nt][0], c2[nt][1], c2[nt][2], c2[nt][3]); } }
            LBAR();
            { f32x4 c1[2] = {z4, z4}, c2[2] = {z4, z4};
              mm2(c1, SL(11), SL(7), F.wave, F.lane);
              mm2(c2, SL(1), SL(9), F.wave, F.lane);
              RW_BASE
#pragma unroll
              for (int nt = 0; nt < 2; ++nt) { const int cc = cb_ + nt * 16, r0 = rb_; PK4S(SL(12) + cc * P72 + r0, c1[nt][0], c1[nt][1], c1[nt][2], c1[nt][3]);
                  const u32x2 rw = *(const LAS u32x2*)(SL(6) + cc * P72 + r0);
                  PK4S(SL(13) + cc * P72 + r0, c2[nt][0] + __uint_as_float(rw.x << 16), c2[nt][1] + __uint_as_float(rw.x & 0xffff0000u), c2[nt][2] + __uint_as_float(rw.y << 16), c2[nt][3] + __uint_as_float(rw.y & 0xffff0000u)); } }
            LBAR();
            { f32x4 c1[2] = {z4, z4}, c2[2] = {z4, z4}, c3[2] = {z4, z4};
              mm2(c1, SL(12), SL(9), F.wave, F.lane); mm2(c1, SL(7), SL(10), F.wave, F.lane);
              mm2(c2, SL(1), SL(4), F.wave, F.lane);
              mm2(c3, SL(12), SL(4), F.wave, F.lane); mm2(c3, SL(7), SL(5), F.wave, F.lane);
              float qf[8]; RW_BASE
#pragma unroll
              for (int nt = 0; nt < 2; ++nt) { const int cc = cb_ + nt * 16, r0 = rb_; const float gc = GC[cc];
                  PK4S(SL(14) + cc * P72 + r0, c1[nt][0], c1[nt][1], c1[nt][2], c1[nt][3]);
                  PK4S(SL(0) + cc * P72 + r0, (c2[nt][0] + (cc == r0 ? 1.f : 0.f)) * gc, (c2[nt][1] + (cc == r0 + 1 ? 1.f : 0.f)) * gc, (c2[nt][2] + (cc == r0 + 2 ? 1.f : 0.f)) * gc, (c2[nt][3] + (cc == r0 + 3 ? 1.f : 0.f)) * gc);
#pragma unroll
                  for (int j = 0; j < 4; ++j) qf[nt * 4 + j] = c3[nt][j] * gc; }
              *(u32x4*)(outb + 1 * 4096 + (F.wave * 64 + F.lane) * 8) = pack8(qf); }
            LBAR();
#undef PK4S
            { int tid_ = F.tid; asm volatile("" : "+v"(tid_)); const int row = tid_ >> 3, sg = (tid_ & 7) * 8;
              *(u32x4*)(outb + 0 * 4096 + row * 64 + sg) = *(const LAS u32x4*)(SL(0) + row * P72 + sg);
              *(u32x4*)(outb + 2 * 4096 + row * 64 + sg) = *(const LAS u32x4*)(SL(13) + row * P72 + sg); *(u32x4*)(outb + 3 * 4096 + row * 64 + sg) = *(const LAS u32x4*)(SL(14) + row * P72 + sg); }
        }
    }
    }
#undef SL
}
__device__ __forceinline__ void ph_rwkv_seq(const AP& a, const Frame& F) {
    unsigned char* S = a.ws + WS_SCR; const bf16* CH = (const bf16*)(S + SB_CH); bf16* SS = (bf16*)(S + SB_SS);
    LAS bf16* Sb = (LAS bf16*)F.lds;
    const int r = F.lane & 15, q = F.lane >> 4, mt = F.wave >> 1, nb = (F.wave & 1) * 32;
    for (int chain = blockIdx.x; chain < 160; chain += gridDim.x) { const int dir = chain & 1, hd = (chain >> 1) & 15, sq = chain >> 5; const int c0 = sq == 0 ? 0 : 256 + (sq - 1) * 32, nc = sq == 0 ? 256 : 32;
        f32x4 acc[2] = {(f32x4){0.f, 0.f, 0.f, 0.f}, (f32x4){0.f, 0.f, 0.f, 0.f}};
        __syncthreads();
        u32x4 p0, p1, p2, p3, p4s, p5, p6, p7, p8, p9, p10, p11, p12, p13, p14, p15, q0, q1, q2, q3, q4s, q5, q6, q7, q8, q9, q10, q11, q12, q13, q14, q15;
        const int crow = F.tid >> 3, cseg = (F.tid & 7) * 8;
        LAS bf16* Pb = Sb + 2 * SLOT;
#define SEQ_LOAD(P_, Q_, s_) do { const int s1_ = (s_) < nc ? (s_) : nc - 1; const int cn1_ = c0 + (dir == 0 ? s1_ : nc - 1 - s1_); const bf16* PT_ = CH + (((size_t)cn1_ * 16 + hd) * 2 + dir) * 4 * 4096; \
            P_ = *(const u32x4*)(PT_ + F.tid * 8); Q_ = *(const u32x4*)(PT_ + 4096 + F.tid * 8); } while (0)
#define SEQ_STEP(P_, Q_, Pn_, Qn_, s_) do { const int cn_ = c0 + (dir == 0 ? (s_) : nc - 1 - (s_)); const size_t itd_ = ((size_t)cn_ * 16 + hd) * 2 + dir; \
            SEQ_LOAD(Pn_, Qn_, (s_) + 15); \
            LAS bf16* sb_ = Sb + ((s_) & 1) * SLOT; LAS bf16* pb_ = Pb + ((s_) & 1) * SLOT; \
            _Pragma("unroll") for (int nt = 0; nt < 2; ++nt) _Pragma("unroll") for (int j = 0; j < 4; ++j) sb_[(mt * 16 + q * 4 + j) * P72 + nb + nt * 16 + r] = (bf16)f2bf(acc[nt][j]); \
            *(LAS u32x4*)(pb_ + crow * P72 + cseg) = P_; \
            asm volatile("s_waitcnt lgkmcnt(0)" ::: "memory"); __builtin_amdgcn_s_barrier(); asm volatile("" ::: "memory"); \
            *(u32x4*)(SS + itd_ * 4096 + crow * 64 + cseg) = *(const LAS u32x4*)(sb_ + crow * P72 + cseg);            \
            { float qf_[8]; unpack8(Q_, qf_); acc[0] = (f32x4){qf_[0], qf_[1], qf_[2], qf_[3]}; acc[1] = (f32x4){qf_[4], qf_[5], qf_[6], qf_[7]}; } \
            _Pragma("unroll") for (int ks = 0; ks < 2; ++ks) { const bf16x8 av = *(const LAS bf16x8*)(sb_ + (mt * 16 + r) * P72 + ks * 32 + q * 8); \
                _Pragma("unroll") for (int nt = 0; nt < 2; ++nt) { const bf16x8 bv = *(const LAS bf16x8*)(pb_ + (nb + nt * 16 + r) * P72 + ks * 32 + q * 8); acc[nt] = __builtin_amdgcn_mfma_f32_16x16x32_bf16(av, bv, acc[nt], 0, 0, 0); } } } while (0)
        SEQ_LOAD(p0, q0, 0); SEQ_LOAD(p1, q1, 1); SEQ_LOAD(p2, q2, 2); SEQ_LOAD(p3, q3, 3); SEQ_LOAD(p4s, q4s, 4); SEQ_LOAD(p5, q5, 5); SEQ_LOAD(p6, q6, 6); SEQ_LOAD(p7, q7, 7); SEQ_LOAD(p8, q8, 8); SEQ_LOAD(p9, q9, 9); SEQ_LOAD(p10, q10, 10); SEQ_LOAD(p11, q11, 11); SEQ_LOAD(p12, q12, 12); SEQ_LOAD(p13, q13, 13); SEQ_LOAD(p14, q14, 14);
        for (int s = 0; s < nc; s += 16) {
            SEQ_STEP(p0, q0, p15, q15, s + 0);
            SEQ_STEP(p1, q1, p0, q0, s + 1);
            SEQ_STEP(p2, q2, p1, q1, s + 2);
            SEQ_STEP(p3, q3, p2, q2, s + 3);
            SEQ_STEP(p4s, q4s, p3, q3, s + 4);
            SEQ_STEP(p5, q5, p4s, q4s, s + 5);
            SEQ_STEP(p6, q6, p5, q5, s + 6);
            SEQ_STEP(p7, q7, p6, q6, s + 7);
            SEQ_STEP(p8, q8, p7, q7, s + 8);
            SEQ_STEP(p9, q9, p8, q8, s + 9);
            SEQ_STEP(p10, q10, p9, q9, s + 10);
            SEQ_STEP(p11, q11, p10, q10, s + 11);
            SEQ_STEP(p12, q12, p11, q11, s + 12);
            SEQ_STEP(p13, q13, p12, q12, s + 13);
            SEQ_STEP(p14, q14, p13, q13, s + 14);
            SEQ_STEP(p15, q15, p14, q14, s + 15);
        }
#undef SEQ_LOAD
#undef SEQ_STEP
    }
}
__device__ __forceinline__ void ph_rwkv_out(const AP& a, const Frame& F, int l) {
    unsigned char* S = a.ws + WS_SCR; const bf16* CH = (const bf16*)(S + SB_CH); const bf16* SS = (const bf16*)(S + SB_SS); const bf16* PROJ = (const bf16*)(a.ws + WS_PROJ); bf16* Y = (bf16*)(a.ws + WS_Y);
    const bf16* V = (const bf16*)(S + SB_V);
    const float* BSP = (const float*)(a.ws + WS_RSP); const float* lg = a.in(I_LNG) + (size_t)l * WB; const float* lbp = a.in(I_LNB) + (size_t)l * WB;
    const int r = F.lane & 15, q = F.lane >> 4;
    for (int it = F.gw; it < (T / 64) * 16; it += F.ngw) { const int hd = it & 15, cn = it >> 4; const size_t item = (size_t)cn * 16 + hd;
      bf16x8 bS[2][4][2];
#pragma unroll
      for (int dir = 0; dir < 2; ++dir) { const bf16* Sg = SS + (item * 2 + dir) * 4096;
#pragma unroll
          for (int nt = 0; nt < 4; ++nt)
#pragma unroll
              for (int ks = 0; ks < 2; ++ks) bS[dir][nt][ks] = *(const bf16x8*)(Sg + (4 * r + nt) * 64 + ks * 32 + q * 8); }
#pragma unroll 2
      for (int mt = 0; mt < 4; ++mt) {
        f32x4 acc[4];
#pragma unroll
        for (int nt = 0; nt < 4; ++nt) acc[nt] = (f32x4){0.f, 0.f, 0.f, 0.f};
#pragma unroll
        for (int dir = 0; dir < 2; ++dir) { const bf16* ob = CH + (item * 2 + dir) * 4 * 4096; const bf16* R2T = ob + 2 * 4096; const bf16* Y0 = ob + 3 * 4096;
            const int trow = dir ? 63 - (mt * 16 + r) : mt * 16 + r;
#pragma unroll
            for (int ks = 0; ks < 2; ++ks) { const bf16x8 av = *(const bf16x8*)(R2T + trow * 64 + ks * 32 + q * 8);
#pragma unroll
                for (int nt = 0; nt < 4; ++nt) acc[nt] = __builtin_amdgcn_mfma_f32_16x16x32_bf16(av, bS[dir][nt][ks], acc[nt], 0, 0, 0); }
#pragma unroll
            for (int j = 0; j < 4; ++j) { const int tl = mt * 16 + q * 4 + j; const u32x2 yw = *(const u32x2*)(Y0 + (dir ? 63 - tl : tl) * 64 + 4 * r);
                acc[0][j] += __uint_as_float(yw.x << 16); acc[1][j] += __uint_as_float(yw.x & 0xffff0000u); acc[2][j] += __uint_as_float(yw.y << 16); acc[3][j] += __uint_as_float(yw.y & 0xffff0000u); } }
        const int c = hd * 64 + 4 * r; const f32x4 lg4 = *(const f32x4*)(lg + c), lb4 = *(const f32x4*)(lbp + c);
        u32x2 wq[4][4]; float bsv[4];
#pragma unroll
        for (int j = 0; j < 4; ++j) { const int t = cn * 64 + mt * 16 + q * 4 + j; const size_t o = (size_t)t * WB + c; wq[j][2] = *(const u32x2*)(V + o); wq[j][3] = *(const u32x2*)(PROJ + (size_t)t * NPJ + C_RWZ + c); bsv[j] = BSP[(size_t)t * 16 + hd]; }
#pragma unroll
        for (int j = 0; j < 4; ++j) { const int t = cn * 64 + mt * 16 + q * 4 + j; float s = (acc[0][j] + acc[1][j]) + (acc[2][j] + acc[3][j]);
            s += shx<1>(s); s += shx<2>(s); s += shx<4>(s); s += shx<8>(s); const float mean = s * (1.0f / 64.0f); float vs = 0.f; const float bs = bsv[j];
            float vv[4], zz[4];
            { const u32x2 w3 = wq[j][2], w4 = wq[j][3];
              vv[0] = __uint_as_float(w3.x << 16); vv[1] = __uint_as_float(w3.x & 0xffff0000u); vv[2] = __uint_as_float(w3.y << 16); vv[3] = __uint_as_float(w3.y & 0xffff0000u);
              zz[0] = __uint_as_float(w4.x << 16); zz[1] = __uint_as_float(w4.x & 0xffff0000u); zz[2] = __uint_as_float(w4.y << 16); zz[3] = __uint_as_float(w4.y & 0xffff0000u); }
#pragma unroll
            for (int nt = 0; nt < 4; ++nt) { const float dl = acc[nt][j] - mean; vs += dl * dl; }
            vs += shx<1>(vs); vs += shx<2>(vs); vs += shx<4>(vs); vs += shx<8>(vs);
            const float rstd = __builtin_amdgcn_rsqf(vs * (1.0f / 64.0f) + 64e-5f); float o4[4];
#pragma unroll
            for (int nt = 0; nt < 4; ++nt) { const float yn = (acc[nt][j] - mean) * rstd * lg4[nt] + lb4[nt]; o4[nt] = (yn + bs * vv[nt]) * siluf_(zz[nt]); }
            *(u32x2*)(Y + (size_t)t * 4096 + 1024 + c) = (u32x2){pk2(o4[0], o4[1]), pk2(o4[2], o4[3])}; }
      }
    }
}
constexpr int NPH_PRO = 3, NPH_LAYER = 21, NPH = NPH_PRO + DEPTH * NPH_LAYER + 1;

__global__ void __launch_bounds__(NTHR, 2) fwd(Args ka) {
    extern __shared__ __attribute__((aligned(16))) unsigned char lds_[];
    Frame F; F.lds = (LAS unsigned char*)lds_; F.tid = threadIdx.x; F.lane = F.tid & 63; F.wave = __builtin_amdgcn_readfirstlane(F.tid >> 6);
    F.gw = blockIdx.x * NWAVES + F.wave; F.ngw = gridDim.x * NWAVES; F.gt = blockIdx.x * NTHR + F.tid; F.ngt = gridDim.x * NTHR;
    volatile LAS unsigned* MISC = (volatile LAS unsigned*)(F.lds + LDS_MISC);
    if (F.tid < 64) MISC[F.tid] = 0u;
    { LAS unsigned long long* aq = (LAS unsigned long long*)(F.lds + LDS_ARGS);
#pragma unroll
      for (int i = 0; i < 35; ++i) if (F.tid == i) aq[i] = (unsigned long long)ka.in[i]; }
    __syncthreads();
    AP a; a.q = (const LAS unsigned long long*)(F.lds + LDS_ARGS); a.ws = ka.ws; a.out = ka.out;
    const int ph_lo = ka.ph_lo, ph_hi = ka.ph_hi;
    unsigned* barw = (unsigned*)(a.ws + WS_CTL) + 4096;
    const int wave0 = F.wave;
    XcdBarrier bar; bar.bar = barw; bar.x = 0; bar.st = MISC + 8;
    if (ph_hi - ph_lo > 1) bar = xcd_barrier_post(barw, MISC + 8);
    bar.wave = wave0;
    int gp = 0;
#ifndef PH_DBL
#define PH_DBL 0ull
#endif
#ifndef PH_ONLY
#define PH_ONLY -1
#endif
#define PHASE(pid, ...) do { int lo_ = ph_lo, hi_ = ph_hi; asm volatile("" : "+s"(lo_), "+s"(hi_)); if ((PH_ONLY < 0 || PH_ONLY == (pid)) && lo_ <= gp && gp < hi_) { F.lane = lane_id(); asm volatile("" : "+v"(F.lane)); F.wave = wave0; F.tid = F.wave * 64 + F.lane; F.gw = blockIdx.x * NWAVES + F.wave; F.ngw = gridDim.x * NWAVES; F.ngt = gridDim.x * NTHR; asm volatile("" : "+s"(F.gw), "+s"(F.ngw), "+s"(F.ngt)); F.gt = blockIdx.x * NTHR + F.tid; __VA_ARGS__; if ((PH_DBL >> (pid)) & 1ull) { xcd_barrier(bar); __VA_ARGS__; } if (gp + 1 < hi_) xcd_barrier(bar); } ++gp; } while (0)
    const int G = gridDim.x, cb = blockIdx.x;
    LAS unsigned char* lds = F.lds;
    unsigned char* ws = a.ws;

    PHASE(0, ph_tables(a, F));
    PHASE(1, ph_convert(a, F));
    PHASE(2, { ph_s5mats(a, F); ph_x0(a, F); });

    for (int l = 0; l < DEPTH; ++l) {
        const bf16* WALLT = (const bf16*)(ws + WS_WALLT) + (size_t)l * NALL * D;
        const float* rss_l = (const float*)(ws + WS_RSS) + (size_t)(l & 1) * T;
        PHASE(4, { pg8::Gemm g{(const bf16*)(ws + WS_H), WALLT, D, D, D}; pg8::Order S; S.init(T / 256, NPJ / 256, 1, G, cb, (size_t)256 * D * 2, 0, (size_t)256 * D * 2, 0);
                EpiBf16 E{(bf16*)(ws + WS_PROJ), NPJ, C_WDF / 256, rss_l}; pg8::gemm_phase(lds, g, S, E, F.tid); });
        PHASE(5, ph_lru_conv(a, F, l));
        PHASE(6, { pg8::Gemm g{(const bf16*)(ws + WS_SCR + SA_XC), (const bf16*)(ws + WS_LRUW) + (size_t)l * 4096 * 256, WB, 256, 256}; pg8::Order S; S.init(T / 256, 16, 1, G, cb, (size_t)256 * WB * 2, 0, (size_t)256 * 256 * 2, 0); S.kwin = 256 * 2;
                EpiLru E{a.in(I_BR) + (size_t)l * 2 * WB, a.in(I_BI) + (size_t)l * 2 * WB, a.in(I_LAM) + (size_t)l * 2 * WB, (const bf16*)(ws + WS_SCR + SA_XC), (bf16*)(ws + WS_SCR + SA_LA), (bf16*)(ws + WS_SCR + SA_BB)};
                pg8::gemm_phase(lds, g, S, E, F.tid); });
        PHASE(7, ph_lru_scan1(a, F));
        PHASE(8, ph_lru_scan2(a, F));
        PHASE(9, ph_lru_scan3(a, F));
        PHASE(10, ph_s5_rearr(a, F));
        PHASE(11, { pg8::Gemm g{(const bf16*)(ws + WS_SCR + SD_UC), (const bf16*)(ws + WS_S5INC) + (size_t)l * 64 * 256 * 256, 512, 256, 256}; pg8::Order S;
                S.init(NCH_S5 / 256, 1, 64, G, cb, (size_t)256 * 512 * 2, (size_t)NCH_S5 * 512 * 2, 0, (size_t)256 * 256 * 2);
                EpiF32 E{(float*)(ws + WS_SCR + SD_INC), 256, (size_t)NCH_S5 * 256}; pg8::gemm_phase(lds, g, S, E, F.tid); });
        PHASE(12, ph_s5_scan(a, F, l));
        PHASE(13, { pg8::Gemm g{(const bf16*)(ws + WS_SCR + SD_UC), (const bf16*)(ws + WS_S5MAIN) + (size_t)l * 64 * 256 * 512, 512, 512, 512}; pg8::Order S;
                S.init(NCH_S5 / 256, 1, 64, G, cb, (size_t)256 * 512 * 2, (size_t)NCH_S5 * 512 * 2, 0, (size_t)256 * 512 * 2);
                EpiS5Main E{(bf16*)(ws + WS_SCR + SD_YG)}; pg8::gemm_phase(lds, g, S, E, F.tid); });
        PHASE(14, { pg8::Gemm g{(const bf16*)(ws + WS_SCR + SD_YG), (const bf16*)(ws + WS_GLUT) + (size_t)l * WB * WB, WB, WB, WB}; pg8::Order S; S.init(T / 256, WB / 256, 1, G, cb, (size_t)256 * WB * 2, 0, (size_t)256 * WB * 2, 0);
                EpiGlu E{(const bf16*)(ws + WS_SCR + SD_YG), (const bf16*)(ws + WS_PROJ), a.in(I_GLUB) + (size_t)l * WB, (bf16*)(ws + WS_Y)}; pg8::gemm_phase(lds, g, S, E, F.tid); });
        PHASE(15, ph_ret_kv(a, F));
        PHASE(16, ph_ret_scan(a, F));
        PHASE(25, { pg8::Gemm g{(const bf16*)(ws + WS_PROJ) + C_WDF, (const bf16*)(ws + WS_W2ALL) + (size_t)l * 3072 * 256, NPJ, 256, 256}; pg8::Order S; S.init(T / 256, 3072 / 256, 1, G, cb, (size_t)256 * NPJ * 2, 0, (size_t)256 * 256 * 2, 0);
                EpiBf16 E{(bf16*)(ws + WS_SCR + SB_LO), 3072, -1, nullptr}; pg8::gemm_phase(lds, g, S, E, F.tid); });
        PHASE(18, ph_rwkv_prep(a, F, l));
        PHASE(19, ph_rwkv_chunk(a, F, l));
        PHASE(20, { ph_rwkv_seq(a, F); ph_ret_out(a, F, l); });
        PHASE(24, ph_rwkv_out(a, F, l));
        PHASE(21, { { pg8::Gemm g{(const bf16*)(ws + WS_H), WALLT + (size_t)NPJ * D, D, D, D}; pg8::Order S; S.init(T / 256, 4 * D / 256, 1, G, cb, (size_t)256 * D * 2, 0, (size_t)256 * D * 2, 0);
                      EpiGate E{(bf16*)(ws + WS_SCR + SM_GS), rss_l}; pg8::gemm_phase(lds, g, S, E, F.tid); }
                    xcd_barrier(bar);
                    { pg8::Gemm g{(const bf16*)(ws + WS_Y), (const bf16*)(ws + WS_WBRT) + (size_t)l * D * 4096, 4096, 4096, WB}; pg8::Order S; S.init(T / 256, D / 256, 4, G, cb, (size_t)256 * 4096 * 2, (size_t)WB * 2, (size_t)256 * 4096 * 2, (size_t)WB * 2); S.zfast = 1;
                      EpiBranchAll E{(const bf16*)(ws + WS_SCR + SM_GS), (bf16*)(ws + WS_SCR + SM_MG)}; pg8::gemm_phase(lds, g, S, E, F.tid); } });
        PHASE(22, { pg8::Gemm g{(const bf16*)(ws + WS_SCR + SM_MG), (const bf16*)(ws + WS_WOUTT) + (size_t)l * D * D, D, D, D}; pg8::Order S; S.init(T / 256, D / 256, 1, G, cb, (size_t)256 * D * 2, 0, (size_t)256 * D * 2, 0);
#ifdef OUT_DRY
                { EpiNull E0; pg8::gemm_phase(lds, g, S, E0, F.tid); }
#endif
                EpiOut E{a.in(I_XP), a.in(I_XS), a.out, (bf16*)(ws + WS_H), (float*)(ws + WS_RSP), l == 0 ? 1 : 0}; pg8::gemm_phase(lds, g, S, E, F.tid); });
        PHASE(26, ph_rss(a, F, l));
#ifdef XTRA_BAR
        for (int xb = 0; xb < XTRA_BAR; ++xb) xcd_barrier(bar);
#endif
    }
    PHASE(23, ph_final(a, F));
#undef PHASE
}

extern "C" void kernel_launch(void* const* d_in, const int* in_sizes, int n_in, void* d_out, int out_size, void* d_ws, size_t ws_size, hipStream_t stream) {
    static int grid = 0;
    if (grid == 0) {
        if (n_in != 35 || out_size != T * D || ws_size < WS_END) { fprintf(stderr, "kernel_launch: unexpected shapes (n_in %d out %d ws %zu need %zu)\n", n_in, out_size, ws_size, (size_t)WS_END); grid = -1; return; }
        int dev = 0, cus = 0, per_cu = 0;
        if (hipGetDevice(&dev) != hipSuccess || hipDeviceGetAttribute(&cus, hipDeviceAttributeMultiprocessorCount, dev) != hipSuccess) { grid = -1; return; }
        if (hipFuncSetAttribute((const void*)fwd, hipFuncAttributeMaxDynamicSharedMemorySize, LDS_BYTES) != hipSuccess) { fprintf(stderr, "kernel_launch: hipFuncSetAttribute failed\n"); grid = -1; return; }
        if (hipOccupancyMaxActiveBlocksPerMultiprocessor(&per_cu, (const void*)fwd, NTHR, LDS_BYTES) != hipSuccess || per_cu < 1) fprintf(stderr, "kernel_launch: occupancy query says %d\n", per_cu);
        (void)hipGetLastError();
        grid = cus;
    }
    if (grid < 0) return;
    (void)hipMemsetAsync((char*)d_ws + WS_CTL, 0, CTL_BYTES, stream);
    Args a{};
    for (int i = 0; i < 35; ++i) a.in[i] = (const float*)d_in[i];
    a.out = (float*)d_out; a.ws = (unsigned char*)d_ws;
#if MK_ONE_LAUNCH
    a.ph_lo = 0; a.ph_hi = NPH;
    hipLaunchKernelGGL(fwd, dim3(grid), dim3(NTHR), LDS_BYTES, stream, a);
#else
    for (int p = 0; p < NPH; ++p) { a.ph_lo = p; a.ph_hi = p + 1; hipLaunchKernelGGL(fwd, dim3(grid), dim3(NTHR), LDS_BYTES, stream, a); }
#endif
}
```

```cpp
#include <hip/hip_runtime.h>
#include <cstdio>
#include <cstdint>

#ifndef MK_ONE_LAUNCH
#define MK_ONE_LAUNCH 1
#endif

#define LAS __attribute__((address_space(3)))
#define GAS __attribute__((address_space(1)))
typedef unsigned short bf16;
typedef short bf16x8 __attribute__((ext_vector_type(8)));
typedef float f32x4 __attribute__((ext_vector_type(4)));
typedef float f32x2 __attribute__((ext_vector_type(2)));
typedef unsigned u32x4 __attribute__((ext_vector_type(4)));
typedef unsigned u32x2 __attribute__((ext_vector_type(2)));

constexpr int T = 24576, TP = 16384, LS = 2048, D = 2048, WB = 1024, DEPTH = 4;
constexpr int NPJ = 11520, NIN = 19648, GOFF = 11456, NALL = 19712;
constexpr int C_LRUX = 0, C_LRUZ = 1024, C_RWR = 2048, C_RWK = 3072, C_RWV = 4096, C_WDF = 5120, C_WDB = 5184, C_AD = 5248, C_RWZ = 5312,
              C_RQ = 6336, C_RK = 6848, C_RV = 7360, C_RZ = 8384, C_SU = 9408, C_SZ = 10432;
constexpr int NCH_S5 = T / 16;
constexpr int NCH_RET = T / 128;
constexpr int NCH_LRU = T / 128;

constexpr size_t al(size_t x) { return (x + 0xFFFFFu) & ~(size_t)0xFFFFFu; }
constexpr size_t WS_CTL = 0, CTL_BYTES = 1u << 20;
constexpr size_t WS_WALLT = al(WS_CTL + CTL_BYTES);
constexpr size_t WS_LRUW  = al(WS_WALLT + (size_t)DEPTH * NALL * D * 2);
constexpr size_t WS_GLUT  = al(WS_LRUW + (size_t)DEPTH * 4096 * 256 * 2);
constexpr size_t WS_WBRT  = al(WS_GLUT + (size_t)DEPTH * 1024 * 1024 * 2);
constexpr size_t WS_WOUTT = al(WS_WBRT + (size_t)DEPTH * 2048 * 4096 * 2);
constexpr size_t WS_S5MAIN= al(WS_WOUTT + (size_t)DEPTH * 2048 * 2048 * 2);
constexpr size_t WS_S5INC = al(WS_S5MAIN + (size_t)DEPTH * 64 * 256 * 512 * 2);
constexpr size_t WS_S5TAB = al(WS_S5INC + (size_t)DEPTH * 64 * 256 * 256 * 2);
constexpr size_t WS_W2ALL = al(WS_S5TAB + (size_t)DEPTH * 2 * 64 * 64 * 33 * 8);
constexpr size_t WS_ROT   = al(WS_W2ALL + (size_t)DEPTH * 3072 * 256 * 2);
constexpr size_t WS_RSS   = al(WS_ROT + (size_t)16384 * 64 * 8);
constexpr size_t WS_RSP   = al(WS_RSS + (size_t)2 * T * 4);
constexpr size_t WS_H     = al(WS_RSP + (size_t)T * 32 * 4);
constexpr size_t WS_PROJ  = al(WS_H + (size_t)T * D * 2);
constexpr size_t WS_Y     = al(WS_PROJ + (size_t)T * NPJ * 2);
constexpr size_t WS_STP   = al(WS_Y + (size_t)T * 4096 * 2);
constexpr size_t WS_SCR   = al(WS_STP + (size_t)2 * 768 * 256 * 128 * 2);
constexpr size_t TW4 = (size_t)T * WB * 4, TW2 = (size_t)T * WB * 2;
constexpr int NCH_L32 = T / 32;
constexpr size_t SA_XC = 0, SA_LA = al(SA_XC + TW2), SA_BB = al(SA_LA + 2 * TW2), SA_PA = al(SA_BB + 2 * TW2),
                 SA_PB = al(SA_PA + (size_t)NCH_L32 * 2 * WB * 4), SA_CAR = al(SA_PB + (size_t)NCH_L32 * 2 * WB * 4), SA_END = al(SA_CAR + (size_t)NCH_L32 * 2 * WB * 4);
constexpr size_t SD_UC = 0, SD_INC = al(SD_UC + (size_t)64 * NCH_S5 * 512 * 2), SD_YG = al(SD_INC + (size_t)64 * NCH_S5 * 256 * 4), SD_END = al(SD_YG + TW2);
constexpr size_t SC_KVT = 0, SC_END = al(SC_KVT + (size_t)2 * 768 * 256 * 128 * 4);
constexpr size_t SB_R = 0, SB_KM = al(SB_R + TW2), SB_V = al(SB_KM + TW2), SB_KK = al(SB_V + TW2), SB_AG = al(SB_KK + TW2), SB_LWF = al(SB_AG + TW2), SB_LWB = al(SB_LWF + TW2),
                 SB_CH = al(SB_LWB + TW2), SB_SS = al(SB_CH + (size_t)(T / 64) * 16 * 2 * 4 * 4096 * 2), SB_END = al(SB_SS + (size_t)(T / 64) * 16 * 2 * 4096 * 2), SB_LO = SB_CH;
constexpr size_t SM_GS = 0, SM_MG = al(SM_GS + (size_t)T * 4 * D * 2), SM_END = al(SM_MG + (size_t)T * D * 2);
constexpr size_t cmax(size_t a, size_t b) { return a > b ? a : b; }
constexpr size_t SCR_BYTES = cmax(cmax(cmax(SA_END, SD_END), cmax(SC_END, SB_END)), SM_END);
constexpr size_t WS_END = WS_SCR + SCR_BYTES;
static_assert(WS_END < (size_t)2500 * 1000 * 1000, "workspace budget");

__device__ __forceinline__ float ld_agent(const float* p) { return __hip_atomic_load(p, __ATOMIC_RELAXED, __HIP_MEMORY_SCOPE_AGENT); }
__device__ __forceinline__ void st_agent(float* p, float v) { __hip_atomic_store(p, v, __ATOMIC_RELAXED, __HIP_MEMORY_SCOPE_AGENT); }
__device__ __forceinline__ int lane_id() { unsigned m = ~0u; asm volatile("" : "+s"(m)); return (int)__builtin_amdgcn_mbcnt_hi(m, __builtin_amdgcn_mbcnt_lo(m, 0u)); }
__device__ __forceinline__ float bf2f(bf16 b) { return __uint_as_float(((unsigned)b) << 16); }
typedef __bf16 hwbf16x2 __attribute__((ext_vector_type(2)));
__device__ __forceinline__ unsigned pk2(float lo, float hi) { const f32x2 v = {lo, hi}; return __builtin_bit_cast(unsigned, __builtin_convertvector(v, hwbf16x2)); }
__device__ __forceinline__ unsigned f2bf(float f) { return pk2(f, 0.f) & 0xffffu; }
__device__ __forceinline__ float sigmoidf_(float x) { return __builtin_amdgcn_rcpf(1.0f + __expf(-x)); }
__device__ __forceinline__ float siluf_(float x) { return x * __builtin_amdgcn_rcpf(1.0f + __expf(-x)); }
__device__ __forceinline__ float tanhf_(float x) { const float e = __expf(2.0f * fminf(fmaxf(x, -15.f), 15.f)); return 1.0f - 2.0f * __builtin_amdgcn_rcpf(e + 1.0f); }
__device__ __forceinline__ float softplusf_(float x) { return fmaxf(x, 0.f) + __logf(1.0f + __expf(-fabsf(x))); }
__device__ __forceinline__ float gelu_tanh(float x) { const float u = 0.7978845608028654f * (x + 0.044715f * x * x * x); const float e = __expf(2.f * u); const float th = 1.f - 2.f * __builtin_amdgcn_rcpf(e + 1.f); return 0.5f * x * (1.f + th); }
template <int O> __device__ __forceinline__ float shx(float v) {
    if constexpr (O < 32) return __int_as_float(__builtin_amdgcn_ds_swizzle(__float_as_int(v), (O << 10) | 0x1f));
    else { const int lane = lane_id(); return __int_as_float(__builtin_amdgcn_ds_bpermute((lane ^ O) << 2, __float_as_int(v))); }
}
__device__ __forceinline__ float wave_sum(float v) { v += shx<1>(v); v += shx<2>(v); v += shx<4>(v); v += shx<8>(v); v += shx<16>(v); v += shx<32>(v); return v; }
__device__ __forceinline__ void seq_of(int t, int& pos, int& L) { if (t < TP) { pos = t; L = TP; } else { pos = (t - TP) & (LS - 1); L = LS; } }
__device__ __forceinline__ void unpack8(const u32x4 w, float (&x)[8]) {
    x[0] = __uint_as_float(w.x << 16); x[1] = __uint_as_float(w.x & 0xffff0000u); x[2] = __uint_as_float(w.y << 16); x[3] = __uint_as_float(w.y & 0xffff0000u);
    x[4] = __uint_as_float(w.z << 16); x[5] = __uint_as_float(w.z & 0xffff0000u); x[6] = __uint_as_float(w.w << 16); x[7] = __uint_as_float(w.w & 0xffff0000u);
}
__device__ __forceinline__ u32x4 pack8(const float (&x)[8]) { u32x4 w; w.x = pk2(x[0], x[1]); w.y = pk2(x[2], x[3]); w.z = pk2(x[4], x[5]); w.w = pk2(x[6], x[7]); return w; }

namespace pg8 {
#define PG8_LAS __attribute__((address_space(3)))
typedef unsigned short bf16_t;
constexpr int BM = 256, BK = 64, HALF = 128, HTB = HALF * BK * 2, STAGE_BYTES = 8 * HTB, NXCD = 8, WGM = 4;
__host__ __device__ __forceinline__ int lds_byte(int r, int c) { const int st = (r >> 4) * 2 + (c >> 5), rr = r & 15, cc = c & 31, ob = rr * 64 + cc * 2; return st * 1024 + (ob ^ (((ob >> 9) & 1) << 5)); }
__host__ __device__ __forceinline__ void stage_rc(int b, int& R, int& C) { const int st = b / 1024, sb = b % 1024, swz = sb ^ (((sb >> 9) & 1) << 5); R = (st >> 1) * 16 + swz / 64; C = (st & 1) * 32 + (swz % 64) / 2; }
__host__ __device__ __forceinline__ int perm32(int rho) { const int n = rho >> 4, i = rho & 15; return 8 * (i >> 2) + 4 * n + (i & 3); }

struct Unit { int pm, pn, z; size_t aoff, boff; };
struct Gemm { const bf16_t* A; const bf16_t* Bt; int lda, ldb, K; };

struct Order {
    int nM, nN, nZ, G, c; size_t a_pm, a_z, b_pn, b_z; int kwin = 0; int zfast = 0;
    __device__ __forceinline__ void init(int nM_, int nN_, int nZ_, int G_, int c_, size_t a_pm_, size_t a_z_, size_t b_pn_, size_t b_z_) { nM = nM_; nN = nN_; nZ = nZ_; G = G_; c = c_; a_pm = a_pm_; a_z = a_z_; b_pn = b_pn_; b_z = b_z_; }
    __device__ __forceinline__ bool next(int i, Unit& u) const {
        const int nwg = nM * nN; int z, wgid;
        if (zfast) { const long L = (long)(i / nZ) * G + c; if (L >= (long)nwg) return false; z = i % nZ; wgid = (int)L; }
        else { const long L = (long)i * G + c; if (L >= (long)nwg * nZ) return false; z = (int)(L / nwg); wgid = (int)(L % nwg); }
        { const int q = nwg / NXCD, r = nwg % NXCD, xcd = wgid % NXCD, off = wgid / NXCD; wgid = (xcd < r ? xcd * (q + 1) : r * (q + 1) + (xcd - r) * q) + off; }
        const int nig = WGM * nN, gid = wgid / nig, fm = gid * WGM, gsz = (nM - fm) < WGM ? (nM - fm) : WGM;
        u.pm = fm + ((wgid % nig) % gsz); u.pn = (wgid % nig) / gsz; u.z = z;
        u.aoff = (size_t)u.pm * a_pm + (size_t)z * a_z + (size_t)(((u.pn & 7) >> 1) * kwin); u.boff = (size_t)u.pn * b_pn + (size_t)z * b_z; return true;
    }
};

template <class Epi>
__device__ __forceinline__ void gemm_phase(PG8_LAS unsigned char* lds, const Gemm g, const Order& S, const Epi& E, int tid_in) {
    int tid_ = tid_in; asm volatile("" : "+v"(tid_));
    const int tid = tid_, wid = __builtin_amdgcn_readfirstlane(tid >> 6), lane = tid & 63, wr = wid >> 2, wc = wid & 3, fr = lane & 15, fq = lane >> 4;
    const int K = g.K, nt = K / BK;
    unsigned voffA[2], voffB[2];
#pragma unroll
    for (int i = 0; i < 2; ++i) { int R, C; stage_rc(tid * 16 + i * 8192, R, C); const int Rb = Epi::PERM ? ((R & ~31) + perm32(R & 31)) : R;
        voffA[i] = (unsigned)(R * g.lda + C) * 2u; voffB[i] = (unsigned)(Rb * g.ldb + C) * 2u; }
    const size_t kstep = (size_t)(BK * 2);
    const size_t hstepA = (size_t)HALF * g.lda * 2, hstepB = (size_t)HALF * g.ldb * 2;
    const unsigned ldsw = (unsigned)wid * 1024u;
    const int aoff = lds_byte(wr * 64 + fr, fq * 8), boff = lds_byte(wc * 32 + fr, fq * 8);
#define PG8_SA(b, h) (((b) * 2 + (h)) * HTB)
#define PG8_SB(b, h) ((4 + (b) * 2 + (h)) * HTB)
#define PG8_STAGE(bufoff, gbase, voff) do { _Pragma("unroll") for (int _i = 0; _i < 2; ++_i) \
        __builtin_amdgcn_global_load_lds((const unsigned*)((const char*)(gbase) + (voff)[_i]), (PG8_LAS unsigned*)(lds + (bufoff) + ldsw + _i * 8192), 16, 0, 0); } while (0)
#define PG8_LDA(dst, b, h) do { _Pragma("unroll") for (int m = 0; m < 4; ++m) _Pragma("unroll") for (int k = 0; k < 2; ++k) dst[m][k] = *(const PG8_LAS bf16x8*)(lds + PG8_SA(b, h) + aoff + m * 2048 + k * 1024); } while (0)
#define PG8_LDB(dst, b, h) do { _Pragma("unroll") for (int n = 0; n < 2; ++n) _Pragma("unroll") for (int k = 0; k < 2; ++k) dst[n][k] = *(const PG8_LAS bf16x8*)(lds + PG8_SB(b, h) + boff + n * 2048 + k * 1024); } while (0)
#define PG8_MMA(ai, bj, At, Bt) do { __builtin_amdgcn_s_setprio(1); _Pragma("unroll") for (int m = 0; m < 4; ++m) _Pragma("unroll") for (int n = 0; n < 2; ++n) _Pragma("unroll") for (int k = 0; k < 2; ++k) \
        acc[ai][bj][m][n] = __builtin_amdgcn_mfma_f32_16x16x32_bf16(Bt[n][k], At[m][k], acc[ai][bj][m][n], 0, 0, 0); __builtin_amdgcn_s_setprio(0); } while (0)
#define PG8_WAIT_V(n) asm volatile("s_waitcnt vmcnt(" #n ")" ::: "memory")
#define PG8_WAIT_L(n) asm volatile("s_waitcnt lgkmcnt(" #n ")" ::: "memory")
#define PG8_BAR __builtin_amdgcn_s_barrier()
#define PG8_SCHED __builtin_amdgcn_sched_barrier(0)
    Unit cur, nxt; int ui = 0;
    if (!S.next(0, cur)) return;
    f32x4 acc[2][2][4][2];
#pragma unroll
    for (int a = 0; a < 2; ++a)
#pragma unroll
        for (int b = 0; b < 2; ++b)
#pragma unroll
            for (int m = 0; m < 4; ++m)
#pragma unroll
                for (int n = 0; n < 2; ++n) acc[a][b][m][n] = (f32x4){0.f, 0.f, 0.f, 0.f};
    const char* cA = (const char*)g.A + cur.aoff; const char* cB = (const char*)g.Bt + cur.boff;
    PG8_STAGE(PG8_SB(0, 0), cB, voffB); PG8_STAGE(PG8_SB(0, 1), cB + hstepB, voffB); PG8_STAGE(PG8_SA(0, 0), cA, voffA); PG8_STAGE(PG8_SA(0, 1), cA + hstepA, voffA);
    if (wr == 1) PG8_BAR;
    PG8_WAIT_V(2); PG8_BAR;
    PG8_STAGE(PG8_SB(1, 0), cB + kstep, voffB); PG8_STAGE(PG8_SA(1, 0), cA + kstep, voffA); PG8_STAGE(PG8_SB(1, 1), cB + hstepB + kstep, voffB);
    PG8_WAIT_V(6); PG8_BAR;
    for (;;) {
        const bool has_next = S.next(ui + 1, nxt);
        const char* nA = has_next ? (const char*)g.A + nxt.aoff : cA; const char* nB = has_next ? (const char*)g.Bt + nxt.boff : cB;
#pragma unroll 1
        for (int t = 0; t < nt; t += 2) {
            const bool last = (t == nt - 2);
            const char* a1 = cA + (size_t)(t + 1) * kstep;
            const char* a2 = last ? nA : cA + (size_t)(t + 2) * kstep; const char* b2 = last ? nB : cB + (size_t)(t + 2) * kstep;
            const char* a3 = a2 + kstep; const char* b3 = b2 + kstep;
            bf16x8 At[4][2], B0[2][2], B1[2][2];
            PG8_LDB(B0, 0, 0); PG8_LDB(B1, 0, 1); PG8_SCHED; PG8_LDA(At, 0, 0); PG8_STAGE(PG8_SA(1, 1), a1 + hstepA, voffA);
            PG8_WAIT_V(8); PG8_WAIT_L(0); PG8_BAR; PG8_MMA(0, 0, At, B0); PG8_MMA(0, 1, At, B1); PG8_BAR; PG8_SCHED;
            PG8_LDA(At, 0, 1); PG8_STAGE(PG8_SB(0, 0), b2, voffB); PG8_STAGE(PG8_SB(0, 1), b2 + hstepB, voffB); PG8_STAGE(PG8_SA(0, 0), a2, voffA);
            PG8_WAIT_V(8); PG8_WAIT_L(0); PG8_BAR; PG8_MMA(1, 0, At, B0); PG8_MMA(1, 1, At, B1); PG8_BAR; PG8_SCHED;
            PG8_LDB(B0, 1, 0); PG8_LDB(B1, 1, 1); PG8_SCHED; PG8_LDA(At, 1, 0); PG8_STAGE(PG8_SA(0, 1), a2 + hstepA, voffA);
            PG8_WAIT_V(8); PG8_WAIT_L(0); PG8_BAR; PG8_MMA(0, 0, At, B0); PG8_MMA(0, 1, At, B1); PG8_BAR; PG8_SCHED;
            PG8_LDA(At, 1, 1); PG8_STAGE(PG8_SB(1, 0), b3, voffB); PG8_STAGE(PG8_SB(1, 1), b3 + hstepB, voffB); PG8_STAGE(PG8_SA(1, 0), a3, voffA);
            PG8_WAIT_V(8); PG8_WAIT_L(0); PG8_BAR; PG8_MMA(1, 0, At, B0); PG8_MMA(1, 1, At, B1); PG8_BAR; PG8_SCHED;
        }
        if (wr == 0) PG8_BAR;
        asm volatile("" ::: "memory");
        { const int ln_ = lane_id(); E(acc, cur, wr, wc, ln_ & 15, ln_ >> 4); }
        asm volatile("" ::: "memory");
        if (!has_next) break;
        if (!(Epi::KEEP && cur.z + 1 < S.nZ)) {
#pragma unroll
        for (int a = 0; a < 2; ++a)
#pragma unroll
            for (int b = 0; b < 2; ++b)
#pragma unroll
                for (int m = 0; m < 4; ++m)
#pragma unroll
                    for (int n = 0; n < 2; ++n) acc[a][b][m][n] = (f32x4){0.f, 0.f, 0.f, 0.f}; }
        cur = nxt; cA = nA; cB = nB; ++ui;
        if (wr == 1) PG8_BAR;
    }
    PG8_WAIT_V(0);
    PG8_BAR;
#undef PG8_SA
#undef PG8_SB
#undef PG8_STAGE
#undef PG8_LDA
#undef PG8_LDB
#undef PG8_MMA
#undef PG8_WAIT_V
#undef PG8_WAIT_L
#undef PG8_BAR
#undef PG8_SCHED
}
}
using pg8::Unit; using pg8::HALF; using pg8::BM;
typedef f32x4 AccT[2][2][4][2];

struct EpiBf16 {
    static constexpr bool PERM = true, KEEP = false;
    bf16* O; int ldc; int tanh_pn;
    const float* rss;
    __device__ __forceinline__ void operator()(const AccT& acc, const Unit& u, int wr, int wc, int fr, int fq) const {
        const int row0 = u.pm * BM + wr * 64 + fr, col0 = u.pn * BM + wc * 32 + 8 * fq;
        float rsv[2][4];
#pragma unroll
        for (int ai = 0; ai < 2; ++ai)
#pragma unroll
            for (int m = 0; m < 4; ++m) rsv[ai][m] = rss ? rss[row0 + ai * HALF + m * 16] : 0.f;
#pragma unroll
        for (int ai = 0; ai < 2; ++ai)
#pragma unroll
            for (int m = 0; m < 4; ++m) { bf16* rowp = O + (size_t)(row0 + ai * HALF + m * 16) * ldc + col0; const float rs = rss ? __builtin_amdgcn_rsqf(rsv[ai][m] * (1.0f / D) + 1e-6f) : 1.0f;
#pragma unroll
                for (int bj = 0; bj < 2; ++bj) { f32x4 v0 = acc[ai][bj][m][0] * rs, v1 = acc[ai][bj][m][1] * rs;
                    if (bj == 0 && u.pn == tanh_pn) {
#pragma unroll
                        for (int j = 0; j < 4; ++j) { v0[j] = tanhf_(v0[j]); v1[j] = tanhf_(v1[j]); } }
                    u32x4 w; w.x = pk2(v0[0], v0[1]); w.y = pk2(v0[2], v0[3]); w.z = pk2(v1[0], v1[1]); w.w = pk2(v1[2], v1[3]);
                    *(u32x4*)(rowp + bj * HALF) = w; } }
    }
};
struct EpiLora {
    static constexpr bool PERM = true, KEEP = false;
    unsigned char* scr; const float *w0, *a0;
    __device__ __forceinline__ void operator()(const AccT& acc, const Unit& u, int wr, int wc, int fr, int fq) const {
        const int third = u.pn >> 2; const int row0 = u.pm * BM + wr * 64 + fr, cc0 = (u.pn & 3) * 256 + wc * 32 + 8 * fq;
        const size_t ooff = third == 0 ? SB_LWF : (third == 1 ? SB_LWB : SB_AG); bf16* O = (bf16*)(scr + ooff); const float* bp = w0 + third * WB + cc0; if (third == 2) bp = a0 + cc0; const float sc = third == 2 ? 1.0f : -0.6065306597126334f;
        const f32x4 b00 = *(const f32x4*)(bp), b01 = *(const f32x4*)(bp + 4), b10 = *(const f32x4*)(bp + HALF), b11 = *(const f32x4*)(bp + HALF + 4);
#pragma unroll
        for (int ai = 0; ai < 2; ++ai)
#pragma unroll
            for (int m = 0; m < 4; ++m) { bf16* rowp = O + (size_t)(row0 + ai * HALF + m * 16) * WB + cc0;
#pragma unroll
                for (int bj = 0; bj < 2; ++bj) { const f32x4 v0 = acc[ai][bj][m][0] + (bj ? b10 : b00), v1 = acc[ai][bj][m][1] + (bj ? b11 : b01); float o[8];
#pragma unroll
                    for (int j = 0; j < 4; ++j) { o[j] = sc * sigmoidf_(v0[j]); o[4 + j] = sc * sigmoidf_(v1[j]); }
                    *(u32x4*)(rowp + bj * HALF) = pack8(o); } }
    }
};
struct EpiF32 {
    static constexpr bool PERM = false, KEEP = false;
    float* C; int ldc; size_t zstride;
    __device__ __forceinline__ void operator()(const AccT& acc, const Unit& u, int wr, int wc, int fr, int fq) const {
        const int row0 = u.pm * BM + wr * 64 + fr, col0 = u.pn * BM + wc * 32 + 4 * fq; float* Cz = C + (size_t)u.z * zstride;
#pragma unroll
        for (int ai = 0; ai < 2; ++ai)
#pragma unroll
            for (int m = 0; m < 4; ++m) { float* rowp = Cz + (size_t)(row0 + ai * HALF + m * 16) * ldc + col0;
#pragma unroll
                for (int bj = 0; bj < 2; ++bj)
#pragma unroll
                    for (int n = 0; n < 2; ++n) *(f32x4*)(rowp + bj * HALF + n * 16) = acc[ai][bj][m][n]; }
    }
};
struct EpiLru {
    static constexpr bool PERM = false, KEEP = false;
    const float *b_r, *b_i, *lam;
    const bf16* XC; bf16* LA; bf16* BB;
    __device__ __forceinline__ void operator()(const AccT& acc, const Unit& u, int wr, int wc, int fr, int fq) const {
        const int d = u.pn >> 3, h = u.pn & 7; const int row0 = u.pm * BM + wr * 64 + fr;
#pragma unroll
        for (int n = 0; n < 2; ++n) { const int ch0 = h * 128 + wc * 32 + n * 16 + fq * 4; float br[4], bi[4], sp[4];
#pragma unroll
            for (int j = 0; j < 4; ++j) { br[j] = b_r[d * WB + ch0 + j]; bi[j] = b_i[d * WB + ch0 + j]; sp[j] = -8.0f * softplusf_(-lam[d * WB + ch0 + j]); }
            u32x2 xwv[2][4];
#pragma unroll
            for (int ai = 0; ai < 2; ++ai)
#pragma unroll
                for (int m = 0; m < 4; ++m) xwv[ai][m] = *(const u32x2*)(XC + (size_t)(row0 + ai * HALF + m * 16) * WB + ch0);
#pragma unroll
            for (int ai = 0; ai < 2; ++ai)
#pragma unroll
                for (int m = 0; m < 4; ++m) { const int t = row0 + ai * HALF + m * 16; int pos, L; seq_of(t, pos, L); const bool first = (d == 0) ? (pos == 0) : (pos == L - 1);
                    const f32x4 ar = acc[ai][0][m][n], aiq = acc[ai][1][m][n];
                    const u32x2 xw = xwv[ai][m];
                    const float xc[4] = {__uint_as_float(xw.x << 16), __uint_as_float(xw.x & 0xffff0000u), __uint_as_float(xw.y << 16), __uint_as_float(xw.y & 0xffff0000u)};
                    float oa[4], ob[4];
#pragma unroll
                    for (int j = 0; j < 4; ++j) { const float rg = sigmoidf_(ar[j] + br[j]), ig = sigmoidf_(aiq[j] + bi[j]); const float la = rg * sp[j];
                        float mult = __builtin_amdgcn_sqrtf(fmaxf(1.0f - __expf(2.0f * la), 0.f)); if (first) mult = 1.0f; oa[j] = la; ob[j] = mult * ig * xc[j]; }
                    u32x2 wa, wb; wa.x = pk2(oa[0], oa[1]); wa.y = pk2(oa[2], oa[3]); wb.x = pk2(ob[0], ob[1]); wb.y = pk2(ob[2], ob[3]);
                    *(u32x2*)(LA + ((size_t)d * T + t) * WB + ch0) = wa; *(u32x2*)(BB + ((size_t)d * T + t) * WB + ch0) = wb; } }
    }
};
struct EpiS5Main {
    static constexpr bool PERM = true, KEEP = false;
    bf16* YG;
    __device__ __forceinline__ void operator()(const AccT& acc, const Unit& u, int wr, int wc, int fr, int fq) const {
        const int row0 = u.pm * BM + wr * 64 + fr; const int g = u.z;
#pragma unroll
        for (int ai = 0; ai < 2; ++ai)
#pragma unroll
            for (int m = 0; m < 4; ++m) { const int c = row0 + ai * HALF + m * 16;
#pragma unroll
                for (int bj = 0; bj < 2; ++bj) { const int cc = bj * HALF + wc * 32 + 8 * fq; const int tau = cc >> 4, p0 = cc & 15; const f32x4 v0 = acc[ai][bj][m][0], v1 = acc[ai][bj][m][1];
                    u32x4 w; w.x = pk2(gelu_tanh(v0[0]), gelu_tanh(v0[1])); w.y = pk2(gelu_tanh(v0[2]), gelu_tanh(v0[3])); w.z = pk2(gelu_tanh(v1[0]), gelu_tanh(v1[1])); w.w = pk2(gelu_tanh(v1[2]), gelu_tanh(v1[3]));
                    *(u32x4*)(YG + (size_t)(c * 16 + tau) * WB + g * 16 + p0) = w; } }
    }
};
struct EpiGlu {
    static constexpr bool PERM = true, KEEP = false;
    const bf16* YG; const bf16* PROJ; const float* glu_b; bf16* Y;
    __device__ __forceinline__ void operator()(const AccT& acc, const Unit& u, int wr, int wc, int fr, int fq) const {
        const int row0 = u.pm * BM + wr * 64 + fr, col0 = u.pn * BM + wc * 32 + 8 * fq;
#pragma unroll
        for (int ai = 0; ai < 2; ++ai)
#pragma unroll
            for (int m = 0; m < 4; m += 2) { u32x4 ygw[2][2], zzw[2][2];
#pragma unroll
              for (int mm = 0; mm < 2; ++mm)
#pragma unroll
                for (int bj = 0; bj < 2; ++bj) { const int t = row0 + ai * HALF + (m + mm) * 16, col = col0 + bj * HALF; ygw[mm][bj] = *(const u32x4*)(YG + (size_t)t * WB + col); zzw[mm][bj] = *(const u32x4*)(PROJ + (size_t)t * NPJ + C_SZ + col); }
#pragma unroll
              for (int mm = 0; mm < 2; ++mm) { const int t = row0 + ai * HALF + (m + mm) * 16;
#pragma unroll
                for (int bj = 0; bj < 2; ++bj) { const int col = col0 + bj * HALF; const f32x4 v0 = acc[ai][bj][m + mm][0], v1 = acc[ai][bj][m + mm][1];
                    float yg[8], zz[8], o[8]; unpack8(ygw[mm][bj], yg); unpack8(zzw[mm][bj], zz);
                    const f32x4 b0 = *(const f32x4*)(glu_b + col), b1 = *(const f32x4*)(glu_b + col + 4);
#pragma unroll
                    for (int j = 0; j < 4; ++j) { o[j] = yg[j] * sigmoidf_(v0[j] + b0[j]) * siluf_(zz[j]); o[4 + j] = yg[4 + j] * sigmoidf_(v1[j] + b1[j]) * siluf_(zz[4 + j]); }
                    *(u32x4*)(Y + (size_t)t * 4096 + 3072 + col) = pack8(o); } } }
    }
};
struct EpiGate {
    static constexpr bool PERM = false, KEEP = false;
    bf16* GR; const float* rss;
    __device__ __forceinline__ void operator()(const AccT& acc, const Unit& u, int wr, int wc, int fr, int fq) const {
        const int row0 = u.pm * BM + wr * 64 + fr, ch0 = u.pn * 64 + wc * 16 + 4 * fq;
        float rsv[2][4];
#pragma unroll
        for (int ai = 0; ai < 2; ++ai)
#pragma unroll
            for (int m = 0; m < 4; ++m) rsv[ai][m] = rss[row0 + ai * HALF + m * 16];
#pragma unroll
        for (int ai = 0; ai < 2; ++ai)
#pragma unroll
            for (int m = 0; m < 4; ++m) { const size_t t = (size_t)(row0 + ai * HALF + m * 16); const float rs = __builtin_amdgcn_rsqf(rsv[ai][m] * (1.0f / D) + 1e-6f);
                float e1[4][4], g[4][4];
#pragma unroll
                for (int z = 0; z < 4; ++z) { const f32x4 v = acc[ai][z >> 1][m][z & 1] * rs;
#pragma unroll
                    for (int j = 0; j < 4; ++j) { e1[z][j] = 1.0f + __expf(-__builtin_amdgcn_fmed3f(v[j], -30.0f, 30.0f)); g[z][j] = __builtin_amdgcn_rcpf(e1[z][j]); } }
#pragma unroll
                for (int z = 0; z < 4; ++z) { float f[4];
#pragma unroll
                    for (int j = 0; j < 4; ++j) f[j] = z < 3 ? g[z][j] * e1[z + 1][j] : g[3][j];
                    u32x2 w; w.x = pk2(f[0], f[1]); w.y = pk2(f[2], f[3]); *(u32x2*)(GR + ((size_t)z * T + t) * D + ch0) = w; } }
    }
};
struct EpiBranchAll {
    static constexpr bool PERM = false, KEEP = true;
    const bf16* GR; bf16* MG;
    __device__ __forceinline__ void operator()(AccT& acc, const Unit& u, int wr, int wc, int fr, int fq) const {
        const int row0 = u.pm * BM + wr * 64 + fr, col0 = u.pn * BM + wc * 32 + 4 * fq; const int z = u.z;
#pragma unroll
        for (int ai = 0; ai < 2; ++ai)
          { u32x2 gv[4][2][2];
#pragma unroll
            for (int m = 0; m < 4; ++m)
#pragma unroll
                for (int bj = 0; bj < 2; ++bj)
#pragma unroll
                    for (int n = 0; n < 2; ++n) gv[m][bj][n] = *(const u32x2*)(GR + ((size_t)z * T + (size_t)(row0 + ai * HALF + m * 16)) * D + col0 + bj * HALF + n * 16);
#pragma unroll
            for (int m = 0; m < 4; ++m) { const size_t t = (size_t)(row0 + ai * HALF + m * 16);
#pragma unroll
                for (int bj = 0; bj < 2; ++bj)
#pragma unroll
                    for (int n = 0; n < 2; ++n) { const int o = bj * HALF + n * 16; const u32x2 g0 = gv[m][bj][n]; f32x4& a = acc[ai][bj][m][n];
                        a[0] *= __uint_as_float(g0.x << 16); a[1] *= __uint_as_float(g0.x & 0xffff0000u); a[2] *= __uint_as_float(g0.y << 16); a[3] *= __uint_as_float(g0.y & 0xffff0000u);
                        if (z == 3) { u32x2 w; w.x = pk2(a[0], a[1]); w.y = pk2(a[2], a[3]); *(u32x2*)(MG + t * D + col0 + o) = w; } } } }
    }
};
struct EpiOut {
    static constexpr bool PERM = false, KEEP = false;
    const float* xp; const float* xs; float* out; bf16* XB; float* rsp; int first;
    __device__ __forceinline__ void operator()(const AccT& acc, const Unit& u, int wr, int wc, int fr, int fq) const {
        const int row0 = u.pm * BM + wr * 64 + fr, col0 = u.pn * BM + wc * 32 + 4 * fq;
#pragma unroll
        for (int ai = 0; ai < 2; ++ai)
#pragma unroll
            for (int m2 = 0; m2 < 4; m2 += 2) { f32x4 sv[2][2][2];
#pragma unroll
              for (int mm = 0; mm < 2; ++mm) { const int t = row0 + ai * HALF + (m2 + mm) * 16; const size_t ro = (size_t)t * D + col0; const float* src = first ? (t < TP ? xp + ro : xs + (ro - (size_t)TP * D)) : out + ro;
#pragma unroll
                for (int bj = 0; bj < 2; ++bj)
#pragma unroll
                    for (int n = 0; n < 2; ++n) sv[mm][bj][n] = *(const f32x4*)(src + bj * HALF + n * 16); }
#pragma unroll
              for (int mm = 0; mm < 2; ++mm) { const int m = m2 + mm; const int t = row0 + ai * HALF + m * 16; const size_t ro = (size_t)t * D + col0; float ss = 0.f;
#pragma unroll
                for (int bj = 0; bj < 2; ++bj)
#pragma unroll
                    for (int n = 0; n < 2; ++n) { const int o = bj * HALF + n * 16; const f32x4 v = sv[mm][bj][n] + acc[ai][bj][m][n]; *(f32x4*)(out + ro + o) = v;
                        u32x2 w; w.x = pk2(v[0], v[1]); w.y = pk2(v[2], v[3]); *(u32x2*)(XB + ro + o) = w; ss += (v[0] * v[0] + v[1] * v[1]) + (v[2] * v[2] + v[3] * v[3]); }
                ss += shx<16>(ss); ss += shx<32>(ss);
                if (fq == 0) rsp[(size_t)t * 32 + u.pn * 4 + wc] = ss; } }
    }
};

struct EpiNull { static constexpr bool PERM = false, KEEP = false; __device__ __forceinline__ void operator()(const AccT&, const Unit&, int, int, int, int) const {} };
#define XB_TMO      128
#define XB_XCNT(j)  (256  + 64 * (j))
#define XB_XSUB(j)  (1280 + 64 * (j))
#define XB_XGEN(j)  (2304 + 64 * (j))
#define XB_TOP      3328
#define XB_TOPGEN   3392
#define XCD_BAR_WORDS 3456
#define XB_SPIN_CAP (1u << 24)
__device__ __forceinline__ unsigned xb_ld(unsigned* p)              { return __hip_atomic_load(p, __ATOMIC_RELAXED, __HIP_MEMORY_SCOPE_AGENT); }
__device__ __forceinline__ unsigned xb_add(unsigned* p, unsigned v) { return __hip_atomic_fetch_add(p, v, __ATOMIC_RELAXED, __HIP_MEMORY_SCOPE_AGENT); }
__device__ __forceinline__ unsigned xb_xcc_id() { return (unsigned)__builtin_amdgcn_s_getreg((3 << 11) | 20) & 0xFu; }
#define XB_SPIN(cond, bar) do { unsigned _sp = 0; while (cond) { __builtin_amdgcn_s_sleep(1); \
    if ((++_sp & 255u) == 0u) { if (xb_ld(&(bar)[XB_TMO])) break; if (_sp > XB_SPIN_CAP) { atomicAdd(&(bar)[XB_TMO], 1u); break; } } } } while (0)
struct XcdBarrier { unsigned* bar; unsigned x; volatile LAS unsigned* st; int wave; };
__device__ __forceinline__ XcdBarrier xcd_barrier_post(unsigned* bar, volatile LAS unsigned* st) {
    XcdBarrier b; b.bar = bar; b.x = xb_xcc_id(); b.st = st;
    if (threadIdx.x == 0) (void)xb_add(&bar[XB_XCNT(b.x)], 1u);
    return b;
}
__device__ __forceinline__ void xcd_barrier_complete(unsigned* bar, unsigned x, unsigned& nloc, unsigned& nx) {
    const unsigned G = gridDim.x * gridDim.y * gridDim.z;
    unsigned sum, cnt, mine, sp = 0u;
    for (;;) {
        sum = 0u; cnt = 0u; mine = 0u;
#pragma unroll 1
        for (unsigned j = 0; j < 16; ++j) { const unsigned c = xb_ld(&bar[XB_XCNT(j)]); sum += c; cnt += (c > 0u) ? 1u : 0u; mine = (j == x) ? c : mine; }
        if (sum == G) break;
        __builtin_amdgcn_s_sleep(1);
        if ((++sp & 255u) == 0u) { if (xb_ld(&bar[XB_TMO])) break; if (sp > XB_SPIN_CAP) { atomicAdd(&bar[XB_TMO], 1u); break; } }
    }
    nloc = mine > 0u ? mine : 1u; nx = cnt > 0u ? cnt : 1u;
}
__device__ __forceinline__ void xcd_barrier(const XcdBarrier& b) {
    asm volatile("s_waitcnt vmcnt(0)" ::: "memory");
    __syncthreads();
    if (b.wave == 0 && lane_id() == 0) {
        unsigned* bar = b.bar;
        __builtin_amdgcn_s_waitcnt(0);
        unsigned nloc = b.st[0], nx = b.st[1];
        if (nloc == 0u) { xcd_barrier_complete(bar, b.x, nloc, nx); b.st[0] = nloc; b.st[1] = nx; }
        const unsigned old = xb_add(&bar[XB_XSUB(b.x)], 1u);
        const unsigned gen = old / nloc;
        if (old + 1u == (gen + 1u) * nloc) {
            __builtin_amdgcn_fence(__ATOMIC_RELEASE, "agent");
            asm volatile("s_waitcnt vmcnt(0)" ::: "memory");
            const unsigned og = xb_add(&bar[XB_TOP], 1u);
            const unsigned tg = og / nx;
            if (og + 1u == (tg + 1u) * nx) xb_add(&bar[XB_TOPGEN], 1u);
            else XB_SPIN(xb_ld(&bar[XB_TOPGEN]) == tg, bar);
            __builtin_amdgcn_fence(__ATOMIC_ACQUIRE, "agent");
            xb_add(&bar[XB_XGEN(b.x)], 1u);
            asm volatile("s_waitcnt vmcnt(0)" ::: "memory");
        } else {
            XB_SPIN(xb_ld(&bar[XB_XGEN(b.x)]) == gen, bar);
            __builtin_amdgcn_fence(__ATOMIC_ACQUIRE, "agent");
            asm volatile("s_waitcnt vmcnt(0)" ::: "memory");
        }
    }
    __syncthreads();
}
constexpr int NWAVES = 8, NTHR = 512;
constexpr int LDS_BYTES = 147456;
constexpr int LDS_MISC = LDS_BYTES - 256;
struct Args { const float* in[35]; float* out; unsigned char* ws; int ph_lo, ph_hi; };
constexpr int LDS_ARGS = LDS_BYTES - 1024;
struct AP { const LAS unsigned long long* q; unsigned char* ws; float* out;
    __device__ __forceinline__ const float* in(int i) const { const unsigned long long v = q[i]; const unsigned lo = __builtin_amdgcn_readfirstlane((unsigned)v), hi = __builtin_amdgcn_readfirstlane((unsigned)(v >> 32)); return (const float*)(((unsigned long long)hi << 32) | lo); } };
struct Frame { LAS unsigned char* lds; int tid, lane, wave, gw, ngw, gt, ngt; };
enum { I_XP = 0, I_XS, I_NORMG, I_WIN, I_CONVW, I_CONVB, I_WR, I_BR, I_WI, I_BI, I_LAM, I_MU, I_W0, I_W2, I_A0, I_A2, I_KK, I_KA, I_RK, I_LNG, I_LNB, I_GNG,
       I_SLRE, I_SLIM, I_SLOG, I_SBRE, I_SBIM, I_SCRE, I_SCIM, I_SD, I_GLUW, I_GLUB, I_WBR, I_WOUT, I_FING };

__device__ __forceinline__ float sin_rev(float x) { return __builtin_amdgcn_sinf(x); }
__device__ __forceinline__ float cos_rev(float x) { return __builtin_amdgcn_cosf(x); }
__device__ __forceinline__ f32x2 cexp_pow(float lre, float lim, float st, int k) {
    const float mag = __expf((float)k * lre * st); double ph = (double)k * (double)lim * (double)st * 0.15915494309189535; ph -= rint(ph);
    const float f = (float)ph; return (f32x2){mag * cos_rev(f), mag * sin_rev(f)};
}

__device__ __forceinline__ void ph_tables(const AP& a, const Frame& F) {
    f32x2* TAB = (f32x2*)(a.ws + WS_S5TAB); f32x2* ROT = (f32x2*)(a.ws + WS_ROT);
    for (int i = F.gt; i < DEPTH * 2 * 64 * 64; i += F.ngt) {
        const float lre = fminf(a.in(I_SLRE)[i], -1e-4f), lim = a.in(I_SLIM)[i]; const float st = __expf(a.in(I_SLOG)[i >> 6]);
        const f32x2 p1 = cexp_pow(lre, lim, st, 1); const float nr = p1.x - 1.f, ni = p1.y, den = lre * lre + lim * lim;
        const float gr = (nr * lre + ni * lim) / den, gi = (ni * lre - nr * lim) / den;
        for (int k = 0; k <= 16; ++k) { const f32x2 p = cexp_pow(lre, lim, st, k); TAB[(size_t)i * 33 + 16 + k] = p; if (k < 16) TAB[(size_t)i * 33 + k] = (f32x2){p.x * gr - p.y * gi, p.x * gi + p.y * gr}; }
    }
    for (int i = F.gt; i < 16384 * 64; i += F.ngt) { const int pos = i >> 6, j = i & 63;
        const double inv = exp(-(double)j * (9.210340371976184 / 64.0)); double ph = (double)pos * inv * 0.15915494309189535; ph -= rint(ph); const float f = (float)ph;
        ROT[i] = (f32x2){cos_rev(f), sin_rev(f)}; }
}
struct TrItem { const float* W; int ldw; bf16* WT; int ldt, k0, n0, drow0, dcol0; const float* ksc; int gmap; };
__device__ __forceinline__ TrItem tr_decode(const AP& a, int it) {
    bf16* WALLT = (bf16*)(a.ws + WS_WALLT); bf16* GLUT = (bf16*)(a.ws + WS_GLUT); bf16* WBRT = (bf16*)(a.ws + WS_WBRT); bf16* WOUTT = (bf16*)(a.ws + WS_WOUTT);
    constexpr int I_IN = 32 * (NIN / 32), I_GL = 16 * 32, I_BRI = 16 * 64, I_OUT = 32 * 64, PER = I_IN + I_GL + 4 * I_BRI + I_OUT;
    const int l = it / PER; int r = it % PER; TrItem d;
    if (r < I_IN) { const int kb = r / (NIN / 32), nb = r % (NIN / 32), n0 = nb * 32; d = TrItem{a.in(I_WIN) + (size_t)l * D * NIN, NIN, WALLT + (size_t)l * NALL * D, D, kb * 64, n0, 0, 0, a.in(I_NORMG) + (size_t)l * D, n0 >= GOFF ? 1 : 0}; return d; } r -= I_IN;
    if (r < I_GL) { const int kb = r / 32, nb = r % 32; d = TrItem{a.in(I_GLUW) + (size_t)l * WB * WB, WB, GLUT + (size_t)l * WB * WB, WB, kb * 64, nb * 32, 0, 0, nullptr, 0}; return d; } r -= I_GL;
    if (r < 4 * I_BRI) { const int br = r / I_BRI, q = r % I_BRI, kb = q / 64, nb = q % 64; d = TrItem{a.in(I_WBR) + ((size_t)l * 4 + br) * WB * D, D, WBRT + (size_t)l * D * 4096, 4096, kb * 64, nb * 32, 0, br * WB, nullptr, 0}; return d; } r -= 4 * I_BRI;
    { const int kb = r / 64, nb = r % 64; d = TrItem{a.in(I_WOUT) + (size_t)l * D * D, D, WOUTT + (size_t)l * D * D, D, kb * 64, nb * 32, 0, 0, nullptr, 0}; return d; }
}
__device__ __forceinline__ void tr_load(const TrItem& d, float (&x)[32], int lane) {
#pragma unroll
    for (int i = 0; i < 32; ++i) { const int kk = 2 * i + (lane >> 5); x[i] = d.W[(size_t)(d.k0 + kk) * d.ldw + d.n0 + (lane & 31)] * (d.ksc ? d.ksc[d.k0 + kk] : 1.0f); }
}
__device__ __forceinline__ void tr_store(const TrItem& d, const float (&x)[32], LAS float* scr, int lane) {
#pragma unroll
    for (int i = 0; i < 32; ++i) { const int kk = 2 * i + (lane >> 5); scr[kk * 33 + (lane & 31)] = x[i]; }
    asm volatile("s_waitcnt lgkmcnt(0)" ::: "memory");
    const int c = lane & 7;
#pragma unroll
    for (int j = 0; j < 4; ++j) { const int n = (lane >> 3) + 8 * j; const LAS float* s = scr + (8 * c) * 33 + n;
        u32x4 o; o.x = pk2(s[0 * 33], s[1 * 33]); o.y = pk2(s[2 * 33], s[3 * 33]); o.z = pk2(s[4 * 33], s[5 * 33]); o.w = pk2(s[6 * 33], s[7 * 33]);
        int drow = d.drow0 + d.n0 + n;
        if (d.gmap) { const int g0 = d.n0 + n - GOFF, z = g0 >> 11, nn = g0 & 2047, gp = nn >> 6, nl = nn & 63;
            drow = NPJ + gp * 256 + 128 * (z >> 1) + 16 * (z & 1) + 32 * (nl >> 4) + (nl & 15); }
        *(u32x4*)(d.WT + (size_t)drow * d.ldt + d.dcol0 + d.k0 + 8 * c) = o; }
    asm volatile("s_waitcnt lgkmcnt(0)" ::: "memory");
}
__device__ __forceinline__ void ph_convert(const AP& a, const Frame& F) {
    LAS float* scr = (LAS float*)(F.lds + F.wave * 16384);
    bf16* WALLT = (bf16*)(a.ws + WS_WALLT);
    constexpr int PERI = 32 * (NIN / 32) + 16 * 32 + 4 * 16 * 64 + 32 * 64; const int NIT = DEPTH * PERI;
    { float xa[32], xb[32]; int it = F.gw;
      if (it < NIT) { TrItem da = tr_decode(a, it); tr_load(da, xa, F.lane);
          for (;;) { const int itb = it + F.ngw; TrItem db; const bool hb = itb < NIT; if (hb) { db = tr_decode(a, itb); tr_load(db, xb, F.lane); }
              tr_store(da, xa, scr, F.lane); if (!hb) break;
              const int ita = itb + F.ngw; const bool ha = ita < NIT; if (ha) { da = tr_decode(a, ita); tr_load(da, xa, F.lane); }
              tr_store(db, xb, scr, F.lane); if (!ha) break; it = ita; } } }
    for (int i = F.gt; i < DEPTH * 64 * (D / 8); i += F.ngt) { const int l = i / (64 * (D / 8)), r = (i / (D / 8)) % 64, c8 = i % (D / 8); *(u32x4*)(WALLT + ((size_t)l * NALL + GOFF + r) * D + c8 * 8) = (u32x4){0u, 0u, 0u, 0u}; }
    bf16* LRUW = (bf16*)(a.ws + WS_LRUW);
    for (int i = F.gt; i < DEPTH * 4096 * 32; i += F.ngt) { const int k8 = i & 31, n = (i >> 5) & 4095, l = i >> 17; const int pn = n >> 8, d = pn >> 3, h = pn & 7, gate = (n >> 7) & 1, j = n & 127;
        u32x4 o = (u32x4){0u, 0u, 0u, 0u};
        if ((k8 >> 4) == (h & 1)) { const float* w = (gate ? a.in(I_WI) : a.in(I_WR)) + ((((size_t)l * 2 + d) * 8 + h) * 128) * 128 + j; const int i0 = (k8 & 15) * 8; float x[8];
#pragma unroll
            for (int q = 0; q < 8; ++q) x[q] = w[(size_t)(i0 + q) * 128]; o = pack8(x); }
        *(u32x4*)(LRUW + ((size_t)l * 4096 + n) * 256 + k8 * 8) = o; }
    bf16* W2ALL = (bf16*)(a.ws + WS_W2ALL);
    for (int i = F.gt; i < DEPTH * 3072 * 32; i += F.ngt) { const int k8 = i & 31, n = (i >> 5) % 3072, l = (i >> 5) / 3072; const int blk = n >> 10, c = n & 1023; u32x4 o = (u32x4){0u, 0u, 0u, 0u};
        if ((k8 >> 3) == blk) { const int j0 = (k8 & 7) * 8; const float* w = blk < 2 ? a.in(I_W2) + (((size_t)l * 2 + blk) * 64 + j0) * WB + c : a.in(I_A2) + ((size_t)l * 64 + j0) * WB + c; float x[8];
#pragma unroll
            for (int q = 0; q < 8; ++q) x[q] = w[(size_t)q * WB]; o = pack8(x); }
        *(u32x4*)(W2ALL + ((size_t)l * 3072 + n) * 256 + k8 * 8) = o; }
    float* KTAB = (float*)(a.ws + WS_PROJ); const f32x2* TAB = (const f32x2*)(a.ws + WS_S5TAB);
    for (int i = F.gt; i < DEPTH * 64 * 2 * 16 * 16; i += F.ngt) { const int p = i & 15, dl = (i >> 4) & 15, dir = (i >> 8) & 1, g = (i >> 9) & 63, l = i >> 15;
        const float* cre = a.in(I_SCRE) + (((size_t)l * 64 + g) * 16 + p) * 64; const float* cim = a.in(I_SCIM) + (((size_t)l * 64 + g) * 16 + p) * 64;
        const float* bre = a.in(I_SBRE) + ((size_t)l * 64 + g) * 64 * 16; const float* bim = a.in(I_SBIM) + ((size_t)l * 64 + g) * 64 * 16;
        const f32x2* tb = TAB + ((((size_t)l * 2 + dir) * 64 + g) * 64) * 33 + dl; f32x4 s[4] = {(f32x4){0.f, 0.f, 0.f, 0.f}, (f32x4){0.f, 0.f, 0.f, 0.f}, (f32x4){0.f, 0.f, 0.f, 0.f}, (f32x4){0.f, 0.f, 0.f, 0.f}};
        for (int n = 0; n < 64; ++n) { const f32x2 gk = tb[(size_t)n * 33]; const float cr = cre[n], ci = cim[n]; const float zr = cr * gk.x - ci * gk.y, zi = cr * gk.y + ci * gk.x;
#pragma unroll
            for (int q4 = 0; q4 < 4; ++q4) { const f32x4 br = *(const f32x4*)(bre + n * 16 + q4 * 4), bi = *(const f32x4*)(bim + n * 16 + q4 * 4); s[q4] += br * zr - bi * zi; } }
        float* o = KTAB + ((((size_t)(l * 64 + g) * 2 + dir) * 16 + dl) * 16 + p) * 16;
#pragma unroll
        for (int q4 = 0; q4 < 4; ++q4) *(f32x4*)(o + q4 * 4) = s[q4]; }
}
__device__ __forceinline__ void ph_s5mats(const AP& a, const Frame& F) {
    const float* KTAB = (const float*)(a.ws + WS_PROJ); const f32x2* TAB = (const f32x2*)(a.ws + WS_S5TAB);
    bf16* MAIN = (bf16*)(a.ws + WS_S5MAIN); bf16* INCM = (bf16*)(a.ws + WS_S5INC);
    for (int i = F.gt; i < DEPTH * 64 * 256 * 64; i += F.ngt) { const int c8 = i & 63, row = (i >> 6) & 255, g = (i >> 14) & 63, l = i >> 20; const int tau = row >> 4, p = row & 15; float x[8];
        if (c8 < 32) { const int sg = c8 >> 1, q0 = (c8 & 1) * 8; const float* kb = KTAB + ((size_t)l * 64 + g) * 2 * 16 * 256;
            if (sg < tau) { const float* k = kb + ((0 * 16 + (tau - sg)) * 16 + p) * 16 + q0;
#pragma unroll
                for (int q = 0; q < 8; ++q) x[q] = k[q]; }
            else if (sg > tau) { const float* k = kb + ((1 * 16 + (sg - tau)) * 16 + p) * 16 + q0;
#pragma unroll
                for (int q = 0; q < 8; ++q) x[q] = k[q]; }
            else { const float* k0 = kb + ((0 * 16 + 0) * 16 + p) * 16 + q0; const float* k1 = kb + ((1 * 16 + 0) * 16 + p) * 16 + q0; const float dsk = a.in(I_SD)[(size_t)l * WB + g * 16 + p];
#pragma unroll
                for (int q = 0; q < 8; ++q) x[q] = k0[q] + k1[q] + ((q0 + q) == p ? dsk : 0.f); }
        } else { const int part = (c8 - 32) >> 3, n0 = ((c8 - 32) & 7) * 8, dir = part >> 1; const int k = dir == 0 ? (tau + 1) : (16 - tau);
            const float* cre = a.in(I_SCRE) + (((size_t)l * 64 + g) * 16 + p) * 64 + n0; const float* cim = a.in(I_SCIM) + (((size_t)l * 64 + g) * 16 + p) * 64 + n0;
            const f32x2* tb = TAB + ((((size_t)l * 2 + dir) * 64 + g) * 64 + n0) * 33 + 16 + k;
#pragma unroll
            for (int q = 0; q < 8; ++q) { const f32x2 pw = tb[(size_t)q * 33]; const float zr = cre[q] * pw.x - cim[q] * pw.y, zi = cre[q] * pw.y + cim[q] * pw.x; x[q] = (part & 1) ? -zi : zr; } }
        *(u32x4*)(MAIN + ((((size_t)l * 64 + g) * 256 + row) * 512) + c8 * 8) = pack8(x); }
    for (int i = F.gt; i < DEPTH * 64 * 256 * 32; i += F.ngt) { const int c8 = i & 31, row = (i >> 5) & 255, g = (i >> 13) & 63, l = i >> 19; const int part = row >> 6, n = row & 63, dir = part >> 1, sg = c8 >> 1, q0 = (c8 & 1) * 8;
        const int k = dir == 0 ? (15 - sg) : sg; const f32x2 gk = TAB[((((size_t)l * 2 + dir) * 64 + g) * 64 + n) * 33 + k];
        const float* bre = a.in(I_SBRE) + (((size_t)l * 64 + g) * 64 + n) * 16 + q0; const float* bim = a.in(I_SBIM) + (((size_t)l * 64 + g) * 64 + n) * 16 + q0; float x[8];
#pragma unroll
        for (int q = 0; q < 8; ++q) { const float zr = gk.x * bre[q] - gk.y * bim[q], zi = gk.x * bim[q] + gk.y * bre[q]; x[q] = (part & 1) ? zi : zr; }
        *(u32x4*)(INCM + ((((size_t)l * 64 + g) * 256 + row) * 256) + c8 * 8) = pack8(x); }
}

__device__ __forceinline__ void ph_x0(const AP& a, const Frame& F) {
    bf16* H = (bf16*)(a.ws + WS_H); float* RSS = (float*)(a.ws + WS_RSS);
    for (int t = F.gw; t < T; t += F.ngw) { const float* xr = t < TP ? a.in(I_XP) + (size_t)t * D : a.in(I_XS) + (size_t)(t - TP) * D; float s = 0.f;
#pragma unroll
        for (int j = 0; j < 8; ++j) { const f32x4 v = *(const f32x4*)(xr + (F.lane + 64 * j) * 4); s += (v[0] * v[0] + v[1] * v[1]) + (v[2] * v[2] + v[3] * v[3]); u32x2 w; w.x = pk2(v[0], v[1]); w.y = pk2(v[2], v[3]); *(u32x2*)(H + (size_t)t * D + (F.lane + 64 * j) * 4) = w; }
        s = wave_sum(s); if (F.lane == 0) RSS[t] = s; }
}
__device__ __forceinline__ void ph_rss(const AP& a, const Frame& F, int l) {
    const float* P = (const float*)(a.ws + WS_RSP); float* R = (float*)(a.ws + WS_RSS) + (size_t)((l + 1) & 1) * T;
    for (int t = F.gt; t < T; t += F.ngt) { float s = 0.f;
#pragma unroll
        for (int j = 0; j < 8; ++j) { const f32x4 v = *(const f32x4*)(P + (size_t)t * 32 + j * 4); s += (v[0] + v[1]) + (v[2] + v[3]); }
        R[t] = s; }
}
__device__ __forceinline__ void ph_final(const AP& a, const Frame& F) {
    const float* RSS = (const float*)(a.ws + WS_RSS) + (size_t)(DEPTH & 1) * T; const float* g = a.in(I_FING);
#pragma unroll 4
    for (int i = F.gt; i < T * (D / 4); i += F.ngt) { const int t = i / (D / 4), c4 = (i % (D / 4)) * 4; const float rs = __builtin_amdgcn_rsqf(RSS[t] * (1.0f / D) + 1e-6f);
        float* p = a.out + (size_t)t * D + c4; *(f32x4*)p = *(const f32x4*)p * rs * *(const f32x4*)(g + c4); }
}
__device__ __forceinline__ void ph_lru_conv(const AP& a, const Frame& F, int l) {
    const bf16* PROJ = (const bf16*)(a.ws + WS_PROJ); bf16* XC = (bf16*)(a.ws + WS_SCR + SA_XC);
    const float* cw = a.in(I_CONVW) + (size_t)l * 4 * WB; const float* cb = a.in(I_CONVB) + (size_t)l * WB;
    if ((F.ngt & 127) == 0) {
        const int c8 = (F.gt & 127) * 8; float wv[4][8], bv[8];
#pragma unroll
        for (int q = 0; q < 8; ++q) { bv[q] = cb[c8 + q];
#pragma unroll
            for (int j = 0; j < 4; ++j) wv[j][q] = cw[j * WB + c8 + q]; }
#pragma unroll 2
        for (int i = F.gt; i < T * 128; i += F.ngt) { const int t = i >> 7; int pos, L; seq_of(t, pos, L); u32x4 xr[4];
#pragma unroll
            for (int j = 0; j < 4; ++j) { const int pp = pos + j - 2; xr[j] = (pp >= 0 && pp < L) ? *(const u32x4*)(PROJ + (size_t)(t + j - 2) * NPJ + C_LRUX + c8) : (u32x4){0u, 0u, 0u, 0u}; }
            float acc[8];
#pragma unroll
            for (int q = 0; q < 8; ++q) acc[q] = bv[q];
#pragma unroll
            for (int j = 0; j < 4; ++j) { float x[8]; unpack8(xr[j], x);
#pragma unroll
                for (int q = 0; q < 8; ++q) acc[q] += wv[j][q] * x[q]; }
            *(u32x4*)(XC + (size_t)t * WB + c8) = pack8(acc); }
        return; }
    for (int i = F.gt; i < T * 128; i += F.ngt) { const int t = i >> 7, c8 = (i & 127) * 8; int pos, L; seq_of(t, pos, L); float acc[8];
#pragma unroll
        for (int q = 0; q < 8; ++q) acc[q] = cb[c8 + q];
#pragma unroll
        for (int j = 0; j < 4; ++j) { const int pp = pos + j - 2; if (pp >= 0 && pp < L) { float x[8]; unpack8(*(const u32x4*)(PROJ + (size_t)(t + j - 2) * NPJ + C_LRUX + c8), x);
#pragma unroll
                for (int q = 0; q < 8; ++q) acc[q] += cw[j * WB + c8 + q] * x[q]; } }
        *(u32x4*)(XC + (size_t)t * WB + c8) = pack8(acc); }
}
#define LOF(x) __uint_as_float((x) << 16)
#define HIF(x) __uint_as_float((x) & 0xffff0000u)
__device__ __forceinline__ void ph_lru_scan1(const AP& a, const Frame& F) {
    const bf16* LA = (const bf16*)(a.ws + WS_SCR + SA_LA); const bf16* BB = (const bf16*)(a.ws + WS_SCR + SA_BB); float* PA = (float*)(a.ws + WS_SCR + SA_PA); float* PB = (float*)(a.ws + WS_SCR + SA_PB);
    for (int i = F.gt; i < NCH_L32 * 2 * 512; i += F.ngt) { const int ch = (i & 511) * 2, d = (i >> 9) & 1, c = i >> 10; float s0 = 0.f, s1 = 0.f, h0 = 0.f, h1 = 0.f;
        unsigned la[32], bb[32];
#pragma unroll
        for (int s = 0; s < 32; ++s) { const int t = c * 32 + (d == 0 ? s : 31 - s); const size_t o = ((size_t)d * T + t) * WB + ch; la[s] = *(const unsigned*)(LA + o); bb[s] = *(const unsigned*)(BB + o); }
#pragma unroll
        for (int s = 0; s < 32; ++s) { const float l0 = LOF(la[s]), l1 = HIF(la[s]); h0 = __expf(l0) * h0 + LOF(bb[s]); h1 = __expf(l1) * h1 + HIF(bb[s]); s0 += l0; s1 += l1; }
        const size_t o = ((size_t)c * 2 + d) * WB + ch; *(f32x2*)(PA + o) = (f32x2){__expf(s0), __expf(s1)}; *(f32x2*)(PB + o) = (f32x2){h0, h1}; }
}
__device__ __forceinline__ void ph_lru_scan2(const AP& a, const Frame& F) {
    const float* PA = (const float*)(a.ws + WS_SCR + SA_PA); const float* PB = (const float*)(a.ws + WS_SCR + SA_PB); float* CAR = (float*)(a.ws + WS_SCR + SA_CAR);
    LAS float* ex = (LAS float*)F.lds;
    for (int it = blockIdx.x; it < 5 * 2 * 16; it += gridDim.x) { const int slab = it & 15, d = (it >> 4) & 1, sq = it >> 5; const int c0 = sq == 0 ? 0 : 512 + (sq - 1) * 64, nc = sq == 0 ? 512 : 64, ns = nc / 8;
        const int ch = slab * 64 + F.lane, seg = F.wave; float p = 1.f, h = 0.f;
        for (int s0 = 0; s0 < ns; s0 += 8) { float pa[8], pb[8];
#pragma unroll
            for (int u = 0; u < 8; ++u) { const int sp = seg * ns + s0 + u, c = c0 + (d == 0 ? sp : nc - 1 - sp); const size_t o = ((size_t)c * 2 + d) * WB + ch; pa[u] = PA[o]; pb[u] = PB[o]; }
#pragma unroll
            for (int u = 0; u < 8; ++u) { h = pa[u] * h + pb[u]; p *= pa[u]; } }
        __syncthreads(); ex[(seg * 64 + F.lane) * 2] = p; ex[(seg * 64 + F.lane) * 2 + 1] = h; __syncthreads();
        float x = 0.f;
        for (int s2 = 0; s2 < seg; ++s2) x = ex[(s2 * 64 + F.lane) * 2] * x + ex[(s2 * 64 + F.lane) * 2 + 1];
        for (int s0 = 0; s0 < ns; s0 += 8) { float pa[8], pb[8];
#pragma unroll
            for (int u = 0; u < 8; ++u) { const int sp = seg * ns + s0 + u, c = c0 + (d == 0 ? sp : nc - 1 - sp); const size_t o = ((size_t)c * 2 + d) * WB + ch; pa[u] = PA[o]; pb[u] = PB[o]; }
#pragma unroll
            for (int u = 0; u < 8; ++u) { const int sp = seg * ns + s0 + u, c = c0 + (d == 0 ? sp : nc - 1 - sp); CAR[((size_t)c * 2 + d) * WB + ch] = x; x = pa[u] * x + pb[u]; } }
    }
}
__device__ __forceinline__ void ph_lru_scan3(const AP& a, const Frame& F) {
    const bf16* LA = (const bf16*)(a.ws + WS_SCR + SA_LA); const bf16* BB = (const bf16*)(a.ws + WS_SCR + SA_BB); const float* CAR = (const float*)(a.ws + WS_SCR + SA_CAR);
    const bf16* PROJ = (const bf16*)(a.ws + WS_PROJ); bf16* Y = (bf16*)(a.ws + WS_Y);
    for (int i = F.gt; i < NCH_L32 * 512; i += F.ngt) { const int ch = (i & 511) * 2, c = i >> 9;
        unsigned la[32], bb[32], hf[32];
#pragma unroll
        for (int s = 0; s < 32; ++s) { const size_t o = (size_t)(c * 32 + s) * WB + ch; la[s] = *(const unsigned*)(LA + o); bb[s] = *(const unsigned*)(BB + o); }
        f32x2 h = *(const f32x2*)(CAR + ((size_t)c * 2 + 0) * WB + ch);
#pragma unroll
        for (int s = 0; s < 32; ++s) { h[0] = __expf(LOF(la[s])) * h[0] + LOF(bb[s]); h[1] = __expf(HIF(la[s])) * h[1] + HIF(bb[s]); hf[s] = pk2(h[0], h[1]); }
        asm volatile("" ::: "memory");
#pragma unroll
        for (int s = 0; s < 32; ++s) { const size_t o = ((size_t)T + c * 32 + s) * WB + ch; la[s] = *(const unsigned*)(LA + o); bb[s] = *(const unsigned*)(BB + o); }
        h = *(const f32x2*)(CAR + ((size_t)c * 2 + 1) * WB + ch);
#pragma unroll
        for (int s0 = 16; s0 >= 0; s0 -= 16) { unsigned zq[16];
#pragma unroll
            for (int u = 0; u < 16; ++u) zq[u] = *(const unsigned*)(PROJ + (size_t)(c * 32 + s0 + u) * NPJ + C_LRUZ + ch);
#pragma unroll
            for (int u = 15; u >= 0; --u) { const int s = s0 + u; h[0] = __expf(LOF(la[s])) * h[0] + LOF(bb[s]); h[1] = __expf(HIF(la[s])) * h[1] + HIF(bb[s]); const unsigned zz = zq[u];
                *(unsigned*)(Y + (size_t)(c * 32 + s) * 4096 + ch) = pk2((LOF(hf[s]) + h[0]) * siluf_(LOF(zz)), (HIF(hf[s]) + h[1]) * siluf_(HIF(zz))); } } }
}
#undef LOF
#undef HIF

__device__ __forceinline__ void ph_s5_rearr(const AP& a, const Frame& F) {
    const bf16* PROJ = (const bf16*)(a.ws + WS_PROJ); bf16* UC = (bf16*)(a.ws + WS_SCR + SD_UC);
#pragma unroll 4
    for (int i = F.gt; i < T * 64; i += F.ngt) { const int g = i & 63, t = i >> 6, c = t >> 4, tau = t & 15; const u32x4* s = (const u32x4*)(PROJ + (size_t)t * NPJ + C_SU + g * 16);
        u32x4* d = (u32x4*)(UC + ((size_t)g * NCH_S5 + c) * 512 + tau * 16); d[0] = s[0]; d[1] = s[1]; }
}
__device__ __forceinline__ void ph_s5_scan(const AP& a, const Frame& F, int l) {
    const float* INC = (const float*)(a.ws + WS_SCR + SD_INC); bf16* UC = (bf16*)(a.ws + WS_SCR + SD_UC); const f32x2* TAB = (const f32x2*)(a.ws + WS_S5TAB);
    LAS float* ex = (LAS float*)F.lds;
    for (int it = blockIdx.x; it < 5 * 64 * 2; it += gridDim.x) { const int d = it & 1, g = (it >> 1) & 63, sq = it >> 7; const int c0 = sq == 0 ? 0 : 1024 + (sq - 1) * 128, nc = sq == 0 ? 1024 : 128, ns = nc / 8;
        const int n = F.lane, seg = F.wave; const f32x2 lc = TAB[((((size_t)l * 2 + d) * 64 + g) * 64 + n) * 33 + 32];
        float xr = 0.f, xi = 0.f, pr = 1.f, pi = 0.f;
        for (int s0 = 0; s0 < ns; s0 += 8) { float ir[8], ii[8];
#pragma unroll
            for (int u = 0; u < 8; ++u) { const int sp = seg * ns + s0 + u, c = c0 + (d == 0 ? sp : nc - 1 - sp); const size_t ro = (size_t)g * NCH_S5 + c; ir[u] = INC[ro * 256 + d * 128 + n]; ii[u] = INC[ro * 256 + d * 128 + 64 + n]; }
#pragma unroll
            for (int u = 0; u < 8; ++u) { const float nr = lc.x * xr - lc.y * xi + ir[u], ni = lc.x * xi + lc.y * xr + ii[u]; xr = nr; xi = ni; const float qr = lc.x * pr - lc.y * pi, qi = lc.x * pi + lc.y * pr; pr = qr; pi = qi; } }
        __syncthreads(); ex[(seg * 64 + n) * 2] = xr; ex[(seg * 64 + n) * 2 + 1] = xi; __syncthreads();
        xr = 0.f; xi = 0.f;
        for (int s2 = 0; s2 < seg; ++s2) { const float er = ex[(s2 * 64 + n) * 2], ei = ex[(s2 * 64 + n) * 2 + 1]; const float nr = pr * xr - pi * xi + er, ni = pr * xi + pi * xr + ei; xr = nr; xi = ni; }
        for (int s0 = 0; s0 < ns; s0 += 8) { float ir[8], ii[8];
#pragma unroll
            for (int u = 0; u < 8; ++u) { const int sp = seg * ns + s0 + u, c = c0 + (d == 0 ? sp : nc - 1 - sp); const size_t ro = (size_t)g * NCH_S5 + c; ir[u] = INC[ro * 256 + d * 128 + n]; ii[u] = INC[ro * 256 + d * 128 + 64 + n]; }
#pragma unroll
            for (int u = 0; u < 8; ++u) { const int sp = seg * ns + s0 + u, c = c0 + (d == 0 ? sp : nc - 1 - sp); const size_t ro = (size_t)g * NCH_S5 + c;
                UC[ro * 512 + 256 + d * 128 + n] = (bf16)f2bf(xr); UC[ro * 512 + 256 + d * 128 + 64 + n] = (bf16)f2bf(xi);
                const float nr = lc.x * xr - lc.y * xi + ir[u], ni = lc.x * xi + lc.y * xr + ii[u]; xr = nr; xi = ni; } }
    }
}
template <int NT> __device__ __forceinline__ void mma_lds(f32x4 (&acc)[NT], const LAS bf16* As, int pa, const LAS bf16* Bs, int pb, int K, int lane) {
    const int r = lane & 15, q = lane >> 4;
    for (int kk = 0; kk < K; kk += 32) { const bf16x8 av = *(const LAS bf16x8*)(As + r * pa + kk + q * 8);
#pragma unroll
        for (int nt = 0; nt < NT; ++nt) { const bf16x8 bv = *(const LAS bf16x8*)(Bs + (nt * 16 + r) * pb + kk + q * 8); acc[nt] = __builtin_amdgcn_mfma_f32_16x16x32_bf16(av, bv, acc[nt], 0, 0, 0); } }
}
template <int NT> __device__ __forceinline__ void mma_glb(f32x4 (&acc)[NT], const LAS bf16* As, int pa, const bf16* Bg, int pb, int K, int lane) {
    const int r = lane & 15, q = lane >> 4;
    for (int kk = 0; kk < K; kk += 32) { const bf16x8 av = *(const LAS bf16x8*)(As + r * pa + kk + q * 8);
#pragma unroll
        for (int n0 = 0; n0 < NT; n0 += 8) { bf16x8 bv[8];
#pragma unroll
            for (int u = 0; u < 8; ++u) bv[u] = *(const bf16x8*)(Bg + (size_t)((n0 + u) * 16 + r) * pb + kk + q * 8);
#pragma unroll
            for (int u = 0; u < 8; ++u) acc[n0 + u] = __builtin_amdgcn_mfma_f32_16x16x32_bf16(av, bv[u], acc[n0 + u], 0, 0, 0); } }
}
#define LBAR() do { asm volatile("s_waitcnt lgkmcnt(0)" ::: "memory"); __builtin_amdgcn_s_barrier(); asm volatile("" ::: "memory"); } while (0)
constexpr int RP = 136;
__device__ __forceinline__ float ret_log2g(int h) { return log2f(1.0f - exp2f(-5.0f - (float)h)); }

__device__ __forceinline__ void ph_ret_kv(const AP& a, const Frame& F) {
    const bf16* PROJ = (const bf16*)(a.ws + WS_PROJ); const f32x2* ROT = (const f32x2*)(a.ws + WS_ROT); bf16* KVT = (bf16*)(a.ws + WS_SCR + SC_KVT);
    LAS bf16* VT = (LAS bf16*)F.lds; LAS bf16* KTf = VT + 128 * RP; LAS bf16* KTb = KTf + 128 * RP;
    for (int it = blockIdx.x; it < NCH_RET * 4 * 2; it += gridDim.x) { const int eh = it & 1, h = (it >> 1) & 3, cn = it >> 3; const float l2g = ret_log2g(h);
        LBAR();
        { const int pp = F.lane, ta = cn * 128 + 2 * pp;
#pragma unroll
          for (int oc = 0; oc < 2; ++oc) { const int e8 = (F.wave * 2 + oc) * 8;
              const u32x4 va = *(const u32x4*)(PROJ + (size_t)ta * NPJ + C_RV + h * 256 + eh * 128 + e8), vb = *(const u32x4*)(PROJ + (size_t)(ta + 1) * NPJ + C_RV + h * 256 + eh * 128 + e8);
              const unsigned wa[4] = {va.x, va.y, va.z, va.w}, wb[4] = {vb.x, vb.y, vb.z, vb.w};
#pragma unroll
              for (int i = 0; i < 4; ++i) { *(LAS unsigned*)(VT + (e8 + 2 * i) * RP + 2 * pp) = (wa[i] & 0xffffu) | (wb[i] << 16); *(LAS unsigned*)(VT + (e8 + 2 * i + 1) * RP + 2 * pp) = (wa[i] >> 16) | (wb[i] & 0xffff0000u); } }
          { const int i8 = F.wave * 8; int posa, L; seq_of(ta, posa, L);
            float x1a[8], x2a[8], x1b[8], x2b[8];
            unpack8(*(const u32x4*)(PROJ + (size_t)ta * NPJ + C_RK + h * 128 + i8), x1a); unpack8(*(const u32x4*)(PROJ + (size_t)ta * NPJ + C_RK + h * 128 + 64 + i8), x2a);
            unpack8(*(const u32x4*)(PROJ + (size_t)(ta + 1) * NPJ + C_RK + h * 128 + i8), x1b); unpack8(*(const u32x4*)(PROJ + (size_t)(ta + 1) * NPJ + C_RK + h * 128 + 64 + i8), x2b);
            const f32x4* ra = (const f32x4*)(ROT + (size_t)posa * 64 + i8); const f32x4* rb = (const f32x4*)(ROT + (size_t)(posa + 1) * 64 + i8);
            const float sc = 0.08838834764831845f; const float dfa = __builtin_amdgcn_exp2f(l2g * (float)(127 - 2 * pp)) * sc, dba = __builtin_amdgcn_exp2f(l2g * (float)(2 * pp)) * sc, dfb = __builtin_amdgcn_exp2f(l2g * (float)(126 - 2 * pp)) * sc, dbb = __builtin_amdgcn_exp2f(l2g * (float)(2 * pp + 1)) * sc;
#pragma unroll
            for (int i2 = 0; i2 < 4; ++i2) { const f32x4 ca = ra[i2], cb2 = rb[i2];
#pragma unroll
                for (int u = 0; u < 2; ++u) { const int i = 2 * i2 + u; const float c_a = ca[2 * u], s_a = ca[2 * u + 1], c_b = cb2[2 * u], s_b = cb2[2 * u + 1];
                    const float o1a = x1a[i] * c_a - x2a[i] * s_a, o2a = x1a[i] * s_a + x2a[i] * c_a, o1b = x1b[i] * c_b - x2b[i] * s_b, o2b = x1b[i] * s_b + x2b[i] * c_b;
                    *(LAS unsigned*)(KTf + (i8 + i) * RP + 2 * pp) = pk2(o1a * dfa, o1b * dfb); *(LAS unsigned*)(KTf + (64 + i8 + i) * RP + 2 * pp) = pk2(o2a * dfa, o2b * dfb);
                    *(LAS unsigned*)(KTb + (i8 + i) * RP + 2 * pp) = pk2(o1a * dba, o1b * dbb); *(LAS unsigned*)(KTb + (64 + i8 + i) * RP + 2 * pp) = pk2(o2a * dba, o2b * dbb); } } } }
        LBAR();
        f32x4 af[8], ab[8];
#pragma unroll
        for (int n = 0; n < 8; ++n) { af[n] = (f32x4){0.f, 0.f, 0.f, 0.f}; ab[n] = (f32x4){0.f, 0.f, 0.f, 0.f}; }
        mma_lds<8>(af, KTf + F.wave * 16 * RP, RP, VT, RP, 128, F.lane); mma_lds<8>(ab, KTb + F.wave * 16 * RP, RP, VT, RP, 128, F.lane);
        const int r = F.lane & 15, q4 = F.lane >> 4; const size_t item = (size_t)cn * 4 + h;
#pragma unroll
        for (int n = 0; n < 8; ++n) { const int e = eh * 128 + n * 16 + r, d0 = F.wave * 16 + q4 * 4; *(u32x2*)(KVT + ((0 * 768 + item) * 256 + e) * 128 + d0) = (u32x2){pk2(af[n][0], af[n][1]), pk2(af[n][2], af[n][3])}; *(u32x2*)(KVT + ((768 + item) * 256 + e) * 128 + d0) = (u32x2){pk2(ab[n][0], ab[n][1]), pk2(ab[n][2], ab[n][3])}; }
    }
}
__device__ __forceinline__ void ph_ret_scan(const AP& a, const Frame& F) {
    const unsigned* KVT = (const unsigned*)(a.ws + WS_SCR + SC_KVT); unsigned* STP = (unsigned*)(a.ws + WS_STP);
    for (int i = F.gt; i < 5 * 2 * 4 * 16384; i += F.ngt) { const int ed = i & 16383, h = (i >> 14) & 3, dir = (i >> 16) & 1, sq = i >> 17; const int c0 = sq == 0 ? 0 : 128 + (sq - 1) * 16, nc = sq == 0 ? 128 : 16;
        const float g128 = __builtin_amdgcn_exp2f(ret_log2g(h) * 128.0f); float s0_ = 0.f, s1_ = 0.f;
        for (int s0 = 0; s0 < nc; s0 += 16) { unsigned kv[16];
#pragma unroll
            for (int u = 0; u < 16; ++u) { const int cn = c0 + (dir == 0 ? s0 + u : nc - 1 - s0 - u); kv[u] = KVT[(((size_t)dir * 768 + cn * 4 + h) * 16384) + ed]; }
#pragma unroll
            for (int u = 0; u < 16; ++u) { const int cn = c0 + (dir == 0 ? s0 + u : nc - 1 - s0 - u); STP[(((size_t)dir * 768 + cn * 4 + h) * 16384) + ed] = pk2(s0_, s1_);
                s0_ = g128 * s0_ + __uint_as_float(kv[u] << 16); s1_ = g128 * s1_ + __uint_as_float(kv[u] & 0xffff0000u); } } }
}
__device__ __forceinline__ void ph_ret_out(const AP& a, const Frame& F, int l) {
    const bf16* PROJ = (const bf16*)(a.ws + WS_PROJ); const f32x2* ROT = (const f32x2*)(a.ws + WS_ROT); const bf16* STP = (const bf16*)(a.ws + WS_STP); bf16* Y = (bf16*)(a.ws + WS_Y);
    const float* gn = a.in(I_GNG) + (size_t)l * WB;
    LAS bf16* Qs = (LAS bf16*)F.lds; LAS bf16* Ks = Qs + 128 * RP; LAS bf16* VT = Ks + 128 * RP;
    unsigned* cnt = (unsigned*)(a.ws + WS_CTL) + 16384 + 64 * l; volatile LAS unsigned* tick = (volatile LAS unsigned*)(F.lds + LDS_MISC) + 16;
    for (;;) { LBAR(); if (F.tid == 0) tick[0] = __hip_atomic_fetch_add(cnt, 1u, __ATOMIC_RELAXED, __HIP_MEMORY_SCOPE_AGENT); LBAR();
        const int it = __builtin_amdgcn_readfirstlane((int)tick[0]); if (it >= NCH_RET * 4) break; const int h = it & 3, cn = it >> 2; const float l2g = ret_log2g(h);
        int ln_ = F.lane, td_ = F.tid; asm volatile("" : "+v"(ln_), "+v"(td_));
        LBAR();
        { const int pp = ln_, ta = cn * 128 + 2 * pp;
#pragma unroll
          for (int oc = 0; oc < 4; ++oc) { const int e8 = (F.wave * 4 + oc) * 8;
              const u32x4 va = *(const u32x4*)(PROJ + (size_t)ta * NPJ + C_RV + h * 256 + e8), vb = *(const u32x4*)(PROJ + (size_t)(ta + 1) * NPJ + C_RV + h * 256 + e8);
              const unsigned wa[4] = {va.x, va.y, va.z, va.w}, wb[4] = {vb.x, vb.y, vb.z, vb.w};
#pragma unroll
              for (int i = 0; i < 4; ++i) { *(LAS unsigned*)(VT + (e8 + 2 * i) * RP + 2 * pp) = (wa[i] & 0xffffu) | (wb[i] << 16); *(LAS unsigned*)(VT + (e8 + 2 * i + 1) * RP + 2 * pp) = (wa[i] >> 16) | (wb[i] & 0xffff0000u); } } }
#pragma unroll
        for (int rep2 = 0; rep2 < 2; ++rep2) { const int qq = td_ + rep2 * NTHR, j = qq >> 3, i8 = (qq & 7) * 8; const int t = cn * 128 + j; int pos, L; seq_of(t, pos, L);
            float k1[8], k2[8], q1[8], q2[8], ok1[8], ok2[8], oq1[8], oq2[8];
            unpack8(*(const u32x4*)(PROJ + (size_t)t * NPJ + C_RK + h * 128 + i8), k1); unpack8(*(const u32x4*)(PROJ + (size_t)t * NPJ + C_RK + h * 128 + 64 + i8), k2);
            unpack8(*(const u32x4*)(PROJ + (size_t)t * NPJ + C_RQ + h * 128 + i8), q1); unpack8(*(const u32x4*)(PROJ + (size_t)t * NPJ + C_RQ + h * 128 + 64 + i8), q2);
            const f32x4* rr = (const f32x4*)(ROT + (size_t)pos * 64 + i8); const float sc = 0.08838834764831845f;
#pragma unroll
            for (int i2 = 0; i2 < 4; ++i2) { const f32x4 cs4 = rr[i2];
#pragma unroll
                for (int u = 0; u < 2; ++u) { const int i = 2 * i2 + u; const float c = cs4[2 * u], s = cs4[2 * u + 1];
                    ok1[i] = (k1[i] * c - k2[i] * s) * sc; ok2[i] = (k1[i] * s + k2[i] * c) * sc; oq1[i] = q1[i] * c - q2[i] * s; oq2[i] = q1[i] * s + q2[i] * c; } }
            *(LAS u32x4*)(Ks + j * RP + i8) = pack8(ok1); *(LAS u32x4*)(Ks + j * RP + 64 + i8) = pack8(ok2); *(LAS u32x4*)(Qs + j * RP + i8) = pack8(oq1); *(LAS u32x4*)(Qs + j * RP + 64 + i8) = pack8(oq2); }
        LBAR();
        const int r = ln_ & 15, q4 = ln_ >> 4, i0 = F.wave * 16 + q4 * 4;
        f32x4 sa[8];
#pragma unroll
        for (int n = 0; n < 8; ++n) sa[n] = (f32x4){0.f, 0.f, 0.f, 0.f};
        mma_lds<8>(sa, Qs + F.wave * 16 * RP, RP, Ks, RP, 128, ln_);
        LBAR();
#pragma unroll
        for (int n = 0; n < 8; ++n)
#pragma unroll
            for (int j = 0; j < 4; ++j) { const int i = i0 + j, jj = n * 16 + r; const int dd = i > jj ? i - jj : jj - i; Ks[i * RP + jj] = (bf16)f2bf(sa[n][j] * __builtin_amdgcn_exp2f(l2g * (float)dd)); }
        asm volatile("s_waitcnt lgkmcnt(0)" ::: "memory");
        f32x4 o[16];
#pragma unroll
        for (int n = 0; n < 16; ++n) o[n] = (f32x4){0.f, 0.f, 0.f, 0.f};
        const size_t item = (size_t)cn * 4 + h;
        float r1[4], f2[4];
#pragma unroll
        for (int j = 0; j < 4; ++j) { r1[j] = __builtin_amdgcn_exp2f(l2g * (float)(2 * (i0 + j) - 127)); f2[j] = __builtin_amdgcn_exp2f(l2g * (float)(128 - i0 - j)); }
        { const bf16* Bd0 = STP + (0 * 768 + item) * 32768 + (size_t)r * 128 + q4 * 8; const bf16* Bd1 = STP + (768 + item) * 32768 + (size_t)r * 128 + q4 * 8;
          const LAS bf16* Aq = Qs + (F.wave * 16 + r) * RP + q4 * 8;
          bf16x8 b0[8], b1[8], b2[8];
#define RO_LOAD(dst_, b_) do { const bf16* bp_ = ((b_) < 8 ? Bd0 : Bd1) + (((b_) >> 1) & 3) * 32 + ((b_) & 1) * 8 * 2048; _Pragma("unroll") for (int u = 0; u < 8; ++u) dst_[u] = *(const bf16x8*)(bp_ + u * 2048); } while (0)
#define RO_MMA(src_, b_) do { const bf16x8 av_ = *(const LAS bf16x8*)(Aq + (((b_) >> 1) & 3) * 32); _Pragma("unroll") for (int u = 0; u < 8; ++u) o[((b_) & 1) * 8 + u] = __builtin_amdgcn_mfma_f32_16x16x32_bf16(av_, src_[u], o[((b_) & 1) * 8 + u], 0, 0, 0); } while (0)
          RO_LOAD(b0, 0); RO_LOAD(b1, 1); RO_LOAD(b2, 2);
          RO_MMA(b0, 0); RO_LOAD(b0, 3);
          RO_MMA(b1, 1); RO_LOAD(b1, 4);
          RO_MMA(b2, 2); RO_LOAD(b2, 5);
          RO_MMA(b0, 3); RO_LOAD(b0, 6);
          RO_MMA(b1, 4); RO_LOAD(b1, 7);
          RO_MMA(b2, 5); RO_LOAD(b2, 8);
          RO_MMA(b0, 6); RO_LOAD(b0, 9);
          RO_MMA(b1, 7); RO_LOAD(b1, 10);
#pragma unroll
          for (int n = 0; n < 16; ++n)
#pragma unroll
              for (int j = 0; j < 4; ++j) o[n][j] *= r1[j];
          RO_MMA(b2, 8); RO_LOAD(b2, 11);
          RO_MMA(b0, 9); RO_LOAD(b0, 12);
          RO_MMA(b1, 10); RO_LOAD(b1, 13);
          RO_MMA(b2, 11); RO_LOAD(b2, 14);
          RO_MMA(b0, 12); RO_LOAD(b0, 15);
          RO_MMA(b1, 13);
          RO_MMA(b2, 14);
          RO_MMA(b0, 15);
#undef RO_LOAD
#undef RO_MMA
        }
#pragma unroll
        for (int n = 0; n < 16; ++n)
#pragma unroll
            for (int j = 0; j < 4; ++j) o[n][j] *= f2[j];
        mma_lds<16>(o, Ks + F.wave * 16 * RP, RP, VT, RP, 128, ln_);
        float gnv[16];
#pragma unroll
        for (int n = 0; n < 16; ++n) gnv[n] = gn[h * 256 + n * 16 + r];
#pragma unroll
        for (int j = 0; j < 4; ++j) { float s = 0.f; unsigned short zz[16];
#pragma unroll
            for (int n = 0; n < 16; ++n) zz[n] = PROJ[(size_t)(cn * 128 + i0 + j) * NPJ + C_RZ + h * 256 + n * 16 + r];
#pragma unroll
            for (int n = 0; n < 16; ++n) s += o[n][j];
            s += shx<1>(s); s += shx<2>(s); s += shx<4>(s); s += shx<8>(s); const float mean = s * (1.0f / 256.0f); float v = 0.f;
#pragma unroll
            for (int n = 0; n < 16; ++n) { const float dlt = o[n][j] - mean; v += dlt * dlt; }
            v += shx<1>(v); v += shx<2>(v); v += shx<4>(v); v += shx<8>(v); const float rstd = __builtin_amdgcn_rsqf(v * (1.0f / 256.0f) + 1e-5f);
            const int t = cn * 128 + i0 + j;
#pragma unroll
            for (int n = 0; n < 16; ++n) { const int e = n * 16 + r; Y[(size_t)t * 4096 + 2048 + h * 256 + e] = (bf16)f2bf((o[n][j] - mean) * rstd * gnv[n] * siluf_(bf2f(zz[n]))); } }
    }
}

__device__ __forceinline__ float rdl(float x, int j) { return __int_as_float(__builtin_amdgcn_readlane(__float_as_int(x), j)); }
__device__ __forceinline__ void ph_rwkv_prep(const AP& a, const Frame& F, int l) {
    const bf16* PROJ = (const bf16*)(a.ws + WS_PROJ); unsigned char* S = a.ws + WS_SCR;
    bf16* R = (bf16*)(S + SB_R); bf16* KM = (bf16*)(S + SB_KM); bf16* V = (bf16*)(S + SB_V); bf16* KK = (bf16*)(S + SB_KK); const bf16* AG = (const bf16*)(S + SB_AG);
    const float* mu = a.in(I_MU) + (size_t)l * 3 * WB;
    const float* kkp = a.in(I_KK) + (size_t)l * WB; const float* kap = a.in(I_KA) + (size_t)l * WB;
#define UP4(W_, O_) do { const u32x2 w_ = (W_); O_[0] = __uint_as_float(w_[0] << 16); O_[1] = __uint_as_float(w_[0] & 0xffff0000u); O_[2] = __uint_as_float(w_[1] << 16); O_[3] = __uint_as_float(w_[1] & 0xffff0000u); } while (0)
#define PK4(O_) ((u32x2){pk2(O_[0], O_[1]), pk2(O_[2], O_[3])})
    for (int it = F.gw; it < (T / 4) * 4; it += F.ngw) { const int hq = it & 3, t0 = (it >> 2) * 4, c = hq * 256 + F.lane * 4; int pos0, L; seq_of(t0, pos0, L);
        u32x2 xr[6], xk[6], xv[6];
#pragma unroll
        for (int i = 0; i < 6; ++i) { const int pp = pos0 + i - 1; const bool ok = pp >= 0 && pp < L; const bf16* pr = PROJ + (size_t)(t0 + i - 1) * NPJ + c; const u32x2 z2 = (u32x2){0u, 0u};
            xr[i] = ok ? *(const u32x2*)(pr + C_RWR) : z2; xk[i] = ok ? *(const u32x2*)(pr + C_RWK) : z2; xv[i] = ok ? *(const u32x2*)(pr + C_RWV) : z2; }
        u32x2 agw[4];
#pragma unroll
        for (int i = 0; i < 4; ++i) agw[i] = *(const u32x2*)(AG + (size_t)(t0 + i) * WB + c);
        const f32x4 mur = *(const f32x4*)(mu + c), muk = *(const f32x4*)(mu + WB + c), muv = *(const f32x4*)(mu + 2 * WB + c), kkw = *(const f32x4*)(kkp + c), kaw = *(const f32x4*)(kap + c);
#pragma unroll
        for (int i = 0; i < 4; ++i) { const int t = t0 + i; float rp[4], r0[4], rn[4], kp[4], k0[4], kn[4], vp[4], v0[4], vn[4], ag[4];
            UP4(xr[i], rp); UP4(xr[i + 1], r0); UP4(xr[i + 2], rn); UP4(xk[i], kp); UP4(xk[i + 1], k0); UP4(xk[i + 2], kn); UP4(xv[i], vp); UP4(xv[i + 1], v0); UP4(xv[i + 2], vn); UP4(agw[i], ag);
            float rm[4], km[4], vm[4], kk[4], kd[4]; float ss = 0.f;
#pragma unroll
            for (int e = 0; e < 4; ++e) { rm[e] = r0[e] + mur[e] * (0.5f * (rp[e] + rn[e]) - r0[e]); km[e] = k0[e] + muk[e] * (0.5f * (kp[e] + kn[e]) - k0[e]); vm[e] = v0[e] + muv[e] * (0.5f * (vp[e] + vn[e]) - v0[e]);
                kk[e] = km[e] * kkw[e]; ss += kk[e] * kk[e]; kd[e] = km[e] * (1.0f + (ag[e] - 1.0f) * kaw[e]); }
            ss += shx<1>(ss); ss += shx<2>(ss); ss += shx<4>(ss); ss += shx<8>(ss);
            const float inv = fminf(__builtin_amdgcn_rsqf(ss), 1e12f);
#pragma unroll
            for (int e = 0; e < 4; ++e) kk[e] *= inv;
            const size_t o = (size_t)t * WB + c;
            *(u32x2*)(R + o) = PK4(rm); *(u32x2*)(KM + o) = PK4(kd); *(u32x2*)(V + o) = PK4(vm); *(u32x2*)(KK + o) = PK4(kk); }
    }
}
constexpr int P72 = 72, SLOT = 64 * P72;
__device__ __forceinline__ void mm2(f32x4 (&acc)[2], const LAS bf16* A, const LAS bf16* Bt, int wave, int lane) { asm volatile("" : "+v"(lane));
    mma_lds<2>(acc, A + (wave >> 1) * 16 * P72, P72, Bt + (wave & 1) * 32 * P72, P72, 64, lane); }
#define RW_FOREACH(acc) _Pragma("unroll") for (int nt = 0; nt < 2; ++nt) _Pragma("unroll") for (int j = 0; j < 4; ++j)
#define RW_BASE int rb_ = (F.wave >> 1) * 16 + (F.lane >> 4) * 4, cb_ = (F.wave & 1) * 32 + (F.lane & 15); asm volatile("" : "+v"(rb_), "+v"(cb_));
#define RW_ROW (rb_ + j)
#define RW_COL (cb_ + nt * 16)
__device__ __forceinline__ void ph_rwkv_chunk(const AP& a, const Frame& F, int l) {
    unsigned char* S = a.ws + WS_SCR; bf16* CH = (bf16*)(S + SB_CH);
    const bf16* R = (const bf16*)(S + SB_R); const bf16* KM = (const bf16*)(S + SB_KM); const bf16* V = (const bf16*)(S + SB_V); const bf16* KK = (const bf16*)(S + SB_KK); const bf16* AG = (const bf16*)(S + SB_AG);
    LAS bf16* lb = (LAS bf16*)F.lds;
#define SL(i) (lb + (i) * SLOT)
    LAS float* NF = (LAS float*)SL(12);
    LAS float* GC = (LAS float*)(F.lds + 15 * SLOT * 2);
    LAS float* TOT = GC + 64;
    const f32x4 z4 = (f32x4){0.f, 0.f, 0.f, 0.f};
#ifndef CHUNK_REP
#define CHUNK_REP 1
#endif
    u32x4 pre0, pre1, pre2, pre3, pre4, pre5, pre6;
#define RAW_LOAD(it_, dir_) do { const int hd_ = (it_) & 15, cn_ = (it_) >> 4; const bf16* LW_ = (const bf16*)(S + ((dir_) ? SB_LWB : SB_LWF)); int tid_ = F.tid; asm volatile("" : "+v"(tid_)); \
        const int j_ = tid_ >> 3, c8_ = (tid_ & 7) * 8; const int t_ = cn_ * 64 + ((dir_) ? 63 - j_ : j_); const size_t o_ = (size_t)t_ * WB + hd_ * 64 + c8_; \
        pre0 = *(const u32x4*)(LW_ + o_); pre1 = *(const u32x4*)(KK + o_); pre2 = *(const u32x4*)(AG + o_); pre3 = *(const u32x4*)(KM + o_); pre4 = *(const u32x4*)(R + o_); \
        const int pp_ = tid_ & 31, v8_ = ((tid_ >> 5) & 7) * 8; const int ta_ = cn_ * 64 + ((dir_) ? 63 - 2 * pp_ : 2 * pp_), tb_ = cn_ * 64 + ((dir_) ? 62 - 2 * pp_ : 2 * pp_ + 1); \
        pre5 = *(const u32x4*)(V + (size_t)ta_ * WB + hd_ * 64 + v8_); pre6 = *(const u32x4*)(V + (size_t)tb_ * WB + hd_ * 64 + v8_); } while (0)
    for (int rep = 0; rep < CHUNK_REP; ++rep) {
    if ((int)blockIdx.x < (T / 64) * 16) RAW_LOAD((int)blockIdx.x, 0);
    for (int it = blockIdx.x; it < (T / 64) * 16; it += gridDim.x) { const int hd = it & 15, cn = it >> 4; (void)hd; (void)cn;
        for (int dir = 0; dir < 2; ++dir) {
            bf16* outb = CH + ((size_t)it * 2 + dir) * 4 * 4096;
            LBAR();
            { int tid_ = F.tid; asm volatile("" : "+v"(tid_)); const int j = tid_ >> 3, c8 = (tid_ & 7) * 8;
              *(LAS u32x4*)(SL(8) + j * P72 + c8) = pre0; *(LAS u32x4*)(SL(9) + j * P72 + c8) = pre1; *(LAS u32x4*)(SL(10) + j * P72 + c8) = pre2; *(LAS u32x4*)(SL(11) + j * P72 + c8) = pre3; *(LAS u32x4*)(SL(12) + j * P72 + c8) = pre4;
              if (tid_ < 256) { const int pp = tid_ & 31, v8 = (tid_ >> 5) * 8; const unsigned wa[4] = {pre5.x, pre5.y, pre5.z, pre5.w}, wb[4] = {pre6.x, pre6.y, pre6.z, pre6.w};
#pragma unroll
                  for (int i = 0; i < 4; ++i) { *(LAS unsigned*)(SL(7) + (v8 + 2 * i) * P72 + 2 * pp) = (wa[i] & 0xffffu) | (wb[i] << 16); *(LAS unsigned*)(SL(7) + (v8 + 2 * i + 1) * P72 + 2 * pp) = (wa[i] >> 16) | (wb[i] & 0xffff0000u); } }
              if (dir == 0) {
                  float kmf_[8], rf_[8]; unpack8(pre3, kmf_); unpack8(pre4, rf_); const float* rkp_ = a.in(I_RK) + (size_t)l * WB + hd * 64 + c8; const f32x4 ra_ = *(const f32x4*)rkp_, rb_ = *(const f32x4*)(rkp_ + 4);
                  float s_ = ((rf_[0] * kmf_[0] * ra_[0] + rf_[1] * kmf_[1] * ra_[1]) + (rf_[2] * kmf_[2] * ra_[2] + rf_[3] * kmf_[3] * ra_[3])) + ((rf_[4] * kmf_[4] * rb_[0] + rf_[5] * kmf_[5] * rb_[1]) + (rf_[6] * kmf_[6] * rb_[2] + rf_[7] * kmf_[7] * rb_[3]));
                  s_ += shx<1>(s_); s_ += shx<2>(s_); s_ += shx<4>(s_);
                  if ((tid_ & 7) == 0) ((float*)(a.ws + WS_RSP))[(size_t)(cn * 64 + j) * 16 + hd] = s_; }
              const int nit = dir ? it + (int)gridDim.x : it;
              if (nit < (T / 64) * 16) RAW_LOAD(nit, dir ^ 1); }
            LBAR();
            { int k = F.lane; asm volatile("" : "+v"(k)); const int seg = F.wave;
              float cum[8]; float run = 0.f;
#pragma unroll
              for (int i = 0; i < 8; ++i) { run += bf2f(SL(8)[(seg * 8 + i) * P72 + k]); cum[i] = run; }
              TOT[seg * 64 + k] = run;
              LBAR();
              float off = 0.f;
              for (int s2 = 0; s2 < seg; ++s2) off += TOT[s2 * 64 + k];
              unsigned ta[4], tb[4], tk[4]; float Gprev = __expf(off);
#pragma unroll
              for (int ip = 0; ip < 4; ++ip) { float fa[2], fb[2], fk[2], fr[2];
#pragma unroll
                  for (int u = 0; u < 2; ++u) { const int i = 2 * ip + u, t = seg * 8 + i; const float cl = off + cum[i];
                      const float kkv = bf2f(SL(9)[t * P72 + k]), agv = bf2f(SL(10)[t * P72 + k]), kmv = bf2f(SL(11)[t * P72 + k]), rv = bf2f(SL(12)[t * P72 + k]);
                      const float G = __expf(cl), Gi = __expf(-cl);
                      fa[u] = -kkv * Gprev; fb[u] = kkv * agv * Gi; fk[u] = kmv * Gi; fr[u] = rv * G; Gprev = G;
                      if (t == 63) GC[k] = G; }
                  const unsigned wa = pk2(fa[0], fa[1]), wb = pk2(fb[0], fb[1]), wk = pk2(fk[0], fk[1]), wr2 = pk2(fr[0], fr[1]); const int t0 = seg * 8 + 2 * ip;
                  SL(0)[t0 * P72 + k] = (bf16)wa; SL(0)[(t0 + 1) * P72 + k] = (bf16)(wa >> 16); SL(1)[t0 * P72 + k] = (bf16)wb; SL(1)[(t0 + 1) * P72 + k] = (bf16)(wb >> 16);
                  SL(2)[t0 * P72 + k] = (bf16)wk; SL(2)[(t0 + 1) * P72 + k] = (bf16)(wk >> 16); SL(6)[t0 * P72 + k] = (bf16)wr2; SL(6)[(t0 + 1) * P72 + k] = (bf16)(wr2 >> 16);
                  ta[ip] = wa; tb[ip] = wb; tk[ip] = wk; }
              *(LAS u32x4*)(SL(3) + k * P72 + seg * 8) = (u32x4){ta[0], ta[1], ta[2], ta[3]}; *(LAS u32x4*)(SL(4) + k * P72 + seg * 8) = (u32x4){tb[0], tb[1], tb[2], tb[3]}; *(LAS u32x4*)(SL(5) + k * P72 + seg * 8) = (u32x4){tk[0], tk[1], tk[2], tk[3]}; }
            LBAR();
#define PK4S(dst_, v0_, v1_, v2_, v3_) *(LAS u32x2*)(dst_) = (u32x2){pk2(v0_, v1_), pk2(v2_, v3_)}
            { f32x4 c1[2] = {z4, z4}, c2[2] = {z4, z4}, c3[2] = {z4, z4}, c4[2] = {z4, z4};
              mm2(c1, SL(1), SL(0), F.wave, F.lane);
              mm2(c2, SL(0), SL(2), F.wave, F.lane);
              mm2(c3, SL(1), SL(6), F.wave, F.lane);
              mm2(c4, SL(2), SL(6), F.wave, F.lane);
              RW_BASE
#pragma unroll
              for (int nt = 0; nt < 2; ++nt) { const int cc = cb_ + nt * 16, r0 = rb_;
                  { f32x4 v;
#pragma unroll
                    for (int j = 0; j < 4; ++j) v[j] = (r0 + j) < cc ? c1[nt][j] : 0.f;
                    *(LAS f32x4*)(NF + cc * 68 + r0) = v; }
                  PK4S(SL(8) + cc * P72 + r0, cc < r0 ? c2[nt][0] : 0.f, cc < r0 + 1 ? c2[nt][1] : 0.f, cc < r0 + 2 ? c2[nt][2] : 0.f, cc < r0 + 3 ? c2[nt][3] : 0.f);
                  PK4S(SL(9) + cc * P72 + r0, r0 <= cc ? c3[nt][0] : 0.f, r0 + 1 <= cc ? c3[nt][1] : 0.f, r0 + 2 <= cc ? c3[nt][2] : 0.f, r0 + 3 <= cc ? c3[nt][3] : 0.f);
                  PK4S(SL(10) + cc * P72 + r0, r0 <= cc ? c4[nt][0] : 0.f, r0 + 1 <= cc ? c4[nt][1] : 0.f, r0 + 2 <= cc ? c4[nt][2] : 0.f, r0 + 3 <= cc ? c4[nt][3] : 0.f); } }
            LBAR();
            {
              int tid2_ = F.tid; asm volatile("" : "+v"(tid2_)); const int t = tid2_ >> 3, j8 = (tid2_ & 7) * 8; const bool offd = (t >> 4) != (j8 >> 4);
              { const f32x4 n0 = *(const LAS f32x4*)(NF + t * 68 + j8), n1 = *(const LAS f32x4*)(NF + t * 68 + j8 + 4); u32x4 w = (u32x4){0u, 0u, 0u, 0u};
                if (offd) { w.x = pk2(n0[0], n0[1]); w.y = pk2(n0[2], n0[3]); w.z = pk2(n1[0], n1[1]); w.w = pk2(n1[2], n1[3]); }
                *(LAS u32x4*)(SL(0) + t * P72 + j8) = w;
                if (offd) { *(LAS u32x4*)(SL(1) + t * P72 + j8) = (u32x4){0u, 0u, 0u, 0u}; *(LAS u32x4*)(SL(2) + t * P72 + j8) = (u32x4){0u, 0u, 0u, 0u}; } }
              if (tid2_ < 64) { const int b0 = (tid2_ >> 4) * 16, i = tid2_ & 15; float tr[16];
#pragma unroll
                  for (int tt = 0; tt < 16; ++tt) { float val = (tt == i) ? 1.f : 0.f;
#pragma unroll
                      for (int jj = 0; jj < tt; ++jj) val += (jj >= i ? tr[jj] : 0.f) * NF[(b0 + tt) * 68 + b0 + jj];
                      tr[tt] = (tt < i) ? 0.f : val; }
#pragma unroll
                  for (int tt = 0; tt < 16; ++tt) { const bf16 x = (bf16)f2bf(tr[tt]); SL(1)[(b0 + i) * P72 + b0 + tt] = x; SL(2)[(b0 + tt) * P72 + b0 + i] = x; } } }
            LBAR();
            { f32x4 c1[2] = {z4, z4}, c2[2] = {z4, z4};
              mm2(c1, SL(1), SL(0), F.wave, F.lane);
              mm2(c2, SL(0), SL(1), F.wave, F.lane);
              RW_BASE
#pragma unroll
              for (int nt = 0; nt < 2; ++nt) { const int cc = cb_ + nt * 16, r0 = rb_;
                  PK4S(SL(14) + cc * P72 + r0, c1[nt][0], c1[nt][1], c1[nt][2], c1[nt][3]);
                  PK4S(SL(11) + cc * P72 + r0, c2[nt][0], c2[nt][1], c2[nt][2], c2[nt][3]);
                  PK4S(SL(13) + cc * P72 + r0, c2[nt][0] + (cc == r0 ? 1.f : 0.f), c2[nt][1] + (cc == r0 + 1 ? 1.f : 0.f), c2[nt][2] + (cc == r0 + 2 ? 1.f : 0.f), c2[nt][3] + (cc == r0 + 3 ? 1.f : 0.f)); } }
            LBAR();
            { f32x4 c[2] = {z4, z4}; mm2(c, SL(11), SL(14), F.wave, F.lane);
              RW_BASE
#pragma unroll
              for (int nt = 0; nt < 2; ++nt) { const int cc = cb_ + nt * 16, r0 = rb_;
                  PK4S(SL(12) + cc * P72 + r0, c[nt][0] + (cc == r0 ? 1.f : 0.f), c[nt][1] + (cc == r0 + 1 ? 1.f : 0.f), c[nt][2] + (cc == r0 + 2 ? 1.f : 0.f), c[nt][3] + (cc == r0 + 3 ? 1.f : 0.f)); } }
            LBAR();
            { f32x4 c[2] = {z4, z4}; mm2(c, SL(12), SL(13), F.wave, F.lane);
              RW_BASE
#pragma unroll
              for (int nt = 0; nt < 2; ++nt) PK4S(SL(1) + (cb_ + nt * 16) * P72 + rb_, c[nt][0], c[nt][1], c[nt][2], c[nt][3]); }
            LBAR();
            { f32x4 c[2] = {z4, z4}; mm2(c, SL(1), SL(2), F.wave, F.lane);
              RW_BASE
#pragma unroll
              for (int nt = 0; nt < 2; ++nt) PK4S(SL(0) + (cb_ + nt * 16) * P72 + rb_, c[nt][0], c[nt][1], c[nt][2], c[nt][3]); }
            LBAR();
            { f32x4 c1[2] = {z4, z4}, c2[2] = {z4, z4};
              mm2(c1, SL(0), SL(3), F.wave, F.lane);
              mm2(c2, SL(8), SL(0), F.wave, F.lane);
              RW_BASE
#pragma unroll
              for (int nt = 0; nt < 2; ++nt) { const int cc = cb_ + nt * 16, r0 = rb_; PK4S(SL(1) + cc * P72 + r0, c1[nt][0], c1[nt][1], c1[nt][2], c1[nt][3]); PK4S(SL(11) + cc * P72 + r0, c2[nt][0], c2[nt][1], c2[nt][2], c2[nt][3]); } }
            LBAR();
            { f32x4 c1[2] = {z4, z4}, c2[2] = {z4, z4};
              mm2(c1, SL(11), SL(7), F.wave, F.lane);
              mm2(c2, SL(1), SL(9), F.wave, F.lane);
              RW_BASE
#pragma unroll
              for (int nt = 0; nt < 2; ++nt) { const int cc = cb_ + nt * 16, r0 = rb_; PK4S(SL(12) + cc * P72 + r0, c1[nt][0], c1[nt][1], c1[nt][2], c1[nt][3]);
                  const u32x2 rw = *(const LAS u32x2*)(SL(6) + cc * P72 + r0);
                  PK4S(SL(13) + cc * P72 + r0, c2[nt][0] + __uint_as_float(rw.x << 16), c2[nt][1] + __uint_as_float(rw.x & 0xffff0000u), c2[nt][2] + __uint_as_float(rw.y << 16), c2[nt][3] + __uint_as_float(rw.y & 0xffff0000u)); } }
            LBAR();
            { f32x4 c1[2] = {z4, z4}, c2[2] = {z4, z4}, c3[2] = {z4, z4};
              mm2(c1, SL(12), SL(9), F.wave, F.lane); mm2(c1, SL(7), SL(10), F.wave, F.lane);
              mm2(c2, SL(1), SL(4), F.wave, F.lane);
              mm2(c3, SL(12), SL(4), F.wave, F.lane); mm2(c3, SL(7), SL(5), F.wave, F.lane);
              float qf[8]; RW_BASE
#pragma unroll
              for (int nt = 0; nt < 2; ++nt) { const int cc = cb_ + nt * 16, r0 = rb_; const float gc = GC[cc];
                  PK4S(SL(14) + cc * P72 + r0, c1[nt][0], c1[nt][1], c1[nt][2], c1[nt][3]);
                  PK4S(SL(0) + cc * P72 + r0, (c2[nt][0] + (cc == r0 ? 1.f : 0.f)) * gc, (c2[nt][1] + (cc == r0 + 1 ? 1.f : 0.f)) * gc, (c2[nt][2] + (cc == r0 + 2 ? 1.f : 0.f)) * gc, (c2[nt][3] + (cc == r0 + 3 ? 1.f : 0.f)) * gc);
#pragma unroll
                  for (int j = 0; j < 4; ++j) qf[nt * 4 + j] = c3[nt][j] * gc; }
              *(u32x4*)(outb + 1 * 4096 + (F.wave * 64 + F.lane) * 8) = pack8(qf); }
            LBAR();
#undef PK4S
            { int tid_ = F.tid; asm volatile("" : "+v"(tid_)); const int row = tid_ >> 3, sg = (tid_ & 7) * 8;
              *(u32x4*)(outb + 0 * 4096 + row * 64 + sg) = *(const LAS u32x4*)(SL(0) + row * P72 + sg);
              *(u32x4*)(outb + 2 * 4096 + row * 64 + sg) = *(const LAS u32x4*)(SL(13) + row * P72 + sg); *(u32x4*)(outb + 3 * 4096 + row * 64 + sg) = *(const LAS u32x4*)(SL(14) + row * P72 + sg); }
        }
    }
    }
#undef SL
}
__device__ __forceinline__ void ph_rwkv_seq(const AP& a, const Frame& F) {
    unsigned char* S = a.ws + WS_SCR; const bf16* CH = (const bf16*)(S + SB_CH); bf16* SS = (bf16*)(S + SB_SS);
    LAS bf16* Sb = (LAS bf16*)F.lds;
    const int r = F.lane & 15, q = F.lane >> 4, mt = F.wave >> 1, nb = (F.wave & 1) * 32;
    for (int chain = blockIdx.x; chain < 160; chain += gridDim.x) { const int dir = chain & 1, hd = (chain >> 1) & 15, sq = chain >> 5; const int c0 = sq == 0 ? 0 : 256 + (sq - 1) * 32, nc = sq == 0 ? 256 : 32;
        f32x4 acc[2] = {(f32x4){0.f, 0.f, 0.f, 0.f}, (f32x4){0.f, 0.f, 0.f, 0.f}};
        __syncthreads();
        u32x4 p0, p1, p2, p3, p4s, p5, p6, p7, p8, p9, p10, p11, p12, p13, p14, p15, q0, q1, q2, q3, q4s, q5, q6, q7, q8, q9, q10, q11, q12, q13, q14, q15;
        const int crow = F.tid >> 3, cseg = (F.tid & 7) * 8;
        LAS bf16* Pb = Sb + 2 * SLOT;
#define SEQ_LOAD(P_, Q_, s_) do { const int s1_ = (s_) < nc ? (s_) : nc - 1; const int cn1_ = c0 + (dir == 0 ? s1_ : nc - 1 - s1_); const bf16* PT_ = CH + (((size_t)cn1_ * 16 + hd) * 2 + dir) * 4 * 4096; \
            P_ = *(const u32x4*)(PT_ + F.tid * 8); Q_ = *(const u32x4*)(PT_ + 4096 + F.tid * 8); } while (0)
#define SEQ_STEP(P_, Q_, Pn_, Qn_, s_) do { const int cn_ = c0 + (dir == 0 ? (s_) : nc - 1 - (s_)); const size_t itd_ = ((size_t)cn_ * 16 + hd) * 2 + dir; \
            SEQ_LOAD(Pn_, Qn_, (s_) + 15); \
            LAS bf16* sb_ = Sb + ((s_) & 1) * SLOT; LAS bf16* pb_ = Pb + ((s_) & 1) * SLOT; \
            _Pragma("unroll") for (int nt = 0; nt < 2; ++nt) _Pragma("unroll") for (int j = 0; j < 4; ++j) sb_[(mt * 16 + q * 4 + j) * P72 + nb + nt * 16 + r] = (bf16)f2bf(acc[nt][j]); \
            *(LAS u32x4*)(pb_ + crow * P72 + cseg) = P_; \
            asm volatile("s_waitcnt lgkmcnt(0)" ::: "memory"); __builtin_amdgcn_s_barrier(); asm volatile("" ::: "memory"); \
            *(u32x4*)(SS + itd_ * 4096 + crow * 64 + cseg) = *(const LAS u32x4*)(sb_ + crow * P72 + cseg);            \
            { float qf_[8]; unpack8(Q_, qf_); acc[0] = (f32x4){qf_[0], qf_[1], qf_[2], qf_[3]}; acc[1] = (f32x4){qf_[4], qf_[5], qf_[6], qf_[7]}; } \
            _Pragma("unroll") for (int ks = 0; ks < 2; ++ks) { const bf16x8 av = *(const LAS bf16x8*)(sb_ + (mt * 16 + r) * P72 + ks * 32 + q * 8); \
                _Pragma("unroll") for (int nt = 0; nt < 2; ++nt) { const bf16x8 bv = *(const LAS bf16x8*)(pb_ + (nb + nt * 16 + r) * P72 + ks * 32 + q * 8); acc[nt] = __builtin_amdgcn_mfma_f32_16x16x32_bf16(av, bv, acc[nt], 0, 0, 0); } } } while (0)
        SEQ_LOAD(p0, q0, 0); SEQ_LOAD(p1, q1, 1); SEQ_LOAD(p2, q2, 2); SEQ_LOAD(p3, q3, 3); SEQ_LOAD(p4s, q4s, 4); SEQ_LOAD(p5, q5, 5); SEQ_LOAD(p6, q6, 6); SEQ_LOAD(p7, q7, 7); SEQ_LOAD(p8, q8, 8); SEQ_LOAD(p9, q9, 9); SEQ_LOAD(p10, q10, 10); SEQ_LOAD(p11, q11, 11); SEQ_LOAD(p12, q12, 12); SEQ_LOAD(p13, q13, 13); SEQ_LOAD(p14, q14, 14);
        for (int s = 0; s < nc; s += 16) {
            SEQ_STEP(p0, q0, p15, q15, s + 0);
            SEQ_STEP(p1, q1, p0, q0, s + 1);
            SEQ_STEP(p2, q2, p1, q1, s + 2);
            SEQ_STEP(p3, q3, p2, q2, s + 3);
            SEQ_STEP(p4s, q4s, p3, q3, s + 4);
            SEQ_STEP(p5, q5, p4s, q4s, s + 5);
            SEQ_STEP(p6, q6, p5, q5, s + 6);
            SEQ_STEP(p7, q7, p6, q6, s + 7);
            SEQ_STEP(p8, q8, p7, q7, s + 8);
            SEQ_STEP(p9, q9, p8, q8, s + 9);
            SEQ_STEP(p10, q10, p9, q9, s + 10);
            SEQ_STEP(p11, q11, p10, q10, s + 11);
            SEQ_STEP(p12, q12, p11, q11, s + 12);
            SEQ_STEP(p13, q13, p12, q12, s + 13);
            SEQ_STEP(p14, q14, p13, q13, s + 14);
            SEQ_STEP(p15, q15, p14, q14, s + 15);
        }
#undef SEQ_LOAD
#undef SEQ_STEP
    }
}
__device__ __forceinline__ void ph_rwkv_out(const AP& a, const Frame& F, int l) {
    unsigned char* S = a.ws + WS_SCR; const bf16* CH = (const bf16*)(S + SB_CH); const bf16* SS = (const bf16*)(S + SB_SS); const bf16* PROJ = (const bf16*)(a.ws + WS_PROJ); bf16* Y = (bf16*)(a.ws + WS_Y);
    const bf16* V = (const bf16*)(S + SB_V);
    const float* BSP = (const float*)(a.ws + WS_RSP); const float* lg = a.in(I_LNG) + (size_t)l * WB; const float* lbp = a.in(I_LNB) + (size_t)l * WB;
    const int r = F.lane & 15, q = F.lane >> 4;
    for (int it = F.gw; it < (T / 64) * 16; it += F.ngw) { const int hd = it & 15, cn = it >> 4; const size_t item = (size_t)cn * 16 + hd;
      bf16x8 bS[2][4][2];
#pragma unroll
      for (int dir = 0; dir < 2; ++dir) { const bf16* Sg = SS + (item * 2 + dir) * 4096;
#pragma unroll
          for (int nt = 0; nt < 4; ++nt)
#pragma unroll
              for (int ks = 0; ks < 2; ++ks) bS[dir][nt][ks] = *(const bf16x8*)(Sg + (4 * r + nt) * 64 + ks * 32 + q * 8); }
#pragma unroll 2
      for (int mt = 0; mt < 4; ++mt) {
        f32x4 acc[4];
#pragma unroll
        for (int nt = 0; nt < 4; ++nt) acc[nt] = (f32x4){0.f, 0.f, 0.f, 0.f};
#pragma unroll
        for (int dir = 0; dir < 2; ++dir) { const bf16* ob = CH + (item * 2 + dir) * 4 * 4096; const bf16* R2T = ob + 2 * 4096; const bf16* Y0 = ob + 3 * 4096;
            const int trow = dir ? 63 - (mt * 16 + r) : mt * 16 + r;
#pragma unroll
            for (int ks = 0; ks < 2; ++ks) { const bf16x8 av = *(const bf16x8*)(R2T + trow * 64 + ks * 32 + q * 8);
#pragma unroll
                for (int nt = 0; nt < 4; ++nt) acc[nt] = __builtin_amdgcn_mfma_f32_16x16x32_bf16(av, bS[dir][nt][ks], acc[nt], 0, 0, 0); }
#pragma unroll
            for (int j = 0; j < 4; ++j) { const int tl = mt * 16 + q * 4 + j; const u32x2 yw = *(const u32x2*)(Y0 + (dir ? 63 - tl : tl) * 64 + 4 * r);
                acc[0][j] += __uint_as_float(yw.x << 16); acc[1][j] += __uint_as_float(yw.x & 0xffff0000u); acc[2][j] += __uint_as_float(yw.y << 16); acc[3][j] += __uint_as_float(yw.y & 0xffff0000u); } }
        const int c = hd * 64 + 4 * r; const f32x4 lg4 = *(const f32x4*)(lg + c), lb4 = *(const f32x4*)(lbp + c);
        u32x2 wq[4][4]; float bsv[4];
#pragma unroll
        for (int j = 0; j < 4; ++j) { const int t = cn * 64 + mt * 16 + q * 4 + j; const size_t o = (size_t)t * WB + c; wq[j][2] = *(const u32x2*)(V + o); wq[j][3] = *(const u32x2*)(PROJ + (size_t)t * NPJ + C_RWZ + c); bsv[j] = BSP[(size_t)t * 16 + hd]; }
#pragma unroll
        for (int j = 0; j < 4; ++j) { const int t = cn * 64 + mt * 16 + q * 4 + j; float s = (acc[0][j] + acc[1][j]) + (acc[2][j] + acc[3][j]);
            s += shx<1>(s); s += shx<2>(s); s += shx<4>(s); s += shx<8>(s); const float mean = s * (1.0f / 64.0f); float vs = 0.f; const float bs = bsv[j];
            float vv[4], zz[4];
            { const u32x2 w3 = wq[j][2], w4 = wq[j][3];
              vv[0] = __uint_as_float(w3.x << 16); vv[1] = __uint_as_float(w3.x & 0xffff0000u); vv[2] = __uint_as_float(w3.y << 16); vv[3] = __uint_as_float(w3.y & 0xffff0000u);
              zz[0] = __uint_as_float(w4.x << 16); zz[1] = __uint_as_float(w4.x & 0xffff0000u); zz[2] = __uint_as_float(w4.y << 16); zz[3] = __uint_as_float(w4.y & 0xffff0000u); }
#pragma unroll
            for (int nt = 0; nt < 4; ++nt) { const float dl = acc[nt][j] - mean; vs += dl * dl; }
            vs += shx<1>(vs); vs += shx<2>(vs); vs += shx<4>(vs); vs += shx<8>(vs);
            const float rstd = __builtin_amdgcn_rsqf(vs * (1.0f / 64.0f) + 64e-5f); float o4[4];
#pragma unroll
            for (int nt = 0; nt < 4; ++nt) { const float yn = (acc[nt][j] - mean) * rstd * lg4[nt] + lb4[nt]; o4[nt] = (yn + bs * vv[nt]) * siluf_(zz[nt]); }
            *(u32x2*)(Y + (size_t)t * 4096 + 1024 + c) = (u32x2){pk2(o4[0], o4[1]), pk2(o4[2], o4[3])}; }
      }
    }
}
constexpr int NPH_PRO = 3, NPH_LAYER = 21, NPH = NPH_PRO + DEPTH * NPH_LAYER + 1;

__global__ void __launch_bounds__(NTHR, 2) fwd(Args ka) {
    extern __shared__ __attribute__((aligned(16))) unsigned char lds_[];
    Frame F; F.lds = (LAS unsigned char*)lds_; F.tid = threadIdx.x; F.lane = F.tid & 63; F.wave = __builtin_amdgcn_readfirstlane(F.tid >> 6);
    F.gw = blockIdx.x * NWAVES + F.wave; F.ngw = gridDim.x * NWAVES; F.gt = blockIdx.x * NTHR + F.tid; F.ngt = gridDim.x * NTHR;
    volatile LAS unsigned* MISC = (volatile LAS unsigned*)(F.lds + LDS_MISC);
    if (F.tid < 64) MISC[F.tid] = 0u;
    { LAS unsigned long long* aq = (LAS unsigned long long*)(F.lds + LDS_ARGS);
#pragma unroll
      for (int i = 0; i < 35; ++i) if (F.tid == i) aq[i] = (unsigned long long)ka.in[i]; }
    __syncthreads();
    AP a; a.q = (const LAS unsigned long long*)(F.lds + LDS_ARGS); a.ws = ka.ws; a.out = ka.out;
    const int ph_lo = ka.ph_lo, ph_hi = ka.ph_hi;
    unsigned* barw = (unsigned*)(a.ws + WS_CTL) + 4096;
    const int wave0 = F.wave;
    XcdBarrier bar; bar.bar = barw; bar.x = 0; bar.st = MISC + 8;
    if (ph_hi - ph_lo > 1) bar = xcd_barrier_post(barw, MISC + 8);
    bar.wave = wave0;
    int gp = 0;
#ifndef PH_DBL
#define PH_DBL 0ull
#endif
#ifndef PH_ONLY
#define PH_ONLY -1
#endif
#define PHASE(pid, ...) do { int lo_ = ph_lo, hi_ = ph_hi; asm volatile("" : "+s"(lo_), "+s"(hi_)); if ((PH_ONLY < 0 || PH_ONLY == (pid)) && lo_ <= gp && gp < hi_) { F.lane = lane_id(); asm volatile("" : "+v"(F.lane)); F.wave = wave0; F.tid = F.wave * 64 + F.lane; F.gw = blockIdx.x * NWAVES + F.wave; F.ngw = gridDim.x * NWAVES; F.ngt = gridDim.x * NTHR; asm volatile("" : "+s"(F.gw), "+s"(F.ngw), "+s"(F.ngt)); F.gt = blockIdx.x * NTHR + F.tid; __VA_ARGS__; if ((PH_DBL >> (pid)) & 1ull) { xcd_barrier(bar); __VA_ARGS__; } if (gp + 1 < hi_) xcd_barrier(bar); } ++gp; } while (0)
    const int G = gridDim.x, cb = blockIdx.x;
    LAS unsigned char* lds = F.lds;
    unsigned char* ws = a.ws;

    PHASE(0, ph_tables(a, F));
    PHASE(1, ph_convert(a, F));
    PHASE(2, { ph_s5mats(a, F); ph_x0(a, F); });

    for (int l = 0; l < DEPTH; ++l) {
        const bf16* WALLT = (const bf16*)(ws + WS_WALLT) + (size_t)l * NALL * D;
        const float* rss_l = (const float*)(ws + WS_RSS) + (size_t)(l & 1) * T;
        PHASE(4, { pg8::Gemm g{(const bf16*)(ws + WS_H), WALLT, D, D, D}; pg8::Order S; S.init(T / 256, NPJ / 256, 1, G, cb, (size_t)256 * D * 2, 0, (size_t)256 * D * 2, 0);
                EpiBf16 E{(bf16*)(ws + WS_PROJ), NPJ, C_WDF / 256, rss_l}; pg8::gemm_phase(lds, g, S, E, F.tid); });
        PHASE(5, ph_lru_conv(a, F, l));
        PHASE(6, { pg8::Gemm g{(const bf16*)(ws + WS_SCR + SA_XC), (const bf16*)(ws + WS_LRUW) + (size_t)l * 4096 * 256, WB, 256, 256}; pg8::Order S; S.init(T / 256, 16, 1, G, cb, (size_t)256 * WB * 2, 0, (size_t)256 * 256 * 2, 0); S.kwin = 256 * 2;
                EpiLru E{a.in(I_BR) + (size_t)l * 2 * WB, a.in(I_BI) + (size_t)l * 2 * WB, a.in(I_LAM) + (size_t)l * 2 * WB, (const bf16*)(ws + WS_SCR + SA_XC), (bf16*)(ws + WS_SCR + SA_LA), (bf16*)(ws + WS_SCR + SA_BB)};
                pg8::gemm_phase(lds, g, S, E, F.tid); });
        PHASE(7, ph_lru_scan1(a, F));
        PHASE(8, ph_lru_scan2(a, F));
        PHASE(9, ph_lru_scan3(a, F));
        PHASE(10, ph_s5_rearr(a, F));
        PHASE(11, { pg8::Gemm g{(const bf16*)(ws + WS_SCR + SD_UC), (const bf16*)(ws + WS_S5INC) + (size_t)l * 64 * 256 * 256, 512, 256, 256}; pg8::Order S;
                S.init(NCH_S5 / 256, 1, 64, G, cb, (size_t)256 * 512 * 2, (size_t)NCH_S5 * 512 * 2, 0, (size_t)256 * 256 * 2);
                EpiF32 E{(float*)(ws + WS_SCR + SD_INC), 256, (size_t)NCH_S5 * 256}; pg8::gemm_phase(lds, g, S, E, F.tid); });
        PHASE(12, ph_s5_scan(a, F, l));
        PHASE(13, { pg8::Gemm g{(const bf16*)(ws + WS_SCR + SD_UC), (const bf16*)(ws + WS_S5MAIN) + (size_t)l * 64 * 256 * 512, 512, 512, 512}; pg8::Order S;
                S.init(NCH_S5 / 256, 1, 64, G, cb, (size_t)256 * 512 * 2, (size_t)NCH_S5 * 512 * 2, 0, (size_t)256 * 512 * 2);
                EpiS5Main E{(bf16*)(ws + WS_SCR + SD_YG)}; pg8::gemm_phase(lds, g, S, E, F.tid); });
        PHASE(14, { pg8::Gemm g{(const bf16*)(ws + WS_SCR + SD_YG), (const bf16*)(ws + WS_GLUT) + (size_t)l * WB * WB, WB, WB, WB}; pg8::Order S; S.init(T / 256, WB / 256, 1, G, cb, (size_t)256 * WB * 2, 0, (size_t)256 * WB * 2, 0);
                EpiGlu E{(const bf16*)(ws + WS_SCR + SD_YG), (const bf16*)(ws + WS_PROJ), a.in(I_GLUB) + (size_t)l * WB, (bf16*)(ws + WS_Y)}; pg8::gemm_phase(lds, g, S, E, F.tid); });
        PHASE(15, ph_ret_kv(a, F));
        PHASE(16, ph_ret_scan(a, F));
        PHASE(25, { pg8::Gemm g{(const bf16*)(ws + WS_PROJ) + C_WDF, (const bf16*)(ws + WS_W2ALL) + (size_t)l * 3072 * 256, NPJ, 256, 256}; pg8::Order S; S.init(T / 256, 3072 / 256, 1, G, cb, (size_t)256 * NPJ * 2, 0, (size_t)256 * 256 * 2, 0);
                EpiLora E{ws + WS_SCR, a.in(I_W0) + (size_t)l * 2 * WB, a.in(I_A0) + (size_t)l * WB}; pg8::gemm_phase(lds, g, S, E, F.tid); });
        PHASE(18, ph_rwkv_prep(a, F, l));
        PHASE(19, ph_rwkv_chunk(a, F, l));
        PHASE(20, { ph_rwkv_seq(a, F); ph_ret_out(a, F, l); });
        PHASE(24, ph_rwkv_out(a, F, l));
        PHASE(21, { { pg8::Gemm g{(const bf16*)(ws + WS_H), WALLT + (size_t)NPJ * D, D, D, D}; pg8::Order S; S.init(T / 256, 4 * D / 256, 1, G, cb, (size_t)256 * D * 2, 0, (size_t)256 * D * 2, 0);
                      EpiGate E{(bf16*)(ws + WS_SCR + SM_GS), rss_l}; pg8::gemm_phase(lds, g, S, E, F.tid); }
                    xcd_barrier(bar);
                    { pg8::Gemm g{(const bf16*)(ws + WS_Y), (const bf16*)(ws + WS_WBRT) + (size_t)l * D * 4096, 4096, 4096, WB}; pg8::Order S; S.init(T / 256, D / 256, 4, G, cb, (size_t)256 * 4096 * 2, (size_t)WB * 2, (size_t)256 * 4096 * 2, (size_t)WB * 2); S.zfast = 1;
                      EpiBranchAll E{(const bf16*)(ws + WS_SCR + SM_GS), (bf16*)(ws + WS_SCR + SM_MG)}; pg8::gemm_phase(lds, g, S, E, F.tid); } });
        PHASE(22, { pg8::Gemm g{(const bf16*)(ws + WS_SCR + SM_MG), (const bf16*)(ws + WS_WOUTT) + (size_t)l * D * D, D, D, D}; pg8::Order S; S.init(T / 256, D / 256, 1, G, cb, (size_t)256 * D * 2, 0, (size_t)256 * D * 2, 0);
#ifdef OUT_DRY
                { EpiNull E0; pg8::gemm_phase(lds, g, S, E0, F.tid); }
#endif
                EpiOut E{a.in(I_XP), a.in(I_XS), a.out, (bf16*)(ws + WS_H), (float*)(ws + WS_RSP), l == 0 ? 1 : 0}; pg8::gemm_phase(lds, g, S, E, F.tid); });
        PHASE(26, ph_rss(a, F, l));
#ifdef XTRA_BAR
        for (int xb = 0; xb < XTRA_BAR; ++xb) xcd_barrier(bar);
#endif
    }
    PHASE(23, ph_final(a, F));
#undef PHASE
}

extern "C" void kernel_launch(void* const* d_in, const int* in_sizes, int n_in, void* d_out, int out_size, void* d_ws, size_t ws_size, hipStream_t stream) {
    static int grid = 0;
    if (grid == 0) {
        if (n_in != 35 || out_size != T * D || ws_size < WS_END) { fprintf(stderr, "kernel_launch: unexpected shapes (n_in %d out %d ws %zu need %zu)\n", n_in, out_size, ws_size, (size_t)WS_END); grid = -1; return; }
        int dev = 0, cus = 0, per_cu = 0;
        if (hipGetDevice(&dev) != hipSuccess || hipDeviceGetAttribute(&cus, hipDeviceAttributeMultiprocessorCount, dev) != hipSuccess) { grid = -1; return; }
        if (hipFuncSetAttribute((const void*)fwd, hipFuncAttributeMaxDynamicSharedMemorySize, LDS_BYTES) != hipSuccess) { fprintf(stderr, "kernel_launch: hipFuncSetAttribute failed\n"); grid = -1; return; }
        if (hipOccupancyMaxActiveBlocksPerMultiprocessor(&per_cu, (const void*)fwd, NTHR, LDS_BYTES) != hipSuccess || per_cu < 1) fprintf(stderr, "kernel_launch: occupancy query says %d\n", per_cu);
        (void)hipGetLastError();
        grid = cus;
    }
    if (grid < 0) return;
    (void)hipMemsetAsync((char*)d_ws + WS_CTL, 0, CTL_BYTES, stream);
    Args a{};
    for (int i = 0; i < 35; ++i) a.in[i] = (const float*)d_in[i];
    a.out = (float*)d_out; a.ws = (unsigned char*)d_ws;
#if MK_ONE_LAUNCH
    a.ph_lo = 0; a.ph_hi = NPH;
    hipLaunchKernelGGL(fwd, dim3(grid), dim3(NTHR), LDS_BYTES, stream, a);
#else
    for (int p = 0; p < NPH; ++p) { a.ph_lo = p; a.ph_hi = p + 1; hipLaunchKernelGGL(fwd, dim3(grid), dim3(NTHR), LDS_BYTES, stream, a); }
#endif
}
```

```cpp
#include <hip/hip_runtime.h>
#include <cstdio>
#include <cstdint>

#ifndef MK_ONE_LAUNCH
#define MK_ONE_LAUNCH 1
#endif

#define LAS __attribute__((address_space(3)))
#define GAS __attribute__((address_space(1)))
typedef unsigned short bf16;
typedef short bf16x8 __attribute__((ext_vector_type(8)));
typedef float f32x4 __attribute__((ext_vector_type(4)));
typedef float f32x2 __attribute__((ext_vector_type(2)));
typedef unsigned u32x4 __attribute__((ext_vector_type(4)));
typedef unsigned u32x2 __attribute__((ext_vector_type(2)));

constexpr int T = 24576, TP = 16384, LS = 2048, D = 2048, WB = 1024, DEPTH = 4;
constexpr int NPJ = 11520, NIN = 19648, GOFF = 11456, NALL = 19712;
constexpr int C_LRUX = 0, C_LRUZ = 1024, C_RWR = 2048, C_RWK = 3072, C_RWV = 4096, C_WDF = 5120, C_WDB = 5184, C_AD = 5248, C_RWZ = 5312,
              C_RQ = 6336, C_RK = 6848, C_RV = 7360, C_RZ = 8384, C_SU = 9408, C_SZ = 10432;
constexpr int NCH_S5 = T / 16;
constexpr int NCH_RET = T / 128;
constexpr int NCH_LRU = T / 128;

constexpr size_t al(size_t x) { return (x + 0xFFFFFu) & ~(size_t)0xFFFFFu; }
constexpr size_t WS_CTL = 0, CTL_BYTES = 1u << 20;
constexpr size_t WS_WALLT = al(WS_CTL + CTL_BYTES);
constexpr size_t WS_LRUW  = al(WS_WALLT + (size_t)DEPTH * NALL * D * 2);
constexpr size_t WS_GLUT  = al(WS_LRUW + (size_t)DEPTH * 4096 * 256 * 2);
constexpr size_t WS_WBRT  = al(WS_GLUT + (size_t)DEPTH * 1024 * 1024 * 2);
constexpr size_t WS_WOUTT = al(WS_WBRT + (size_t)DEPTH * 2048 * 4096 * 2);
constexpr size_t WS_S5MAIN= al(WS_WOUTT + (size_t)DEPTH * 2048 * 2048 * 2);
constexpr size_t WS_S5INC = al(WS_S5MAIN + (size_t)DEPTH * 64 * 256 * 512 * 2);
constexpr size_t WS_S5TAB = al(WS_S5INC + (size_t)DEPTH * 64 * 256 * 256 * 2);
constexpr size_t WS_W2ALL = al(WS_S5TAB + (size_t)DEPTH * 2 * 64 * 64 * 33 * 8);
constexpr size_t WS_ROT   = al(WS_W2ALL + (size_t)DEPTH * 3072 * 256 * 2);
constexpr size_t WS_RSS   = al(WS_ROT + (size_t)16384 * 64 * 8);
constexpr size_t WS_RSP   = al(WS_RSS + (size_t)2 * T * 4);
constexpr size_t WS_H     = al(WS_RSP + (size_t)T * 32 * 4);
constexpr size_t WS_PROJ  = al(WS_H + (size_t)T * D * 2);
constexpr size_t WS_Y     = al(WS_PROJ + (size_t)T * NPJ * 2);
constexpr size_t WS_STP   = al(WS_Y + (size_t)T * 4096 * 2);
constexpr size_t WS_SCR   = al(WS_STP + (size_t)2 * 768 * 256 * 128 * 2);
constexpr size_t TW4 = (size_t)T * WB * 4, TW2 = (size_t)T * WB * 2;
constexpr int NCH_L32 = T / 32;
constexpr size_t SA_XC = 0, SA_LA = al(SA_XC + TW2), SA_BB = al(SA_LA + 2 * TW2), SA_PA = al(SA_BB + 2 * TW2),
                 SA_PB = al(SA_PA + (size_t)NCH_L32 * 2 * WB * 4), SA_CAR = al(SA_PB + (size_t)NCH_L32 * 2 * WB * 4), SA_END = al(SA_CAR + (size_t)NCH_L32 * 2 * WB * 4);
constexpr size_t SD_UC = 0, SD_INC = al(SD_UC + (size_t)64 * NCH_S5 * 512 * 2), SD_YG = al(SD_INC + (size_t)64 * NCH_S5 * 256 * 4), SD_END = al(SD_YG + TW2);
constexpr size_t SC_KVT = 0, SC_END = al(SC_KVT + (size_t)2 * 768 * 256 * 128 * 4);
constexpr size_t SB_R = 0, SB_KM = al(SB_R + TW2), SB_V = al(SB_KM + TW2), SB_KK = al(SB_V + TW2), SB_AG = al(SB_KK + TW2), SB_LWF = al(SB_AG + TW2), SB_LWB = al(SB_LWF + TW2),
                 SB_CH = al(SB_LWB + TW2), SB_SS = al(SB_CH + (size_t)(T / 64) * 16 * 2 * 4 * 4096 * 2), SB_END = al(SB_SS + (size_t)(T / 64) * 16 * 2 * 4096 * 2), SB_LO = SB_CH;
constexpr size_t SM_GS = 0, SM_MG = al(SM_GS + (size_t)T * 4 * D * 2), SM_END = al(SM_MG + (size_t)T * D * 2);
constexpr size_t cmax(size_t a, size_t b) { return a > b ? a : b; }
constexpr size_t SCR_BYTES = cmax(cmax(cmax(SA_END, SD_END), cmax(SC_END, SB_END)), SM_END);
constexpr size_t WS_END = WS_SCR + SCR_BYTES;
static_assert(WS_END < (size_t)2500 * 1000 * 1000, "workspace budget");

__device__ __forceinline__ float ld_agent(const float* p) { return __hip_atomic_load(p, __ATOMIC_RELAXED, __HIP_MEMORY_SCOPE_AGENT); }
__device__ __forceinline__ void st_agent(float* p, float v) { __hip_atomic_store(p, v, __ATOMIC_RELAXED, __HIP_MEMORY_SCOPE_AGENT); }
__device__ __forceinline__ int lane_id() { unsigned m = ~0u; asm volatile("" : "+s"(m)); return (int)__builtin_amdgcn_mbcnt_hi(m, __builtin_amdgcn_mbcnt_lo(m, 0u)); }
__device__ __forceinline__ float bf2f(bf16 b) { return __uint_as_float(((unsigned)b) << 16); }
typedef __bf16 hwbf16x2 __attribute__((ext_vector_type(2)));
__device__ __forceinline__ unsigned pk2(float lo, float hi) { const f32x2 v = {lo, hi}; return __builtin_bit_cast(unsigned, __builtin_convertvector(v, hwbf16x2)); }
__device__ __forceinline__ unsigned f2bf(float f) { return pk2(f, 0.f) & 0xffffu; }
__device__ __forceinline__ float sigmoidf_(float x) { return __builtin_amdgcn_rcpf(1.0f + __expf(-x)); }
__device__ __forceinline__ float siluf_(float x) { return x * __builtin_amdgcn_rcpf(1.0f + __expf(-x)); }
__device__ __forceinline__ float tanhf_(float x) { const float e = __expf(2.0f * fminf(fmaxf(x, -15.f), 15.f)); return 1.0f - 2.0f * __builtin_amdgcn_rcpf(e + 1.0f); }
__device__ __forceinline__ float softplusf_(float x) { return fmaxf(x, 0.f) + __logf(1.0f + __expf(-fabsf(x))); }
__device__ __forceinline__ float gelu_tanh(float x) { const float u = 0.7978845608028654f * (x + 0.044715f * x * x * x); const float e = __expf(2.f * u); const float th = 1.f - 2.f * __builtin_amdgcn_rcpf(e + 1.f); return 0.5f * x * (1.f + th); }
template <int O> __device__ __forceinline__ float shx(float v) {
    if constexpr (O < 32) return __int_as_float(__builtin_amdgcn_ds_swizzle(__float_as_int(v), (O << 10) | 0x1f));
    else { const int lane = lane_id(); return __int_as_float(__builtin_amdgcn_ds_bpermute((lane ^ O) << 2, __float_as_int(v))); }
}
__device__ __forceinline__ float wave_sum(float v) { v += shx<1>(v); v += shx<2>(v); v += shx<4>(v); v += shx<8>(v); v += shx<16>(v); v += shx<32>(v); return v; }
__device__ __forceinline__ void seq_of(int t, int& pos, int& L) { if (t < TP) { pos = t; L = TP; } else { pos = (t - TP) & (LS - 1); L = LS; } }
__device__ __forceinline__ void unpack8(const u32x4 w, float (&x)[8]) {
    x[0] = __uint_as_float(w.x << 16); x[1] = __uint_as_float(w.x & 0xffff0000u); x[2] = __uint_as_float(w.y << 16); x[3] = __uint_as_float(w.y & 0xffff0000u);
    x[4] = __uint_as_float(w.z << 16); x[5] = __uint_as_float(w.z & 0xffff0000u); x[6] = __uint_as_float(w.w << 16); x[7] = __uint_as_float(w.w & 0xffff0000u);
}
__device__ __forceinline__ u32x4 pack8(const float (&x)[8]) { u32x4 w; w.x = pk2(x[0], x[1]); w.y = pk2(x[2], x[3]); w.z = pk2(x[4], x[5]); w.w = pk2(x[6], x[7]); return w; }

namespace pg8 {
#define PG8_LAS __attribute__((address_space(3)))
typedef unsigned short bf16_t;
constexpr int BM = 256, BK = 64, HALF = 128, HTB = HALF * BK * 2, STAGE_BYTES = 8 * HTB, NXCD = 8, WGM = 4;
__host__ __device__ __forceinline__ int lds_byte(int r, int c) { const int st = (r >> 4) * 2 + (c >> 5), rr = r & 15, cc = c & 31, ob = rr * 64 + cc * 2; return st * 1024 + (ob ^ (((ob >> 9) & 1) << 5)); }
__host__ __device__ __forceinline__ void stage_rc(int b, int& R, int& C) { const int st = b / 1024, sb = b % 1024, swz = sb ^ (((sb >> 9) & 1) << 5); R = (st >> 1) * 16 + swz / 64; C = (st & 1) * 32 + (swz % 64) / 2; }
__host__ __device__ __forceinline__ int perm32(int rho) { const int n = rho >> 4, i = rho & 15; return 8 * (i >> 2) + 4 * n + (i & 3); }

struct Unit { int pm, pn, z; size_t aoff, boff; };
struct Gemm { const bf16_t* A; const bf16_t* Bt; int lda, ldb, K; };

struct Order {
    int nM, nN, nZ, G, c; size_t a_pm, a_z, b_pn, b_z; int kwin = 0; int zfast = 0;
    __device__ __forceinline__ void init(int nM_, int nN_, int nZ_, int G_, int c_, size_t a_pm_, size_t a_z_, size_t b_pn_, size_t b_z_) { nM = nM_; nN = nN_; nZ = nZ_; G = G_; c = c_; a_pm = a_pm_; a_z = a_z_; b_pn = b_pn_; b_z = b_z_; }
    __device__ __forceinline__ bool next(int i, Unit& u) const {
        const int nwg = nM * nN; int z, wgid;
        if (zfast) { const long L = (long)(i / nZ) * G + c; if (L >= (long)nwg) return false; z = i % nZ; wgid = (int)L; }
        else { const long L = (long)i * G + c; if (L >= (long)nwg * nZ) return false; z = (int)(L / nwg); wgid = (int)(L % nwg); }
        { const int q = nwg / NXCD, r = nwg % NXCD, xcd = wgid % NXCD, off = wgid / NXCD; wgid = (xcd < r ? xcd * (q + 1) : r * (q + 1) + (xcd - r) * q) + off; }
        const int nig = WGM * nN, gid = wgid / nig, fm = gid * WGM, gsz = (nM - fm) < WGM ? (nM - fm) : WGM;
        u.pm = fm + ((wgid % nig) % gsz); u.pn = (wgid % nig) / gsz; u.z = z;
        u.aoff = (size_t)u.pm * a_pm + (size_t)z * a_z + (size_t)(((u.pn & 7) >> 1) * kwin); u.boff = (size_t)u.pn * b_pn + (size_t)z * b_z; return true;
    }
};

template <class Epi>
__device__ __forceinline__ void gemm_phase(PG8_LAS unsigned char* lds, const Gemm g, const Order& S, const Epi& E, int tid_in) {
    int tid_ = tid_in; asm volatile("" : "+v"(tid_));
    const int tid = tid_, wid = __builtin_amdgcn_readfirstlane(tid >> 6), lane = tid & 63, wr = wid >> 2, wc = wid & 3, fr = lane & 15, fq = lane >> 4;
    const int K = g.K, nt = K / BK;
    unsigned voffA[2], voffB[2];
#pragma unroll
    for (int i = 0; i < 2; ++i) { int R, C; stage_rc(tid * 16 + i * 8192, R, C); const int Rb = Epi::PERM ? ((R & ~31) + perm32(R & 31)) : R;
        voffA[i] = (unsigned)(R * g.lda + C) * 2u; voffB[i] = (unsigned)(Rb * g.ldb + C) * 2u; }
    const size_t kstep = (size_t)(BK * 2);
    const size_t hstepA = (size_t)HALF * g.lda * 2, hstepB = (size_t)HALF * g.ldb * 2;
    const unsigned ldsw = (unsigned)wid * 1024u;
    const int aoff = lds_byte(wr * 64 + fr, fq * 8), boff = lds_byte(wc * 32 + fr, fq * 8);
#define PG8_SA(b, h) (((b) * 2 + (h)) * HTB)
#define PG8_SB(b, h) ((4 + (b) * 2 + (h)) * HTB)
#define PG8_STAGE(bufoff, gbase, voff) do { _Pragma("unroll") for (int _i = 0; _i < 2; ++_i) \
        __builtin_amdgcn_global_load_lds((const unsigned*)((const char*)(gbase) + (voff)[_i]), (PG8_LAS unsigned*)(lds + (bufoff) + ldsw + _i * 8192), 16, 0, 0); } while (0)
#define PG8_LDA(dst, b, h) do { _Pragma("unroll") for (int m = 0; m < 4; ++m) _Pragma("unroll") for (int k = 0; k < 2; ++k) dst[m][k] = *(const PG8_LAS bf16x8*)(lds + PG8_SA(b, h) + aoff + m * 2048 + k * 1024); } while (0)
#define PG8_LDB(dst, b, h) do { _Pragma("unroll") for (int n = 0; n < 2; ++n) _Pragma("unroll") for (int k = 0; k < 2; ++k) dst[n][k] = *(const PG8_LAS bf16x8*)(lds + PG8_SB(b, h) + boff + n * 2048 + k * 1024); } while (0)
#define PG8_MMA(ai, bj, At, Bt) do { __builtin_amdgcn_s_setprio(1); _Pragma("unroll") for (int m = 0; m < 4; ++m) _Pragma("unroll") for (int n = 0; n < 2; ++n) _Pragma("unroll") for (int k = 0; k < 2; ++k) \
        acc[ai][bj][m][n] = __builtin_amdgcn_mfma_f32_16x16x32_bf16(Bt[n][k], At[m][k], acc[ai][bj][m][n], 0, 0, 0); __builtin_amdgcn_s_setprio(0); } while (0)
#define PG8_WAIT_V(n) asm volatile("s_waitcnt vmcnt(" #n ")" ::: "memory")
#define PG8_WAIT_L(n) asm volatile("s_waitcnt lgkmcnt(" #n ")" ::: "memory")
#define PG8_BAR __builtin_amdgcn_s_barrier()
#define PG8_SCHED __builtin_amdgcn_sched_barrier(0)
    Unit cur, nxt; int ui = 0;
    if (!S.next(0, cur)) return;
    f32x4 acc[2][2][4][2];
#pragma unroll
    for (int a = 0; a < 2; ++a)
#pragma unroll
        for (int b = 0; b < 2; ++b)
#pragma unroll
            for (int m = 0; m < 4; ++m)
#pragma unroll
                for (int n = 0; n < 2; ++n) acc[a][b][m][n] = (f32x4){0.f, 0.f, 0.f, 0.f};
    const char* cA = (const char*)g.A + cur.aoff; const char* cB = (const char*)g.Bt + cur.boff;
    PG8_STAGE(PG8_SB(0, 0), cB, voffB); PG8_STAGE(PG8_SB(0, 1), cB + hstepB, voffB); PG8_STAGE(PG8_SA(0, 0), cA, voffA); PG8_STAGE(PG8_SA(0, 1), cA + hstepA, voffA);
    if (wr == 1) PG8_BAR;
    PG8_WAIT_V(2); PG8_BAR;
    PG8_STAGE(PG8_SB(1, 0), cB + kstep, voffB); PG8_STAGE(PG8_SA(1, 0), cA + kstep, voffA); PG8_STAGE(PG8_SB(1, 1), cB + hstepB + kstep, voffB);
    PG8_WAIT_V(6); PG8_BAR;
    for (;;) {
        const bool has_next = S.next(ui + 1, nxt);
        const char* nA = has_next ? (const char*)g.A + nxt.aoff : cA; const char* nB = has_next ? (const char*)g.Bt + nxt.boff : cB;
#pragma unroll 1
        for (int t = 0; t < nt; t += 2) {
            const bool last = (t == nt - 2);
            const char* a1 = cA + (size_t)(t + 1) * kstep;
            const char* a2 = last ? nA : cA + (size_t)(t + 2) * kstep; const char* b2 = last ? nB : cB + (size_t)(t + 2) * kstep;
            const char* a3 = a2 + kstep; const char* b3 = b2 + kstep;
            bf16x8 At[4][2], B0[2][2], B1[2][2];
            PG8_LDB(B0, 0, 0); PG8_LDB(B1, 0, 1); PG8_SCHED; PG8_LDA(At, 0, 0); PG8_STAGE(PG8_SA(1, 1), a1 + hstepA, voffA);
            PG8_WAIT_V(8); PG8_WAIT_L(0); PG8_BAR; PG8_MMA(0, 0, At, B0); PG8_MMA(0, 1, At, B1); PG8_BAR; PG8_SCHED;
            PG8_LDA(At, 0, 1); PG8_STAGE(PG8_SB(0, 0), b2, voffB); PG8_STAGE(PG8_SB(0, 1), b2 + hstepB, voffB); PG8_STAGE(PG8_SA(0, 0), a2, voffA);
            PG8_WAIT_V(8); PG8_WAIT_L(0); PG8_BAR; PG8_MMA(1, 0, At, B0); PG8_MMA(1, 1, At, B1); PG8_BAR; PG8_SCHED;
            PG8_LDB(B0, 1, 0); PG8_LDB(B1, 1, 1); PG8_SCHED; PG8_LDA(At, 1, 0); PG8_STAGE(PG8_SA(0, 1), a2 + hstepA, voffA);
            PG8_WAIT_V(8); PG8_WAIT_L(0); PG8_BAR; PG8_MMA(0, 0, At, B0); PG8_MMA(0, 1, At, B1); PG8_BAR; PG8_SCHED;
            PG8_LDA(At, 1, 1); PG8_STAGE(PG8_SB(1, 0), b3, voffB); PG8_STAGE(PG8_SB(1, 1), b3 + hstepB, voffB); PG8_STAGE(PG8_SA(1, 0), a3, voffA);
            PG8_WAIT_V(8); PG8_WAIT_L(0); PG8_BAR; PG8_MMA(1, 0, At, B0); PG8_MMA(1, 1, At, B1); PG8_BAR; PG8_SCHED;
        }
        if (wr == 0) PG8_BAR;
        asm volatile("" ::: "memory");
        { const int ln_ = lane_id(); E(acc, cur, wr, wc, ln_ & 15, ln_ >> 4); }
        asm volatile("" ::: "memory");
        if (!has_next) break;
        if (!(Epi::KEEP && cur.z + 1 < S.nZ)) {
#pragma unroll
        for (int a = 0; a < 2; ++a)
#pragma unroll
            for (int b = 0; b < 2; ++b)
#pragma unroll
                for (int m = 0; m < 4; ++m)
#pragma unroll
                    for (int n = 0; n < 2; ++n) acc[a][b][m][n] = (f32x4){0.f, 0.f, 0.f, 0.f}; }
        cur = nxt; cA = nA; cB = nB; ++ui;
        if (wr == 1) PG8_BAR;
    }
    PG8_WAIT_V(0);
    PG8_BAR;
#undef PG8_SA
#undef PG8_SB
#undef PG8_STAGE
#undef PG8_LDA
#undef PG8_LDB
#undef PG8_MMA
#undef PG8_WAIT_V
#undef PG8_WAIT_L
#undef PG8_BAR
#undef PG8_SCHED
}
}
using pg8::Unit; using pg8::HALF; using pg8::BM;
typedef f32x4 AccT[2][2][4][2];

struct EpiBf16 {
    static constexpr bool PERM = true, KEEP = false;
    bf16* O; int ldc; int tanh_pn;
    const float* rss;
    bf16* uc = nullptr;
    __device__ __forceinline__ void operator()(const AccT& acc, const Unit& u, int wr, int wc, int fr, int fq) const {
        const int row0 = u.pm * BM + wr * 64 + fr, col0 = u.pn * BM + wc * 32 + 8 * fq;
        float rsv[2][4];
#pragma unroll
        for (int ai = 0; ai < 2; ++ai)
#pragma unroll
            for (int m = 0; m < 4; ++m) rsv[ai][m] = rss ? rss[row0 + ai * HALF + m * 16] : 0.f;
#pragma unroll
        for (int ai = 0; ai < 2; ++ai)
#pragma unroll
            for (int m = 0; m < 4; ++m) { bf16* rowp = O + (size_t)(row0 + ai * HALF + m * 16) * ldc + col0; const float rs = rss ? __builtin_amdgcn_rsqf(rsv[ai][m] * (1.0f / D) + 1e-6f) : 1.0f;
#pragma unroll
                for (int bj = 0; bj < 2; ++bj) { f32x4 v0 = acc[ai][bj][m][0] * rs, v1 = acc[ai][bj][m][1] * rs;
                    if (bj == 0 && u.pn == tanh_pn) {
#pragma unroll
                        for (int j = 0; j < 4; ++j) { v0[j] = tanhf_(v0[j]); v1[j] = tanhf_(v1[j]); } }
                    u32x4 w; w.x = pk2(v0[0], v0[1]); w.y = pk2(v0[2], v0[3]); w.z = pk2(v1[0], v1[1]); w.w = pk2(v1[2], v1[3]);
                    bf16* dst = rowp + bj * HALF;
                    if (uc && u.pn >= C_SU / 256 && u.pn <= (C_SZ - 1) / 256) { const int col = col0 + bj * HALF;
                        if (col >= C_SU && col < C_SZ) { const int t = row0 + ai * HALF + m * 16, cs = col - C_SU; dst = uc + ((size_t)(cs >> 4) * NCH_S5 + (t >> 4)) * 512 + (t & 15) * 16 + (cs & 8); } }
                    *(u32x4*)dst = w; } }
    }
};
struct EpiLora {
    static constexpr bool PERM = true, KEEP = false;
    unsigned char* scr; const float *w0, *a0;
    __device__ __forceinline__ void operator()(const AccT& acc, const Unit& u, int wr, int wc, int fr, int fq) const {
        const int third = u.pn >> 2; const int row0 = u.pm * BM + wr * 64 + fr, cc0 = (u.pn & 3) * 256 + wc * 32 + 8 * fq;
        const size_t ooff = third == 0 ? SB_LWF : (third == 1 ? SB_LWB : SB_AG); bf16* O = (bf16*)(scr + ooff); const float* bp = w0 + third * WB + cc0; if (third == 2) bp = a0 + cc0; const float sc = third == 2 ? 1.0f : -0.6065306597126334f;
        const f32x4 b00 = *(const f32x4*)(bp), b01 = *(const f32x4*)(bp + 4), b10 = *(const f32x4*)(bp + HALF), b11 = *(const f32x4*)(bp + HALF + 4);
#pragma unroll
        for (int ai = 0; ai < 2; ++ai)
#pragma unroll
            for (int m = 0; m < 4; ++m) { bf16* rowp = O + (size_t)(row0 + ai * HALF + m * 16) * WB + cc0;
#pragma unroll
                for (int bj = 0; bj < 2; ++bj) { const f32x4 v0 = acc[ai][bj][m][0] + (bj ? b10 : b00), v1 = acc[ai][bj][m][1] + (bj ? b11 : b01); float o[8];
#pragma unroll
                    for (int j = 0; j < 4; ++j) { o[j] = sc * sigmoidf_(v0[j]); o[4 + j] = sc * sigmoidf_(v1[j]); }
                    *(u32x4*)(rowp + bj * HALF) = pack8(o); } }
    }
};
struct EpiF32 {
    static constexpr bool PERM = false, KEEP = false;
    float* C; int ldc; size_t zstride;
    __device__ __forceinline__ void operator()(const AccT& acc, const Unit& u, int wr, int wc, int fr, int fq) const {
        const int row0 = u.pm * BM + wr * 64 + fr, col0 = u.pn * BM + wc * 32 + 4 * fq; float* Cz = C + (size_t)u.z * zstride;
#pragma unroll
        for (int ai = 0; ai < 2; ++ai)
#pragma unroll
            for (int m = 0; m < 4; ++m) { float* rowp = Cz + (size_t)(row0 + ai * HALF + m * 16) * ldc + col0;
#pragma unroll
                for (int bj = 0; bj < 2; ++bj)
#pragma unroll
                    for (int n = 0; n < 2; ++n) *(f32x4*)(rowp + bj * HALF + n * 16) = acc[ai][bj][m][n]; }
    }
};
struct EpiLru {
    static constexpr bool PERM = false, KEEP = false;
    const float *b_r, *b_i, *lam;
    const bf16* XC; bf16* LA; bf16* BB;
    __device__ __forceinline__ void operator()(const AccT& acc, const Unit& u, int wr, int wc, int fr, int fq) const {
        const int d = u.pn >> 3, h = u.pn & 7; const int row0 = u.pm * BM + wr * 64 + fr;
#pragma unroll
        for (int n = 0; n < 2; ++n) { const int ch0 = h * 128 + wc * 32 + n * 16 + fq * 4; float br[4], bi[4], sp[4];
#pragma unroll
            for (int j = 0; j < 4; ++j) { br[j] = b_r[d * WB + ch0 + j]; bi[j] = b_i[d * WB + ch0 + j]; sp[j] = -8.0f * softplusf_(-lam[d * WB + ch0 + j]); }
            u32x2 xwv[2][4];
#pragma unroll
            for (int ai = 0; ai < 2; ++ai)
#pragma unroll
                for (int m = 0; m < 4; ++m) xwv[ai][m] = *(const u32x2*)(XC + (size_t)(row0 + ai * HALF + m * 16) * WB + ch0);
#pragma unroll
            for (int ai = 0; ai < 2; ++ai)
#pragma unroll
                for (int m = 0; m < 4; ++m) { const int t = row0 + ai * HALF + m * 16; int pos, L; seq_of(t, pos, L); const bool first = (d == 0) ? (pos == 0) : (pos == L - 1);
                    const f32x4 ar = acc[ai][0][m][n], aiq = acc[ai][1][m][n];
                    const u32x2 xw = xwv[ai][m];
                    const float xc[4] = {__uint_as_float(xw.x << 16), __uint_as_float(xw.x & 0xffff0000u), __uint_as_float(xw.y << 16), __uint_as_float(xw.y & 0xffff0000u)};
                    float oa[4], ob[4];
#pragma unroll
                    for (int j = 0; j < 4; ++j) { const float rg = sigmoidf_(ar[j] + br[j]), ig = sigmoidf_(aiq[j] + bi[j]); const float la = rg * sp[j];
                        float mult = __builtin_amdgcn_sqrtf(fmaxf(1.0f - __expf(2.0f * la), 0.f)); if (first) mult = 1.0f; oa[j] = la; ob[j] = mult * ig * xc[j]; }
                    u32x2 wa, wb; wa.x = pk2(oa[0], oa[1]); wa.y = pk2(oa[2], oa[3]); wb.x = pk2(ob[0], ob[1]); wb.y = pk2(ob[2], ob[3]);
                    *(u32x2*)(LA + ((size_t)d * T + t) * WB + ch0) = wa; *(u32x2*)(BB + ((size_t)d * T + t) * WB + ch0) = wb; } }
    }
};
struct EpiS5Main {
    static constexpr bool PERM = true, KEEP = false;
    bf16* YG;
    __device__ __forceinline__ void operator()(const AccT& acc, const Unit& u, int wr, int wc, int fr, int fq) const {
        const int row0 = u.pm * BM + wr * 64 + fr; const int g = u.z;
#pragma unroll
        for (int ai = 0; ai < 2; ++ai)
#pragma unroll
            for (int m = 0; m < 4; ++m) { const int c = row0 + ai * HALF + m * 16;
#pragma unroll
                for (int bj = 0; bj < 2; ++bj) { const int cc = bj * HALF + wc * 32 + 8 * fq; const int tau = cc >> 4, p0 = cc & 15; const f32x4 v0 = acc[ai][bj][m][0], v1 = acc[ai][bj][m][1];
                    u32x4 w; w.x = pk2(gelu_tanh(v0[0]), gelu_tanh(v0[1])); w.y = pk2(gelu_tanh(v0[2]), gelu_tanh(v0[3])); w.z = pk2(gelu_tanh(v1[0]), gelu_tanh(v1[1])); w.w = pk2(gelu_tanh(v1[2]), gelu_tanh(v1[3]));
                    *(u32x4*)(YG + (size_t)(c * 16 + tau) * WB + g * 16 + p0) = w; } }
    }
};
struct EpiGlu {
    static constexpr bool PERM = true, KEEP = false;
    const bf16* YG; const bf16* PROJ; const float* glu_b; bf16* Y;
    __device__ __forceinline__ void operator()(const AccT& acc, const Unit& u, int wr, int wc, int fr, int fq) const {
        const int row0 = u.pm * BM + wr * 64 + fr, col0 = u.pn * BM + wc * 32 + 8 * fq;
#pragma unroll
        for (int ai = 0; ai < 2; ++ai)
#pragma unroll
            for (int m = 0; m < 4; m += 2) { u32x4 ygw[2][2], zzw[2][2];
#pragma unroll
              for (int mm = 0; mm < 2; ++mm)
#pragma unroll
                for (int bj = 0; bj < 2; ++bj) { const int t = row0 + ai * HALF + (m + mm) * 16, col = col0 + bj * HALF; ygw[mm][bj] = *(const u32x4*)(YG + (size_t)t * WB + col); zzw[mm][bj] = *(const u32x4*)(PROJ + (size_t)t * NPJ + C_SZ + col); }
#pragma unroll
              for (int mm = 0; mm < 2; ++mm) { const int t = row0 + ai * HALF + (m + mm) * 16;
#pragma unroll
                for (int bj = 0; bj < 2; ++bj) { const int col = col0 + bj * HALF; const f32x4 v0 = acc[ai][bj][m + mm][0], v1 = acc[ai][bj][m + mm][1];
                    float yg[8], zz[8], o[8]; unpack8(ygw[mm][bj], yg); unpack8(zzw[mm][bj], zz);
                    const f32x4 b0 = *(const f32x4*)(glu_b + col), b1 = *(const f32x4*)(glu_b + col + 4);
#pragma unroll
                    for (int j = 0; j < 4; ++j) { o[j] = yg[j] * sigmoidf_(v0[j] + b0[j]) * siluf_(zz[j]); o[4 + j] = yg[4 + j] * sigmoidf_(v1[j] + b1[j]) * siluf_(zz[4 + j]); }
                    *(u32x4*)(Y + (size_t)t * 4096 + 3072 + col) = pack8(o); } } }
    }
};
struct EpiGate {
    static constexpr bool PERM = false, KEEP = false;
    bf16* GR; const float* rss;
    __device__ __forceinline__ void operator()(const AccT& acc, const Unit& u, int wr, int wc, int fr, int fq) const {
        const int row0 = u.pm * BM + wr * 64 + fr, ch0 = u.pn * 64 + wc * 16 + 4 * fq;
        float rsv[2][4];
#pragma unroll
        for (int ai = 0; ai < 2; ++ai)
#pragma unroll
            for (int m = 0; m < 4; ++m) rsv[ai][m] = rss[row0 + ai * HALF + m * 16];
#pragma unroll
        for (int ai = 0; ai < 2; ++ai)
#pragma unroll
            for (int m = 0; m < 4; ++m) { const size_t t = (size_t)(row0 + ai * HALF + m * 16); const float rs = __builtin_amdgcn_rsqf(rsv[ai][m] * (1.0f / D) + 1e-6f);
                float e1[4][4], g[4][4];
#pragma unroll
                for (int z = 0; z < 4; ++z) { const f32x4 v = acc[ai][z >> 1][m][z & 1] * rs;
#pragma unroll
                    for (int j = 0; j < 4; ++j) { e1[z][j] = 1.0f + __expf(-__builtin_amdgcn_fmed3f(v[j], -30.0f, 30.0f)); g[z][j] = __builtin_amdgcn_rcpf(e1[z][j]); } }
#pragma unroll
                for (int z = 0; z < 4; ++z) { float f[4];
#pragma unroll
                    for (int j = 0; j < 4; ++j) f[j] = z < 3 ? g[z][j] * e1[z + 1][j] : g[3][j];
                    u32x2 w; w.x = pk2(f[0], f[1]); w.y = pk2(f[2], f[3]); *(u32x2*)(GR + ((size_t)z * T + t) * D + ch0) = w; } }
    }
};
struct EpiBranchAll {
    static constexpr bool PERM = false, KEEP = true;
    const bf16* GR; bf16* MG;
    __device__ __forceinline__ void operator()(AccT& acc, const Unit& u, int wr, int wc, int fr, int fq) const {
        const int row0 = u.pm * BM + wr * 64 + fr, col0 = u.pn * BM + wc * 32 + 4 * fq; const int z = u.z;
#pragma unroll
        for (int ai = 0; ai < 2; ++ai)
          { u32x2 gv[4][2][2];
#pragma unroll
            for (int m = 0; m < 4; ++m)
#pragma unroll
                for (int bj = 0; bj < 2; ++bj)
#pragma unroll
                    for (int n = 0; n < 2; ++n) gv[m][bj][n] = *(const u32x2*)(GR + ((size_t)z * T + (size_t)(row0 + ai * HALF + m * 16)) * D + col0 + bj * HALF + n * 16);
#pragma unroll
            for (int m = 0; m < 4; ++m) { const size_t t = (size_t)(row0 + ai * HALF + m * 16);
#pragma unroll
                for (int bj = 0; bj < 2; ++bj)
#pragma unroll
                    for (int n = 0; n < 2; ++n) { const int o = bj * HALF + n * 16; const u32x2 g0 = gv[m][bj][n]; f32x4& a = acc[ai][bj][m][n];
                        a[0] *= __uint_as_float(g0.x << 16); a[1] *= __uint_as_float(g0.x & 0xffff0000u); a[2] *= __uint_as_float(g0.y << 16); a[3] *= __uint_as_float(g0.y & 0xffff0000u);
                        if (z == 3) { u32x2 w; w.x = pk2(a[0], a[1]); w.y = pk2(a[2], a[3]); *(u32x2*)(MG + t * D + col0 + o) = w; } } } }
    }
};
struct EpiOut {
    static constexpr bool PERM = false, KEEP = false;
    const float* xp; const float* xs; float* out; bf16* XB; float* rsp; int first;
    __device__ __forceinline__ void operator()(const AccT& acc, const Unit& u, int wr, int wc, int fr, int fq) const {
        const int row0 = u.pm * BM + wr * 64 + fr, col0 = u.pn * BM + wc * 32 + 4 * fq;
#pragma unroll
        for (int ai = 0; ai < 2; ++ai)
#pragma unroll
            for (int m2 = 0; m2 < 4; m2 += 2) { f32x4 sv[2][2][2];
#pragma unroll
              for (int mm = 0; mm < 2; ++mm) { const int t = row0 + ai * HALF + (m2 + mm) * 16; const size_t ro = (size_t)t * D + col0; const float* src = first ? (t < TP ? xp + ro : xs + (ro - (size_t)TP * D)) : out + ro;
#pragma unroll
                for (int bj = 0; bj < 2; ++bj)
#pragma unroll
                    for (int n = 0; n < 2; ++n) sv[mm][bj][n] = *(const f32x4*)(src + bj * HALF + n * 16); }
#pragma unroll
              for (int mm = 0; mm < 2; ++mm) { const int m = m2 + mm; const int t = row0 + ai * HALF + m * 16; const size_t ro = (size_t)t * D + col0; float ss = 0.f;
#pragma unroll
                for (int bj = 0; bj < 2; ++bj)
#pragma unroll
                    for (int n = 0; n < 2; ++n) { const int o = bj * HALF + n * 16; const f32x4 v = sv[mm][bj][n] + acc[ai][bj][m][n]; *(f32x4*)(out + ro + o) = v;
                        u32x2 w; w.x = pk2(v[0], v[1]); w.y = pk2(v[2], v[3]); *(u32x2*)(XB + ro + o) = w; ss += (v[0] * v[0] + v[1] * v[1]) + (v[2] * v[2] + v[3] * v[3]); }
                ss += shx<16>(ss); ss += shx<32>(ss);
                if (fq == 0) rsp[(size_t)t * 32 + u.pn * 4 + wc] = ss; } }
    }
};

struct EpiNull { static constexpr bool PERM = false, KEEP = false; __device__ __forceinline__ void operator()(const AccT&, const Unit&, int, int, int, int) const {} };
#define XB_TMO      128
#define XB_XCNT(j)  (256  + 64 * (j))
#define XB_XSUB(j)  (1280 + 64 * (j))
#define XB_XGEN(j)  (2304 + 64 * (j))
#define XB_TOP      3328
#define XB_TOPGEN   3392
#define XCD_BAR_WORDS 3456
#define XB_SPIN_CAP (1u << 24)
__device__ __forceinline__ unsigned xb_ld(unsigned* p)              { return __hip_atomic_load(p, __ATOMIC_RELAXED, __HIP_MEMORY_SCOPE_AGENT); }
__device__ __forceinline__ unsigned xb_add(unsigned* p, unsigned v) { return __hip_atomic_fetch_add(p, v, __ATOMIC_RELAXED, __HIP_MEMORY_SCOPE_AGENT); }
__device__ __forceinline__ unsigned xb_xcc_id() { return (unsigned)__builtin_amdgcn_s_getreg((3 << 11) | 20) & 0xFu; }
#define XB_SPIN(cond, bar) do { unsigned _sp = 0; while (cond) { __builtin_amdgcn_s_sleep(1); \
    if ((++_sp & 255u) == 0u) { if (xb_ld(&(bar)[XB_TMO])) break; if (_sp > XB_SPIN_CAP) { atomicAdd(&(bar)[XB_TMO], 1u); break; } } } } while (0)
struct XcdBarrier { unsigned* bar; unsigned x; volatile LAS unsigned* st; int wave; };
__device__ __forceinline__ XcdBarrier xcd_barrier_post(unsigned* bar, volatile LAS unsigned* st) {
    XcdBarrier b; b.bar = bar; b.x = xb_xcc_id(); b.st = st;
    if (threadIdx.x == 0) (void)xb_add(&bar[XB_XCNT(b.x)], 1u);
    return b;
}
__device__ __forceinline__ void xcd_barrier_complete(unsigned* bar, unsigned x, unsigned& nloc, unsigned& nx) {
    const unsigned G = gridDim.x * gridDim.y * gridDim.z;
    unsigned sum, cnt, mine, sp = 0u;
    for (;;) {
        sum = 0u; cnt = 0u; mine = 0u;
#pragma unroll 1
        for (unsigned j = 0; j < 16; ++j) { const unsigned c = xb_ld(&bar[XB_XCNT(j)]); sum += c; cnt += (c > 0u) ? 1u : 0u; mine = (j == x) ? c : mine; }
        if (sum == G) break;
        __builtin_amdgcn_s_sleep(1);
        if ((++sp & 255u) == 0u) { if (xb_ld(&bar[XB_TMO])) break; if (sp > XB_SPIN_CAP) { atomicAdd(&bar[XB_TMO], 1u); break; } }
    }
    nloc = mine > 0u ? mine : 1u; nx = cnt > 0u ? cnt : 1u;
}
__device__ __forceinline__ void xcd_barrier(const XcdBarrier& b) {
    asm volatile("s_waitcnt vmcnt(0)" ::: "memory");
    __syncthreads();
    if (b.wave == 0 && lane_id() == 0) {
        unsigned* bar = b.bar;
        __builtin_amdgcn_s_waitcnt(0);
        unsigned nloc = b.st[0], nx = b.st[1];
        if (nloc == 0u) { xcd_barrier_complete(bar, b.x, nloc, nx); b.st[0] = nloc; b.st[1] = nx; }
        const unsigned old = xb_add(&bar[XB_XSUB(b.x)], 1u);
        const unsigned gen = old / nloc;
        if (old + 1u == (gen + 1u) * nloc) {
            __builtin_amdgcn_fence(__ATOMIC_RELEASE, "agent");
            asm volatile("s_waitcnt vmcnt(0)" ::: "memory");
            const unsigned og = xb_add(&bar[XB_TOP], 1u);
            const unsigned tg = og / nx;
            if (og + 1u == (tg + 1u) * nx) xb_add(&bar[XB_TOPGEN], 1u);
            else XB_SPIN(xb_ld(&bar[XB_TOPGEN]) == tg, bar);
            __builtin_amdgcn_fence(__ATOMIC_ACQUIRE, "agent");
            xb_add(&bar[XB_XGEN(b.x)], 1u);
            asm volatile("s_waitcnt vmcnt(0)" ::: "memory");
        } else {
            XB_SPIN(xb_ld(&bar[XB_XGEN(b.x)]) == gen, bar);
            __builtin_amdgcn_fence(__ATOMIC_ACQUIRE, "agent");
            asm volatile("s_waitcnt vmcnt(0)" ::: "memory");
        }
    }
    __syncthreads();
}
constexpr int NWAVES = 8, NTHR = 512;
constexpr int LDS_BYTES = 147456;
constexpr int LDS_MISC = LDS_BYTES - 256;
struct Args { const float* in[35]; float* out; unsigned char* ws; int ph_lo, ph_hi; };
constexpr int LDS_ARGS = LDS_BYTES - 1024;
struct AP { const LAS unsigned long long* q; unsigned char* ws; float* out;
    __device__ __forceinline__ const float* in(int i) const { const unsigned long long v = q[i]; const unsigned lo = __builtin_amdgcn_readfirstlane((unsigned)v), hi = __builtin_amdgcn_readfirstlane((unsigned)(v >> 32)); return (const float*)(((unsigned long long)hi << 32) | lo); } };
struct Frame { LAS unsigned char* lds; int tid, lane, wave, gw, ngw, gt, ngt; };
enum { I_XP = 0, I_XS, I_NORMG, I_WIN, I_CONVW, I_CONVB, I_WR, I_BR, I_WI, I_BI, I_LAM, I_MU, I_W0, I_W2, I_A0, I_A2, I_KK, I_KA, I_RK, I_LNG, I_LNB, I_GNG,
       I_SLRE, I_SLIM, I_SLOG, I_SBRE, I_SBIM, I_SCRE, I_SCIM, I_SD, I_GLUW, I_GLUB, I_WBR, I_WOUT, I_FING };

__device__ __forceinline__ float sin_rev(float x) { return __builtin_amdgcn_sinf(x); }
__device__ __forceinline__ float cos_rev(float x) { return __builtin_amdgcn_cosf(x); }
__device__ __forceinline__ f32x2 cexp_pow(float lre, float lim, float st, int k) {
    const float mag = __expf((float)k * lre * st); double ph = (double)k * (double)lim * (double)st * 0.15915494309189535; ph -= rint(ph);
    const float f = (float)ph; return (f32x2){mag * cos_rev(f), mag * sin_rev(f)};
}

__device__ __forceinline__ void ph_tables(const AP& a, const Frame& F) {
    f32x2* TAB = (f32x2*)(a.ws + WS_S5TAB); f32x2* ROT = (f32x2*)(a.ws + WS_ROT);
    for (int i = F.gt; i < DEPTH * 2 * 64 * 64; i += F.ngt) {
        const float lre = fminf(a.in(I_SLRE)[i], -1e-4f), lim = a.in(I_SLIM)[i]; const float st = __expf(a.in(I_SLOG)[i >> 6]);
        const f32x2 p1 = cexp_pow(lre, lim, st, 1); const float nr = p1.x - 1.f, ni = p1.y, den = lre * lre + lim * lim;
        const float gr = (nr * lre + ni * lim) / den, gi = (ni * lre - nr * lim) / den;
        for (int k = 0; k <= 16; ++k) { const f32x2 p = cexp_pow(lre, lim, st, k); TAB[(size_t)i * 33 + 16 + k] = p; if (k < 16) TAB[(size_t)i * 33 + k] = (f32x2){p.x * gr - p.y * gi, p.x * gi + p.y * gr}; }
    }
    for (int i = F.gt; i < 16384 * 64; i += F.ngt) { const int pos = i >> 6, j = i & 63;
        const double inv = exp(-(double)j * (9.210340371976184 / 64.0)); double ph = (double)pos * inv * 0.15915494309189535; ph -= rint(ph); const float f = (float)ph;
        ROT[i] = (f32x2){cos_rev(f), sin_rev(f)}; }
}
struct TrItem { const float* W; int ldw; bf16* WT; int ldt, k0, n0, drow0, dcol0; const float* ksc; int gmap; };
__device__ __forceinline__ TrItem tr_decode(const AP& a, int it) {
    bf16* WALLT = (bf16*)(a.ws + WS_WALLT); bf16* GLUT = (bf16*)(a.ws + WS_GLUT); bf16* WBRT = (bf16*)(a.ws + WS_WBRT); bf16* WOUTT = (bf16*)(a.ws + WS_WOUTT);
    constexpr int I_IN = 32 * (NIN / 32), I_GL = 16 * 32, I_BRI = 16 * 64, I_OUT = 32 * 64, PER = I_IN + I_GL + 4 * I_BRI + I_OUT;
    const int l = it / PER; int r = it % PER; TrItem d;
    if (r < I_IN) { const int kb = r / (NIN / 32), nb = r % (NIN / 32), n0 = nb * 32; d = TrItem{a.in(I_WIN) + (size_t)l * D * NIN, NIN, WALLT + (size_t)l * NALL * D, D, kb * 64, n0, 0, 0, a.in(I_NORMG) + (size_t)l * D, n0 >= GOFF ? 1 : 0}; return d; } r -= I_IN;
    if (r < I_GL) { const int kb = r / 32, nb = r % 32; d = TrItem{a.in(I_GLUW) + (size_t)l * WB * WB, WB, GLUT + (size_t)l * WB * WB, WB, kb * 64, nb * 32, 0, 0, nullptr, 0}; return d; } r -= I_GL;
    if (r < 4 * I_BRI) { const int br = r / I_BRI, q = r % I_BRI, kb = q / 64, nb = q % 64; d = TrItem{a.in(I_WBR) + ((size_t)l * 4 + br) * WB * D, D, WBRT + (size_t)l * D * 4096, 4096, kb * 64, nb * 32, 0, br * WB, nullptr, 0}; return d; } r -= 4 * I_BRI;
    { const int kb = r / 64, nb = r % 64; d = TrItem{a.in(I_WOUT) + (size_t)l * D * D, D, WOUTT + (size_t)l * D * D, D, kb * 64, nb * 32, 0, 0, nullptr, 0}; return d; }
}
__device__ __forceinline__ void tr_load(const TrItem& d, float (&x)[32], int lane) {
#pragma unroll
    for (int i = 0; i < 32; ++i) { const int kk = 2 * i + (lane >> 5); x[i] = d.W[(size_t)(d.k0 + kk) * d.ldw + d.n0 + (lane & 31)] * (d.ksc ? d.ksc[d.k0 + kk] : 1.0f); }
}
__device__ __forceinline__ void tr_store(const TrItem& d, const float (&x)[32], LAS float* scr, int lane) {
#pragma unroll
    for (int i = 0; i < 32; ++i) { const int kk = 2 * i + (lane >> 5); scr[kk * 33 + (lane & 31)] = x[i]; }
    asm volatile("s_waitcnt lgkmcnt(0)" ::: "memory");
    const int c = lane & 7;
#pragma unroll
    for (int j = 0; j < 4; ++j) { const int n = (lane >> 3) + 8 * j; const LAS float* s = scr + (8 * c) * 33 + n;
        u32x4 o; o.x = pk2(s[0 * 33], s[1 * 33]); o.y = pk2(s[2 * 33], s[3 * 33]); o.z = pk2(s[4 * 33], s[5 * 33]); o.w = pk2(s[6 * 33], s[7 * 33]);
        int drow = d.drow0 + d.n0 + n;
        if (d.gmap) { const int g0 = d.n0 + n - GOFF, z = g0 >> 11, nn = g0 & 2047, gp = nn >> 6, nl = nn & 63;
            drow = NPJ + gp * 256 + 128 * (z >> 1) + 16 * (z & 1) + 32 * (nl >> 4) + (nl & 15); }
        *(u32x4*)(d.WT + (size_t)drow * d.ldt + d.dcol0 + d.k0 + 8 * c) = o; }
    asm volatile("s_waitcnt lgkmcnt(0)" ::: "memory");
}
__device__ __forceinline__ void ph_convert(const AP& a, const Frame& F) {
    LAS float* scr = (LAS float*)(F.lds + F.wave * 16384);
    bf16* WALLT = (bf16*)(a.ws + WS_WALLT);
    constexpr int PERI = 32 * (NIN / 32) + 16 * 32 + 4 * 16 * 64 + 32 * 64; const int NIT = DEPTH * PERI;
    { float xa[32], xb[32]; int it = F.gw;
      if (it < NIT) { TrItem da = tr_decode(a, it); tr_load(da, xa, F.lane);
          for (;;) { const int itb = it + F.ngw; TrItem db; const bool hb = itb < NIT; if (hb) { db = tr_decode(a, itb); tr_load(db, xb, F.lane); }
              tr_store(da, xa, scr, F.lane); if (!hb) break;
              const int ita = itb + F.ngw; const bool ha = ita < NIT; if (ha) { da = tr_decode(a, ita); tr_load(da, xa, F.lane); }
              tr_store(db, xb, scr, F.lane); if (!ha) break; it = ita; } } }
    for (int i = F.gt; i < DEPTH * 64 * (D / 8); i += F.ngt) { const int l = i / (64 * (D / 8)), r = (i / (D / 8)) % 64, c8 = i % (D / 8); *(u32x4*)(WALLT + ((size_t)l * NALL + GOFF + r) * D + c8 * 8) = (u32x4){0u, 0u, 0u, 0u}; }
    bf16* LRUW = (bf16*)(a.ws + WS_LRUW);
    for (int i = F.gt; i < DEPTH * 4096 * 32; i += F.ngt) { const int k8 = i & 31, n = (i >> 5) & 4095, l = i >> 17; const int pn = n >> 8, d = pn >> 3, h = pn & 7, gate = (n >> 7) & 1, j = n & 127;
        u32x4 o = (u32x4){0u, 0u, 0u, 0u};
        if ((k8 >> 4) == (h & 1)) { const float* w = (gate ? a.in(I_WI) : a.in(I_WR)) + ((((size_t)l * 2 + d) * 8 + h) * 128) * 128 + j; const int i0 = (k8 & 15) * 8; float x[8];
#pragma unroll
            for (int q = 0; q < 8; ++q) x[q] = w[(size_t)(i0 + q) * 128]; o = pack8(x); }
        *(u32x4*)(LRUW + ((size_t)l * 4096 + n) * 256 + k8 * 8) = o; }
    bf16* W2ALL = (bf16*)(a.ws + WS_W2ALL);
    for (int i = F.gt; i < DEPTH * 3072 * 32; i += F.ngt) { const int k8 = i & 31, n = (i >> 5) % 3072, l = (i >> 5) / 3072; const int blk = n >> 10, c = n & 1023; u32x4 o = (u32x4){0u, 0u, 0u, 0u};
        if ((k8 >> 3) == blk) { const int j0 = (k8 & 7) * 8; const float* w = blk < 2 ? a.in(I_W2) + (((size_t)l * 2 + blk) * 64 + j0) * WB + c : a.in(I_A2) + ((size_t)l * 64 + j0) * WB + c; float x[8];
#pragma unroll
            for (int q = 0; q < 8; ++q) x[q] = w[(size_t)q * WB]; o = pack8(x); }
        *(u32x4*)(W2ALL + ((size_t)l * 3072 + n) * 256 + k8 * 8) = o; }
    float* KTAB = (float*)(a.ws + WS_PROJ); const f32x2* TAB = (const f32x2*)(a.ws + WS_S5TAB);
    for (int i = F.gt; i < DEPTH * 64 * 2 * 16 * 16; i += F.ngt) { const int p = i & 15, dl = (i >> 4) & 15, dir = (i >> 8) & 1, g = (i >> 9) & 63, l = i >> 15;
        const float* cre = a.in(I_SCRE) + (((size_t)l * 64 + g) * 16 + p) * 64; const float* cim = a.in(I_SCIM) + (((size_t)l * 64 + g) * 16 + p) * 64;
        const float* bre = a.in(I_SBRE) + ((size_t)l * 64 + g) * 64 * 16; const float* bim = a.in(I_SBIM) + ((size_t)l * 64 + g) * 64 * 16;
        const f32x2* tb = TAB + ((((size_t)l * 2 + dir) * 64 + g) * 64) * 33 + dl; f32x4 s[4] = {(f32x4){0.f, 0.f, 0.f, 0.f}, (f32x4){0.f, 0.f, 0.f, 0.f}, (f32x4){0.f, 0.f, 0.f, 0.f}, (f32x4){0.f, 0.f, 0.f, 0.f}};
        for (int n = 0; n < 64; ++n) { const f32x2 gk = tb[(size_t)n * 33]; const float cr = cre[n], ci = cim[n]; const float zr = cr * gk.x - ci * gk.y, zi = cr * gk.y + ci * gk.x;
#pragma unroll
            for (int q4 = 0; q4 < 4; ++q4) { const f32x4 br = *(const f32x4*)(bre + n * 16 + q4 * 4), bi = *(const f32x4*)(bim + n * 16 + q4 * 4); s[q4] += br * zr - bi * zi; } }
        float* o = KTAB + ((((size_t)(l * 64 + g) * 2 + dir) * 16 + dl) * 16 + p) * 16;
#pragma unroll
        for (int q4 = 0; q4 < 4; ++q4) *(f32x4*)(o + q4 * 4) = s[q4]; }
}
__device__ __forceinline__ void ph_s5mats(const AP& a, const Frame& F) {
    const float* KTAB = (const float*)(a.ws + WS_PROJ); const f32x2* TAB = (const f32x2*)(a.ws + WS_S5TAB);
    bf16* MAIN = (bf16*)(a.ws + WS_S5MAIN); bf16* INCM = (bf16*)(a.ws + WS_S5INC);
    for (int i = F.gt; i < DEPTH * 64 * 256 * 64; i += F.ngt) { const int c8 = i & 63, row = (i >> 6) & 255, g = (i >> 14) & 63, l = i >> 20; const int tau = row >> 4, p = row & 15; float x[8];
        if (c8 < 32) { const int sg = c8 >> 1, q0 = (c8 & 1) * 8; const float* kb = KTAB + ((size_t)l * 64 + g) * 2 * 16 * 256;
            if (sg < tau) { const float* k = kb + ((0 * 16 + (tau - sg)) * 16 + p) * 16 + q0;
#pragma unroll
                for (int q = 0; q < 8; ++q) x[q] = k[q]; }
            else if (sg > tau) { const float* k = kb + ((1 * 16 + (sg - tau)) * 16 + p) * 16 + q0;
#pragma unroll
                for (int q = 0; q < 8; ++q) x[q] = k[q]; }
            else { const float* k0 = kb + ((0 * 16 + 0) * 16 + p) * 16 + q0; const float* k1 = kb + ((1 * 16 + 0) * 16 + p) * 16 + q0; const float dsk = a.in(I_SD)[(size_t)l * WB + g * 16 + p];
#pragma unroll
                for (int q = 0; q < 8; ++q) x[q] = k0[q] + k1[q] + ((q0 + q) == p ? dsk : 0.f); }
        } else { const int part = (c8 - 32) >> 3, n0 = ((c8 - 32) & 7) * 8, dir = part >> 1; const int k = dir == 0 ? (tau + 1) : (16 - tau);
            const float* cre = a.in(I_SCRE) + (((size_t)l * 64 + g) * 16 + p) * 64 + n0; const float* cim = a.in(I_SCIM) + (((size_t)l * 64 + g) * 16 + p) * 64 + n0;
            const f32x2* tb = TAB + ((((size_t)l * 2 + dir) * 64 + g) * 64 + n0) * 33 + 16 + k;
#pragma unroll
            for (int q = 0; q < 8; ++q) { const f32x2 pw = tb[(size_t)q * 33]; const float zr = cre[q] * pw.x - cim[q] * pw.y, zi = cre[q] * pw.y + cim[q] * pw.x; x[q] = (part & 1) ? -zi : zr; } }
        *(u32x4*)(MAIN + ((((size_t)l * 64 + g) * 256 + row) * 512) + c8 * 8) = pack8(x); }
    for (int i = F.gt; i < DEPTH * 64 * 256 * 32; i += F.ngt) { const int c8 = i & 31, row = (i >> 5) & 255, g = (i >> 13) & 63, l = i >> 19; const int part = row >> 6, n = row & 63, dir = part >> 1, sg = c8 >> 1, q0 = (c8 & 1) * 8;
        const int k = dir == 0 ? (15 - sg) : sg; const f32x2 gk = TAB[((((size_t)l * 2 + dir) * 64 + g) * 64 + n) * 33 + k];
        const float* bre = a.in(I_SBRE) + (((size_t)l * 64 + g) * 64 + n) * 16 + q0; const float* bim = a.in(I_SBIM) + (((size_t)l * 64 + g) * 64 + n) * 16 + q0; float x[8];
#pragma unroll
        for (int q = 0; q < 8; ++q) { const float zr = gk.x * bre[q] - gk.y * bim[q], zi = gk.x * bim[q] + gk.y * bre[q]; x[q] = (part & 1) ? zi : zr; }
        *(u32x4*)(INCM + ((((size_t)l * 64 + g) * 256 + row) * 256) + c8 * 8) = pack8(x); }
}

__device__ __forceinline__ void ph_x0(const AP& a, const Frame& F) {
    bf16* H = (bf16*)(a.ws + WS_H); float* RSS = (float*)(a.ws + WS_RSS);
    for (int t = F.gw; t < T; t += F.ngw) { const float* xr = t < TP ? a.in(I_XP) + (size_t)t * D : a.in(I_XS) + (size_t)(t - TP) * D; float s = 0.f;
#pragma unroll
        for (int j = 0; j < 8; ++j) { const f32x4 v = *(const f32x4*)(xr + (F.lane + 64 * j) * 4); s += (v[0] * v[0] + v[1] * v[1]) + (v[2] * v[2] + v[3] * v[3]); u32x2 w; w.x = pk2(v[0], v[1]); w.y = pk2(v[2], v[3]); *(u32x2*)(H + (size_t)t * D + (F.lane + 64 * j) * 4) = w; }
        s = wave_sum(s); if (F.lane == 0) RSS[t] = s; }
}
__device__ __forceinline__ void ph_rss(const AP& a, const Frame& F, int l) {
    const float* P = (const float*)(a.ws + WS_RSP); float* R = (float*)(a.ws + WS_RSS) + (size_t)((l + 1) & 1) * T;
    for (int t = F.gt; t < T; t += F.ngt) { float s = 0.f;
#pragma unroll
        for (int j = 0; j < 8; ++j) { const f32x4 v = *(const f32x4*)(P + (size_t)t * 32 + j * 4); s += (v[0] + v[1]) + (v[2] + v[3]); }
        R[t] = s; }
}
__device__ __forceinline__ void ph_final(const AP& a, const Frame& F) {
    const float* RSS = (const float*)(a.ws + WS_RSS) + (size_t)(DEPTH & 1) * T; const float* g = a.in(I_FING);
#pragma unroll 4
    for (int i = F.gt; i < T * (D / 4); i += F.ngt) { const int t = i / (D / 4), c4 = (i % (D / 4)) * 4; const float rs = __builtin_amdgcn_rsqf(RSS[t] * (1.0f / D) + 1e-6f);
        float* p = a.out + (size_t)t * D + c4; *(f32x4*)p = *(const f32x4*)p * rs * *(const f32x4*)(g + c4); }
}
__device__ __forceinline__ void ph_lru_conv(const AP& a, const Frame& F, int l) {
    const bf16* PROJ = (const bf16*)(a.ws + WS_PROJ); bf16* XC = (bf16*)(a.ws + WS_SCR + SA_XC);
    const float* cw = a.in(I_CONVW) + (size_t)l * 4 * WB; const float* cb = a.in(I_CONVB) + (size_t)l * WB;
    if ((F.ngt & 127) == 0) {
        const int c8 = (F.gt & 127) * 8; float wv[4][8], bv[8];
#pragma unroll
        for (int q = 0; q < 8; ++q) { bv[q] = cb[c8 + q];
#pragma unroll
            for (int j = 0; j < 4; ++j) wv[j][q] = cw[j * WB + c8 + q]; }
#pragma unroll 2
        for (int i = F.gt; i < T * 128; i += F.ngt) { const int t = i >> 7; int pos, L; seq_of(t, pos, L); u32x4 xr[4];
#pragma unroll
            for (int j = 0; j < 4; ++j) { const int pp = pos + j - 2; xr[j] = (pp >= 0 && pp < L) ? *(const u32x4*)(PROJ + (size_t)(t + j - 2) * NPJ + C_LRUX + c8) : (u32x4){0u, 0u, 0u, 0u}; }
            float acc[8];
#pragma unroll
            for (int q = 0; q < 8; ++q) acc[q] = bv[q];
#pragma unroll
            for (int j = 0; j < 4; ++j) { float x[8]; unpack8(xr[j], x);
#pragma unroll
                for (int q = 0; q < 8; ++q) acc[q] += wv[j][q] * x[q]; }
            *(u32x4*)(XC + (size_t)t * WB + c8) = pack8(acc); }
        return; }
    for (int i = F.gt; i < T * 128; i += F.ngt) { const int t = i >> 7, c8 = (i & 127) * 8; int pos, L; seq_of(t, pos, L); float acc[8];
#pragma unroll
        for (int q = 0; q < 8; ++q) acc[q] = cb[c8 + q];
#pragma unroll
        for (int j = 0; j < 4; ++j) { const int pp = pos + j - 2; if (pp >= 0 && pp < L) { float x[8]; unpack8(*(const u32x4*)(PROJ + (size_t)(t + j - 2) * NPJ + C_LRUX + c8), x);
#pragma unroll
                for (int q = 0; q < 8; ++q) acc[q] += cw[j * WB + c8 + q] * x[q]; } }
        *(u32x4*)(XC + (size_t)t * WB + c8) = pack8(acc); }
}
#define LOF(x) __uint_as_float((x) << 16)
#define HIF(x) __uint_as_float((x) & 0xffff0000u)
__device__ __forceinline__ void ph_lru_scan1(const AP& a, const Frame& F) {
    const bf16* LA = (const bf16*)(a.ws + WS_SCR + SA_LA); const bf16* BB = (const bf16*)(a.ws + WS_SCR + SA_BB); float* PA = (float*)(a.ws + WS_SCR + SA_PA); float* PB = (float*)(a.ws + WS_SCR + SA_PB);
    for (int i = F.gt; i < NCH_L32 * 2 * 512; i += F.ngt) { const int ch = (i & 511) * 2, d = (i >> 9) & 1, c = i >> 10; float s0 = 0.f, s1 = 0.f, h0 = 0.f, h1 = 0.f;
        unsigned la[32], bb[32];
#pragma unroll
        for (int s = 0; s < 32; ++s) { const int t = c * 32 + (d == 0 ? s : 31 - s); const size_t o = ((size_t)d * T + t) * WB + ch; la[s] = *(const unsigned*)(LA + o); bb[s] = *(const unsigned*)(BB + o); }
#pragma unroll
        for (int s = 0; s < 32; ++s) { const float l0 = LOF(la[s]), l1 = HIF(la[s]); h0 = __expf(l0) * h0 + LOF(bb[s]); h1 = __expf(l1) * h1 + HIF(bb[s]); s0 += l0; s1 += l1; }
        const size_t o = ((size_t)c * 2 + d) * WB + ch; *(f32x2*)(PA + o) = (f32x2){__expf(s0), __expf(s1)}; *(f32x2*)(PB + o) = (f32x2){h0, h1}; }
}
__device__ __forceinline__ void ph_lru_scan2(const AP& a, const Frame& F) {
    const float* PA = (const float*)(a.ws + WS_SCR + SA_PA); const float* PB = (const float*)(a.ws + WS_SCR + SA_PB); float* CAR = (float*)(a.ws + WS_SCR + SA_CAR);
    LAS float* ex = (LAS float*)F.lds;
    for (int it = blockIdx.x; it < 5 * 2 * 16; it += gridDim.x) { const int slab = it & 15, d = (it >> 4) & 1, sq = it >> 5; const int c0 = sq == 0 ? 0 : 512 + (sq - 1) * 64, nc = sq == 0 ? 512 : 64, ns = nc / 8;
        const int ch = slab * 64 + F.lane, seg = F.wave; float p = 1.f, h = 0.f;
        for (int s0 = 0; s0 < ns; s0 += 8) { float pa[8], pb[8];
#pragma unroll
            for (int u = 0; u < 8; ++u) { const int sp = seg * ns + s0 + u, c = c0 + (d == 0 ? sp : nc - 1 - sp); const size_t o = ((size_t)c * 2 + d) * WB + ch; pa[u] = PA[o]; pb[u] = PB[o]; }
#pragma unroll
            for (int u = 0; u < 8; ++u) { h = pa[u] * h + pb[u]; p *= pa[u]; } }
        __syncthreads(); ex[(seg * 64 + F.lane) * 2] = p; ex[(seg * 64 + F.lane) * 2 + 1] = h; __syncthreads();
        float x = 0.f;
        for (int s2 = 0; s2 < seg; ++s2) x = ex[(s2 * 64 + F.lane) * 2] * x + ex[(s2 * 64 + F.lane) * 2 + 1];
        for (int s0 = 0; s0 < ns; s0 += 8) { float pa[8], pb[8];
#pragma unroll
            for (int u = 0; u < 8; ++u) { const int sp = seg * ns + s0 + u, c = c0 + (d == 0 ? sp : nc - 1 - sp); const size_t o = ((size_t)c * 2 + d) * WB + ch; pa[u] = PA[o]; pb[u] = PB[o]; }
#pragma unroll
            for (int u = 0; u < 8; ++u) { const int sp = seg * ns + s0 + u, c = c0 + (d == 0 ? sp : nc - 1 - sp); CAR[((size_t)c * 2 + d) * WB + ch] = x; x = pa[u] * x + pb[u]; } }
    }
}
__device__ __forceinline__ void ph_lru_scan3(const AP& a, const Frame& F) {
    const bf16* LA = (const bf16*)(a.ws + WS_SCR + SA_LA); const bf16* BB = (const bf16*)(a.ws + WS_SCR + SA_BB); const float* CAR = (const float*)(a.ws + WS_SCR + SA_CAR);
    const bf16* PROJ = (const bf16*)(a.ws + WS_PROJ); bf16* Y = (bf16*)(a.ws + WS_Y);
    for (int i = F.gt; i < NCH_L32 * 512; i += F.ngt) { const int ch = (i & 511) * 2, c = i >> 9;
        unsigned la[32], bb[32], hf[32];
#pragma unroll
        for (int s = 0; s < 32; ++s) { const size_t o = (size_t)(c * 32 + s) * WB + ch; la[s] = *(const unsigned*)(LA + o); bb[s] = *(const unsigned*)(BB + o); }
        f32x2 h = *(const f32x2*)(CAR + ((size_t)c * 2 + 0) * WB + ch);
#pragma unroll
        for (int s = 0; s < 32; ++s) { h[0] = __expf(LOF(la[s])) * h[0] + LOF(bb[s]); h[1] = __expf(HIF(la[s])) * h[1] + HIF(bb[s]); hf[s] = pk2(h[0], h[1]); }
        asm volatile("" ::: "memory");
#pragma unroll
        for (int s = 0; s < 32; ++s) { const size_t o = ((size_t)T + c * 32 + s) * WB + ch; la[s] = *(const unsigned*)(LA + o); bb[s] = *(const unsigned*)(BB + o); }
        h = *(const f32x2*)(CAR + ((size_t)c * 2 + 1) * WB + ch);
#pragma unroll
        for (int s0 = 16; s0 >= 0; s0 -= 16) { unsigned zq[16];
#pragma unroll
            for (int u = 0; u < 16; ++u) zq[u] = *(const unsigned*)(PROJ + (size_t)(c * 32 + s0 + u) * NPJ + C_LRUZ + ch);
#pragma unroll
            for (int u = 15; u >= 0; --u) { const int s = s0 + u; h[0] = __expf(LOF(la[s])) * h[0] + LOF(bb[s]); h[1] = __expf(HIF(la[s])) * h[1] + HIF(bb[s]); const unsigned zz = zq[u];
                *(unsigned*)(Y + (size_t)(c * 32 + s) * 4096 + ch) = pk2((LOF(hf[s]) + h[0]) * siluf_(LOF(zz)), (HIF(hf[s]) + h[1]) * siluf_(HIF(zz))); } } }
}
#undef LOF
#undef HIF

__device__ __forceinline__ void ph_s5_rearr(const AP& a, const Frame& F) {
    const bf16* PROJ = (const bf16*)(a.ws + WS_PROJ); bf16* UC = (bf16*)(a.ws + WS_SCR + SD_UC);
#pragma unroll 4
    for (int i = F.gt; i < T * 64; i += F.ngt) { const int g = i & 63, t = i >> 6, c = t >> 4, tau = t & 15; const u32x4* s = (const u32x4*)(PROJ + (size_t)t * NPJ + C_SU + g * 16);
        u32x4* d = (u32x4*)(UC + ((size_t)g * NCH_S5 + c) * 512 + tau * 16); d[0] = s[0]; d[1] = s[1]; }
}
__device__ __forceinline__ void ph_s5_scan(const AP& a, const Frame& F, int l) {
    const float* INC = (const float*)(a.ws + WS_SCR + SD_INC); bf16* UC = (bf16*)(a.ws + WS_SCR + SD_UC); const f32x2* TAB = (const f32x2*)(a.ws + WS_S5TAB);
    LAS float* ex = (LAS float*)F.lds;
    for (int it = blockIdx.x; it < 5 * 64 * 2; it += gridDim.x) { const int d = it & 1, g = (it >> 1) & 63, sq = it >> 7; const int c0 = sq == 0 ? 0 : 1024 + (sq - 1) * 128, nc = sq == 0 ? 1024 : 128, ns = nc / 8;
        const int n = F.lane, seg = F.wave; const f32x2 lc = TAB[((((size_t)l * 2 + d) * 64 + g) * 64 + n) * 33 + 32];
        float xr = 0.f, xi = 0.f, pr = 1.f, pi = 0.f;
        for (int s0 = 0; s0 < ns; s0 += 8) { float ir[8], ii[8];
#pragma unroll
            for (int u = 0; u < 8; ++u) { const int sp = seg * ns + s0 + u, c = c0 + (d == 0 ? sp : nc - 1 - sp); const size_t ro = (size_t)g * NCH_S5 + c; ir[u] = INC[ro * 256 + d * 128 + n]; ii[u] = INC[ro * 256 + d * 128 + 64 + n]; }
#pragma unroll
            for (int u = 0; u < 8; ++u) { const float nr = lc.x * xr - lc.y * xi + ir[u], ni = lc.x * xi + lc.y * xr + ii[u]; xr = nr; xi = ni; const float qr = lc.x * pr - lc.y * pi, qi = lc.x * pi + lc.y * pr; pr = qr; pi = qi; } }
        __syncthreads(); ex[(seg * 64 + n) * 2] = xr; ex[(seg * 64 + n) * 2 + 1] = xi; __syncthreads();
        xr = 0.f; xi = 0.f;
        for (int s2 = 0; s2 < seg; ++s2) { const float er = ex[(s2 * 64 + n) * 2], ei = ex[(s2 * 64 + n) * 2 + 1]; const float nr = pr * xr - pi * xi + er, ni = pr * xi + pi * xr + ei; xr = nr; xi = ni; }
        for (int s0 = 0; s0 < ns; s0 += 8) { float ir[8], ii[8];
#pragma unroll
            for (int u = 0; u < 8; ++u) { const int sp = seg * ns + s0 + u, c = c0 + (d == 0 ? sp : nc - 1 - sp); const size_t ro = (size_t)g * NCH_S5 + c; ir[u] = INC[ro * 256 + d * 128 + n]; ii[u] = INC[ro * 256 + d * 128 + 64 + n]; }
#pragma unroll
            for (int u = 0; u < 8; ++u) { const int sp = seg * ns + s0 + u, c = c0 + (d == 0 ? sp : nc - 1 - sp); const size_t ro = (size_t)g * NCH_S5 + c;
                UC[ro * 512 + 256 + d * 128 + n] = (bf16)f2bf(xr); UC[ro * 512 + 256 + d * 128 + 64 + n] = (bf16)f2bf(xi);
                const float nr = lc.x * xr - lc.y * xi + ir[u], ni = lc.x * xi + lc.y * xr + ii[u]; xr = nr; xi = ni; } }
    }
}
template <int NT> __device__ __forceinline__ void mma_lds(f32x4 (&acc)[NT], const LAS bf16* As, int pa, const LAS bf16* Bs, int pb, int K, int lane) {
    const int r = lane & 15, q = lane >> 4;
    for (int kk = 0; kk < K; kk += 32) { const bf16x8 av = *(const LAS bf16x8*)(As + r * pa + kk + q * 8);
#pragma unroll
        for (int nt = 0; nt < NT; ++nt) { const bf16x8 bv = *(const LAS bf16x8*)(Bs + (nt * 16 + r) * pb + kk + q * 8); acc[nt] = __builtin_amdgcn_mfma_f32_16x16x32_bf16(av, bv, acc[nt], 0, 0, 0); } }
}
template <int NT> __device__ __forceinline__ void mma_glb(f32x4 (&acc)[NT], const LAS bf16* As, int pa, const bf16* Bg, int pb, int K, int lane) {
    const int r = lane & 15, q = lane >> 4;
    for (int kk = 0; kk < K; kk += 32) { const bf16x8 av = *(const LAS bf16x8*)(As + r * pa + kk + q * 8);
#pragma unroll
        for (int n0 = 0; n0 < NT; n0 += 8) { bf16x8 bv[8];
#pragma unroll
            for (int u = 0; u < 8; ++u) bv[u] = *(const bf16x8*)(Bg + (size_t)((n0 + u) * 16 + r) * pb + kk + q * 8);
#pragma unroll
            for (int u = 0; u < 8; ++u) acc[n0 + u] = __builtin_amdgcn_mfma_f32_16x16x32_bf16(av, bv[u], acc[n0 + u], 0, 0, 0); } }
}
#define LBAR() do { asm volatile("s_waitcnt lgkmcnt(0)" ::: "memory"); __builtin_amdgcn_s_barrier(); asm volatile("" ::: "memory"); } while (0)
constexpr int RP = 136;
__device__ __forceinline__ float ret_log2g(int h) { return log2f(1.0f - exp2f(-5.0f - (float)h)); }

__device__ __forceinline__ void ph_ret_kv(const AP& a, const Frame& F) {
    const bf16* PROJ = (const bf16*)(a.ws + WS_PROJ); const f32x2* ROT = (const f32x2*)(a.ws + WS_ROT); bf16* KVT = (bf16*)(a.ws + WS_SCR + SC_KVT);
    LAS bf16* VT = (LAS bf16*)F.lds; LAS bf16* KTf = VT + 128 * RP; LAS bf16* KTb = KTf + 128 * RP;
    for (int it = blockIdx.x; it < NCH_RET * 4 * 2; it += gridDim.x) { const int eh = it & 1, h = (it >> 1) & 3, cn = it >> 3; const float l2g = ret_log2g(h);
        LBAR();
        { const int pp = F.lane, ta = cn * 128 + 2 * pp;
#pragma unroll
          for (int oc = 0; oc < 2; ++oc) { const int e8 = (F.wave * 2 + oc) * 8;
              const u32x4 va = *(const u32x4*)(PROJ + (size_t)ta * NPJ + C_RV + h * 256 + eh * 128 + e8), vb = *(const u32x4*)(PROJ + (size_t)(ta + 1) * NPJ + C_RV + h * 256 + eh * 128 + e8);
              const unsigned wa[4] = {va.x, va.y, va.z, va.w}, wb[4] = {vb.x, vb.y, vb.z, vb.w};
#pragma unroll
              for (int i = 0; i < 4; ++i) { *(LAS unsigned*)(VT + (e8 + 2 * i) * RP + 2 * pp) = (wa[i] & 0xffffu) | (wb[i] << 16); *(LAS unsigned*)(VT + (e8 + 2 * i + 1) * RP + 2 * pp) = (wa[i] >> 16) | (wb[i] & 0xffff0000u); } }
          { const int i8 = F.wave * 8; int posa, L; seq_of(ta, posa, L);
            float x1a[8], x2a[8], x1b[8], x2b[8];
            unpack8(*(const u32x4*)(PROJ + (size_t)ta * NPJ + C_RK + h * 128 + i8), x1a); unpack8(*(const u32x4*)(PROJ + (size_t)ta * NPJ + C_RK + h * 128 + 64 + i8), x2a);
            unpack8(*(const u32x4*)(PROJ + (size_t)(ta + 1) * NPJ + C_RK + h * 128 + i8), x1b); unpack8(*(const u32x4*)(PROJ + (size_t)(ta + 1) * NPJ + C_RK + h * 128 + 64 + i8), x2b);
            const f32x4* ra = (const f32x4*)(ROT + (size_t)posa * 64 + i8); const f32x4* rb = (const f32x4*)(ROT + (size_t)(posa + 1) * 64 + i8);
            const float sc = 0.08838834764831845f; const float dfa = __builtin_amdgcn_exp2f(l2g * (float)(127 - 2 * pp)) * sc, dba = __builtin_amdgcn_exp2f(l2g * (float)(2 * pp)) * sc, dfb = __builtin_amdgcn_exp2f(l2g * (float)(126 - 2 * pp)) * sc, dbb = __builtin_amdgcn_exp2f(l2g * (float)(2 * pp + 1)) * sc;
#pragma unroll
            for (int i2 = 0; i2 < 4; ++i2) { const f32x4 ca = ra[i2], cb2 = rb[i2];
#pragma unroll
                for (int u = 0; u < 2; ++u) { const int i = 2 * i2 + u; const float c_a = ca[2 * u], s_a = ca[2 * u + 1], c_b = cb2[2 * u], s_b = cb2[2 * u + 1];
                    const float o1a = x1a[i] * c_a - x2a[i] * s_a, o2a = x1a[i] * s_a + x2a[i] * c_a, o1b = x1b[i] * c_b - x2b[i] * s_b, o2b = x1b[i] * s_b + x2b[i] * c_b;
                    *(LAS unsigned*)(KTf + (i8 + i) * RP + 2 * pp) = pk2(o1a * dfa, o1b * dfb); *(LAS unsigned*)(KTf + (64 + i8 + i) * RP + 2 * pp) = pk2(o2a * dfa, o2b * dfb);
                    *(LAS unsigned*)(KTb + (i8 + i) * RP + 2 * pp) = pk2(o1a * dba, o1b * dbb); *(LAS unsigned*)(KTb + (64 + i8 + i) * RP + 2 * pp) = pk2(o2a * dba, o2b * dbb); } } } }
        LBAR();
        f32x4 af[8], ab[8];
#pragma unroll
        for (int n = 0; n < 8; ++n) { af[n] = (f32x4){0.f, 0.f, 0.f, 0.f}; ab[n] = (f32x4){0.f, 0.f, 0.f, 0.f}; }
        mma_lds<8>(af, KTf + F.wave * 16 * RP, RP, VT, RP, 128, F.lane); mma_lds<8>(ab, KTb + F.wave * 16 * RP, RP, VT, RP, 128, F.lane);
        const int r = F.lane & 15, q4 = F.lane >> 4; const size_t item = (size_t)cn * 4 + h;
#pragma unroll
        for (int n = 0; n < 8; ++n) { const int e = eh * 128 + n * 16 + r, d0 = F.wave * 16 + q4 * 4; *(u32x2*)(KVT + ((0 * 768 + item) * 256 + e) * 128 + d0) = (u32x2){pk2(af[n][0], af[n][1]), pk2(af[n][2], af[n][3])}; *(u32x2*)(KVT + ((768 + item) * 256 + e) * 128 + d0) = (u32x2){pk2(ab[n][0], ab[n][1]), pk2(ab[n][2], ab[n][3])}; }
    }
}
__device__ __forceinline__ void ph_ret_scan(const AP& a, const Frame& F) {
    const unsigned* KVT = (const unsigned*)(a.ws + WS_SCR + SC_KVT); unsigned* STP = (unsigned*)(a.ws + WS_STP);
    for (int i = F.gt; i < 5 * 2 * 4 * 16384; i += F.ngt) { const int ed = i & 16383, h = (i >> 14) & 3, dir = (i >> 16) & 1, sq = i >> 17; const int c0 = sq == 0 ? 0 : 128 + (sq - 1) * 16, nc = sq == 0 ? 128 : 16;
        const float g128 = __builtin_amdgcn_exp2f(ret_log2g(h) * 128.0f); float s0_ = 0.f, s1_ = 0.f;
        for (int s0 = 0; s0 < nc; s0 += 16) { unsigned kv[16];
#pragma unroll
            for (int u = 0; u < 16; ++u) { const int cn = c0 + (dir == 0 ? s0 + u : nc - 1 - s0 - u); kv[u] = KVT[(((size_t)dir * 768 + cn * 4 + h) * 16384) + ed]; }
#pragma unroll
            for (int u = 0; u < 16; ++u) { const int cn = c0 + (dir == 0 ? s0 + u : nc - 1 - s0 - u); STP[(((size_t)dir * 768 + cn * 4 + h) * 16384) + ed] = pk2(s0_, s1_);
                s0_ = g128 * s0_ + __uint_as_float(kv[u] << 16); s1_ = g128 * s1_ + __uint_as_float(kv[u] & 0xffff0000u); } } }
}
__device__ __forceinline__ void ph_ret_out(const AP& a, const Frame& F, int l) {
    const bf16* PROJ = (const bf16*)(a.ws + WS_PROJ); const f32x2* ROT = (const f32x2*)(a.ws + WS_ROT); const bf16* STP = (const bf16*)(a.ws + WS_STP); bf16* Y = (bf16*)(a.ws + WS_Y);
    const float* gn = a.in(I_GNG) + (size_t)l * WB;
    LAS bf16* Qs = (LAS bf16*)F.lds; LAS bf16* Ks = Qs + 128 * RP; LAS bf16* VT = Ks + 128 * RP;
    unsigned* cnt = (unsigned*)(a.ws + WS_CTL) + 16384 + 64 * l; volatile LAS unsigned* tick = (volatile LAS unsigned*)(F.lds + LDS_MISC) + 16;
    for (;;) { LBAR(); if (F.tid == 0) tick[0] = __hip_atomic_fetch_add(cnt, 1u, __ATOMIC_RELAXED, __HIP_MEMORY_SCOPE_AGENT); LBAR();
        const int it = __builtin_amdgcn_readfirstlane((int)tick[0]); if (it >= NCH_RET * 4) break; const int h = it & 3, cn = it >> 2; const float l2g = ret_log2g(h);
        int ln_ = F.lane, td_ = F.tid; asm volatile("" : "+v"(ln_), "+v"(td_));
        LBAR();
        { const int pp = ln_, ta = cn * 128 + 2 * pp;
#pragma unroll
          for (int oc = 0; oc < 4; ++oc) { const int e8 = (F.wave * 4 + oc) * 8;
              const u32x4 va = *(const u32x4*)(PROJ + (size_t)ta * NPJ + C_RV + h * 256 + e8), vb = *(const u32x4*)(PROJ + (size_t)(ta + 1) * NPJ + C_RV + h * 256 + e8);
              const unsigned wa[4] = {va.x, va.y, va.z, va.w}, wb[4] = {vb.x, vb.y, vb.z, vb.w};
#pragma unroll
              for (int i = 0; i < 4; ++i) { *(LAS unsigned*)(VT + (e8 + 2 * i) * RP + 2 * pp) = (wa[i] & 0xffffu) | (wb[i] << 16); *(LAS unsigned*)(VT + (e8 + 2 * i + 1) * RP + 2 * pp) = (wa[i] >> 16) | (wb[i] & 0xffff0000u); } } }
#pragma unroll
        for (int rep2 = 0; rep2 < 2; ++rep2) { const int qq = td_ + rep2 * NTHR, j = qq >> 3, i8 = (qq & 7) * 8; const int t = cn * 128 + j; int pos, L; seq_of(t, pos, L);
            float k1[8], k2[8], q1[8], q2[8], ok1[8], ok2[8], oq1[8], oq2[8];
            unpack8(*(const u32x4*)(PROJ + (size_t)t * NPJ + C_RK + h * 128 + i8), k1); unpack8(*(const u32x4*)(PROJ + (size_t)t * NPJ + C_RK + h * 128 + 64 + i8), k2);
            unpack8(*(const u32x4*)(PROJ + (size_t)t * NPJ + C_RQ + h * 128 + i8), q1); unpack8(*(const u32x4*)(PROJ + (size_t)t * NPJ + C_RQ + h * 128 + 64 + i8), q2);
            const f32x4* rr = (const f32x4*)(ROT + (size_t)pos * 64 + i8); const float sc = 0.08838834764831845f;
#pragma unroll
            for (int i2 = 0; i2 < 4; ++i2) { const f32x4 cs4 = rr[i2];
#pragma unroll
                for (int u = 0; u < 2; ++u) { const int i = 2 * i2 + u; const float c = cs4[2 * u], s = cs4[2 * u + 1];
                    ok1[i] = (k1[i] * c - k2[i] * s) * sc; ok2[i] = (k1[i] * s + k2[i] * c) * sc; oq1[i] = q1[i] * c - q2[i] * s; oq2[i] = q1[i] * s + q2[i] * c; } }
            *(LAS u32x4*)(Ks + j * RP + i8) = pack8(ok1); *(LAS u32x4*)(Ks + j * RP + 64 + i8) = pack8(ok2); *(LAS u32x4*)(Qs + j * RP + i8) = pack8(oq1); *(LAS u32x4*)(Qs + j * RP + 64 + i8) = pack8(oq2); }
        LBAR();
        const int r = ln_ & 15, q4 = ln_ >> 4, i0 = F.wave * 16 + q4 * 4;
        f32x4 sa[8];
#pragma unroll
        for (int n = 0; n < 8; ++n) sa[n] = (f32x4){0.f, 0.f, 0.f, 0.f};
        mma_lds<8>(sa, Qs + F.wave * 16 * RP, RP, Ks, RP, 128, ln_);
        LBAR();
#pragma unroll
        for (int n = 0; n < 8; ++n)
#pragma unroll
            for (int j = 0; j < 4; ++j) { const int i = i0 + j, jj = n * 16 + r; const int dd = i > jj ? i - jj : jj - i; Ks[i * RP + jj] = (bf16)f2bf(sa[n][j] * __builtin_amdgcn_exp2f(l2g * (float)dd)); }
        asm volatile("s_waitcnt lgkmcnt(0)" ::: "memory");
        f32x4 o[16];
#pragma unroll
        for (int n = 0; n < 16; ++n) o[n] = (f32x4){0.f, 0.f, 0.f, 0.f};
        const size_t item = (size_t)cn * 4 + h;
        float r1[4], f2[4];
#pragma unroll
        for (int j = 0; j < 4; ++j) { r1[j] = __builtin_amdgcn_exp2f(l2g * (float)(2 * (i0 + j) - 127)); f2[j] = __builtin_amdgcn_exp2f(l2g * (float)(128 - i0 - j)); }
        { const bf16* Bd0 = STP + (0 * 768 + item) * 32768 + (size_t)r * 128 + q4 * 8; const bf16* Bd1 = STP + (768 + item) * 32768 + (size_t)r * 128 + q4 * 8;
          const LAS bf16* Aq = Qs + (F.wave * 16 + r) * RP + q4 * 8;
          bf16x8 b0[8], b1[8], b2[8];
#define RO_LOAD(dst_, b_) do { const bf16* bp_ = ((b_) < 8 ? Bd0 : Bd1) + (((b_) >> 1) & 3) * 32 + ((b_) & 1) * 8 * 2048; _Pragma("unroll") for (int u = 0; u < 8; ++u) dst_[u] = *(const bf16x8*)(bp_ + u * 2048); } while (0)
#define RO_MMA(src_, b_) do { const bf16x8 av_ = *(const LAS bf16x8*)(Aq + (((b_) >> 1) & 3) * 32); _Pragma("unroll") for (int u = 0; u < 8; ++u) o[((b_) & 1) * 8 + u] = __builtin_amdgcn_mfma_f32_16x16x32_bf16(av_, src_[u], o[((b_) & 1) * 8 + u], 0, 0, 0); } while (0)
          RO_LOAD(b0, 0); RO_LOAD(b1, 1); RO_LOAD(b2, 2);
          RO_MMA(b0, 0); RO_LOAD(b0, 3);
          RO_MMA(b1, 1); RO_LOAD(b1, 4);
          RO_MMA(b2, 2); RO_LOAD(b2, 5);
          RO_MMA(b0, 3); RO_LOAD(b0, 6);
          RO_MMA(b1, 4); RO_LOAD(b1, 7);
          RO_MMA(b2, 5); RO_LOAD(b2, 8);
          RO_MMA(b0, 6); RO_LOAD(b0, 9);
          RO_MMA(b1, 7); RO_LOAD(b1, 10);
#pragma unroll
          for (int n = 0; n < 16; ++n)
#pragma unroll
              for (int j = 0; j < 4; ++j) o[n][j] *= r1[j];
          RO_MMA(b2, 8); RO_LOAD(b2, 11);
          RO_MMA(b0, 9); RO_LOAD(b0, 12);
          RO_MMA(b1, 10); RO_LOAD(b1, 13);
          RO_MMA(b2, 11); RO_LOAD(b2, 14);
          RO_MMA(b0, 12); RO_LOAD(b0, 15);
          RO_MMA(b1, 13);
          RO_MMA(b2, 14);
          RO_MMA(b0, 15);
#undef RO_LOAD
#undef RO_MMA
        }
#pragma unroll
        for (int n = 0; n < 16; ++n)
#pragma unroll
            for (int j = 0; j < 4; ++j) o[n][j] *= f2[j];
        mma_lds<16>(o, Ks + F.wave * 16 * RP, RP, VT, RP, 128, ln_);
        float gnv[16];
#pragma unroll
        for (int n = 0; n < 16; ++n) gnv[n] = gn[h * 256 + n * 16 + r];
#pragma unroll
        for (int j = 0; j < 4; ++j) { float s = 0.f; unsigned short zz[16];
#pragma unroll
            for (int n = 0; n < 16; ++n) zz[n] = PROJ[(size_t)(cn * 128 + i0 + j) * NPJ + C_RZ + h * 256 + n * 16 + r];
#pragma unroll
            for (int n = 0; n < 16; ++n) s += o[n][j];
            s += shx<1>(s); s += shx<2>(s); s += shx<4>(s); s += shx<8>(s); const float mean = s * (1.0f / 256.0f); float v = 0.f;
#pragma unroll
            for (int n = 0; n < 16; ++n) { const float dlt = o[n][j] - mean; v += dlt * dlt; }
            v += shx<1>(v); v += shx<2>(v); v += shx<4>(v); v += shx<8>(v); const float rstd = __builtin_amdgcn_rsqf(v * (1.0f / 256.0f) + 1e-5f);
            const int t = cn * 128 + i0 + j;
#pragma unroll
            for (int n = 0; n < 16; ++n) { const int e = n * 16 + r; Y[(size_t)t * 4096 + 2048 + h * 256 + e] = (bf16)f2bf((o[n][j] - mean) * rstd * gnv[n] * siluf_(bf2f(zz[n]))); } }
    }
}

__device__ __forceinline__ float rdl(float x, int j) { return __int_as_float(__builtin_amdgcn_readlane(__float_as_int(x), j)); }
__device__ __forceinline__ void ph_rwkv_prep(const AP& a, const Frame& F, int l) {
    const bf16* PROJ = (const bf16*)(a.ws + WS_PROJ); unsigned char* S = a.ws + WS_SCR;
    bf16* R = (bf16*)(S + SB_R); bf16* KM = (bf16*)(S + SB_KM); bf16* V = (bf16*)(S + SB_V); bf16* KK = (bf16*)(S + SB_KK); const bf16* AG = (const bf16*)(S + SB_AG);
    const float* mu = a.in(I_MU) + (size_t)l * 3 * WB;
    const float* kkp = a.in(I_KK) + (size_t)l * WB; const float* kap = a.in(I_KA) + (size_t)l * WB;
#define UP4(W_, O_) do { const u32x2 w_ = (W_); O_[0] = __uint_as_float(w_[0] << 16); O_[1] = __uint_as_float(w_[0] & 0xffff0000u); O_[2] = __uint_as_float(w_[1] << 16); O_[3] = __uint_as_float(w_[1] & 0xffff0000u); } while (0)
#define PK4(O_) ((u32x2){pk2(O_[0], O_[1]), pk2(O_[2], O_[3])})
    for (int it = F.gw; it < (T / 4) * 4; it += F.ngw) { const int hq = it & 3, t0 = (it >> 2) * 4, c = hq * 256 + F.lane * 4; int pos0, L; seq_of(t0, pos0, L);
        u32x2 xr[6], xk[6], xv[6];
#pragma unroll
        for (int i = 0; i < 6; ++i) { const int pp = pos0 + i - 1; const bool ok = pp >= 0 && pp < L; const bf16* pr = PROJ + (size_t)(t0 + i - 1) * NPJ + c; const u32x2 z2 = (u32x2){0u, 0u};
            xr[i] = ok ? *(const u32x2*)(pr + C_RWR) : z2; xk[i] = ok ? *(const u32x2*)(pr + C_RWK) : z2; xv[i] = ok ? *(const u32x2*)(pr + C_RWV) : z2; }
        u32x2 agw[4];
#pragma unroll
        for (int i = 0; i < 4; ++i) agw[i] = *(const u32x2*)(AG + (size_t)(t0 + i) * WB + c);
        const f32x4 mur = *(const f32x4*)(mu + c), muk = *(const f32x4*)(mu + WB + c), muv = *(const f32x4*)(mu + 2 * WB + c), kkw = *(const f32x4*)(kkp + c), kaw = *(const f32x4*)(kap + c);
#pragma unroll
        for (int i = 0; i < 4; ++i) { const int t = t0 + i; float rp[4], r0[4], rn[4], kp[4], k0[4], kn[4], vp[4], v0[4], vn[4], ag[4];
            UP4(xr[i], rp); UP4(xr[i + 1], r0); UP4(xr[i + 2], rn); UP4(xk[i], kp); UP4(xk[i + 1], k0); UP4(xk[i + 2], kn); UP4(xv[i], vp); UP4(xv[i + 1], v0); UP4(xv[i + 2], vn); UP4(agw[i], ag);
            float rm[4], km[4], vm[4], kk[4], kd[4]; float ss = 0.f;
#pragma unroll
            for (int e = 0; e < 4; ++e) { rm[e] = r0[e] + mur[e] * (0.5f * (rp[e] + rn[e]) - r0[e]); km[e] = k0[e] + muk[e] * (0.5f * (kp[e] + kn[e]) - k0[e]); vm[e] = v0[e] + muv[e] * (0.5f * (vp[e] + vn[e]) - v0[e]);
                kk[e] = km[e] * kkw[e]; ss += kk[e] * kk[e]; kd[e] = km[e] * (1.0f + (ag[e] - 1.0f) * kaw[e]); }
            ss += shx<1>(ss); ss += shx<2>(ss); ss += shx<4>(ss); ss += shx<8>(ss);
            const float inv = fminf(__builtin_amdgcn_rsqf(ss), 1e12f);
#pragma unroll
            for (int e = 0; e < 4; ++e) kk[e] *= inv;
            const size_t o = (size_t)t * WB + c;
            *(u32x2*)(R + o) = PK4(rm); *(u32x2*)(KM + o) = PK4(kd); *(u32x2*)(V + o) = PK4(vm); *(u32x2*)(KK + o) = PK4(kk); }
    }
}
constexpr int P72 = 72, SLOT = 64 * P72;
__device__ __forceinline__ void mm2(f32x4 (&acc)[2], const LAS bf16* A, const LAS bf16* Bt, int wave, int lane) { asm volatile("" : "+v"(lane));
    mma_lds<2>(acc, A + (wave >> 1) * 16 * P72, P72, Bt + (wave & 1) * 32 * P72, P72, 64, lane); }
#define RW_FOREACH(acc) _Pragma("unroll") for (int nt = 0; nt < 2; ++nt) _Pragma("unroll") for (int j = 0; j < 4; ++j)
#define RW_BASE int rb_ = (F.wave >> 1) * 16 + (F.lane >> 4) * 4, cb_ = (F.wave & 1) * 32 + (F.lane & 15); asm volatile("" : "+v"(rb_), "+v"(cb_));
#define RW_ROW (rb_ + j)
#define RW_COL (cb_ + nt * 16)
__device__ __forceinline__ void ph_rwkv_chunk(const AP& a, const Frame& F, int l) {
    unsigned char* S = a.ws + WS_SCR; bf16* CH = (bf16*)(S + SB_CH);
    const bf16* R = (const bf16*)(S + SB_R); const bf16* KM = (const bf16*)(S + SB_KM); const bf16* V = (const bf16*)(S + SB_V); const bf16* KK = (const bf16*)(S + SB_KK); const bf16* AG = (const bf16*)(S + SB_AG);
    LAS bf16* lb = (LAS bf16*)F.lds;
#define SL(i) (lb + (i) * SLOT)
    LAS float* NF = (LAS float*)SL(12);
    LAS float* GC = (LAS float*)(F.lds + 15 * SLOT * 2);
    LAS float* TOT = GC + 64;
    const f32x4 z4 = (f32x4){0.f, 0.f, 0.f, 0.f};
#ifndef CHUNK_REP
#define CHUNK_REP 1
#endif
    u32x4 pre0, pre1, pre2, pre3, pre4, pre5, pre6;
#define RAW_LOAD(it_, dir_) do { const int hd_ = (it_) & 15, cn_ = (it_) >> 4; const bf16* LW_ = (const bf16*)(S + ((dir_) ? SB_LWB : SB_LWF)); int tid_ = F.tid; asm volatile("" : "+v"(tid_)); \
        const int j_ = tid_ >> 3, c8_ = (tid_ & 7) * 8; const int t_ = cn_ * 64 + ((dir_) ? 63 - j_ : j_); const size_t o_ = (size_t)t_ * WB + hd_ * 64 + c8_; \
        pre0 = *(const u32x4*)(LW_ + o_); pre1 = *(const u32x4*)(KK + o_); pre2 = *(const u32x4*)(AG + o_); pre3 = *(const u32x4*)(KM + o_); pre4 = *(const u32x4*)(R + o_); \
        const int pp_ = tid_ & 31, v8_ = ((tid_ >> 5) & 7) * 8; const int ta_ = cn_ * 64 + ((dir_) ? 63 - 2 * pp_ : 2 * pp_), tb_ = cn_ * 64 + ((dir_) ? 62 - 2 * pp_ : 2 * pp_ + 1); \
        pre5 = *(const u32x4*)(V + (size_t)ta_ * WB + hd_ * 64 + v8_); pre6 = *(const u32x4*)(V + (size_t)tb_ * WB + hd_ * 64 + v8_); } while (0)
    for (int rep = 0; rep < CHUNK_REP; ++rep) {
    if ((int)blockIdx.x < (T / 64) * 16) RAW_LOAD((int)blockIdx.x, 0);
    for (int it = blockIdx.x; it < (T / 64) * 16; it += gridDim.x) { const int hd = it & 15, cn = it >> 4; (void)hd; (void)cn;
        for (int dir = 0; dir < 2; ++dir) {
            bf16* outb = CH + ((size_t)it * 2 + dir) * 4 * 4096;
            LBAR();
            { int tid_ = F.tid; asm volatile("" : "+v"(tid_)); const int j = tid_ >> 3, c8 = (tid_ & 7) * 8;
              *(LAS u32x4*)(SL(8) + j * P72 + c8) = pre0; *(LAS u32x4*)(SL(9) + j * P72 + c8) = pre1; *(LAS u32x4*)(SL(10) + j * P72 + c8) = pre2; *(LAS u32x4*)(SL(11) + j * P72 + c8) = pre3; *(LAS u32x4*)(SL(12) + j * P72 + c8) = pre4;
              if (tid_ < 256) { const int pp = tid_ & 31, v8 = (tid_ >> 5) * 8; const unsigned wa[4] = {pre5.x, pre5.y, pre5.z, pre5.w}, wb[4] = {pre6.x, pre6.y, pre6.z, pre6.w};
#pragma unroll
                  for (int i = 0; i < 4; ++i) { *(LAS unsigned*)(SL(7) + (v8 + 2 * i) * P72 + 2 * pp) = (wa[i] & 0xffffu) | (wb[i] << 16); *(LAS unsigned*)(SL(7) + (v8 + 2 * i + 1) * P72 + 2 * pp) = (wa[i] >> 16) | (wb[i] & 0xffff0000u); } }
              if (dir == 0) {
                  float kmf_[8], rf_[8]; unpack8(pre3, kmf_); unpack8(pre4, rf_); const float* rkp_ = a.in(I_RK) + (size_t)l * WB + hd * 64 + c8; const f32x4 ra_ = *(const f32x4*)rkp_, rb_ = *(const f32x4*)(rkp_ + 4);
                  float s_ = ((rf_[0] * kmf_[0] * ra_[0] + rf_[1] * kmf_[1] * ra_[1]) + (rf_[2] * kmf_[2] * ra_[2] + rf_[3] * kmf_[3] * ra_[3])) + ((rf_[4] * kmf_[4] * rb_[0] + rf_[5] * kmf_[5] * rb_[1]) + (rf_[6] * kmf_[6] * rb_[2] + rf_[7] * kmf_[7] * rb_[3]));
                  s_ += shx<1>(s_); s_ += shx<2>(s_); s_ += shx<4>(s_);
                  if ((tid_ & 7) == 0) ((float*)(a.ws + WS_RSP))[(size_t)(cn * 64 + j) * 16 + hd] = s_; }
              const int nit = dir ? it + (int)gridDim.x : it;
              if (nit < (T / 64) * 16) RAW_LOAD(nit, dir ^ 1); }
            LBAR();
            { int k = F.lane; asm volatile("" : "+v"(k)); const int seg = F.wave;
              float cum[8]; float run = 0.f;
#pragma unroll
              for (int i = 0; i < 8; ++i) { run += bf2f(SL(8)[(seg * 8 + i) * P72 + k]); cum[i] = run; }
              TOT[seg * 64 + k] = run;
              LBAR();
              float off = 0.f;
              for (int s2 = 0; s2 < seg; ++s2) off += TOT[s2 * 64 + k];
              unsigned ta[4], tb[4], tk[4]; float Gprev = __expf(off);
#pragma unroll
              for (int ip = 0; ip < 4; ++ip) { float fa[2], fb[2], fk[2], fr[2];
#pragma unroll
                  for (int u = 0; u < 2; ++u) { const int i = 2 * ip + u, t = seg * 8 + i; const float cl = off + cum[i];
                      const float kkv = bf2f(SL(9)[t * P72 + k]), agv = bf2f(SL(10)[t * P72 + k]), kmv = bf2f(SL(11)[t * P72 + k]), rv = bf2f(SL(12)[t * P72 + k]);
                      const float G = __expf(cl), Gi = __expf(-cl);
                      fa[u] = -kkv * Gprev; fb[u] = kkv * agv * Gi; fk[u] = kmv * Gi; fr[u] = rv * G; Gprev = G;
                      if (t == 63) GC[k] = G; }
                  const unsigned wa = pk2(fa[0], fa[1]), wb = pk2(fb[0], fb[1]), wk = pk2(fk[0], fk[1]), wr2 = pk2(fr[0], fr[1]); const int t0 = seg * 8 + 2 * ip;
                  SL(0)[t0 * P72 + k] = (bf16)wa; SL(0)[(t0 + 1) * P72 + k] = (bf16)(wa >> 16); SL(1)[t0 * P72 + k] = (bf16)wb; SL(1)[(t0 + 1) * P72 + k] = (bf16)(wb >> 16);
                  SL(2)[t0 * P72 + k] = (bf16)wk; SL(2)[(t0 + 1) * P72 + k] = (bf16)(wk >> 16); SL(6)[t0 * P72 + k] = (bf16)wr2; SL(6)[(t0 + 1) * P72 + k] = (bf16)(wr2 >> 16);
                  ta[ip] = wa; tb[ip] = wb; tk[ip] = wk; }
              *(LAS u32x4*)(SL(3) + k * P72 + seg * 8) = (u32x4){ta[0], ta[1], ta[2], ta[3]}; *(LAS u32x4*)(SL(4) + k * P72 + seg * 8) = (u32x4){tb[0], tb[1], tb[2], tb[3]}; *(LAS u32x4*)(SL(5) + k * P72 + seg * 8) = (u32x4){tk[0], tk[1], tk[2], tk[3]}; }
            LBAR();
#define PK4S(dst_, v0_, v1_, v2_, v3_) *(LAS u32x2*)(dst_) = (u32x2){pk2(v0_, v1_), pk2(v2_, v3_)}
            { f32x4 c1[2] = {z4, z4}, c2[2] = {z4, z4}, c3[2] = {z4, z4}, c4[2] = {z4, z4};
              mm2(c1, SL(1), SL(0), F.wave, F.lane);
              mm2(c2, SL(0), SL(2), F.wave, F.lane);
              mm2(c3, SL(1), SL(6), F.wave, F.lane);
              mm2(c4, SL(2), SL(6), F.wave, F.lane);
              RW_BASE
#pragma unroll
              for (int nt = 0; nt < 2; ++nt) { const int cc = cb_ + nt * 16, r0 = rb_;
                  { f32x4 v;
#pragma unroll
                    for (int j = 0; j < 4; ++j) v[j] = (r0 + j) < cc ? c1[nt][j] : 0.f;
                    *(LAS f32x4*)(NF + cc * 68 + r0) = v; }
                  PK4S(SL(8) + cc * P72 + r0, cc < r0 ? c2[nt][0] : 0.f, cc < r0 + 1 ? c2[nt][1] : 0.f, cc < r0 + 2 ? c2[nt][2] : 0.f, cc < r0 + 3 ? c2[nt][3] : 0.f);
                  PK4S(SL(9) + cc * P72 + r0, r0 <= cc ? c3[nt][0] : 0.f, r0 + 1 <= cc ? c3[nt][1] : 0.f, r0 + 2 <= cc ? c3[nt][2] : 0.f, r0 + 3 <= cc ? c3[nt][3] : 0.f);
                  PK4S(SL(10) + cc * P72 + r0, r0 <= cc ? c4[nt][0] : 0.f, r0 + 1 <= cc ? c4[nt][1] : 0.f, r0 + 2 <= cc ? c4[nt][2] : 0.f, r0 + 3 <= cc ? c4[nt][3] : 0.f); } }
            LBAR();
            {
              int tid2_ = F.tid; asm volatile("" : "+v"(tid2_)); const int t = tid2_ >> 3, j8 = (tid2_ & 7) * 8; const bool offd = (t >> 4) != (j8 >> 4);
              { const f32x4 n0 = *(const LAS f32x4*)(NF + t * 68 + j8), n1 = *(const LAS f32x4*)(NF + t * 68 + j8 + 4); u32x4 w = (u32x4){0u, 0u, 0u, 0u};
                if (offd) { w.x = pk2(n0[0], n0[1]); w.y = pk2(n0[2], n0[3]); w.z = pk2(n1[0], n1[1]); w.w = pk2(n1[2], n1[3]); }
                *(LAS u32x4*)(SL(0) + t * P72 + j8) = w;
                if (offd) { *(LAS u32x4*)(SL(1) + t * P72 + j8) = (u32x4){0u, 0u, 0u, 0u}; *(LAS u32x4*)(SL(2) + t * P72 + j8) = (u32x4){0u, 0u, 0u, 0u}; } }
              if (tid2_ < 64) { const int b0 = (tid2_ >> 4) * 16, i = tid2_ & 15; float tr[16];
#pragma unroll
                  for (int tt = 0; tt < 16; ++tt) { float val = (tt == i) ? 1.f : 0.f;
#pragma unroll
                      for (int jj = 0; jj < tt; ++jj) val += (jj >= i ? tr[jj] : 0.f) * NF[(b0 + tt) * 68 + b0 + jj];
                      tr[tt] = (tt < i) ? 0.f : val; }
#pragma unroll
                  for (int tt = 0; tt < 16; ++tt) { const bf16 x = (bf16)f2bf(tr[tt]); SL(1)[(b0 + i) * P72 + b0 + tt] = x; SL(2)[(b0 + tt) * P72 + b0 + i] = x; } } }
            LBAR();
            { f32x4 c1[2] = {z4, z4}, c2[2] = {z4, z4};
              mm2(c1, SL(1), SL(0), F.wave, F.lane);
              mm2(c2, SL(0), SL(1), F.wave, F.lane);
              RW_BASE
#pragma unroll
              for (int nt = 0; nt < 2; ++nt) { const int cc = cb_ + nt * 16, r0 = rb_;
                  PK4S(SL(14) + cc * P72 + r0, c1[nt][0], c1[nt][1], c1[nt][2], c1[nt][3]);
                  PK4S(SL(11) + cc * P72 + r0, c2[nt][0], c2[nt][1], c2[nt][2], c2[nt][3]);
                  PK4S(SL(13) + cc * P72 + r0, c2[nt][0] + (cc == r0 ? 1.f : 0.f), c2[nt][1] + (cc == r0 + 1 ? 1.f : 0.f), c2[nt][2] + (cc == r0 + 2 ? 1.f : 0.f), c2[nt][3] + (cc == r0 + 3 ? 1.f : 0.f)); } }
            LBAR();
            { f32x4 c[2] = {z4, z4}; mm2(c, SL(11), SL(14), F.wave, F.lane);
              RW_BASE
#pragma unroll
              for (int nt = 0; nt < 2; ++nt) { const int cc = cb_ + nt * 16, r0 = rb_;
                  PK4S(SL(12) + cc * P72 + r0, c[nt][0] + (cc == r0 ? 1.f : 0.f), c[nt][1] + (cc == r0 + 1 ? 1.f : 0.f), c[nt][2] + (cc == r0 + 2 ? 1.f : 0.f), c[nt][3] + (cc == r0 + 3 ? 1.f : 0.f)); } }
            LBAR();
            { f32x4 c[2] = {z4, z4}; mm2(c, SL(12), SL(13), F.wave, F.lane);
              RW_BASE
#pragma unroll
              for (int nt = 0; nt < 2; ++nt) PK4S(SL(1) + (cb_ + nt * 16) * P72 + rb_, c[nt][0], c[nt][1], c[nt][2], c[nt][3]); }
            LBAR();
            { f32x4 c[2] = {z4, z4}; mm2(c, SL(1), SL(2), F.wave, F.lane);
              RW_BASE
#pragma unroll
              for (int nt = 0; nt < 2; ++nt) PK4S(SL(0) + (cb_ + nt * 16) * P72 + rb_, c[nt][0], c[nt][1], c[nt][2], c[nt][3]); }
            LBAR();
            { f32x4 c1[2] = {z4, z4}, c2[2] = {z4, z4};
              mm2(c1, SL(0), SL(3), F.wave, F.lane);
              mm2(c2, SL(8), SL(0), F.wave, F.lane);
              RW_BASE
#pragma unroll
              for (int nt = 0; nt < 2; ++nt) { const int cc = cb_ + nt * 16, r0 = rb_; PK4S(SL(1) + cc * P72 + r0, c1[nt][0], c1[nt][1], c1[nt][2], c1[nt][3]); PK4S(SL(11) + cc * P72 + r0, c2[nt][0], c2[nt][1], c2[nt][2], c2[nt][3]); } }
            LBAR();
            { f32x4 c1[2] = {z4, z4}, c2[2] = {z4, z4};
              mm2(c1, SL(11), SL(7), F.wave, F.lane);
              mm2(c2, SL(1), SL(9), F.wave, F.lane);
              RW_BASE
#pragma unroll
              for (int nt = 0; nt < 2; ++nt) { const int cc = cb_ + nt * 16, r0 = rb_; PK4S(SL(12) + cc * P72 + r0, c1[nt][0], c1[nt][1], c1[nt][2], c1[nt][3]);
                  const u32x2 rw = *(const LAS u32x2*)(SL(6) + cc * P72 + r0);
                  PK4S(SL(13) + cc * P72 + r0, c2[nt][0] + __uint_as_float(rw.x << 16), c2[nt][1] + __uint_as_float(rw.x & 0xffff0000u), c2[nt][2] + __uint_as_float(rw.y << 16), c2[nt][3] + __uint_as_float(rw.y & 0xffff0000u)); } }
            LBAR();
            { f32x4 c1[2] = {z4, z4}, c2[2] = {z4, z4}, c3[2] = {z4, z4};
              mm2(c1, SL(12), SL(9), F.wave, F.lane); mm2(c1, SL(7), SL(10), F.wave, F.lane);
              mm2(c2, SL(1), SL(4), F.wave, F.lane);
              mm2(c3, SL(12), SL(4), F.wave, F.lane); mm2(c3, SL(7), SL(5), F.wave, F.lane);
              float qf[8]; RW_BASE
#pragma unroll
              for (int nt = 0; nt < 2; ++nt) { const int cc = cb_ + nt * 16, r0 = rb_; const float gc = GC[cc];
                  PK4S(SL(14) + cc * P72 + r0, c1[nt][0], c1[nt][1], c1[nt][2], c1[nt][3]);
                  PK4S(SL(0) + cc * P72 + r0, (c2[nt][0] + (cc == r0 ? 1.f : 0.f)) * gc, (c2[nt][1] + (cc == r0 + 1 ? 1.f : 0.f)) * gc, (c2[nt][2] + (cc == r0 + 2 ? 1.f : 0.f)) * gc, (c2[nt][3] + (cc == r0 + 3 ? 1.f : 0.f)) * gc);
#pragma unroll
                  for (int j = 0; j < 4; ++j) qf[nt * 4 + j] = c3[nt][j] * gc; }
              *(u32x4*)(outb + 1 * 4096 + (F.wave * 64 + F.lane) * 8) = pack8(qf); }
            LBAR();
#undef PK4S
            { int tid_ = F.tid; asm volatile("" : "+v"(tid_)); const int row = tid_ >> 3, sg = (tid_ & 7) * 8;
              *(u32x4*)(outb + 0 * 4096 + row * 64 + sg) = *(const LAS u32x4*)(SL(0) + row * P72 + sg);
              *(u32x4*)(outb + 2 * 4096 + row * 64 + sg) = *(const LAS u32x4*)(SL(13) + row * P72 + sg); *(u32x4*)(outb + 3 * 4096 + row * 64 + sg) = *(const LAS u32x4*)(SL(14) + row * P72 + sg); }
        }
    }
    }
#undef SL
}
__device__ __forceinline__ void ph_rwkv_seq(const AP& a, const Frame& F) {
    unsigned char* S = a.ws + WS_SCR; const bf16* CH = (const bf16*)(S + SB_CH); bf16* SS = (bf16*)(S + SB_SS);
    LAS bf16* Sb = (LAS bf16*)F.lds;
    const int r = F.lane & 15, q = F.lane >> 4, mt = F.wave >> 1, nb = (F.wave & 1) * 32;
    for (int chain = blockIdx.x; chain < 160; chain += gridDim.x) { const int dir = chain & 1, hd = (chain >> 1) & 15, sq = chain >> 5; const int c0 = sq == 0 ? 0 : 256 + (sq - 1) * 32, nc = sq == 0 ? 256 : 32;
        f32x4 acc[2] = {(f32x4){0.f, 0.f, 0.f, 0.f}, (f32x4){0.f, 0.f, 0.f, 0.f}};
        __syncthreads();
        u32x4 p0, p1, p2, p3, p4s, p5, p6, p7, p8, p9, p10, p11, p12, p13, p14, p15, q0, q1, q2, q3, q4s, q5, q6, q7, q8, q9, q10, q11, q12, q13, q14, q15;
        const int crow = F.tid >> 3, cseg = (F.tid & 7) * 8;
        LAS bf16* Pb = Sb + 2 * SLOT;
#define SEQ_LOAD(P_, Q_, s_) do { const int s1_ = (s_) < nc ? (s_) : nc - 1; const int cn1_ = c0 + (dir == 0 ? s1_ : nc - 1 - s1_); const bf16* PT_ = CH + (((size_t)cn1_ * 16 + hd) * 2 + dir) * 4 * 4096; \
            P_ = *(const u32x4*)(PT_ + F.tid * 8); Q_ = *(const u32x4*)(PT_ + 4096 + F.tid * 8); } while (0)
#define SEQ_STEP(P_, Q_, Pn_, Qn_, s_) do { const int cn_ = c0 + (dir == 0 ? (s_) : nc - 1 - (s_)); const size_t itd_ = ((size_t)cn_ * 16 + hd) * 2 + dir; \
            SEQ_LOAD(Pn_, Qn_, (s_) + 15); \
            LAS bf16* sb_ = Sb + ((s_) & 1) * SLOT; LAS bf16* pb_ = Pb + ((s_) & 1) * SLOT; \
            _Pragma("unroll") for (int nt = 0; nt < 2; ++nt) _Pragma("unroll") for (int j = 0; j < 4; ++j) sb_[(mt * 16 + q * 4 + j) * P72 + nb + nt * 16 + r] = (bf16)f2bf(acc[nt][j]); \
            *(LAS u32x4*)(pb_ + crow * P72 + cseg) = P_; \
            asm volatile("s_waitcnt lgkmcnt(0)" ::: "memory"); __builtin_amdgcn_s_barrier(); asm volatile("" ::: "memory"); \
            *(u32x4*)(SS + itd_ * 4096 + crow * 64 + cseg) = *(const LAS u32x4*)(sb_ + crow * P72 + cseg);            \
            { float qf_[8]; unpack8(Q_, qf_); acc[0] = (f32x4){qf_[0], qf_[1], qf_[2], qf_[3]}; acc[1] = (f32x4){qf_[4], qf_[5], qf_[6], qf_[7]}; } \
            _Pragma("unroll") for (int ks = 0; ks < 2; ++ks) { const bf16x8 av = *(const LAS bf16x8*)(sb_ + (mt * 16 + r) * P72 + ks * 32 + q * 8); \
                _Pragma("unroll") for (int nt = 0; nt < 2; ++nt) { const bf16x8 bv = *(const LAS bf16x8*)(pb_ + (nb + nt * 16 + r) * P72 + ks * 32 + q * 8); acc[nt] = __builtin_amdgcn_mfma_f32_16x16x32_bf16(av, bv, acc[nt], 0, 0, 0); } } } while (0)
        SEQ_LOAD(p0, q0, 0); SEQ_LOAD(p1, q1, 1); SEQ_LOAD(p2, q2, 2); SEQ_LOAD(p3, q3, 3); SEQ_LOAD(p4s, q4s, 4); SEQ_LOAD(p5, q5, 5); SEQ_LOAD(p6, q6, 6); SEQ_LOAD(p7, q7, 7); SEQ_LOAD(p8, q8, 8); SEQ_LOAD(p9, q9, 9); SEQ_LOAD(p10, q10, 10); SEQ_LOAD(p11, q11, 11); SEQ_LOAD(p12, q12, 12); SEQ_LOAD(p13, q13, 13); SEQ_LOAD(p14, q14, 14);
        for (int s = 0; s < nc; s += 16) {
            SEQ_STEP(p0, q0, p15, q15, s + 0);
            SEQ_STEP(p1, q1, p0, q0, s + 1);
            SEQ_STEP(p2, q2, p1, q1, s + 2);
            SEQ_STEP(p3, q3, p2, q2, s + 3);
            SEQ_STEP(p4s, q4s, p3, q3, s + 4);
            SEQ_STEP(p5, q5, p4s, q4s, s + 5);
            SEQ_STEP(p6, q6, p5, q5, s + 6);
            SEQ_STEP(p7, q7, p6, q6, s + 7);
            SEQ_STEP(p8, q8, p7, q7, s + 8);
            SEQ_STEP(p9, q9, p8, q8, s + 9);
            SEQ_STEP(p10, q10, p9, q9, s + 10);
            SEQ_STEP(p11, q11, p10, q10, s + 11);
            SEQ_STEP(p12, q12, p11, q11, s + 12);
            SEQ_STEP(p13, q13, p12, q12, s + 13);
            SEQ_STEP(p14, q14, p13, q13, s + 14);
            SEQ_STEP(p15, q15, p14, q14, s + 15);
        }
#undef SEQ_LOAD
#undef SEQ_STEP
    }
}
__device__ __forceinline__ void ph_rwkv_out(const AP& a, const Frame& F, int l) {
    unsigned char* S = a.ws + WS_SCR; const bf16* CH = (const bf16*)(S + SB_CH); const bf16* SS = (const bf16*)(S + SB_SS); const bf16* PROJ = (const bf16*)(a.ws + WS_PROJ); bf16* Y = (bf16*)(a.ws + WS_Y);
    const bf16* V = (const bf16*)(S + SB_V);
    const float* BSP = (const float*)(a.ws + WS_RSP); const float* lg = a.in(I_LNG) + (size_t)l * WB; const float* lbp = a.in(I_LNB) + (size_t)l * WB;
    const int r = F.lane & 15, q = F.lane >> 4;
    for (int it = F.gw; it < (T / 64) * 16; it += F.ngw) { const int hd = it & 15, cn = it >> 4; const size_t item = (size_t)cn * 16 + hd;
      bf16x8 bS[2][4][2];
#pragma unroll
      for (int dir = 0; dir < 2; ++dir) { const bf16* Sg = SS + (item * 2 + dir) * 4096;
#pragma unroll
          for (int nt = 0; nt < 4; ++nt)
#pragma unroll
              for (int ks = 0; ks < 2; ++ks) bS[dir][nt][ks] = *(const bf16x8*)(Sg + (4 * r + nt) * 64 + ks * 32 + q * 8); }
#pragma unroll 2
      for (int mt = 0; mt < 4; ++mt) {
        f32x4 acc[4];
#pragma unroll
        for (int nt = 0; nt < 4; ++nt) acc[nt] = (f32x4){0.f, 0.f, 0.f, 0.f};
#pragma unroll
        for (int dir = 0; dir < 2; ++dir) { const bf16* ob = CH + (item * 2 + dir) * 4 * 4096; const bf16* R2T = ob + 2 * 4096; const bf16* Y0 = ob + 3 * 4096;
            const int trow = dir ? 63 - (mt * 16 + r) : mt * 16 + r;
#pragma unroll
            for (int ks = 0; ks < 2; ++ks) { const bf16x8 av = *(const bf16x8*)(R2T + trow * 64 + ks * 32 + q * 8);
#pragma unroll
                for (int nt = 0; nt < 4; ++nt) acc[nt] = __builtin_amdgcn_mfma_f32_16x16x32_bf16(av, bS[dir][nt][ks], acc[nt], 0, 0, 0); }
#pragma unroll
            for (int j = 0; j < 4; ++j) { const int tl = mt * 16 + q * 4 + j; const u32x2 yw = *(const u32x2*)(Y0 + (dir ? 63 - tl : tl) * 64 + 4 * r);
                acc[0][j] += __uint_as_float(yw.x << 16); acc[1][j] += __uint_as_float(yw.x & 0xffff0000u); acc[2][j] += __uint_as_float(yw.y << 16); acc[3][j] += __uint_as_float(yw.y & 0xffff0000u); } }
        const int c = hd * 64 + 4 * r; const f32x4 lg4 = *(const f32x4*)(lg + c), lb4 = *(const f32x4*)(lbp + c);
        u32x2 wq[4][4]; float bsv[4];
#pragma unroll
        for (int j = 0; j < 4; ++j) { const int t = cn * 64 + mt * 16 + q * 4 + j; const size_t o = (size_t)t * WB + c; wq[j][2] = *(const u32x2*)(V + o); wq[j][3] = *(const u32x2*)(PROJ + (size_t)t * NPJ + C_RWZ + c); bsv[j] = BSP[(size_t)t * 16 + hd]; }
#pragma unroll
        for (int j = 0; j < 4; ++j) { const int t = cn * 64 + mt * 16 + q * 4 + j; float s = (acc[0][j] + acc[1][j]) + (acc[2][j] + acc[3][j]);
            s += shx<1>(s); s += shx<2>(s); s += shx<4>(s); s += shx<8>(s); const float mean = s * (1.0f / 64.0f); float vs = 0.f; const float bs = bsv[j];
            float vv[4], zz[4];
            { const u32x2 w3 = wq[j][2], w4 = wq[j][3];
              vv[0] = __uint_as_float(w3.x << 16); vv[1] = __uint_as_float(w3.x & 0xffff0000u); vv[2] = __uint_as_float(w3.y << 16); vv[3] = __uint_as_float(w3.y & 0xffff0000u);
              zz[0] = __uint_as_float(w4.x << 16); zz[1] = __uint_as_float(w4.x & 0xffff0000u); zz[2] = __uint_as_float(w4.y << 16); zz[3] = __uint_as_float(w4.y & 0xffff0000u); }
#pragma unroll
            for (int nt = 0; nt < 4; ++nt) { const float dl = acc[nt][j] - mean; vs += dl * dl; }
            vs += shx<1>(vs); vs += shx<2>(vs); vs += shx<4>(vs); vs += shx<8>(vs);
            const float rstd = __builtin_amdgcn_rsqf(vs * (1.0f / 64.0f) + 64e-5f); float o4[4];
#pragma unroll
            for (int nt = 0; nt < 4; ++nt) { const float yn = (acc[nt][j] - mean) * rstd * lg4[nt] + lb4[nt]; o4[nt] = (yn + bs * vv[nt]) * siluf_(zz[nt]); }
            *(u32x2*)(Y + (size_t)t * 4096 + 1024 + c) = (u32x2){pk2(o4[0], o4[1]), pk2(o4[2], o4[3])}; }
      }
    }
}
constexpr int NPH_PRO = 3, NPH_LAYER = 20, NPH = NPH_PRO + DEPTH * NPH_LAYER + 1;

__global__ void __launch_bounds__(NTHR, 2) fwd(Args ka) {
    extern __shared__ __attribute__((aligned(16))) unsigned char lds_[];
    Frame F; F.lds = (LAS unsigned char*)lds_; F.tid = threadIdx.x; F.lane = F.tid & 63; F.wave = __builtin_amdgcn_readfirstlane(F.tid >> 6);
    F.gw = blockIdx.x * NWAVES + F.wave; F.ngw = gridDim.x * NWAVES; F.gt = blockIdx.x * NTHR + F.tid; F.ngt = gridDim.x * NTHR;
    volatile LAS unsigned* MISC = (volatile LAS unsigned*)(F.lds + LDS_MISC);
    if (F.tid < 64) MISC[F.tid] = 0u;
    { LAS unsigned long long* aq = (LAS unsigned long long*)(F.lds + LDS_ARGS);
#pragma unroll
      for (int i = 0; i < 35; ++i) if (F.tid == i) aq[i] = (unsigned long long)ka.in[i]; }
    __syncthreads();
    AP a; a.q = (const LAS unsigned long long*)(F.lds + LDS_ARGS); a.ws = ka.ws; a.out = ka.out;
    const int ph_lo = ka.ph_lo, ph_hi = ka.ph_hi;
    unsigned* barw = (unsigned*)(a.ws + WS_CTL) + 4096;
    const int wave0 = F.wave;
    XcdBarrier bar; bar.bar = barw; bar.x = 0; bar.st = MISC + 8;
    if (ph_hi - ph_lo > 1) bar = xcd_barrier_post(barw, MISC + 8);
    bar.wave = wave0;
    int gp = 0;
#ifndef PH_DBL
#define PH_DBL 0ull
#endif
#ifndef PH_ONLY
#define PH_ONLY -1
#endif
#define PHASE(pid, ...) do { int lo_ = ph_lo, hi_ = ph_hi; asm volatile("" : "+s"(lo_), "+s"(hi_)); if ((PH_ONLY < 0 || PH_ONLY == (pid)) && lo_ <= gp && gp < hi_) { F.lane = lane_id(); asm volatile("" : "+v"(F.lane)); F.wave = wave0; F.tid = F.wave * 64 + F.lane; F.gw = blockIdx.x * NWAVES + F.wave; F.ngw = gridDim.x * NWAVES; F.ngt = gridDim.x * NTHR; asm volatile("" : "+s"(F.gw), "+s"(F.ngw), "+s"(F.ngt)); F.gt = blockIdx.x * NTHR + F.tid; __VA_ARGS__; if ((PH_DBL >> (pid)) & 1ull) { xcd_barrier(bar); __VA_ARGS__; } if (gp + 1 < hi_) xcd_barrier(bar); } ++gp; } while (0)
    const int G = gridDim.x, cb = blockIdx.x;
    LAS unsigned char* lds = F.lds;
    unsigned char* ws = a.ws;

    PHASE(0, ph_tables(a, F));
    PHASE(1, ph_convert(a, F));
    PHASE(2, { ph_s5mats(a, F); ph_x0(a, F); });

    for (int l = 0; l < DEPTH; ++l) {
        const bf16* WALLT = (const bf16*)(ws + WS_WALLT) + (size_t)l * NALL * D;
        const float* rss_l = (const float*)(ws + WS_RSS) + (size_t)(l & 1) * T;
        PHASE(4, { pg8::Gemm g{(const bf16*)(ws + WS_H), WALLT, D, D, D}; pg8::Order S; S.init(T / 256, NPJ / 256, 1, G, cb, (size_t)256 * D * 2, 0, (size_t)256 * D * 2, 0);
                EpiBf16 E{(bf16*)(ws + WS_PROJ), NPJ, C_WDF / 256, rss_l, (bf16*)(ws + WS_SCR + SD_UC)}; pg8::gemm_phase(lds, g, S, E, F.tid); });
        PHASE(11, { pg8::Gemm g{(const bf16*)(ws + WS_SCR + SD_UC), (const bf16*)(ws + WS_S5INC) + (size_t)l * 64 * 256 * 256, 512, 256, 256}; pg8::Order S;
                S.init(NCH_S5 / 256, 1, 64, G, cb, (size_t)256 * 512 * 2, (size_t)NCH_S5 * 512 * 2, 0, (size_t)256 * 256 * 2);
                EpiF32 E{(float*)(ws + WS_SCR + SD_INC), 256, (size_t)NCH_S5 * 256}; pg8::gemm_phase(lds, g, S, E, F.tid); });
        PHASE(12, ph_s5_scan(a, F, l));
        PHASE(13, { pg8::Gemm g{(const bf16*)(ws + WS_SCR + SD_UC), (const bf16*)(ws + WS_S5MAIN) + (size_t)l * 64 * 256 * 512, 512, 512, 512}; pg8::Order S;
                S.init(NCH_S5 / 256, 1, 64, G, cb, (size_t)256 * 512 * 2, (size_t)NCH_S5 * 512 * 2, 0, (size_t)256 * 512 * 2);
                EpiS5Main E{(bf16*)(ws + WS_SCR + SD_YG)}; pg8::gemm_phase(lds, g, S, E, F.tid); });
        PHASE(14, { pg8::Gemm g{(const bf16*)(ws + WS_SCR + SD_YG), (const bf16*)(ws + WS_GLUT) + (size_t)l * WB * WB, WB, WB, WB}; pg8::Order S; S.init(T / 256, WB / 256, 1, G, cb, (size_t)256 * WB * 2, 0, (size_t)256 * WB * 2, 0);
                EpiGlu E{(const bf16*)(ws + WS_SCR + SD_YG), (const bf16*)(ws + WS_PROJ), a.in(I_GLUB) + (size_t)l * WB, (bf16*)(ws + WS_Y)}; pg8::gemm_phase(lds, g, S, E, F.tid); });
        PHASE(5, ph_lru_conv(a, F, l));
        PHASE(6, { pg8::Gemm g{(const bf16*)(ws + WS_SCR + SA_XC), (const bf16*)(ws + WS_LRUW) + (size_t)l * 4096 * 256, WB, 256, 256}; pg8::Order S; S.init(T / 256, 16, 1, G, cb, (size_t)256 * WB * 2, 0, (size_t)256 * 256 * 2, 0); S.kwin = 256 * 2;
                EpiLru E{a.in(I_BR) + (size_t)l * 2 * WB, a.in(I_BI) + (size_t)l * 2 * WB, a.in(I_LAM) + (size_t)l * 2 * WB, (const bf16*)(ws + WS_SCR + SA_XC), (bf16*)(ws + WS_SCR + SA_LA), (bf16*)(ws + WS_SCR + SA_BB)};
                pg8::gemm_phase(lds, g, S, E, F.tid); });
        PHASE(7, ph_lru_scan1(a, F));
        PHASE(8, ph_lru_scan2(a, F));
        PHASE(9, ph_lru_scan3(a, F));
        PHASE(15, ph_ret_kv(a, F));
        PHASE(16, ph_ret_scan(a, F));
        PHASE(25, { pg8::Gemm g{(const bf16*)(ws + WS_PROJ) + C_WDF, (const bf16*)(ws + WS_W2ALL) + (size_t)l * 3072 * 256, NPJ, 256, 256}; pg8::Order S; S.init(T / 256, 3072 / 256, 1, G, cb, (size_t)256 * NPJ * 2, 0, (size_t)256 * 256 * 2, 0);
                EpiLora E{ws + WS_SCR, a.in(I_W0) + (size_t)l * 2 * WB, a.in(I_A0) + (size_t)l * WB}; pg8::gemm_phase(lds, g, S, E, F.tid); });
        PHASE(18, ph_rwkv_prep(a, F, l));
        PHASE(19, ph_rwkv_chunk(a, F, l));
        PHASE(20, { ph_rwkv_seq(a, F); ph_ret_out(a, F, l); });
        PHASE(24, ph_rwkv_out(a, F, l));
        PHASE(21, { { pg8::Gemm g{(const bf16*)(ws + WS_H), WALLT + (size_t)NPJ * D, D, D, D}; pg8::Order S; S.init(T / 256, 4 * D / 256, 1, G, cb, (size_t)256 * D * 2, 0, (size_t)256 * D * 2, 0);
                      EpiGate E{(bf16*)(ws + WS_SCR + SM_GS), rss_l}; pg8::gemm_phase(lds, g, S, E, F.tid); }
                    xcd_barrier(bar);
                    { pg8::Gemm g{(const bf16*)(ws + WS_Y), (const bf16*)(ws + WS_WBRT) + (size_t)l * D * 4096, 4096, 4096, WB}; pg8::Order S; S.init(T / 256, D / 256, 4, G, cb, (size_t)256 * 4096 * 2, (size_t)WB * 2, (size_t)256 * 4096 * 2, (size_t)WB * 2); S.zfast = 1;
                      EpiBranchAll E{(const bf16*)(ws + WS_SCR + SM_GS), (bf16*)(ws + WS_SCR + SM_MG)}; pg8::gemm_phase(lds, g, S, E, F.tid); } });
        PHASE(22, { pg8::Gemm g{(const bf16*)(ws + WS_SCR + SM_MG), (const bf16*)(ws + WS_WOUTT) + (size_t)l * D * D, D, D, D}; pg8::Order S; S.init(T / 256, D / 256, 1, G, cb, (size_t)256 * D * 2, 0, (size_t)256 * D * 2, 0);
#ifdef OUT_DRY
                { EpiNull E0; pg8::gemm_phase(lds, g, S, E0, F.tid); }
#endif
                EpiOut E{a.in(I_XP), a.in(I_XS), a.out, (bf16*)(ws + WS_H), (float*)(ws + WS_RSP), l == 0 ? 1 : 0}; pg8::gemm_phase(lds, g, S, E, F.tid); });
        PHASE(26, ph_rss(a, F, l));
#ifdef XTRA_BAR
        for (int xb = 0; xb < XTRA_BAR; ++xb) xcd_barrier(bar);
#endif
    }
    PHASE(23, ph_final(a, F));
#undef PHASE
}

extern "C" void kernel_launch(void* const* d_in, const int* in_sizes, int n_in, void* d_out, int out_size, void* d_ws, size_t ws_size, hipStream_t stream) {
    static int grid = 0;
    if (grid == 0) {
        if (n_in != 35 || out_size != T * D || ws_size < WS_END) { fprintf(stderr, "kernel_launch: unexpected shapes (n_in %d out %d ws %zu need %zu)\n", n_in, out_size, ws_size, (size_t)WS_END); grid = -1; return; }
        int dev = 0, cus = 0, per_cu = 0;
        if (hipGetDevice(&dev) != hipSuccess || hipDeviceGetAttribute(&cus, hipDeviceAttributeMultiprocessorCount, dev) != hipSuccess) { grid = -1; return; }
        if (hipFuncSetAttribute((const void*)fwd, hipFuncAttributeMaxDynamicSharedMemorySize, LDS_BYTES) != hipSuccess) { fprintf(stderr, "kernel_launch: hipFuncSetAttribute failed\n"); grid = -1; return; }
        if (hipOccupancyMaxActiveBlocksPerMultiprocessor(&per_cu, (const void*)fwd, NTHR, LDS_BYTES) != hipSuccess || per_cu < 1) fprintf(stderr, "kernel_launch: occupancy query says %d\n", per_cu);
        (void)hipGetLastError();
        grid = cus;
    }
    if (grid < 0) return;
    (void)hipMemsetAsync((char*)d_ws + WS_CTL, 0, CTL_BYTES, stream);
    Args a{};
    for (int i = 0; i < 35; ++i) a.in[i] = (const float*)d_in[i];
    a.out = (float*)d_out; a.ws = (unsigned char*)d_ws;
#if MK_ONE_LAUNCH
    a.ph_lo = 0; a.ph_hi = NPH;
    hipLaunchKernelGGL(fwd, dim3(grid), dim3(NTHR), LDS_BYTES, stream, a);
#else
    for (int p = 0; p < NPH; ++p) { a.ph_lo = p; a.ph_hi = p + 1; hipLaunchKernelGGL(fwd, dim3(grid), dim3(NTHR), LDS_BYTES, stream, a); }
#endif
}
```
